# Optimizing an MI355X kernel written in HIP

```python
import math
import jax
import jax.numpy as jnp
from jax import lax
import numpy as np


D_MODEL = 1024
BATCH = 4
SEQ = 4096
DEPTH = 2

GRID_W = 64
CTX_LEN = 256
N_EVEN = (DEPTH + 1) // 2
N_ODD = DEPTH // 2
RMS_EPS = 1e-6
N_MOD = 6

MIX_W = D_MODEL
GLA_W = MIX_W // 2
GLA_HEADS = 4
GLA_DV_HEAD = GLA_W // GLA_HEADS
GLA_DK_HEAD = GLA_DV_HEAD // 2
GLA_KEY_W = GLA_HEADS * GLA_DK_HEAD
GLA_GATE_RANK = 16
GLA_GATE_NORM = 16.0
GLA_CHUNK = 64
S5_W = MIX_W - GLA_W
S5_GROUP_CH = 16
S5_GROUPS = S5_W // S5_GROUP_CH
S5_STATE = 64
S5_DT_MIN = 0.001
S5_DT_MAX = 0.1
REC_IN_SPLITS = (GLA_KEY_W, GLA_KEY_W, GLA_W, GLA_W, GLA_GATE_RANK, GLA_GATE_RANK, S5_W)
REC_IN_W = 2 * GLA_KEY_W + 2 * GLA_W + 2 * GLA_GATE_RANK + S5_W
MLA_HEADS = 8
MLA_Q_RANK = 384
MLA_KV_RANK = 256
MLA_NOPE = 128
MLA_ROPE = 64
MLA_V = 128
ROPE_THETA = 10000.0
Q_BLOCK = 128
N_EXPERTS = 32
TOP_K = 4
D_EXPERT = D_MODEL
SWIGLU_LIMIT = 7.0
SWIGLU_ALPHA = 1.702
MOE_BLOCK = 128

kernel_name = 'hybrid_gla_s5_mla_moe_prefix_dit'


def rmsnorm(t, g):
    t32 = t.astype(jnp.float32)
    y = t32 * lax.rsqrt(jnp.mean(t32 * t32, axis=-1, keepdims=True) + RMS_EPS)
    return (y * g.astype(jnp.float32)).astype(t.dtype)


def modulate(t, g, shift, scale):
    return rmsnorm(t, g) * (1.0 + scale) + shift


def split_widths(t, widths):
    out = []
    start = 0
    for w in widths:
        out.append(t[..., start:start + w])
        start += w
    return out


def to_heads(t, n_heads):
    b, l, w = t.shape
    return t.reshape(b, l, n_heads, w // n_heads).transpose(0, 2, 1, 3)


def gla_chunked(q, k, v, log_g, s0):
    q, k, v, log_g = (t.astype(jnp.float32) for t in (q, k, v, log_g))
    b, h, l, dk = q.shape
    dv = v.shape[-1]
    n = l // GLA_CHUNK
    q, k, v, log_g = (t.reshape(b, h, n, GLA_CHUNK, t.shape[-1]) for t in (q, k, v, log_g))
    cum = jnp.cumsum(log_g, axis=3)
    cum_last = cum[:, :, :, -1:, :]
    q_dec = q * jnp.exp(cum)
    k_inv = k * jnp.exp(-cum)
    k_end = k * jnp.exp(cum_last - cum)
    mask = jnp.tril(jnp.ones((GLA_CHUNK, GLA_CHUNK), bool))
    att = jnp.where(mask, jnp.einsum('bhnid,bhnjd->bhnij', q_dec, k_inv), 0.0)
    o_intra = jnp.einsum('bhnij,bhnjv->bhniv', att, v)

    def step(s, inp):
        qd, ke, vc, dl = inp
        o = jnp.einsum('bhid,bhdv->bhiv', qd, s)
        s = dl[..., None] * s + jnp.einsum('bhjd,bhjv->bhdv', ke, vc)
        return s, o

    xs = (q_dec.transpose(2, 0, 1, 3, 4), k_end.transpose(2, 0, 1, 3, 4),
          v.transpose(2, 0, 1, 3, 4), jnp.exp(cum_last[:, :, :, 0, :]).transpose(2, 0, 1, 3))
    s_fin, o_inter = lax.scan(step, s0.astype(jnp.float32), xs)
    o = o_intra + o_inter.transpose(1, 2, 0, 3, 4)
    return o.reshape(b, h, l, dv), s_fin


def _linear_combine(e1, e2):
    a1, b1 = e1
    a2, b2 = e2
    return a1 * a2, a2 * b1 + b2


def s5_scan(u, lam_re, lam_im, log_dt, b_re, b_im, c_re, c_im, h0, reverse):
    f32 = jnp.float32
    lam = lax.complex(lam_re.astype(f32), lam_im.astype(f32))
    dt = jnp.exp(log_dt.astype(f32))[:, None]
    a_bar = jnp.exp(lam * dt)
    b_bar = ((a_bar - 1.0) / lam)[..., None] * lax.complex(b_re.astype(f32), b_im.astype(f32))
    bu = jnp.einsum('gph,blgh->blgp', b_bar, u.astype(f32))
    first = -1 if reverse else 0
    bu = bu.at[:, first].add(a_bar * h0)
    a = jnp.broadcast_to(a_bar, (1,) + bu.shape[1:])
    _, hs = lax.associative_scan(_linear_combine, (a, bu), reverse=reverse, axis=1)
    cmat = lax.complex(c_re.astype(f32), c_im.astype(f32))
    y = jnp.real(jnp.einsum('ghp,blgp->blgh', cmat, hs))
    h_fin = hs[:, 0] if reverse else hs[:, -1]
    return y, h_fin


def ab_mixer(hx, hz, w_in, w_out, gate_w, gate_b, gla_g, lam_re, lam_im, log_dt,
             b_re, b_im, c_re, c_im, s5_d, glu_w, glu_b, ctx_out):
    px = split_widths(hx @ w_in, REC_IN_SPLITS)
    pz = split_widths(hz @ w_in, REC_IN_SPLITS)

    def gla_inputs(p):
        q, k, v, _, rf, rb, _ = p
        gf = jax.nn.log_sigmoid((rf @ gate_w[0] + gate_b[0]).astype(jnp.float32)) / GLA_GATE_NORM
        gb = jax.nn.log_sigmoid((rb @ gate_w[1] + gate_b[1]).astype(jnp.float32)) / GLA_GATE_NORM
        return (to_heads(q * GLA_DK_HEAD ** -0.5, GLA_HEADS), to_heads(k, GLA_HEADS),
                to_heads(v, GLA_HEADS), to_heads(gf, GLA_HEADS), to_heads(gb, GLA_HEADS))

    def flip(t):
        return jnp.flip(t, axis=2)

    qz, kz, vz, gfz, gbz = gla_inputs(pz)
    qx, kx, vx, gfx, gbx = gla_inputs(px)
    b = hx.shape[0]
    s0 = jnp.zeros((b, GLA_HEADS, GLA_DK_HEAD, GLA_DV_HEAD), jnp.float32)
    oz_f, sz_f = gla_chunked(qz, kz, vz, gfz, s0)
    oz_b, sz_b = gla_chunked(flip(qz), flip(kz), flip(vz), flip(gbz), s0)
    ox_f, _ = gla_chunked(qx, kx, vx, gfx, sz_f)
    ox_b, _ = gla_chunked(flip(qx), flip(kx), flip(vx), flip(gbx), sz_b)

    def gla_out(o, g):
        bb, hh, ll, dv = o.shape
        o = rmsnorm(o, gla_g).transpose(0, 2, 1, 3).reshape(bb, ll, hh * dv)
        return o.astype(g.dtype) * jax.nn.silu(g)

    def s5_in(p):
        u = p[6]
        return u.reshape(u.shape[0], u.shape[1], S5_GROUPS, S5_GROUP_CH)

    uz, ux = s5_in(pz), s5_in(px)
    h_zero = jnp.zeros((b, S5_GROUPS, S5_STATE), jnp.complex64)
    fwd = (lam_re[0], lam_im[0], log_dt[0], b_re[0], b_im[0], c_re[0], c_im[0])
    bwd = (lam_re[1], lam_im[1], log_dt[1], b_re[1], b_im[1], c_re[1], c_im[1])
    yz_f, hz_f = s5_scan(uz, *fwd, h_zero, False)
    yz_b, hz_b = s5_scan(uz, *bwd, h_zero, True)
    yx_f, _ = s5_scan(ux, *fwd, hz_f, False)
    yx_b, _ = s5_scan(ux, *bwd, hz_b, True)

    def s5_out(yf, yb, u_flat):
        bb, ll = u_flat.shape[0], u_flat.shape[1]
        y = (yf + yb).reshape(bb, ll, S5_W).astype(u_flat.dtype) + s5_d * u_flat
        y = jax.nn.gelu(y)
        return y * jax.nn.sigmoid(y @ glu_w + glu_b)

    yx = jnp.concatenate([gla_out(ox_f + flip(ox_b), px[3]), s5_out(yx_f, yx_b, px[6])], axis=-1) @ w_out
    if ctx_out:
        yz = jnp.concatenate([gla_out(oz_f + flip(oz_b), pz[3]), s5_out(yz_f, yz_b, pz[6])], axis=-1) @ w_out
    else:
        yz = None
    return yx, yz


def axial_rope_tables(seq_len):
    rows = seq_len // GRID_W
    f32 = jnp.float32
    row = jnp.broadcast_to(jnp.arange(rows, dtype=f32)[:, None], (rows, GRID_W)).reshape(-1)
    col = jnp.broadcast_to(jnp.arange(GRID_W, dtype=f32)[None, :], (rows, GRID_W)).reshape(-1)
    n_freq = MLA_ROPE // 4
    inv = ROPE_THETA ** (-jnp.arange(n_freq, dtype=f32) / n_freq)
    ang_r = row[:, None] * inv
    ang_c = col[:, None] * inv
    return (jnp.cos(ang_r)[:, None, :], jnp.sin(ang_r)[:, None, :],
            jnp.cos(ang_c)[:, None, :], jnp.sin(ang_c)[:, None, :])


def axial_rope(t, tabs):
    cos_r, sin_r, cos_c, sin_c = tabs
    t32 = t.astype(jnp.float32)
    half = MLA_ROPE // 2
    quarter = half // 2

    def rot(u, cs, sn):
        u1, u2 = u[..., :quarter], u[..., quarter:]
        return jnp.concatenate([u1 * cs - u2 * sn, u2 * cs + u1 * sn], axis=-1)

    out = jnp.concatenate([rot(t32[..., :half], cos_r, sin_r), rot(t32[..., half:], cos_c, sin_c)], axis=-1)
    return out.astype(t.dtype)


def block_attention(q, k, v):
    b, lq, h, dq = q.shape
    nb = lq // Q_BLOCK
    qb = q.reshape(b, nb, Q_BLOCK, h, dq).transpose(1, 0, 2, 3, 4)
    scale = dq ** -0.5

    def one(qi):
        s = jnp.einsum('bqhd,bkhd->bhqk', qi, k).astype(jnp.float32) * scale
        p = jax.nn.softmax(s, axis=-1).astype(v.dtype)
        return jnp.einsum('bhqk,bkhv->bqhv', p, v)

    o = lax.map(one, qb)
    return o.transpose(1, 0, 2, 3, 4).reshape(b, lq, h, v.shape[-1])


def mla_mixer(hx, hz, w_down, q_norm, kv_norm, w_uq, w_ukv, w_o, rope, ctx_out):
    def project(h, tabs):
        b, l, _ = h.shape
        cq, ckv, kr = split_widths(h @ w_down, (MLA_Q_RANK, MLA_KV_RANK, MLA_ROPE))
        q = (rmsnorm(cq, q_norm) @ w_uq).reshape(b, l, MLA_HEADS, MLA_NOPE + MLA_ROPE)
        kv = (rmsnorm(ckv, kv_norm) @ w_ukv).reshape(b, l, MLA_HEADS, MLA_NOPE + MLA_V)
        q_nope, q_rope = q[..., :MLA_NOPE], q[..., MLA_NOPE:]
        k_nope, v = kv[..., :MLA_NOPE], kv[..., MLA_NOPE:]
        kr = kr[:, :, None, :]
        if tabs is not None:
            q_rope = axial_rope(q_rope, tabs)
            kr = axial_rope(kr, tabs)
        q = jnp.concatenate([q_nope, q_rope], axis=-1)
        k = jnp.concatenate([k_nope, jnp.broadcast_to(kr, (b, l, MLA_HEADS, MLA_ROPE))], axis=-1)
        return q, k, v

    qz, kz, vz = project(hz, None)
    qx, kx, vx = project(hx, rope)
    ox = block_attention(qx, jnp.concatenate([kz, kx], axis=1), jnp.concatenate([vz, vx], axis=1))
    yx = ox.reshape(hx.shape[0], hx.shape[1], MLA_HEADS * MLA_V) @ w_o
    if ctx_out:
        oz = block_attention(qz, kz, vz)
        yz = oz.reshape(hz.shape[0], hz.shape[1], MLA_HEADS * MLA_V) @ w_o
    else:
        yz = None
    return yx, yz


def moe(t, router_w, router_b, w_in, b_in, w_out, b_out):
    n_tok, d = t.shape
    logits = (t @ router_w + router_b).astype(jnp.float32)
    top_val, top_idx = lax.top_k(logits, TOP_K)
    gates = jax.nn.softmax(top_val, axis=-1)
    n_asg = n_tok * TOP_K
    flat_e = top_idx.reshape(-1)
    order = jnp.argsort(flat_e)
    sorted_e = flat_e[order]
    counts = jnp.bincount(flat_e, length=N_EXPERTS)
    padded = (counts + MOE_BLOCK - 1) // MOE_BLOCK * MOE_BLOCK
    pad_end = jnp.cumsum(padded)
    pad_start = pad_end - padded
    grp_start = jnp.cumsum(counts) - counts
    dest_sorted = pad_start[sorted_e] + jnp.arange(n_asg) - grp_start[sorted_e]
    n_blocks = -(-n_asg // MOE_BLOCK) + N_EXPERTS
    n_rows = n_blocks * MOE_BLOCK
    row_tok = jnp.full((n_rows,), n_tok, jnp.int32).at[dest_sorted].set((order // TOP_K).astype(jnp.int32))
    t_ext = jnp.concatenate([t, jnp.zeros((1, d), t.dtype)], axis=0)
    rows = t_ext[row_tok].reshape(n_blocks, MOE_BLOCK, d)
    blk_e = jnp.minimum(jnp.searchsorted(pad_end, jnp.arange(n_blocks) * MOE_BLOCK, side='right'), N_EXPERTS - 1)

    def expert_block(args):
        xb, e = args
        gu = xb @ w_in[e] + b_in[e]
        gate, up = gu[:, :D_EXPERT], gu[:, D_EXPERT:]
        gate = jnp.minimum(gate, SWIGLU_LIMIT)
        up = jnp.clip(up, -SWIGLU_LIMIT, SWIGLU_LIMIT)
        act = (up + 1.0) * gate * jax.nn.sigmoid(SWIGLU_ALPHA * gate)
        return act @ w_out[e] + b_out[e]

    y_rows = lax.map(expert_block, (rows, blk_e)).reshape(n_rows, d)
    dest = jnp.zeros((n_asg,), dest_sorted.dtype).at[order].set(dest_sorted)
    y_asg = y_rows[dest].reshape(n_tok, TOP_K, d)
    return jnp.einsum('tk,tkd->td', gates.astype(t.dtype), y_asg)


def setup_inputs(seed: int = 0) -> dict:
    key = jax.random.key(seed)
    ks = iter(jax.random.split(key, 64))
    f32 = jnp.float32
    D = D_MODEL

    def nrm(shape, scale):
        return scale * jax.random.normal(next(ks), shape, f32)

    def gain(shape):
        return 1.0 + nrm(shape, 0.02)

    inp = {}
    inp['x'] = nrm((BATCH, SEQ, D), 1.0)
    inp['c'] = nrm((BATCH, D), 1.0)
    inp['ctx'] = nrm((BATCH, CTX_LEN, D), 1.0)
    inp['c_ctx'] = nrm((D,), 1.0)
    inp['mod_w'] = nrm((DEPTH, D, N_MOD * D), 0.5 * D ** -0.5)
    inp['mod_b'] = nrm((DEPTH, N_MOD * D), 0.02)
    inp['norm_mix_pre'] = gain((DEPTH, D))
    inp['norm_mix_post'] = gain((DEPTH, D))
    inp['norm_ffn_pre'] = gain((DEPTH, D))
    inp['norm_ffn_post'] = gain((DEPTH, D))
    inp['router_w'] = nrm((DEPTH, D, N_EXPERTS), D ** -0.5)
    inp['router_b'] = nrm((DEPTH, N_EXPERTS), 0.01)
    inp['exp_w_in'] = nrm((DEPTH, N_EXPERTS, D, 2 * D_EXPERT), D ** -0.5)
    inp['exp_b_in'] = nrm((DEPTH, N_EXPERTS, 2 * D_EXPERT), 0.01)
    inp['exp_w_out'] = nrm((DEPTH, N_EXPERTS, D_EXPERT, D), D_EXPERT ** -0.5)
    inp['exp_b_out'] = nrm((DEPTH, N_EXPERTS, D), 0.01)
    inp['rec_w_in'] = nrm((N_EVEN, D, REC_IN_W), D ** -0.5)
    inp['rec_w_out'] = nrm((N_EVEN, MIX_W, D), MIX_W ** -0.5)
    inp['gla_gate_w'] = nrm((N_EVEN, 2, GLA_GATE_RANK, GLA_KEY_W), GLA_GATE_RANK ** -0.5)
    inp['gla_gate_b'] = nrm((N_EVEN, 2, GLA_KEY_W), 0.02)
    inp['gla_norm'] = gain((N_EVEN, GLA_DV_HEAD))
    s5_shape = (N_EVEN, 2, S5_GROUPS, S5_STATE)
    inp['s5_lam_re'] = -0.5 + nrm(s5_shape, 0.01)
    inp['s5_lam_im'] = math.pi * jnp.arange(S5_STATE, dtype=f32) + nrm(s5_shape, 0.01)
    inp['s5_log_dt'] = jax.random.uniform(next(ks), (N_EVEN, 2, S5_GROUPS), f32,
                                          minval=math.log(S5_DT_MIN), maxval=math.log(S5_DT_MAX))
    inp['s5_b_re'] = nrm((N_EVEN, 2, S5_GROUPS, S5_STATE, S5_GROUP_CH), (2 * S5_GROUP_CH) ** -0.5)
    inp['s5_b_im'] = nrm((N_EVEN, 2, S5_GROUPS, S5_STATE, S5_GROUP_CH), (2 * S5_GROUP_CH) ** -0.5)
    inp['s5_c_re'] = nrm((N_EVEN, 2, S5_GROUPS, S5_GROUP_CH, S5_STATE), S5_STATE ** -0.5)
    inp['s5_c_im'] = nrm((N_EVEN, 2, S5_GROUPS, S5_GROUP_CH, S5_STATE), S5_STATE ** -0.5)
    inp['s5_d'] = nrm((N_EVEN, S5_W), 1.0)
    inp['s5_glu_w'] = nrm((N_EVEN, S5_W, S5_W), S5_W ** -0.5)
    inp['s5_glu_b'] = nrm((N_EVEN, S5_W), 0.02)
    inp['mla_w_down'] = nrm((N_ODD, D, MLA_Q_RANK + MLA_KV_RANK + MLA_ROPE), D ** -0.5)
    inp['mla_q_norm'] = gain((N_ODD, MLA_Q_RANK))
    inp['mla_kv_norm'] = gain((N_ODD, MLA_KV_RANK))
    inp['mla_w_uq'] = nrm((N_ODD, MLA_Q_RANK, MLA_HEADS * (MLA_NOPE + MLA_ROPE)), MLA_Q_RANK ** -0.5)
    inp['mla_w_ukv'] = nrm((N_ODD, MLA_KV_RANK, MLA_HEADS * (MLA_NOPE + MLA_V)), MLA_KV_RANK ** -0.5)
    inp['mla_w_o'] = nrm((N_ODD, MLA_HEADS * MLA_V, D), (MLA_HEADS * MLA_V) ** -0.5)
    return inp


def reference(x, c, ctx, c_ctx, mod_w, mod_b, norm_mix_pre, norm_mix_post, norm_ffn_pre, norm_ffn_post,
              router_w, router_b, exp_w_in, exp_b_in, exp_w_out, exp_b_out, rec_w_in, rec_w_out,
              gla_gate_w, gla_gate_b, gla_norm, s5_lam_re, s5_lam_im, s5_log_dt, s5_b_re, s5_b_im,
              s5_c_re, s5_c_im, s5_d, s5_glu_w, s5_glu_b, mla_w_down, mla_q_norm, mla_kv_norm,
              mla_w_uq, mla_w_ukv, mla_w_o):
    seq_len = x.shape[1]
    d = x.shape[2]
    rope = axial_rope_tables(seq_len)
    z = ctx
    c_act = jax.nn.silu(c)
    cc_act = jax.nn.silu(c_ctx)
    for i in range(DEPTH):
        last = i == DEPTH - 1
        j = i // 2
        mods_x = jnp.split((c_act @ mod_w[i] + mod_b[i])[:, None, :], N_MOD, axis=-1)
        mods_z = jnp.split((cc_act @ mod_w[i] + mod_b[i])[None, None, :], N_MOD, axis=-1)
        hx = modulate(x, norm_mix_pre[i], mods_x[0], mods_x[1])
        hz = modulate(z, norm_mix_pre[i], mods_z[0], mods_z[1])
        if i % 2 == 0:
            yx, yz = ab_mixer(hx, hz, rec_w_in[j], rec_w_out[j], gla_gate_w[j], gla_gate_b[j], gla_norm[j],
                              s5_lam_re[j], s5_lam_im[j], s5_log_dt[j], s5_b_re[j], s5_b_im[j],
                              s5_c_re[j], s5_c_im[j], s5_d[j], s5_glu_w[j], s5_glu_b[j], not last)
        else:
            yx, yz = mla_mixer(hx, hz, mla_w_down[j], mla_q_norm[j], mla_kv_norm[j], mla_w_uq[j],
                               mla_w_ukv[j], mla_w_o[j], rope, not last)
        x = x + mods_x[2] * rmsnorm(yx, norm_mix_post[i])
        fx_in = modulate(x, norm_ffn_pre[i], mods_x[3], mods_x[4]).reshape(-1, d)
        if last:
            fx = moe(fx_in, router_w[i], router_b[i], exp_w_in[i], exp_b_in[i], exp_w_out[i], exp_b_out[i])
        else:
            z = z + mods_z[2] * rmsnorm(yz, norm_mix_post[i])
            fz_in = modulate(z, norm_ffn_pre[i], mods_z[3], mods_z[4]).reshape(-1, d)
            f = moe(jnp.concatenate([fx_in, fz_in], axis=0), router_w[i], router_b[i],
                    exp_w_in[i], exp_b_in[i], exp_w_out[i], exp_b_out[i])
            n_x = fx_in.shape[0]
            fx = f[:n_x]
            z = z + mods_z[5] * rmsnorm(f[n_x:].reshape(z.shape), norm_ffn_post[i])
        x = x + mods_x[5] * rmsnorm(fx.reshape(x.shape), norm_ffn_post[i])
    return x
```

```cpp
#include <hip/hip_runtime.h>
#include <stdint.h>
#include <stdio.h>

#ifndef DBG_STOP
#define DBG_STOP -1
#endif
#ifndef DBG_SRC
#define DBG_SRC 0
#endif
#ifndef DBG_COL
#define DBG_COL 0
#endif
#ifndef FP8_G1
#define FP8_G1 1
#endif
#ifndef FP8_G2
#define FP8_G2 1
#endif
#ifndef MK_MULTI
#define MK_MULTI 0
#endif

typedef unsigned short bf16_t;
typedef short bf16x8 __attribute__((ext_vector_type(8)));
typedef float f32x4 __attribute__((ext_vector_type(4)));

constexpr int D = 1024, NB = 4, SEQ = 4096, CTXL = 256;
constexpr int SB = SEQ + CTXL;
constexpr int NT = NB * SB;
constexpr int NCH = SB / 64;
constexpr int PW = 2176;
constexpr int COL_Q = 0, COL_K = 256, COL_V = 512, COL_G = 1024, COL_RF = 1536, COL_U = 1568;
constexpr int NE = 32, TOPK = 4;
constexpr int MAXPR = 78080;
constexpr int DNW = 768;
constexpr float EPS = 1e-6f;
constexpr int NPHASE = 22;

constexpr size_t al256(size_t x) { return (x + 255) & ~(size_t)255; }
constexpr size_t OFF_BAR = 0;
constexpr size_t OFF_CNT = 16384;
constexpr size_t ZERO_BYTES = 20480;
constexpr size_t OFF_MP = ZERO_BYTES;
constexpr size_t OFF_MF = OFF_MP + al256((size_t)8 * 2 * 5 * 6144 * 4);
constexpr size_t OFF_ROPE = OFF_MF + al256((size_t)2 * 5 * 6144 * 4);
constexpr size_t OFF_ABAR = OFF_ROPE + al256(2 * 1024 * 4);
constexpr size_t OFF_A64 = OFF_ABAR + al256(4096 * 8);
constexpr size_t OFF_BBAR = OFF_A64 + al256(4096 * 8);
constexpr size_t OFF_CMAT = OFF_BBAR + al256((size_t)4096 * 16 * 8);
constexpr size_t OFF_WRI = OFF_CMAT + al256((size_t)64 * 16 * 128 * 2);
constexpr size_t OFF_WRO = OFF_WRI + al256((size_t)2304 * 1024 * 2);
constexpr size_t OFF_WGLU = OFF_WRO + al256((size_t)1024 * 1024 * 2);
constexpr size_t OFF_WDN = OFF_WGLU + al256((size_t)512 * 512 * 2);
constexpr size_t OFF_WUQ = OFF_WDN + al256((size_t)DNW * 1024 * 2);
constexpr size_t OFF_WUKV = OFF_WUQ + al256((size_t)1536 * 384 * 2);
constexpr size_t OFF_WO = OFF_WUKV + al256((size_t)2048 * 256 * 2);
constexpr size_t OFF_EWI = OFF_WO + al256((size_t)1024 * 1024 * 2);
constexpr size_t OFF_EWO = OFF_EWI + al256((size_t)64 * 2048 * 1024 * 2);
constexpr size_t OFF_XS = OFF_EWO + al256((size_t)64 * 1024 * 1024 * 2);
constexpr size_t OFF_HB = OFF_XS + al256((size_t)NT * 1024 * 4);
constexpr size_t OFF_PB = OFF_HB + al256((size_t)NT * 1024 * 2);
constexpr size_t OFF_KV = OFF_PB + al256((size_t)NT * PW * 2);
constexpr size_t OFF_DL = OFF_KV + al256((size_t)32 * NCH * 64 * 128 * 4);
constexpr size_t OFF_HE = OFF_DL + al256((size_t)32 * NCH * 64 * 4);
constexpr size_t OFF_Y = OFF_HE + al256((size_t)4 * 2 * 32 * NCH * 64 * 8);
constexpr size_t OFF_MIX = OFF_Y + al256((size_t)NT * 512 * 2);
constexpr size_t OFF_YX = OFF_MIX + al256((size_t)NT * 1024 * 2);
constexpr size_t OFF_LIST = OFF_YX + al256((size_t)NT * 1024 * 4);
constexpr size_t OFF_SE = OFF_LIST + al256((size_t)NE * NT * 4);
constexpr size_t OFF_SP = OFF_SE + al256((size_t)NT * 4 * 4);
constexpr size_t OFF_GT = OFF_SP + al256((size_t)NT * 4 * 4);
constexpr size_t OFF_ACT = OFF_GT + al256((size_t)NT * 4 * 4);
constexpr size_t OFF_YR = OFF_ACT + al256((size_t)MAXPR * 1024 * 2);
constexpr size_t OFF_DN = OFF_YR + al256((size_t)MAXPR * 1024 * 2);
constexpr size_t OFF_CQ = OFF_DN + al256((size_t)NT * DNW * 4);
constexpr size_t OFF_CKV = OFF_CQ + al256((size_t)NT * 384 * 2);
constexpr size_t OFF_KR = OFF_CKV + al256((size_t)NT * 256 * 2);
constexpr size_t OFF_QF = OFF_KR + al256((size_t)NT * 64 * 2);
constexpr size_t OFF_KN = OFF_QF + al256((size_t)NT * 1536 * 2);
constexpr size_t OFF_VT = OFF_KN + al256((size_t)NT * 1024 * 2);
constexpr size_t OFF_OB = OFF_VT + al256((size_t)NT * 1024 * 2);
constexpr size_t OFF_HB8 = OFF_OB + al256((size_t)NT * 1024 * 2);
constexpr size_t OFF_CUM = OFF_HB8 + al256((size_t)NT * 1024);
constexpr size_t WS_TOTAL = OFF_CUM + al256((size_t)1088 * 8192 * 4);
static_assert(WS_TOTAL < (1ull << 31), "32-bit workspace offsets");

struct Params {
    const float *x, *c, *ctx, *c_ctx, *mod_w, *mod_b, *norm_mix_pre, *norm_mix_post, *norm_ffn_pre, *norm_ffn_post;
    const float *router_w, *router_b, *exp_w_in, *exp_b_in, *exp_w_out, *exp_b_out, *rec_w_in, *rec_w_out;
    const float *gla_gate_w, *gla_gate_b, *gla_norm, *s5_lam_re, *s5_lam_im, *s5_log_dt, *s5_b_re, *s5_b_im;
    const float *s5_c_re, *s5_c_im, *s5_d, *s5_glu_w, *s5_glu_b, *mla_w_down, *mla_q_norm, *mla_kv_norm;
    const float *mla_w_uq, *mla_w_ukv, *mla_w_o;
    float* out;
    char* ws;
    int phase_lo, phase_hi;
};

#define XB_TMO      128
#define XB_XCNT(j)  (256  + 64 * (j))
#define XB_XSUB(j)  (1280 + 64 * (j))
#define XB_XGEN(j)  (2304 + 64 * (j))
#define XB_TOP      3328
#define XB_TOPGEN   3392
#define XCD_BAR_WORDS 3456
#define XB_SPIN_CAP (1u << 22)
#define LAS __attribute__((address_space(3)))

__device__ __forceinline__ unsigned xb_ld(unsigned* p)              { return __hip_atomic_load(p, __ATOMIC_RELAXED, __HIP_MEMORY_SCOPE_AGENT); }
__device__ __forceinline__ unsigned xb_add(unsigned* p, unsigned v) { return __hip_atomic_fetch_add(p, v, __ATOMIC_RELAXED, __HIP_MEMORY_SCOPE_AGENT); }
__device__ __forceinline__ unsigned xb_xcc_id() { return (unsigned)__builtin_amdgcn_s_getreg((3 << 11) | 20) & 0xFu; }
#define XB_SPIN(cond, bar) do { unsigned _sp = 0; while (cond) { __builtin_amdgcn_s_sleep(1); \
    if ((++_sp & 255u) == 0u) { if (xb_ld(&(bar)[XB_TMO])) break; if (_sp > XB_SPIN_CAP) { atomicAdd(&(bar)[XB_TMO], 1u); break; } } } } while (0)

struct XcdBarrier { unsigned* bar; unsigned x; volatile LAS unsigned* st; };

__device__ __forceinline__ XcdBarrier xcd_barrier_post(unsigned* bar, volatile LAS unsigned* st) {
    XcdBarrier b; b.bar = bar; b.x = xb_xcc_id(); b.st = st;
    if (threadIdx.x == 0) (void)xb_add(&bar[XB_XCNT(b.x)], 1u);
    return b;
}
__device__ __forceinline__ void xcd_barrier_complete(unsigned* bar, unsigned x, unsigned& nloc, unsigned& nx) {
    const unsigned G = gridDim.x * gridDim.y * gridDim.z;
    unsigned sum, cnt, mine, sp = 0u;
    for (;;) {
        sum = 0u; cnt = 0u; mine = 0u;
#pragma unroll
        for (unsigned j = 0; j < 16; ++j) { const unsigned c = xb_ld(&bar[XB_XCNT(j)]); sum += c; cnt += (c > 0u) ? 1u : 0u; mine = (j == x) ? c : mine; }
        if (sum == G) break;
        __builtin_amdgcn_s_sleep(1);
        if ((++sp & 255u) == 0u) { if (xb_ld(&bar[XB_TMO])) break; if (sp > XB_SPIN_CAP) { atomicAdd(&bar[XB_TMO], 1u); break; } }
    }
    nloc = mine > 0u ? mine : 1u; nx = cnt > 0u ? cnt : 1u;
}
__device__ __forceinline__ void xcd_barrier(const XcdBarrier& b) {
    asm volatile("s_waitcnt vmcnt(0)" ::: "memory");
    __syncthreads();
    if (threadIdx.x == 0) {
        unsigned* bar = b.bar;
        __builtin_amdgcn_s_waitcnt(0);
        unsigned nloc = b.st[0], nx = b.st[1];
        if (nloc == 0u) { xcd_barrier_complete(bar, b.x, nloc, nx); b.st[0] = nloc; b.st[1] = nx; }
        const unsigned old = xb_add(&bar[XB_XSUB(b.x)], 1u);
        const unsigned gen = old / nloc;
        if (old + 1u == (gen + 1u) * nloc) {
            __builtin_amdgcn_fence(__ATOMIC_RELEASE, "agent");
            asm volatile("s_waitcnt vmcnt(0)" ::: "memory");
            const unsigned og = xb_add(&bar[XB_TOP], 1u);
            const unsigned tg = og / nx;
            if (og + 1u == (tg + 1u) * nx) xb_add(&bar[XB_TOPGEN], 1u);
            else XB_SPIN(xb_ld(&bar[XB_TOPGEN]) == tg, bar);
            __builtin_amdgcn_fence(__ATOMIC_ACQUIRE, "agent");
            xb_add(&bar[XB_XGEN(b.x)], 1u);
            asm volatile("s_waitcnt vmcnt(0)" ::: "memory");
        } else {
            XB_SPIN(xb_ld(&bar[XB_XGEN(b.x)]) == gen, bar);
            __builtin_amdgcn_fence(__ATOMIC_ACQUIRE, "agent");
            asm volatile("s_waitcnt vmcnt(0)" ::: "memory");
        }
    }
    __syncthreads();
}

__device__ __forceinline__ int vG() { extern __shared__ __attribute__((aligned(16))) char smem_hdr[]; return __builtin_amdgcn_readfirstlane(*(volatile int*)(smem_hdr + 8)); }
__device__ __forceinline__ void set_vG(int v) { extern __shared__ __attribute__((aligned(16))) char smem_hdr[]; __syncthreads(); if (threadIdx.x == 0) *(volatile int*)(smem_hdr + 8) = v; __syncthreads(); }

__device__ __forceinline__ int fresh_tid() { int t = threadIdx.x; asm volatile("" : "+v"(t)); return t; }
__device__ __forceinline__ float bf2f(bf16_t h) { return __uint_as_float(((unsigned)h) << 16); }
typedef float f32x2_t __attribute__((ext_vector_type(2)));
typedef __bf16 bf16x2_t __attribute__((ext_vector_type(2)));
__device__ __forceinline__ unsigned pack2(float lo, float hi) { const f32x2_t v = {lo, hi}; const bf16x2_t b = __builtin_convertvector(v, bf16x2_t); return __builtin_bit_cast(unsigned, b); }
__device__ __forceinline__ unsigned pack4_fp8(float a, float b, float c, float d) {
    int r = __builtin_amdgcn_cvt_pk_fp8_f32(a, b, 0, false); r = __builtin_amdgcn_cvt_pk_fp8_f32(c, d, r, true); return (unsigned)r;
}
__device__ __forceinline__ float lo_bf(unsigned u) { return __uint_as_float(u << 16); }
__device__ __forceinline__ float hi_bf(unsigned u) { return __uint_as_float(u & 0xffff0000u); }
__device__ __forceinline__ float wave_sum(float v) {
#pragma unroll
    for (int o = 32; o >= 1; o >>= 1) v += __shfl_xor(v, o);
    return v;
}
__device__ __forceinline__ float sigmoidf_(float x) { return __builtin_amdgcn_rcpf(1.0f + __builtin_amdgcn_exp2f(-1.4426950408889634f * x)); }
__device__ __forceinline__ int swz(int r, int c, int RS) { return r * RS + ((c ^ ((r >> 1) & 7)) << 4); }
__device__ __forceinline__ int swz256(int r, int c) { return r * 256 + ((c ^ (r & 15)) << 4); }
__device__ __forceinline__ f32x4 mfma16(bf16x8 a, bf16x8 b, f32x4 c) { return __builtin_amdgcn_mfma_f32_16x16x32_bf16(a, b, c, 0, 0, 0); }
__device__ __forceinline__ bf16x8 ldfrag(const char* tile, int RS, int row0, int k0, int lane) {
    return *(const bf16x8*)(tile + swz(row0 + (lane & 15), (k0 >> 3) + (lane >> 4), RS));
}

struct FragBase { int b0, b1; };
__device__ __forceinline__ FragBase fragbase(int lane, int RS) {
    const int r = lane & 15, t = (lane >> 4) ^ ((r >> 1) & 7);
    FragBase f; f.b0 = r * RS + (t << 4); f.b1 = r * RS + ((t ^ 4) << 4); return f;
}
__device__ __forceinline__ bf16x8 ldfrag2(const char* tile, const FragBase& fb, int RS, int row0, int ks) {
    return *(const bf16x8*)(tile + ((ks & 1) ? fb.b1 : fb.b0) + row0 * RS + (ks >> 1) * 128);
}

constexpr int G_ABYTES = 256 * 128, G_BBYTES = 128 * 128, G_STAGE = G_ABYTES + G_BBYTES;
template <bool TRANS, class Epi>
__device__ __forceinline__ void gemm_tile(const bf16_t* a0, const bf16_t* a1, const bf16_t* a2, const bf16_t* a3,
                                          const bf16_t* b0, const bf16_t* b1, int K, char* lds, const Epi& epi) {
    const int tid = threadIdx.x, lane = tid & 63, w = tid >> 6, wm = w >> 1, wn = w & 1;
    const int srow = tid >> 3, sch = tid & 7, soff = swz(srow, sch, 128);
    const FragBase fb = fragbase(lane, 128);
    f32x4 acc[4][4];
#pragma unroll
    for (int m = 0; m < 4; ++m)
#pragma unroll
        for (int n = 0; n < 4; ++n) acc[m][n] = (f32x4){0.f, 0.f, 0.f, 0.f};
    uint4 ra0 = *(const uint4*)a0, ra1 = *(const uint4*)a1, ra2 = *(const uint4*)a2, ra3 = *(const uint4*)a3;
    uint4 rb0 = *(const uint4*)b0, rb1 = *(const uint4*)b1;
    {
        char* As = lds; char* Bs = lds + G_ABYTES;
        *(uint4*)(As + soff) = ra0; *(uint4*)(As + soff + 8192) = ra1; *(uint4*)(As + soff + 16384) = ra2; *(uint4*)(As + soff + 24576) = ra3;
        *(uint4*)(Bs + soff) = rb0; *(uint4*)(Bs + soff + 8192) = rb1;
    }
    __syncthreads();
    const int nk = K >> 6;
    for (int kt = 0; kt < nk; ++kt) {
        const bool more = (kt + 1) < nk;
        if (more) {
            const int ko = (kt + 1) * 64;
            ra0 = *(const uint4*)(a0 + ko); ra1 = *(const uint4*)(a1 + ko); ra2 = *(const uint4*)(a2 + ko); ra3 = *(const uint4*)(a3 + ko);
            rb0 = *(const uint4*)(b0 + ko); rb1 = *(const uint4*)(b1 + ko);
        }
        const char* As = lds + (kt & 1) * G_STAGE; const char* Bs = As + G_ABYTES;
#pragma unroll
        for (int ks = 0; ks < 2; ++ks) {
            bf16x8 af[4], bfr[4];
#pragma unroll
            for (int m = 0; m < 4; ++m) af[m] = ldfrag2(As + wm * 8192, fb, 128, m * 16, ks);
#pragma unroll
            for (int n = 0; n < 4; ++n) bfr[n] = ldfrag2(Bs + wn * 8192, fb, 128, n * 16, ks);
#pragma unroll
            for (int m = 0; m < 4; ++m)
#pragma unroll
                for (int n = 0; n < 4; ++n) acc[m][n] = TRANS ? mfma16(bfr[n], af[m], acc[m][n]) : mfma16(af[m], bfr[n], acc[m][n]);
        }
        if (more) {
            char* As2 = lds + ((kt + 1) & 1) * G_STAGE; char* Bs2 = As2 + G_ABYTES;
            *(uint4*)(As2 + soff) = ra0; *(uint4*)(As2 + soff + 8192) = ra1; *(uint4*)(As2 + soff + 16384) = ra2; *(uint4*)(As2 + soff + 24576) = ra3;
            *(uint4*)(Bs2 + soff) = rb0; *(uint4*)(Bs2 + soff + 8192) = rb1;
        }
        __syncthreads();
    }
    epi(acc, wm, wn, lane);
}
template <bool TRANS, class Epi>
__device__ __forceinline__ void gemm_dense(const bf16_t* A, int lda, int row0, const bf16_t* Bt, int ldb, int col0, int K, char* lds, const Epi& epi) {
    const int tid = threadIdx.x, srow = tid >> 3, sch = (tid & 7) * 8;
    const bf16_t* a = A + (size_t)(row0 + srow) * lda + sch;
    const bf16_t* b = Bt + (size_t)(col0 + srow) * ldb + sch;
    gemm_tile<TRANS>(a, a + (size_t)64 * lda, a + (size_t)128 * lda, a + (size_t)192 * lda, b, b + (size_t)64 * ldb, K, lds, epi);
}

namespace g8 {
constexpr int BK = 64, HALF = 128, HTB = HALF * BK * 2, STAGE_BYTES = 8 * HTB;
__device__ __forceinline__ int lds_byte(int r, int c) { const int st = (r >> 4) * 2 + (c >> 5), rr = r & 15, cc = c & 31, ob = rr * 64 + cc * 2; return st * 1024 + (ob ^ (((ob >> 9) & 1) << 5)); }
__device__ __forceinline__ void stage_rc(int b, int& R, int& C) { const int st = b / 1024, sb = b % 1024, swz_ = sb ^ (((sb >> 9) & 1) << 5); R = (st >> 1) * 16 + swz_ / 64; C = (st & 1) * 32 + (swz_ % 64) / 2; }
struct Unit { const char* B; int row0, tn, e, slot; };

typedef int i32x8 __attribute__((ext_vector_type(8)));
typedef int i32x4_t __attribute__((ext_vector_type(4)));
__device__ __forceinline__ bf16x8 lo8(i32x8 v) { return __builtin_bit_cast(bf16x8, __builtin_shufflevector(v, v, 0, 1, 2, 3)); }
__device__ __forceinline__ bf16x8 hi8(i32x8 v) { return __builtin_bit_cast(bf16x8, __builtin_shufflevector(v, v, 4, 5, 6, 7)); }
template <bool FP8, class Epi, class Sched>
__device__ __forceinline__ void gemm8(LAS unsigned char* lds, const char* Abase, int rowB, const Sched& S, const Epi& E) {
    const int tid = threadIdx.x, wid = __builtin_amdgcn_readfirstlane(tid >> 6), lane = tid & 63, wr = wid >> 2, wc = wid & 3, fr = lane & 15, fq = lane >> 4;
    const int nt = rowB / 128;
    int R[2], C[2]; unsigned voffB[2];
#pragma unroll
    for (int i = 0; i < 2; ++i) { stage_rc(tid * 16 + i * 8192, R[i], C[i]); voffB[i] = (unsigned)(R[i] * rowB + C[i] * 2); }
    const size_t kstep = (size_t)(BK * 2);
    const size_t hstep = (size_t)HALF * rowB;
    const unsigned ldsw = (unsigned)wid * 1024u;
    const int aoff = lds_byte(wr * 64 + fr, fq * 8), boff = lds_byte(wc * 32 + fr, fq * 8);
#define G8_SA(b, h) (((b) * 2 + (h)) * HTB)
#define G8_SB(b, h) ((4 + (b) * 2 + (h)) * HTB)
#define G8_STAGE(bufoff, gbase, voff) do { _Pragma("unroll") for (int _i = 0; _i < 2; ++_i) \
        __builtin_amdgcn_global_load_lds((const unsigned*)((const char*)(gbase) + (voff)[_i]), (LAS unsigned*)(lds + (bufoff) + ldsw + _i * 8192), 16, 0, 0); } while (0)
#define G8_LD2(addr) __builtin_shufflevector(*(const LAS i32x4_t*)(addr), *(const LAS i32x4_t*)((addr) + 1024), 0, 1, 2, 3, 4, 5, 6, 7)
#define G8_LDA(dst, b, h) do { _Pragma("unroll") for (int m = 0; m < 4; ++m) dst[m] = G8_LD2(lds + G8_SA(b, h) + aoff + m * 2048); } while (0)
#define G8_LDB(dst, b, h) do { _Pragma("unroll") for (int n = 0; n < 2; ++n) dst[n] = G8_LD2(lds + G8_SB(b, h) + boff + n * 2048); } while (0)
#define G8_MMA(ai, bj, At, Bt) do { __builtin_amdgcn_s_setprio(1); _Pragma("unroll") for (int m = 0; m < 4; ++m) _Pragma("unroll") for (int n = 0; n < 2; ++n) { \
        if constexpr (FP8) asm volatile("s_nop 1\n\tv_mfma_scale_f32_16x16x128_f8f6f4 %0, %1, %2, %0, %3, %3 op_sel_hi:[0,0,0]" : "+v"(acc[ai][bj][m][n]) : "v"(Bt[n]), "v"(At[m]), "v"(scl)); \
        else { acc[ai][bj][m][n] = __builtin_amdgcn_mfma_f32_16x16x32_bf16(lo8(Bt[n]), lo8(At[m]), acc[ai][bj][m][n], 0, 0, 0); \
               acc[ai][bj][m][n] = __builtin_amdgcn_mfma_f32_16x16x32_bf16(hi8(Bt[n]), hi8(At[m]), acc[ai][bj][m][n], 0, 0, 0); } } \
        __builtin_amdgcn_s_setprio(0); } while (0)
#define G8_WAIT_V(n) asm volatile("s_waitcnt vmcnt(" #n ")" ::: "memory")
#define G8_WAIT_L(n) asm volatile("s_waitcnt lgkmcnt(" #n ")" ::: "memory")
#define G8_BAR __builtin_amdgcn_s_barrier()
#define G8_SCHED __builtin_amdgcn_sched_barrier(0)
    Unit cur, nxt; int ui = 0;
    if (!S.next(0, cur)) return;
    f32x4 acc[2][2][4][2];
#pragma unroll
    for (int a = 0; a < 2; ++a)
#pragma unroll
        for (int b = 0; b < 2; ++b)
#pragma unroll
            for (int m = 0; m < 4; ++m)
#pragma unroll
                for (int n = 0; n < 2; ++n) acc[a][b][m][n] = (f32x4){0.f, 0.f, 0.f, 0.f};
    i32x8 At[4], B0[2], B1[2];
    const int scl = 0x7F7F7F7F;
    unsigned co[2][2], no[2][2];
    S.aoff(cur, R, C, co);
    const char* cB = cur.B;
    G8_STAGE(G8_SB(0, 0), cB, voffB); G8_STAGE(G8_SA(0, 0), Abase, co[0]); G8_STAGE(G8_SB(0, 1), cB + hstep, voffB); G8_STAGE(G8_SA(0, 1), Abase, co[1]);
    if (wr == 1) G8_BAR;
    G8_WAIT_V(4); G8_BAR;
    G8_STAGE(G8_SB(1, 0), cB + kstep, voffB); G8_STAGE(G8_SA(1, 0), Abase + kstep, co[0]); G8_STAGE(G8_SB(1, 1), cB + hstep + kstep, voffB);
    G8_WAIT_V(6); G8_BAR;
    for (;;) {
        const bool has_next = S.next(ui + 1, nxt);
        unsigned adelta = 0u;
        if constexpr (Sched::AFFINE) { adelta = has_next ? (unsigned)((nxt.row0 - cur.row0) * rowB) : 0u; }
        else { if (has_next) { int tz = tid; asm volatile("" : "+v"(tz)); int R2[2], C2[2]; stage_rc(tz * 16, R2[0], C2[0]); stage_rc(tz * 16 + 8192, R2[1], C2[1]); S.aoff(nxt, R2, C2, no); } else { no[0][0] = co[0][0]; no[0][1] = co[0][1]; no[1][0] = co[1][0]; no[1][1] = co[1][1]; } }
        const char* nB = has_next ? nxt.B : cB;
#pragma nounroll
        for (int t = 0; t < nt; t += 2) {
            const bool last = (t == nt - 2);
            const char* a1 = Abase + (size_t)(t + 1) * kstep;
            const char* a2 = last ? Abase : Abase + (size_t)(t + 2) * kstep; const char* b2 = last ? nB : cB + (size_t)(t + 2) * kstep;
            const char* a3 = a2 + kstep; const char* b3 = b2 + kstep;
            unsigned o2[2][2];
            if constexpr (Sched::AFFINE) { const unsigned dd = last ? adelta : 0u; o2[0][0] = co[0][0] + dd; o2[0][1] = co[0][1] + dd; o2[1][0] = co[1][0] + dd; o2[1][1] = co[1][1] + dd; }
            else { o2[0][0] = last ? no[0][0] : co[0][0]; o2[0][1] = last ? no[0][1] : co[0][1]; o2[1][0] = last ? no[1][0] : co[1][0]; o2[1][1] = last ? no[1][1] : co[1][1]; }
            G8_LDB(B0, 0, 0); G8_SCHED; G8_LDA(At, 0, 0); G8_STAGE(G8_SA(1, 1), a1, co[1]);
            G8_WAIT_L(8); G8_BAR; G8_WAIT_L(0); G8_MMA(0, 0, At, B0); G8_BAR; G8_SCHED;
            G8_LDB(B1, 0, 1); G8_STAGE(G8_SB(0, 0), b2, voffB);
            G8_BAR; G8_WAIT_L(0); G8_MMA(0, 1, At, B1); G8_BAR;
            G8_LDA(At, 0, 1); G8_STAGE(G8_SA(0, 0), a2, o2[0]);
            G8_BAR; G8_WAIT_L(0); G8_MMA(1, 0, At, B0); G8_BAR; G8_SCHED;
            G8_STAGE(G8_SB(0, 1), b2 + hstep, voffB);
            G8_WAIT_V(6); G8_BAR; G8_MMA(1, 1, At, B1); G8_BAR;
            G8_LDB(B0, 1, 0); G8_SCHED; G8_LDA(At, 1, 0); G8_STAGE(G8_SA(0, 1), a2, o2[1]);
            G8_WAIT_L(8); G8_BAR; G8_WAIT_L(0); G8_MMA(0, 0, At, B0); G8_BAR; G8_SCHED;
            G8_LDB(B1, 1, 1); G8_STAGE(G8_SB(1, 0), b3, voffB);
            G8_BAR; G8_WAIT_L(0); G8_MMA(0, 1, At, B1); G8_BAR;
            G8_LDA(At, 1, 1); G8_STAGE(G8_SA(1, 0), a3, o2[0]);
            G8_BAR; G8_WAIT_L(0); G8_MMA(1, 0, At, B0); G8_BAR; G8_SCHED;
            G8_STAGE(G8_SB(1, 1), b3 + hstep, voffB);
            G8_WAIT_V(6); G8_BAR; G8_MMA(1, 1, At, B1); G8_BAR;
        }
        if constexpr (FP8) { __builtin_amdgcn_sched_barrier(0); asm volatile("s_nop 15\n\ts_nop 15" ::: "memory"); __builtin_amdgcn_sched_barrier(0); }
        { int fr2 = fr, fq2 = fq; asm volatile("" : "+v"(fr2), "+v"(fq2)); E(acc, cur, wr, wc, fr2, fq2); }
        if (!has_next) break;
#pragma unroll
        for (int a = 0; a < 2; ++a)
#pragma unroll
            for (int b = 0; b < 2; ++b)
#pragma unroll
                for (int m = 0; m < 4; ++m)
#pragma unroll
                    for (int n = 0; n < 2; ++n) acc[a][b][m][n] = (f32x4){0.f, 0.f, 0.f, 0.f};
        cur = nxt; cB = nB; ++ui;
        if constexpr (Sched::AFFINE) { co[0][0] += adelta; co[0][1] += adelta; co[1][0] += adelta; co[1][1] += adelta; }
        else { co[0][0] = no[0][0]; co[0][1] = no[0][1]; co[1][0] = no[1][0]; co[1][1] = no[1][1]; }
    }
    G8_WAIT_V(0);
    if (wr == 0) G8_BAR;
    G8_BAR;
#undef G8_SA
#undef G8_SB
#undef G8_STAGE
#undef G8_LD2
#undef G8_LDA
#undef G8_LDB
#undef G8_MMA
#undef G8_WAIT_V
#undef G8_WAIT_L
#undef G8_BAR
#undef G8_SCHED
}
__device__ __forceinline__ int xcd_major_block() { const int b = blockIdx.x, G = vG(); return ((G & 7) == 0) ? ((b & 7) * (G >> 3) + (b >> 3)) : b; }
}

__device__ __forceinline__ void phase_prologue0(const Params& p, char* lds) {
    const int tid = threadIdx.x, G = vG();
    {
        float* act = (float*)lds;
        float* part = (float*)(lds + 20480);
        float* MF = (float*)(p.ws + OFF_MF);
        for (int e = tid; e < 5 * 1024; e += 512) {
            const int v = e >> 10, kk = e & 1023;
            const float cv = (v < 4) ? p.c[v * D + kk] : p.c_ctx[kk];
            act[e] = cv / (1.0f + __expf(-cv));
        }
        __syncthreads();
        for (int it = blockIdx.x; it < 192; it += G) {
            const int i = it / 96, n0 = (it % 96) * 64, cg = tid & 15, kq = tid >> 4;
            const float* wp = p.mod_w + ((size_t)i * D + kq * 32) * 6144 + n0 + cg * 4;
            f32x4 a0 = {0.f, 0.f, 0.f, 0.f}, a1 = a0, a2 = a0, a3 = a0, a4 = a0;
#pragma unroll 8
            for (int kk = 0; kk < 32; ++kk) {
                const f32x4 wv = *(const f32x4*)(wp + (size_t)kk * 6144);
                const int k = kq * 32 + kk;
                a0 += act[k] * wv; a1 += act[1024 + k] * wv; a2 += act[2048 + k] * wv; a3 += act[3072 + k] * wv; a4 += act[4096 + k] * wv;
            }
            __syncthreads();
            *(f32x4*)(part + (kq * 5 + 0) * 64 + cg * 4) = a0; *(f32x4*)(part + (kq * 5 + 1) * 64 + cg * 4) = a1; *(f32x4*)(part + (kq * 5 + 2) * 64 + cg * 4) = a2;
            *(f32x4*)(part + (kq * 5 + 3) * 64 + cg * 4) = a3; *(f32x4*)(part + (kq * 5 + 4) * 64 + cg * 4) = a4;
            __syncthreads();
            if (tid < 320) {
                const int v = tid >> 6, c = tid & 63;
                float sum = p.mod_b[i * 6144 + n0 + c];
#pragma unroll 8
                for (int q = 0; q < 32; ++q) sum += part[(q * 5 + v) * 64 + c];
                MF[(size_t)(i * 5 + v) * 6144 + n0 + c] = sum;
            }
        }
    }
    {
        float* rope = (float*)(p.ws + OFF_ROPE);
        for (int e = blockIdx.x * 512 + tid; e < 1024; e += G * 512) {
            const int pos = e >> 4, i = e & 15;
            const float inv = powf(10000.0f, -(float)i / 16.0f);
            const float ang = (float)pos * inv;
            rope[e] = cosf(ang); rope[1024 + e] = sinf(ang);
        }
        float2* ABAR = (float2*)(p.ws + OFF_ABAR); float2* A64 = (float2*)(p.ws + OFF_A64);
        bf16_t* CM = (bf16_t*)(p.ws + OFF_CMAT);
        for (int e = blockIdx.x * 512 + tid; e < 4096; e += G * 512) {
            const int dg = e >> 6;
            const float lre = p.s5_lam_re[e], lim = p.s5_lam_im[e];
            const float dt = expf(p.s5_log_dt[dg]);
            const float mag = expf(lre * dt);
            float sn, cs; sincosf(lim * dt, &sn, &cs);
            const float ar = mag * cs, ai = mag * sn;
            ABAR[e] = make_float2(ar, ai);
            float pr = ar, pi = ai;
#pragma unroll
            for (int q = 0; q < 6; ++q) { const float nr = pr * pr - pi * pi, ni = 2.0f * pr * pi; pr = nr; pi = ni; }
            A64[e] = make_float2(pr, pi);
            const float nr = ar - 1.0f, ni = ai, den = lre * lre + lim * lim;
            const float cr = (nr * lre + ni * lim) / den, ci = (ni * lre - nr * lim) / den;
            const int pidx = e & 63;
            bf16_t* bt = (bf16_t*)(p.ws + OFF_BBAR) + ((size_t)dg * 128 + 2 * pidx) * 16;
#pragma unroll
            for (int h = 0; h < 16; ++h) {
                const float br = p.s5_b_re[(size_t)e * 16 + h], bi = p.s5_b_im[(size_t)e * 16 + h];
                const unsigned pk = pack2(cr * br - ci * bi, cr * bi + ci * br);
                bt[h] = (bf16_t)(pk & 0xffffu); bt[16 + h] = (bf16_t)(pk >> 16);
            }
        }
        for (int e = blockIdx.x * 512 + tid; e < 64 * 16 * 128; e += G * 512) {
            const int k = e & 127, dgh = e >> 7, pp = k >> 1;
            const float v = (k & 1) ? -p.s5_c_im[(size_t)dgh * 64 + pp] : p.s5_c_re[(size_t)dgh * 64 + pp];
            CM[e] = (bf16_t)(pack2(v, 0.f) & 0xffffu);
        }
    }
}

template <bool FP8>
__device__ __forceinline__ void conv_matrices(const float* src, int nmat, int K, int N, int Npad, bf16_t* dst, bool perm, int& base, char* lds) {
    const int tid = threadIdx.x, G = vG();
    const int tk = K >> 6, tn = Npad >> 8, per = tk * tn, total = nmat * per;
    float* T = (float*)lds;
    int start = (int)(((long)blockIdx.x - (long)(base % G) + G) % G);
    f32x4 rv[8];
    auto issue = [&](int ti) {
        const int mat = ti / per, r = ti % per, kt = r / tn, nt = r % tn;
        const float* S = src + (size_t)mat * K * N + (size_t)(kt * 64) * N + nt * 256 + (tid & 63) * 4;
        const bool ok = nt * 256 + (tid & 63) * 4 < N;
#pragma unroll
        for (int i = 0; i < 8; ++i) {
            rv[i] = (f32x4){0.f, 0.f, 0.f, 0.f};
            if (ok) rv[i] = __builtin_nontemporal_load((const f32x4*)(S + (size_t)((tid >> 6) + 8 * i) * N));
        }
    };
    if (start < total) issue(start);
    for (int ti = start; ti < total; ti += G) {
        const int mat = ti / per, r = ti % per, kt = r / tn, nt = r % tn;
        bf16_t* Dm = dst + (size_t)mat * Npad * K;
        const int k0 = kt * 64, n0 = nt * 256;
        __syncthreads();
#pragma unroll
        for (int i = 0; i < 8; ++i) *(f32x4*)(T + ((tid >> 6) + 8 * i) * 260 + (tid & 63) * 4) = rv[i];
        __syncthreads();
        if (ti + G < total) issue(ti + G);
        const int n = tid >> 1, kh = tid & 1;
        int drow = n0 + n;
        if (perm) { const int up = drow >> 10, jj = drow & 1023; drow = ((jj >> 4) << 5) + (up << 4) + (jj & 15); }
        if constexpr (FP8) {
            unsigned pk[8];
#pragma unroll
            for (int j = 0; j < 8; ++j) pk[j] = pack4_fp8(64.f * T[(kh * 32 + 4 * j) * 260 + n], 64.f * T[(kh * 32 + 4 * j + 1) * 260 + n], 64.f * T[(kh * 32 + 4 * j + 2) * 260 + n], 64.f * T[(kh * 32 + 4 * j + 3) * 260 + n]);
            uint4* dp = (uint4*)((char*)dst + (size_t)mat * Npad * K + (size_t)drow * K + k0 + kh * 32);
            dp[0] = make_uint4(pk[0], pk[1], pk[2], pk[3]); dp[1] = make_uint4(pk[4], pk[5], pk[6], pk[7]);
        } else {
            unsigned pk[16];
#pragma unroll
            for (int j = 0; j < 16; ++j) pk[j] = pack2(T[(kh * 32 + 2 * j) * 260 + n], T[(kh * 32 + 2 * j + 1) * 260 + n]);
            uint4* dp = (uint4*)(Dm + (size_t)drow * K + k0 + kh * 32);
            dp[0] = make_uint4(pk[0], pk[1], pk[2], pk[3]); dp[1] = make_uint4(pk[4], pk[5], pk[6], pk[7]);
            dp[2] = make_uint4(pk[8], pk[9], pk[10], pk[11]); dp[3] = make_uint4(pk[12], pk[13], pk[14], pk[15]);
        }
    }
    base += total;
}
__device__ __forceinline__ void phase_prologue1(const Params& p, char* lds) {
    const int tid = threadIdx.x, G = vG();
    int base = 0;
    conv_matrices<false>(p.rec_w_in, 1, 1024, 2080, 2304, (bf16_t*)(p.ws + OFF_WRI), false, base, lds);
    conv_matrices<false>(p.rec_w_out, 1, 1024, 1024, 1024, (bf16_t*)(p.ws + OFF_WRO), false, base, lds);
    conv_matrices<false>(p.s5_glu_w, 1, 512, 512, 512, (bf16_t*)(p.ws + OFF_WGLU), false, base, lds);
    conv_matrices<false>(p.mla_w_down, 1, 1024, 704, DNW, (bf16_t*)(p.ws + OFF_WDN), false, base, lds);
    conv_matrices<false>(p.mla_w_uq, 1, 384, 1536, 1536, (bf16_t*)(p.ws + OFF_WUQ), false, base, lds);
    conv_matrices<false>(p.mla_w_ukv, 1, 256, 2048, 2048, (bf16_t*)(p.ws + OFF_WUKV), false, base, lds);
    conv_matrices<false>(p.mla_w_o, 1, 1024, 1024, 1024, (bf16_t*)(p.ws + OFF_WO), false, base, lds);
}

constexpr int CV_TILES_IN = 32 * 16 * 8, CV_TILES_OUT = 32 * 16 * 4, CV_TILES_SET = CV_TILES_IN + CV_TILES_OUT;
constexpr size_t OFF_TICKET = OFF_CNT + 1024;
constexpr int N_COMPUTE = 208;
struct CvTile { const float* S; char* dst; int N, k0, drow, f8; };
__device__ __forceinline__ CvTile cv_decode(const Params& p, int tg) {
    const int tid = threadIdx.x, set = tg / CV_TILES_SET, t = tg % CV_TILES_SET;
    const bool is_in = t < CV_TILES_IN; const int tt = is_in ? t : t - CV_TILES_IN;
    const int N = is_in ? 2048 : 1024, tn = N >> 8, per = 16 * tn;
    const int mat = set * NE + tt / per, r = tt % per, kt = r / tn, nt = r % tn, k0 = kt * 64, n0 = nt * 256;
    CvTile c; c.N = N; c.k0 = k0;
    c.S = (is_in ? p.exp_w_in : p.exp_w_out) + (size_t)mat * 1024 * N + (size_t)k0 * N + n0 + (tid & 63) * 4;
    int drow = n0 + (tid >> 1);
    if (is_in) { const int up = drow >> 10, jj = drow & 1023; drow = ((jj >> 4) << 5) + (up << 4) + (jj & 15); }
    c.drow = drow; c.f8 = is_in ? (FP8_G1 != 0) : (FP8_G2 != 0);
    c.dst = p.ws + (is_in ? OFF_EWI : OFF_EWO) + (size_t)mat * N * 1024 * (c.f8 ? 1 : 2);
    return c;
}
__device__ __forceinline__ void cv_load(const CvTile& c, f32x4 (&rv)[8]) {
#pragma unroll
    for (int i = 0; i < 8; ++i) rv[i] = __builtin_nontemporal_load((const f32x4*)(c.S + (size_t)((threadIdx.x >> 6) + 8 * i) * c.N));
}
__device__ __forceinline__ void cv_to_lds(const f32x4 (&rv)[8], float* T) {
#pragma unroll
    for (int i = 0; i < 8; ++i) *(f32x4*)(T + ((threadIdx.x >> 6) + 8 * i) * 260 + (threadIdx.x & 63) * 4) = rv[i];
}
__device__ __forceinline__ void cv_store(const CvTile& c, const float* T) {
    const int n = threadIdx.x >> 1, kh = threadIdx.x & 1;
    if (c.f8) {
        unsigned pk[8];
#pragma unroll
        for (int j = 0; j < 8; ++j) pk[j] = pack4_fp8(64.f * T[(kh * 32 + 4 * j) * 260 + n], 64.f * T[(kh * 32 + 4 * j + 1) * 260 + n], 64.f * T[(kh * 32 + 4 * j + 2) * 260 + n], 64.f * T[(kh * 32 + 4 * j + 3) * 260 + n]);
        uint4* dp = (uint4*)(c.dst + (size_t)c.drow * 1024 + c.k0 + kh * 32);
        dp[0] = make_uint4(pk[0], pk[1], pk[2], pk[3]); dp[1] = make_uint4(pk[4], pk[5], pk[6], pk[7]);
    } else {
        unsigned pk[16];
#pragma unroll
        for (int j = 0; j < 16; ++j) pk[j] = pack2(T[(kh * 32 + 2 * j) * 260 + n], T[(kh * 32 + 2 * j + 1) * 260 + n]);
        uint4* dp = (uint4*)(c.dst + ((size_t)c.drow * 1024 + c.k0 + kh * 32) * 2);
        dp[0] = make_uint4(pk[0], pk[1], pk[2], pk[3]); dp[1] = make_uint4(pk[4], pk[5], pk[6], pk[7]);
        dp[2] = make_uint4(pk[8], pk[9], pk[10], pk[11]); dp[3] = make_uint4(pk[12], pk[13], pk[14], pk[15]);
    }
}
__device__ __forceinline__ void convert_static(const Params& p, int base, int c, int stride, int count, int hi, char* lds) {
    float* T = (float*)lds;
    __syncthreads();
    const int t0 = base + c;
    if (count <= 0 || t0 >= hi) return;
    int n = (hi - 1 - t0) / stride + 1; if (n > count) n = count;
    f32x4 r0[8], r1[8], r2[8];
    CvTile c0 = cv_decode(p, t0), c1 = c0, c2 = c0;
    cv_load(c0, r0);
    if (n > 1) { c1 = cv_decode(p, t0 + stride); cv_load(c1, r1); }
    if (n > 2) { c2 = cv_decode(p, t0 + 2 * stride); cv_load(c2, r2); }
    for (int i = 0; i < n; i += 3) {
        { CvTile cur = c0; cv_to_lds(r0, T); __syncthreads(); if (i + 3 < n) { c0 = cv_decode(p, t0 + (i + 3) * stride); cv_load(c0, r0); } cv_store(cur, T); __syncthreads(); }
        if (i + 1 >= n) break;
        { CvTile cur = c1; cv_to_lds(r1, T); __syncthreads(); if (i + 4 < n) { c1 = cv_decode(p, t0 + (i + 4) * stride); cv_load(c1, r1); } cv_store(cur, T); __syncthreads(); }
        if (i + 2 >= n) break;
        { CvTile cur = c2; cv_to_lds(r2, T); __syncthreads(); if (i + 5 < n) { c2 = cv_decode(p, t0 + (i + 5) * stride); cv_load(c2, r2); } cv_store(cur, T); __syncthreads(); }
    }
}
constexpr int CV3_NC = 204, CV3_Q = 21, CV7_NC = 136, CV7_Q = 2, CV8_NC = 136, CV8_Q = 14, CV13_NC = 204, CV13_Q = 6, CV15_NC = 192, CV15_Q = 14;
constexpr int CV46_Q = 0;
constexpr int CV_B3 = 0, CV_B7 = CV_B3 + (256 - CV3_NC) * CV3_Q, CV_B8 = CV_B7 + (256 - CV7_NC) * CV7_Q, CV_B4 = CV_B8 + (256 - CV8_NC) * CV8_Q, CV_B6 = CV_B4 + 128 * CV46_Q, CV_B9 = CV_B6 + 128 * CV46_Q;
constexpr int CV_B13 = CV_TILES_SET, CV_B15 = CV_B13 + (256 - CV13_NC) * CV13_Q, CV_B17 = CV_B15 + (256 - CV15_NC) * CV15_Q;
static_assert(CV_B9 <= CV_TILES_SET && CV_B17 <= 2 * CV_TILES_SET, "conversion quotas exceed the tile sets");

__device__ __forceinline__ void load_row(const float* rp, int lane, float4 (&v)[4]) {
#pragma unroll
    for (int j = 0; j < 4; ++j) v[j] = *(const float4*)(rp + 4 * lane + 256 * j);
}
__device__ __forceinline__ float row_rstd(const float4 (&v)[4]) {
    float ss = 0.f;
#pragma unroll
    for (int j = 0; j < 4; ++j) ss += v[j].x * v[j].x + v[j].y * v[j].y + v[j].z * v[j].z + v[j].w * v[j].w;
    ss = wave_sum(ss);
    return rsqrtf(ss * (1.0f / 1024.0f) + EPS);
}
__device__ __forceinline__ void modulate_store(const float4 (&v)[4], float rstd, const float* g, const float* shift, const float* scale,
                                               bf16_t* dst, int lane, float4 (&o)[4]) {
#pragma unroll
    for (int j = 0; j < 4; ++j) {
        const int col = 4 * lane + 256 * j;
        const float4 gg = *(const float4*)(g + col), sh = *(const float4*)(shift + col), sc = *(const float4*)(scale + col);
        o[j].x = v[j].x * rstd * gg.x * (1.0f + sc.x) + sh.x; o[j].y = v[j].y * rstd * gg.y * (1.0f + sc.y) + sh.y;
        o[j].z = v[j].z * rstd * gg.z * (1.0f + sc.z) + sh.z; o[j].w = v[j].w * rstd * gg.w * (1.0f + sc.w) + sh.w;
        *(uint2*)(dst + col) = make_uint2(pack2(o[j].x, o[j].y), pack2(o[j].z, o[j].w));
    }
}
__device__ __forceinline__ const float* input_row(const Params& p, int r) { const int b = r / SB, s = r % SB; return (s < CTXL) ? p.ctx + ((size_t)b * CTXL + s) * D : p.x + ((size_t)b * SEQ + (s - CTXL)) * D; }
__device__ __forceinline__ int row_modv(int r) { const int b = r / SB, s = r % SB; return (s < CTXL) ? 4 : b; }

__device__ __forceinline__ void phase_prenorm(const Params& p, int L) {
    const int lane = threadIdx.x & 63, gw = blockIdx.x * 8 + (threadIdx.x >> 6), GW = vG() * 8;
    const float* xs = (const float*)(p.ws + OFF_XS); bf16_t* HB = (bf16_t*)(p.ws + OFF_HB);
    const float* MF = (const float*)(p.ws + OFF_MF);
    for (int r = gw; r < NT; r += GW) {
        float4 v[4], o[4]; load_row(L == 0 ? input_row(p, r) : xs + (size_t)r * D, lane, v);
        const float rstd = row_rstd(v);
        const float* mv = MF + (size_t)(L * 5 + row_modv(r)) * 6144;
        modulate_store(v, rstd, p.norm_mix_pre + L * D, mv, mv + 1024, HB + (size_t)r * D, lane, o);
    }
}

struct EpiBf16 {
    bf16_t* O; int ld; int row0, col0;
    __device__ __forceinline__ void operator()(const f32x4 (&acc)[4][4], int wm, int wn, int lane) const {
#pragma unroll
        for (int m = 0; m < 4; ++m) {
            bf16_t* rp = O + (size_t)(row0 + wm * 64 + m * 16 + (lane & 15)) * ld + col0 + wn * 64 + 4 * (lane >> 4);
#pragma unroll
            for (int n = 0; n < 4; ++n) *(uint2*)(rp + n * 16) = make_uint2(pack2(acc[m][n][0], acc[m][n][1]), pack2(acc[m][n][2], acc[m][n][3]));
        }
    }
};
struct EpiF32 {
    float* O; int ld; int row0, col0;
    __device__ __forceinline__ void operator()(const f32x4 (&acc)[4][4], int wm, int wn, int lane) const {
#pragma unroll
        for (int m = 0; m < 4; ++m) {
            float* rp = O + (size_t)(row0 + wm * 64 + m * 16 + (lane & 15)) * ld + col0 + wn * 64 + 4 * (lane >> 4);
#pragma unroll
            for (int n = 0; n < 4; ++n) *(f32x4*)(rp + n * 16) = acc[m][n];
        }
    }
};
struct EpiGlu {
    bf16_t* MIX; const bf16_t* Y; const float* bias; int row0, col0;
    __device__ __forceinline__ void operator()(const f32x4 (&acc)[4][4], int wm, int wn, int lane) const {
#pragma unroll
        for (int m = 0; m < 4; ++m) {
            const int row = row0 + wm * 64 + m * 16 + (lane & 15);
#pragma unroll
            for (int n = 0; n < 4; ++n) {
                const int col = col0 + wn * 64 + n * 16 + 4 * (lane >> 4);
                const uint2 yv = *(const uint2*)(Y + (size_t)row * 512 + col);
                const f32x4 bb = *(const f32x4*)(bias + col);
                const float y0 = lo_bf(yv.x), y1 = hi_bf(yv.x), y2 = lo_bf(yv.y), y3 = hi_bf(yv.y);
                const float o0 = y0 * sigmoidf_(acc[m][n][0] + bb[0]), o1 = y1 * sigmoidf_(acc[m][n][1] + bb[1]);
                const float o2 = y2 * sigmoidf_(acc[m][n][2] + bb[2]), o3 = y3 * sigmoidf_(acc[m][n][3] + bb[3]);
                *(uint2*)(MIX + (size_t)row * D + 512 + col) = make_uint2(pack2(o0, o1), pack2(o2, o3));
            }
        }
    }
};
struct EpiMoe1 {
    bf16_t* ACT; const float* bin; int prow0, tn;
    __device__ __forceinline__ void operator()(const f32x4 (&acc)[4][4], int wm, int wn, int lane) const {
#pragma unroll
        for (int m = 0; m < 4; ++m) {
            const int row = prow0 + wm * 64 + m * 16 + (lane & 15);
#pragma unroll
            for (int h = 0; h < 2; ++h) {
                const int j0 = 64 * tn + 32 * wn + 16 * h + 4 * (lane >> 4);
                const f32x4 bg = *(const f32x4*)(bin + j0), bu = *(const f32x4*)(bin + 1024 + j0);
                float o[4];
#pragma unroll
                for (int q = 0; q < 4; ++q) {
                    float gt = acc[m][2 * h][q] + bg[q], up = acc[m][2 * h + 1][q] + bu[q];
                    gt = fminf(gt, 7.0f); up = fminf(fmaxf(up, -7.0f), 7.0f);
                    o[q] = (up + 1.0f) * gt * sigmoidf_(1.702f * gt);
                }
                *(uint2*)(ACT + (size_t)row * D + j0) = make_uint2(pack2(o[0], o[1]), pack2(o[2], o[3]));
            }
        }
    }
};
struct EpiBf16Bias {
    bf16_t* O; const float* bias; int row0, col0;
    __device__ __forceinline__ void operator()(const f32x4 (&acc)[4][4], int wm, int wn, int lane) const {
#pragma unroll
        for (int m = 0; m < 4; ++m) {
            bf16_t* rp = O + (size_t)(row0 + wm * 64 + m * 16 + (lane & 15)) * D;
#pragma unroll
            for (int n = 0; n < 4; ++n) {
                const int col = col0 + wn * 64 + n * 16 + 4 * (lane >> 4);
                const f32x4 bb = *(const f32x4*)(bias + col);
                *(uint2*)(rp + col) = make_uint2(pack2(acc[m][n][0] + bb[0], acc[m][n][1] + bb[1]), pack2(acc[m][n][2] + bb[2], acc[m][n][3] + bb[3]));
            }
        }
    }
};

__device__ __forceinline__ void phase_gemm_recin(const Params& p, char* lds) {
    const bf16_t* A = (const bf16_t*)(p.ws + OFF_HB); const bf16_t* Bt = (const bf16_t*)(p.ws + OFF_WRI); bf16_t* O = (bf16_t*)(p.ws + OFF_PB);
    const int nN = PW / 128, nunits = (NT / 256) * nN;
    for (int u = blockIdx.x; u < nunits; u += vG()) {
        const int mt = u / nN, tn = u % nN;
        EpiBf16 epi{O, PW, mt * 256, tn * 128};
        gemm_dense<true>(A, D, mt * 256, Bt, D, tn * 128, D, lds, epi);
    }
}
__device__ __forceinline__ void phase_gemm_glu(const Params& p, char* lds) {
    const bf16_t* A = (const bf16_t*)(p.ws + OFF_Y); const bf16_t* Bt = (const bf16_t*)(p.ws + OFF_WGLU);
    const int nunits = (NT / 256) * 4;
    for (int u = blockIdx.x; u < nunits; u += vG()) {
        const int mt = u >> 2, tn = u & 3;
        EpiGlu epi{(bf16_t*)(p.ws + OFF_MIX), A, p.s5_glu_b, mt * 256, tn * 128};
        gemm_dense<true>(A, 512, mt * 256, Bt, 512, tn * 128, 512, lds, epi);
    }
}
__device__ __forceinline__ void phase_gemm_out(const Params& p, size_t offA, size_t offW, bool xonly, char* lds) {
    const bf16_t* A = (const bf16_t*)(p.ws + offA); const bf16_t* Bt = (const bf16_t*)(p.ws + offW); float* O = (float*)(p.ws + OFF_YX);
    const int nmt = xonly ? 64 : 68, nunits = nmt * 8;
    for (int u = blockIdx.x; u < nunits; u += vG()) {
        const int mi = u >> 3, tn = u & 7;
        const int row0 = xonly ? ((mi >> 4) * SB + ((mi & 15) + 1) * 256) : mi * 256;
        EpiF32 epi{O, D, row0, tn * 128};
        gemm_dense<true>(A, D, row0, Bt, D, tn * 128, D, lds, epi);
    }
}

__device__ __forceinline__ void phase_postmix(const Params& p, int L, bool xonly, char* lds) {
    const int tid = fresh_tid(), lane = tid & 63, gw = blockIdx.x * 8 + (tid >> 6), GW = vG() * 8;
    float* rwT = (float*)lds;
    const float* rw = p.router_w + (size_t)L * D * NE;
    for (int e = tid; e < D * NE; e += 512) rwT[(e & 31) * 1024 + (e >> 5)] = rw[e];
    __syncthreads();
    float* __restrict__ xs = (float*)(p.ws + OFF_XS); bf16_t* __restrict__ HB = (bf16_t*)(p.ws + OFF_HB);
    const float* __restrict__ MF = (const float*)(p.ws + OFF_MF);
    int* CNT = (int*)(p.ws + OFF_CNT) + L * NE; int* __restrict__ LIST = (int*)(p.ws + OFF_LIST);
    int* SE = (int*)(p.ws + OFF_SE); int* SP = (int*)(p.ws + OFF_SP); float* GT = (float*)(p.ws + OFF_GT);
    const float* gpost = p.norm_mix_post + L * D; const float* gpre = p.norm_ffn_pre + L * D;
    const float rbias = p.router_b[L * NE + ((lane >> 1) & 31)];
    const int nrows = xonly ? NB * SEQ : NT;
#pragma unroll 1
    for (int ri = gw; ri < nrows; ri += GW) {
        const int r = xonly ? ((ri >> 12) * SB + CTXL + (ri & 4095)) : ri;
        const float* mv = MF + (size_t)(L * 5 + row_modv(r)) * 6144;
        float4 y[4], xv[4], f[4];
        {
            const bf16_t* yp = (const bf16_t*)(p.ws + OFF_YX) + (size_t)r * D;
#pragma unroll
            for (int j = 0; j < 4; ++j) { const uint2 t = *(const uint2*)(yp + 4 * lane + 256 * j); y[j] = make_float4(lo_bf(t.x), hi_bf(t.x), lo_bf(t.y), hi_bf(t.y)); }
        }
        load_row(L == 0 ? input_row(p, r) : xs + (size_t)r * D, lane, xv);
        const float rs1 = row_rstd(y);
#pragma unroll
        for (int j = 0; j < 4; ++j) {
            const int col = 4 * lane + 256 * j;
            const float4 gg = *(const float4*)(gpost + col), g2 = *(const float4*)(mv + 2048 + col);
            xv[j].x += g2.x * (y[j].x * rs1 * gg.x); xv[j].y += g2.y * (y[j].y * rs1 * gg.y);
            xv[j].z += g2.z * (y[j].z * rs1 * gg.z); xv[j].w += g2.w * (y[j].w * rs1 * gg.w);
            *(float4*)(xs + (size_t)r * D + col) = xv[j];
        }
        const float rs2 = row_rstd(xv);
        modulate_store(xv, rs2, gpre, mv + 3 * 1024, mv + 4 * 1024, HB + (size_t)r * D, lane, f);
        if (FP8_G1) {
#pragma unroll
            for (int j = 0; j < 4; ++j) *(unsigned*)(p.ws + OFF_HB8 + (size_t)r * D + 4 * lane + 256 * j) = pack4_fp8(f[j].x, f[j].y, f[j].z, f[j].w);
        }
        float pl[32];
#pragma unroll
        for (int e = 0; e < NE; ++e) {
            float s = 0.f;
#pragma unroll
            for (int j = 0; j < 4; ++j) {
                const float4 wv = *(const float4*)(rwT + e * 1024 + 4 * lane + 256 * j);
                s += f[j].x * wv.x + f[j].y * wv.y + f[j].z * wv.z + f[j].w * wv.w;
            }
            pl[e] = s;
            asm volatile("" ::: "memory");
        }
#pragma unroll
        for (int i = 0; i < 16; ++i) { const bool up = (lane & 32) != 0; const float snd = up ? pl[i] : pl[i + 16], kp = up ? pl[i + 16] : pl[i]; pl[i] = kp + __shfl_xor(snd, 32); }
#pragma unroll
        for (int i = 0; i < 8; ++i) { const bool up = (lane & 16) != 0; const float snd = up ? pl[i] : pl[i + 8], kp = up ? pl[i + 8] : pl[i]; pl[i] = kp + __shfl_xor(snd, 16); }
#pragma unroll
        for (int i = 0; i < 4; ++i) { const bool up = (lane & 8) != 0; const float snd = up ? pl[i] : pl[i + 4], kp = up ? pl[i + 4] : pl[i]; pl[i] = kp + __shfl_xor(snd, 8); }
#pragma unroll
        for (int i = 0; i < 2; ++i) { const bool up = (lane & 4) != 0; const float snd = up ? pl[i] : pl[i + 2], kp = up ? pl[i + 2] : pl[i]; pl[i] = kp + __shfl_xor(snd, 4); }
        { const bool up = (lane & 2) != 0; const float snd = up ? pl[0] : pl[1], kp = up ? pl[1] : pl[0]; pl[0] = kp + __shfl_xor(snd, 2); }
        const int myexp = (lane >> 1) & 31;
        float mylogit = pl[0] + __shfl_xor(pl[0], 1) + rbias;
        float tv[4]; int tix[4];
#pragma unroll
        for (int k = 0; k < 4; ++k) {
            float v = mylogit; int idx = myexp;
#pragma unroll
            for (int o = 32; o >= 2; o >>= 1) {
                const float ov = __shfl_xor(v, o); const int oi = __shfl_xor(idx, o);
                if (ov > v || (ov == v && oi < idx)) { v = ov; idx = oi; }
            }
            tv[k] = v; tix[k] = idx;
            if (myexp == idx) mylogit = -3.0e38f;
        }
        const float e1 = __expf(tv[1] - tv[0]), e2 = __expf(tv[2] - tv[0]), e3 = __expf(tv[3] - tv[0]);
        const float inv = 1.0f / (1.0f + e1 + e2 + e3);
        if (lane < 4) {
            const int ex = lane == 0 ? tix[0] : lane == 1 ? tix[1] : lane == 2 ? tix[2] : tix[3];
            const float gtv = (lane == 0 ? 1.0f : lane == 1 ? e1 : lane == 2 ? e2 : e3) * inv;
            const int pos = atomicAdd(&CNT[ex], 1);
            LIST[(size_t)ex * NT + pos] = r;
            SE[r * 4 + lane] = ex; SP[r * 4 + lane] = pos; GT[r * 4 + lane] = gtv;
        }
    }
}

__device__ __forceinline__ void moe_prefix(const Params& p, int L, int* tp) {
    if (threadIdx.x == 0) {
        unsigned* CNT = (unsigned*)(p.ws + OFF_CNT) + L * NE;
        int s = 0; tp[0] = 0;
        for (int e = 0; e < NE; ++e) { const int c = (int)xb_ld(&CNT[e]); tp[33 + e] = c; s += (c + 255) >> 8; tp[e + 1] = s; }
    }
    __syncthreads();
}
__device__ __forceinline__ void phase_moe1(const Params& p, int L, char* lds) {
    int* tp = (int*)(lds + 2 * G_STAGE);
    moe_prefix(p, L, tp);
    const int tid = threadIdx.x, srow = tid >> 3, sch = (tid & 7) * 8;
    const bf16_t* HB = (const bf16_t*)(p.ws + OFF_HB); const int* LIST = (const int*)(p.ws + OFF_LIST);
    const int nunits = tp[32] * 16;
    for (int u = blockIdx.x; u < nunits; u += vG()) {
        const int mtg = u >> 4, tn = u & 15;
        int e = 0; while (tp[e + 1] <= mtg) ++e;
        const int mt = mtg - tp[e], cnt = tp[33 + e];
        const int* le = LIST + (size_t)e * NT;
        const bf16_t* ap[4];
#pragma unroll
        for (int j = 0; j < 4; ++j) { const int pos = mt * 256 + srow + 64 * j; const int tok = le[pos < cnt ? pos : 0]; ap[j] = HB + (size_t)tok * D + sch; }
        const bf16_t* b = (const bf16_t*)(p.ws + OFF_EWI) + ((size_t)(L * NE + e) * 2048 + tn * 128 + srow) * D + sch;
        EpiMoe1 epi{(bf16_t*)(p.ws + OFF_ACT), p.exp_b_in + (size_t)(L * NE + e) * 2048, mtg * 256, tn};
        gemm_tile<true>(ap[0], ap[1], ap[2], ap[3], b, b + (size_t)64 * D, D, lds, epi);
    }
}
__device__ __forceinline__ void phase_moe2(const Params& p, int L, char* lds) {
    int* tp = (int*)(lds + 2 * G_STAGE);
    moe_prefix(p, L, tp);
    const int nunits = tp[32] * 8;
    for (int u = blockIdx.x; u < nunits; u += vG()) {
        const int mtg = u >> 3, tn = u & 7;
        int e = 0; while (tp[e + 1] <= mtg) ++e;
        EpiBf16Bias epi{(bf16_t*)(p.ws + OFF_YR), p.exp_b_out + (size_t)(L * NE + e) * D, mtg * 256, tn * 128};
        gemm_dense<true>((const bf16_t*)(p.ws + OFF_ACT), D, mtg * 256, (const bf16_t*)(p.ws + OFF_EWO) + (size_t)(L * NE + e) * D * D, D, tn * 128, D, lds, epi);
    }
}
constexpr int G8_TAB = g8::STAGE_BYTES, G8_TP = g8::STAGE_BYTES + 16384;
constexpr int G8_NSLOT = 16;
template <bool GATHER>
struct SchedMoe8 {
    static constexpr bool AFFINE = !GATHER;
    const int* tp; const unsigned* tab; const int* list; const char* Bbase; size_t bexp; int ntn_sh, rowB, x, j, bpx; int tx1, tx2, tx3, tx4;
    __device__ __forceinline__ void init(const int* tp_, const unsigned* tab_, const int* list_, const char* Bbase_, size_t bexp_, int ntn_sh_, int rowB_) {
        tp = tp_; tab = tab_; list = list_; Bbase = Bbase_; bexp = bexp_; ntn_sh = ntn_sh_; rowB = rowB_;
        const int cblk = g8::xcd_major_block(); bpx = vG() >> 3; x = cblk / bpx; j = cblk % bpx;
        tx1 = tp[x + 1] - tp[x]; tx2 = tx1 + tp[x + 9] - tp[x + 8]; tx3 = tx2 + tp[x + 17] - tp[x + 16]; tx4 = tx3 + tp[x + 25] - tp[x + 24];
    }
    __device__ __forceinline__ bool next(int i, g8::Unit& u) const {
        const int l = i * bpx + j, tl = l >> ntn_sh, tn = l & ((1 << ntn_sh) - 1);
        if (tl >= tx4) return false;
        const int k = (tl >= tx1) + (tl >= tx2) + (tl >= tx3), e = x + 8 * k;
        const int mt = tl - (k == 0 ? 0 : k == 1 ? tx1 : k == 2 ? tx2 : tx3);
        u.B = Bbase + (size_t)e * bexp + (size_t)tn * 256 * rowB; u.row0 = (tp[e] + mt) * 256; u.tn = tn; u.e = e; u.slot = i; return true;
    }
    __device__ __forceinline__ void aoff(const g8::Unit& u, const int (&R)[2], const int (&C)[2], unsigned (&o)[2][2]) const {
#pragma unroll
        for (int h = 0; h < 2; ++h)
#pragma unroll
            for (int i = 0; i < 2; ++i) {
                if (GATHER) {
                    unsigned ro;
                    if (u.slot < G8_NSLOT) ro = tab[u.slot * 256 + h * 128 + R[i]];
                    else { const int pos = u.row0 - tp[u.e] * 256 + h * 128 + R[i]; ro = (unsigned)list[(size_t)u.e * NT + (pos < tp[33 + u.e] ? pos : 0)] * (unsigned)rowB; }
                    o[h][i] = ro + (unsigned)C[i] * 2u;
                } else o[h][i] = (unsigned)((u.row0 + h * 128 + R[i]) * rowB + C[i] * 2);
            }
    }
};
struct SchedDense8 {
    static constexpr bool AFFINE = true;
    const char* Bbase; int nunits, ntn, rowB, G, cblk;
    __device__ __forceinline__ bool next(int i, g8::Unit& u) const {
        const int L = i * G + cblk; if (L >= nunits) return false;
        const int mt = L / ntn, tn = L % ntn;
        u.B = Bbase + (size_t)tn * 256 * rowB; u.row0 = mt * 256; u.tn = tn; u.e = 0; u.slot = i; return true;
    }
    __device__ __forceinline__ void aoff(const g8::Unit& u, const int (&R)[2], const int (&C)[2], unsigned (&o)[2][2]) const {
#pragma unroll
        for (int h = 0; h < 2; ++h)
#pragma unroll
            for (int i = 0; i < 2; ++i) o[h][i] = (unsigned)((u.row0 + h * 128 + R[i]) * rowB + C[i] * 2);
    }
};
template <bool OUT8>
struct EpiMoe1_8 {
    bf16_t* ACT; const float* bin_all; float sc;
    __device__ __forceinline__ void operator()(const f32x4 (&acc)[2][2][4][2], const g8::Unit& u, int wr, int wc, int fr, int fq) const {
        const float* bin = bin_all + (size_t)u.e * 2048;
#pragma unroll
        for (int bj = 0; bj < 2; ++bj) {
            const int j0 = 128 * u.tn + 64 * bj + 16 * wc + 4 * fq;
            const f32x4 bg = *(const f32x4*)(bin + j0), bu = *(const f32x4*)(bin + 1024 + j0);
#pragma unroll
            for (int ai = 0; ai < 2; ++ai)
#pragma unroll
                for (int m = 0; m < 4; ++m) {
                    const int row = u.row0 + 128 * ai + 64 * wr + 16 * m + fr;
                    float o[4];
#pragma unroll
                    for (int q = 0; q < 4; ++q) {
                        float gt = acc[ai][bj][m][0][q] * sc + bg[q], up = acc[ai][bj][m][1][q] * sc + bu[q];
                        gt = fminf(gt, 7.0f); up = fminf(fmaxf(up, -7.0f), 7.0f);
                        o[q] = (up + 1.0f) * gt * sigmoidf_(1.702f * gt);
                    }
                    if constexpr (OUT8) *(unsigned*)((char*)ACT + (size_t)row * D + j0) = pack4_fp8(o[0], o[1], o[2], o[3]);
                    else *(uint2*)(ACT + (size_t)row * D + j0) = make_uint2(pack2(o[0], o[1]), pack2(o[2], o[3]));
                }
        }
    }
};
struct EpiBias8 {
    bf16_t* O; const float* bias_all; float sc;
    __device__ __forceinline__ void operator()(const f32x4 (&acc)[2][2][4][2], const g8::Unit& u, int wr, int wc, int fr, int fq) const {
        const float* bias = bias_all + (size_t)u.e * D;
#pragma unroll
        for (int bj = 0; bj < 2; ++bj)
#pragma unroll
            for (int n = 0; n < 2; ++n) {
                const int col = 256 * u.tn + 128 * bj + 32 * wc + 16 * n + 4 * fq;
                const f32x4 bb = *(const f32x4*)(bias + col);
#pragma unroll
                for (int ai = 0; ai < 2; ++ai)
#pragma unroll
                    for (int m = 0; m < 4; ++m) {
                        const int row = u.row0 + 128 * ai + 64 * wr + 16 * m + fr;
                        const f32x4 v = acc[ai][bj][m][n] * sc + bb;
                        *(uint2*)(O + (size_t)row * D + col) = make_uint2(pack2(v[0], v[1]), pack2(v[2], v[3]));
                    }
            }
    }
};
struct EpiBf16_8 {
    bf16_t* O; int ld, ncols;
    __device__ __forceinline__ void operator()(const f32x4 (&acc)[2][2][4][2], const g8::Unit& u, int wr, int wc, int fr, int fq) const {
#pragma unroll
        for (int bj = 0; bj < 2; ++bj)
#pragma unroll
            for (int n = 0; n < 2; ++n) {
                const int col = 256 * u.tn + 128 * bj + 32 * wc + 16 * n + 4 * fq;
                if (col < ncols) {
#pragma unroll
                    for (int ai = 0; ai < 2; ++ai)
#pragma unroll
                        for (int m = 0; m < 4; ++m) {
                            const int row = u.row0 + 128 * ai + 64 * wr + 16 * m + fr;
                            *(uint2*)(O + (size_t)row * ld + col) = make_uint2(pack2(acc[ai][bj][m][n][0], acc[ai][bj][m][n][1]), pack2(acc[ai][bj][m][n][2], acc[ai][bj][m][n][3]));
                        }
                }
            }
    }
};
__device__ __forceinline__ void phase_gemm_recin8(const Params& p, char* lds) {
    SchedDense8 S{p.ws + OFF_WRI, 68 * 9, 9, 2 * D, vG(), g8::xcd_major_block()};
    EpiBf16_8 E{(bf16_t*)(p.ws + OFF_PB), PW, PW};
    g8::gemm8<false>((LAS unsigned char*)lds, p.ws + OFF_HB, 2 * D, S, E);
}
__device__ __forceinline__ void phase_moe1_8(const Params& p, int L, char* lds) {
    int* tp = (int*)(lds + G8_TP); unsigned* tab = (unsigned*)(lds + G8_TAB);
    moe_prefix(p, L, tp);
    const int tid = threadIdx.x;
    const int* LIST = (const int*)(p.ws + OFF_LIST);
    constexpr int EB = FP8_G1 ? 1 : 2;
    SchedMoe8<true> S; S.init(tp, tab, LIST, p.ws + OFF_EWI + (size_t)L * NE * 2048 * D * EB, (size_t)2048 * D * EB, 3, D * EB);
    for (int slot = 0; slot < G8_NSLOT; ++slot) {
        g8::Unit u; if (!S.next(slot, u)) break;
        const int cnt = tp[33 + u.e];
        if (tid < 256) { const int pos = u.row0 - tp[u.e] * 256 + tid; tab[slot * 256 + tid] = (unsigned)LIST[(size_t)u.e * NT + (pos < cnt ? pos : 0)] * (unsigned)(D * EB); }
    }
    __syncthreads();
    EpiMoe1_8<FP8_G2 != 0> E{(bf16_t*)(p.ws + OFF_ACT), p.exp_b_in + (size_t)L * NE * 2048, FP8_G1 ? (1.0f / 64.0f) : 1.0f};
    g8::gemm8<FP8_G1 != 0>((LAS unsigned char*)lds, p.ws + (FP8_G1 ? OFF_HB8 : OFF_HB), D * EB, S, E);
}
__device__ __forceinline__ void phase_moe2_8(const Params& p, int L, char* lds) {
    int* tp = (int*)(lds + G8_TP);
    moe_prefix(p, L, tp);
    constexpr int EB = FP8_G2 ? 1 : 2;
    SchedMoe8<false> S; S.init(tp, nullptr, nullptr, p.ws + OFF_EWO + (size_t)L * NE * D * D * EB, (size_t)D * D * EB, 2, D * EB);
    EpiBias8 E{(bf16_t*)(p.ws + OFF_YR), p.exp_b_out + (size_t)L * NE * D, FP8_G2 ? (1.0f / 64.0f) : 1.0f};
    g8::gemm8<FP8_G2 != 0>((LAS unsigned char*)lds, p.ws + OFF_ACT, D * EB, S, E);
}
struct EpiF32_8 {
    float* O; int ld;
    __device__ __forceinline__ void operator()(const f32x4 (&acc)[2][2][4][2], const g8::Unit& u, int wr, int wc, int fr, int fq) const {
#pragma unroll
        for (int ai = 0; ai < 2; ++ai)
#pragma unroll
            for (int m = 0; m < 4; ++m) {
                float* rp = O + (size_t)(u.row0 + 128 * ai + 64 * wr + 16 * m + fr) * ld + 256 * u.tn + 32 * wc + 4 * fq;
#pragma unroll
                for (int bj = 0; bj < 2; ++bj)
#pragma unroll
                    for (int n = 0; n < 2; ++n) *(f32x4*)(rp + 128 * bj + 16 * n) = acc[ai][bj][m][n];
            }
    }
};
struct SchedX8 {
    static constexpr bool AFFINE = true;
    const char* Bbase; int nunits, ntn, rowB, G, cblk;
    __device__ __forceinline__ bool next(int i, g8::Unit& u) const {
        const int L = i * G + cblk; if (L >= nunits) return false;
        const int mi = L / ntn, tn = L % ntn;
        u.B = Bbase + (size_t)tn * 256 * rowB; u.row0 = (mi >> 4) * SB + ((mi & 15) + 1) * 256; u.tn = tn; u.e = 0; u.slot = i; return true;
    }
    __device__ __forceinline__ void aoff(const g8::Unit& u, const int (&R)[2], const int (&C)[2], unsigned (&o)[2][2]) const {
#pragma unroll
        for (int h = 0; h < 2; ++h)
#pragma unroll
            for (int i = 0; i < 2; ++i) o[h][i] = (unsigned)((u.row0 + h * 128 + R[i]) * rowB + C[i] * 2);
    }
};
struct EpiQ8 {
    bf16_t* QF; const float* rope;
    __device__ __forceinline__ void operator()(const f32x4 (&acc)[2][2][4][2], const g8::Unit& u, int wr, int wc, int fr, int fq) const {
        const float qs = 0.07216878364870322f * 1.4426950408889634f;
        const int sx0 = (u.row0 % SB) - CTXL + 64 * wr + fr;
        const int c0 = 256 * u.tn + 32 * wc;
        const int ta = (c0 >> 4) % 12, tb = ((c0 + 128) >> 4) % 12;
#pragma unroll
        for (int ai = 0; ai < 2; ++ai)
#pragma unroll
            for (int m = 0; m < 4; ++m) {
                const int sx = sx0 + 128 * ai + 16 * m;
                bf16_t* rp = QF + (size_t)(u.row0 + 128 * ai + 64 * wr + 16 * m + fr) * 1536 + c0 + 4 * fq;
#pragma unroll
                for (int bj = 0; bj < 2; ++bj) {
                    const int t12 = bj ? tb : ta;
                    f32x4 o0 = acc[ai][bj][m][0], o1 = acc[ai][bj][m][1];
                    if (t12 >= 8) {
                        const float* rr = rope + ((t12 == 8) ? (sx >> 6) : (sx & 63)) * 16 + 4 * fq;
                        const f32x4 cs = *(const f32x4*)rr, sn = *(const f32x4*)(rr + 1024);
                        const f32x4 t0 = o0 * cs - o1 * sn, t1 = o1 * cs + o0 * sn; o0 = t0; o1 = t1;
                    }
                    *(uint2*)(rp + 128 * bj) = make_uint2(pack2(o0[0] * qs, o0[1] * qs), pack2(o0[2] * qs, o0[3] * qs));
                    *(uint2*)(rp + 128 * bj + 16) = make_uint2(pack2(o1[0] * qs, o1[1] * qs), pack2(o1[2] * qs, o1[3] * qs));
                }
            }
    }
};
struct EpiGlu8 {
    bf16_t* MIX; const bf16_t* Y; const float* bias;
    __device__ __forceinline__ void operator()(const f32x4 (&acc)[2][2][4][2], const g8::Unit& u, int wr, int wc, int fr, int fq) const {
#pragma unroll
        for (int bj = 0; bj < 2; ++bj)
#pragma unroll
            for (int n = 0; n < 2; ++n) {
                const int col = 256 * u.tn + 128 * bj + 32 * wc + 16 * n + 4 * fq;
                const f32x4 bb = *(const f32x4*)(bias + col);
#pragma unroll
                for (int ai = 0; ai < 2; ++ai)
#pragma unroll
                    for (int m = 0; m < 4; ++m) {
                        const int row = u.row0 + 128 * ai + 64 * wr + 16 * m + fr;
                        const uint2 yv = *(const uint2*)(Y + (size_t)row * 512 + col);
                        const f32x4 a = acc[ai][bj][m][n] + bb;
                        const float o0 = lo_bf(yv.x) * sigmoidf_(a[0]), o1 = hi_bf(yv.x) * sigmoidf_(a[1]), o2 = lo_bf(yv.y) * sigmoidf_(a[2]), o3 = hi_bf(yv.y) * sigmoidf_(a[3]);
                        *(uint2*)(MIX + (size_t)row * D + 512 + col) = make_uint2(pack2(o0, o1), pack2(o2, o3));
                    }
            }
    }
};
__device__ __forceinline__ void phase_gemm_glu8(const Params& p, char* lds) {
    SchedDense8 S{p.ws + OFF_WGLU, 68 * 2, 2, 1024, vG(), g8::xcd_major_block()};
    EpiGlu8 E{(bf16_t*)(p.ws + OFF_MIX), (const bf16_t*)(p.ws + OFF_Y), p.s5_glu_b};
    g8::gemm8<false>((LAS unsigned char*)lds, p.ws + OFF_Y, 1024, S, E);
}
__device__ __forceinline__ void phase_gemm_recout8(const Params& p, char* lds) {
    SchedDense8 S{p.ws + OFF_WRO, 68 * 4, 4, 2 * D, vG(), g8::xcd_major_block()};
    EpiBf16_8 E{(bf16_t*)(p.ws + OFF_YX), D, D};
    g8::gemm8<false>((LAS unsigned char*)lds, p.ws + OFF_MIX, 2 * D, S, E);
}
__device__ __forceinline__ void phase_gemm_down8(const Params& p, char* lds) {
    SchedDense8 S{p.ws + OFF_WDN, 68 * 3, 3, 2 * D, vG(), g8::xcd_major_block()};
    EpiBf16_8 E{(bf16_t*)(p.ws + OFF_DN), DNW, DNW};
    g8::gemm8<false>((LAS unsigned char*)lds, p.ws + OFF_HB, 2 * D, S, E);
}
__device__ __forceinline__ void phase_gemm_wo8(const Params& p, char* lds) {
    SchedX8 S{p.ws + OFF_WO, 64 * 4, 4, 2 * D, vG(), g8::xcd_major_block()};
    EpiBf16_8 E{(bf16_t*)(p.ws + OFF_YX), D, D};
    g8::gemm8<false>((LAS unsigned char*)lds, p.ws + OFF_OB, 2 * D, S, E);
}
__device__ __forceinline__ void phase_gemm_q8(const Params& p, char* lds) {
    SchedX8 S{p.ws + OFF_WUQ, 64 * 6, 6, 768, vG(), g8::xcd_major_block()};
    EpiQ8 E{(bf16_t*)(p.ws + OFF_QF), (const float*)(p.ws + OFF_ROPE)};
    g8::gemm8<false>((LAS unsigned char*)lds, p.ws + OFF_CQ, 768, S, E);
}
__device__ __forceinline__ void phase_combine(const Params& p, int L, bool last, char* lds) {
    int* tp = (int*)lds;
    moe_prefix(p, L, tp);
    const int tid = fresh_tid(), lane = tid & 63, gw = blockIdx.x * 8 + (tid >> 6), GW = vG() * 8;
    float* xs = (float*)(p.ws + OFF_XS); const bf16_t* YR = (const bf16_t*)(p.ws + OFF_YR); bf16_t* HB = (bf16_t*)(p.ws + OFF_HB);
    const float* MF = (const float*)(p.ws + OFF_MF);
    const int* SE = (const int*)(p.ws + OFF_SE); const int* SP = (const int*)(p.ws + OFF_SP); const float* GT = (const float*)(p.ws + OFF_GT);
    const float* gpost = p.norm_ffn_post + L * D;
    const int nrows = last ? NB * SEQ : NT;
    auto rowof = [&](int ri) { return last ? ((ri >> 12) * SB + CTXL + (ri & 4095)) : ri; };
    int ne[4], npos[4]; float ng[4];
    uint2 nyv[4][4]; f32x4 nxv[4]; float dg[4];
    auto fetch_idx = [&](int ri) {
        const int r = rowof(ri);
#pragma unroll
        for (int k = 0; k < 4; ++k) { ne[k] = SE[r * 4 + k]; npos[k] = SP[r * 4 + k]; ng[k] = GT[r * 4 + k]; }
    };
    auto fetch_data = [&](int ri) {
        const int r = rowof(ri);
#pragma unroll
        for (int k = 0; k < 4; ++k) {
            const bf16_t* yr = YR + (size_t)(tp[ne[k]] * 256 + npos[k]) * D;
#pragma unroll
            for (int j = 0; j < 4; ++j) nyv[k][j] = *(const uint2*)(yr + 4 * lane + 256 * j);
            dg[k] = ng[k];
        }
#pragma unroll
        for (int j = 0; j < 4; ++j) nxv[j] = *(const f32x4*)(xs + (size_t)r * D + 4 * lane + 256 * j);
    };
    if (gw < nrows) { fetch_idx(gw); fetch_data(gw); }
    if (gw + GW < nrows) fetch_idx(gw + GW);
    for (int ri = gw; ri < nrows; ri += GW) {
        const int r = rowof(ri);
        const float* mv = MF + (size_t)(L * 5 + row_modv(r)) * 6144;
        float4 f[4], xv[4];
#pragma unroll
        for (int j = 0; j < 4; ++j) {
            f[j] = make_float4(0.f, 0.f, 0.f, 0.f);
#pragma unroll
            for (int k = 0; k < 4; ++k) { f[j].x += dg[k] * lo_bf(nyv[k][j].x); f[j].y += dg[k] * hi_bf(nyv[k][j].x); f[j].z += dg[k] * lo_bf(nyv[k][j].y); f[j].w += dg[k] * hi_bf(nyv[k][j].y); }
            xv[j] = make_float4(nxv[j][0], nxv[j][1], nxv[j][2], nxv[j][3]);
        }
        if (ri + GW < nrows) fetch_data(ri + GW);
        if (ri + 2 * GW < nrows) fetch_idx(ri + 2 * GW);
        __builtin_amdgcn_sched_barrier(0);
        const float rs = row_rstd(f);
#pragma unroll
        for (int j = 0; j < 4; ++j) {
            const int col = 4 * lane + 256 * j;
            const float4 gg = *(const float4*)(gpost + col), g5 = *(const float4*)(mv + 5 * 1024 + col);
            xv[j].x += g5.x * (f[j].x * rs * gg.x); xv[j].y += g5.y * (f[j].y * rs * gg.y);
            xv[j].z += g5.z * (f[j].z * rs * gg.z); xv[j].w += g5.w * (f[j].w * rs * gg.w);
            if (last) *(float4*)(p.out + (size_t)ri * D + col) = xv[j];
            else *(float4*)(xs + (size_t)r * D + col) = xv[j];
        }
        if (!last) {
            const float rs2 = row_rstd(xv);
            const float* mv1 = MF + (size_t)((L + 1) * 5 + row_modv(r)) * 6144;
            float4 o[4];
            modulate_store(xv, rs2, p.norm_mix_pre + (L + 1) * D, mv1, mv1 + 1024, HB + (size_t)r * D, lane, o);
        }
    }
}

__device__ __forceinline__ void gla_cum(const Params& p, uint2 v, int h, char* lds) {
    const int tid = threadIdx.x;
    float* Gm = (float*)lds; float* RF = (float*)(lds + 32768);
    {
        const int row = tid >> 3, c4 = (tid & 7) * 4;
        *(float4*)(RF + row * 32 + c4) = make_float4(lo_bf(v.x), hi_bf(v.x), lo_bf(v.y), hi_bf(v.y));
    }
    __syncthreads();
    const int d = tid & 63, dir = (tid >> 6) & 1, tg = tid >> 7;
    {
        float wv[16];
#pragma unroll
        for (int r = 0; r < 16; ++r) wv[r] = p.gla_gate_w[(dir * 16 + r) * 256 + h * 64 + d];
        const float bias = p.gla_gate_b[dir * 256 + h * 64 + d];
        for (int tt = 0; tt < 16; ++tt) {
            const int tok = tg * 16 + tt;
            float x = bias;
#pragma unroll
            for (int r = 0; r < 16; ++r) x += RF[tok * 32 + dir * 16 + r] * wv[r];
            const float ls = fminf(x, 0.f) - 0.6931471805599453f * __builtin_amdgcn_logf(1.0f + __builtin_amdgcn_exp2f(-1.4426950408889634f * fabsf(x)));
            Gm[(dir * 64 + tok) * 64 + d] = ls * (1.0f / 16.0f);
        }
    }
    __syncthreads();
    {
        float* gp = Gm + (dir * 64 + (dir ? 63 - tg * 16 : tg * 16)) * 64 + d;
        const int st = dir ? -64 : 64;
        float v[16];
#pragma unroll
        for (int i = 0; i < 16; ++i) v[i] = gp[i * st];
#pragma unroll
        for (int i = 1; i < 16; ++i) v[i] += v[i - 1];
        RF[(dir * 4 + tg) * 64 + d] = v[15];
        __syncthreads();
        float off = 0.f;
        for (int q = 0; q < tg; ++q) off += RF[(dir * 4 + q) * 64 + d];
#pragma unroll
        for (int i = 0; i < 16; ++i) gp[i * st] = v[i] + off;
    }
    __syncthreads();
}
__device__ __forceinline__ void gla_load_v(const Params& p, int r0, int h, uint2 (&vr)[4]) {
    const int tid = threadIdx.x;
    const bf16_t* Pb = (const bf16_t*)(p.ws + OFF_PB) + (size_t)(r0 + (tid >> 5)) * PW + COL_V + h * 128 + (tid & 31) * 4;
#pragma unroll
    for (int i = 0; i < 4; ++i) vr[i] = *(const uint2*)(Pb + (size_t)(16 * i) * PW);
}
__device__ __forceinline__ void gla_stage_vt(const uint2 (&vr)[4], char* VT) {
    const int tid = threadIdx.x, dv0 = (tid & 31) * 4;
#pragma unroll
    for (int i = 0; i < 4; ++i) {
        const int j = (tid >> 5) + 16 * i, cj = j >> 3, bo = (j & 7) * 2;
        *(bf16_t*)(VT + swz(dv0 + 0, cj, 128) + bo) = (bf16_t)(vr[i].x & 0xffffu); *(bf16_t*)(VT + swz(dv0 + 1, cj, 128) + bo) = (bf16_t)(vr[i].x >> 16);
        *(bf16_t*)(VT + swz(dv0 + 2, cj, 128) + bo) = (bf16_t)(vr[i].y & 0xffffu); *(bf16_t*)(VT + swz(dv0 + 3, cj, 128) + bo) = (bf16_t)(vr[i].y >> 16);
    }
}
__device__ __forceinline__ int dir_chunk(int dir, int c) { return dir ? (c < 4 ? 3 - c : 71 - c) : c; }

__device__ __forceinline__ void gla_local_item(const Params& p, int item, int b, int c, int h, char* lds) {
    const int tid = threadIdx.x, lane = tid & 63, w = tid >> 6, r0 = b * SB + c * 64;
    const bf16_t* Pb = (const bf16_t*)(p.ws + OFF_PB);
    const uint2 rfv = *(const uint2*)(Pb + (size_t)(r0 + (tid >> 3)) * PW + COL_RF + (tid & 7) * 4);
    const uint4 kraw = *(const uint4*)(Pb + (size_t)(r0 + (tid >> 3)) * PW + COL_K + h * 64 + (tid & 7) * 8);
    uint2 vr[4]; gla_load_v(p, r0, h, vr);
    __syncthreads();
    gla_cum(p, rfv, h, lds);
    const float* Gm = (const float*)lds;
    char* KE = lds + 40960; char* VT = lds + 57344;
    {
        float4* cg = (float4*)(p.ws + OFF_CUM) + (size_t)item * 2048;
#pragma unroll
        for (int i = 0; i < 4; ++i) cg[tid + 512 * i] = *(const float4*)(Gm + (tid + 512 * i) * 4);
    }
    {
        const int j = tid >> 3, dgp = tid & 7, cj = j >> 3, bo = (j & 7) * 2;
        const unsigned ka[4] = {kraw.x, kraw.y, kraw.z, kraw.w};
#pragma unroll
        for (int dir = 0; dir < 2; ++dir) {
#pragma unroll
            for (int e = 0; e < 4; ++e) {
                const int d0 = dgp * 8 + 2 * e;
                const float cl0 = dir ? Gm[64 * 64 + d0] : Gm[63 * 64 + d0], cl1 = dir ? Gm[64 * 64 + d0 + 1] : Gm[63 * 64 + d0 + 1];
                const unsigned pk = pack2(lo_bf(ka[e]) * __expf(cl0 - Gm[(dir * 64 + j) * 64 + d0]), hi_bf(ka[e]) * __expf(cl1 - Gm[(dir * 64 + j) * 64 + d0 + 1]));
                *(bf16_t*)(KE + dir * 8192 + swz(d0, cj, 128) + bo) = (bf16_t)(pk & 0xffffu);
                *(bf16_t*)(KE + dir * 8192 + swz(d0 + 1, cj, 128) + bo) = (bf16_t)(pk >> 16);
            }
        }
    }
    gla_stage_vt(vr, VT);
    __syncthreads();
    {
        const int dir = w >> 2, nq = w & 3;
        f32x4 acc[4][2];
#pragma unroll
        for (int m = 0; m < 4; ++m) { acc[m][0] = (f32x4){0.f, 0.f, 0.f, 0.f}; acc[m][1] = (f32x4){0.f, 0.f, 0.f, 0.f}; }
#pragma unroll
        for (int ks = 0; ks < 2; ++ks) {
            bf16x8 bfr[2];
#pragma unroll
            for (int n = 0; n < 2; ++n) bfr[n] = ldfrag(VT, 128, nq * 32 + n * 16, ks * 32, lane);
#pragma unroll
            for (int m = 0; m < 4; ++m) {
                const bf16x8 af = ldfrag(KE + dir * 8192, 128, m * 16, ks * 32, lane);
#pragma unroll
                for (int n = 0; n < 2; ++n) acc[m][n] = mfma16(bfr[n], af, acc[m][n]);
            }
        }
        const int nd = dir_chunk(dir, c);
        float* KVb = (float*)(p.ws + OFF_KV) + ((size_t)(((b * 2 + dir) * 4 + h) * NCH + nd)) * 8192;
#pragma unroll
        for (int m = 0; m < 4; ++m)
#pragma unroll
            for (int n = 0; n < 2; ++n) *(f32x4*)(KVb + (m * 16 + (lane & 15)) * 128 + nq * 32 + n * 16 + 4 * (lane >> 4)) = acc[m][n];
    }
    if (tid < 128) {
        const int dir = tid >> 6, d = tid & 63, nd = dir_chunk(dir, c);
        const float cl = dir ? Gm[(64 + 0) * 64 + d] : Gm[63 * 64 + d];
        ((float*)(p.ws + OFF_DL))[((size_t)(((b * 2 + dir) * 4 + h) * NCH + nd)) * 64 + d] = __expf(cl);
    }
}

__device__ __forceinline__ void phase_gla_scan(const Params& p) {
    const int tid = threadIdx.x;
    for (int it = blockIdx.x; it < 512; it += vG()) {
        const int combo = it >> 4, el = (it & 15) * 512 + tid, d = el >> 7;
        float* base = (float*)(p.ws + OFF_KV) + (size_t)combo * NCH * 8192 + el;
        const float* dl = (const float*)(p.ws + OFF_DL) + (size_t)combo * NCH * 64 + d;
        float s = 0.f;
#pragma unroll 4
        for (int n = 0; n < NCH; ++n) {
            const float kv = base[(size_t)n * 8192], dec = dl[n * 64];
            base[(size_t)n * 8192] = s;
            s = dec * s + kv;
        }
    }
    for (int it = blockIdx.x; it < 32; it += vG()) {
        const int idx = it * 512 + tid, pp = idx & 63, g = (idx >> 6) & 31, dir = (idx >> 11) & 1, b = idx >> 12;
        float2* he = (float2*)(p.ws + OFF_HE) + ((size_t)((b * 2 + dir) * 32 + g) * NCH) * 64 + pp;
        const float2 a64 = ((const float2*)(p.ws + OFF_A64))[(dir * 32 + g) * 64 + pp];
        float hr = 0.f, hi = 0.f;
#pragma unroll 4
        for (int n = 0; n < NCH; ++n) {
            const float2 e = he[(size_t)n * 64];
            he[(size_t)n * 64] = make_float2(hr, hi);
            const float nr = a64.x * hr - a64.y * hi + e.x, ni = a64.x * hi + a64.y * hr + e.y;
            hr = nr; hi = ni;
        }
    }
}

__device__ __forceinline__ void gla_out_item(const Params& p, int item, int b, int c, int h, char* lds) {
    const int tid = threadIdx.x, lane = tid & 63, w = tid >> 6, r0 = b * SB + c * 64;
    float* Gw = (float*)lds; const float* Gm = (const float*)lds;
    char* QD = lds + 40960; char* KI = lds + 49152; char* AT = lds + 57344; char* VT = lds + 65536; char* ST = lds + 81920;
    const bf16_t* Pb = (const bf16_t*)(p.ws + OFF_PB);
    const f32x4* cg = (const f32x4*)(p.ws + OFF_CUM) + (size_t)item * 2048;
    const f32x4 cum0 = cg[tid], cum1 = cg[tid + 512], cum2 = cg[tid + 1024], cum3 = cg[tid + 1536];
    const uint4 qraw = *(const uint4*)(Pb + (size_t)(r0 + (tid >> 3)) * PW + COL_Q + h * 64 + (tid & 7) * 8);
    const uint4 kraw = *(const uint4*)(Pb + (size_t)(r0 + (tid >> 3)) * PW + COL_K + h * 64 + (tid & 7) * 8);
    uint2 vr[4]; gla_load_v(p, r0, h, vr);
    const uint4 g0 = *(const uint4*)(Pb + (size_t)(r0 + (tid >> 3)) * PW + COL_G + h * 128 + (tid & 7) * 16);
    const uint4 g1 = *(const uint4*)(Pb + (size_t)(r0 + (tid >> 3)) * PW + COL_G + h * 128 + (tid & 7) * 16 + 8);
    float sv[2][16];
#pragma unroll
    for (int dir = 0; dir < 2; ++dir) {
        const int dv = tid & 127, dq = tid >> 7, nd = dir_chunk(dir, c);
        const float* S = (const float*)(p.ws + OFF_KV) + ((size_t)(((b * 2 + dir) * 4 + h) * NCH + nd)) * 8192 + (dq * 16) * 128 + dv;
#pragma unroll
        for (int e = 0; e < 16; ++e) sv[dir][e] = S[e * 128];
    }
    __syncthreads();
    *(f32x4*)(Gw + tid * 4) = cum0; *(f32x4*)(Gw + (tid + 512) * 4) = cum1; *(f32x4*)(Gw + (tid + 1024) * 4) = cum2; *(f32x4*)(Gw + (tid + 1536) * 4) = cum3;
    gla_stage_vt(vr, VT);
    __syncthreads();
    f32x4 acco[4];
#pragma unroll
    for (int n = 0; n < 4; ++n) acco[n] = (f32x4){0.f, 0.f, 0.f, 0.f};
    const int mi = w & 3, nd0 = (w >> 2) * 4;
    for (int dir = 0; dir < 2; ++dir) {
        {
            const int i = tid >> 3, dg = tid & 7;
            const unsigned qa[4] = {qraw.x, qraw.y, qraw.z, qraw.w}, ka[4] = {kraw.x, kraw.y, kraw.z, kraw.w};
            unsigned qo[4], ko[4];
#pragma unroll
            for (int e = 0; e < 4; ++e) {
                const float c0 = Gm[(dir * 64 + i) * 64 + dg * 8 + 2 * e], c1 = Gm[(dir * 64 + i) * 64 + dg * 8 + 2 * e + 1];
                qo[e] = pack2(lo_bf(qa[e]) * 0.125f * __expf(c0), hi_bf(qa[e]) * 0.125f * __expf(c1));
                ko[e] = pack2(lo_bf(ka[e]) * __expf(-c0), hi_bf(ka[e]) * __expf(-c1));
            }
            *(uint4*)(QD + swz(i, dg, 128)) = make_uint4(qo[0], qo[1], qo[2], qo[3]);
            *(uint4*)(KI + swz(i, dg, 128)) = make_uint4(ko[0], ko[1], ko[2], ko[3]);
        }
        {
            const int dv = tid & 127, dq = tid >> 7;
            unsigned pk[8];
#pragma unroll
            for (int e = 0; e < 8; ++e) pk[e] = dir ? pack2(sv[1][2 * e], sv[1][2 * e + 1]) : pack2(sv[0][2 * e], sv[0][2 * e + 1]);
            *(uint4*)(ST + swz(dv, dq * 2, 128)) = make_uint4(pk[0], pk[1], pk[2], pk[3]);
            *(uint4*)(ST + swz(dv, dq * 2 + 1, 128)) = make_uint4(pk[4], pk[5], pk[6], pk[7]);
        }
        __syncthreads();
        {
            const int mi2 = w >> 1, nj0 = (w & 1) * 2;
#pragma unroll
            for (int t = 0; t < 2; ++t) {
                const int nj = nj0 + t;
                f32x4 a = (f32x4){0.f, 0.f, 0.f, 0.f};
#pragma unroll
                for (int ks = 0; ks < 2; ++ks) a = mfma16(ldfrag(KI, 128, nj * 16, ks * 32, lane), ldfrag(QD, 128, mi2 * 16, ks * 32, lane), a);
                const int i = mi2 * 16 + (lane & 15), j0 = nj * 16 + 4 * (lane >> 4);
                float v[4];
#pragma unroll
                for (int q = 0; q < 4; ++q) { const int j = j0 + q; const bool keep = dir ? (j >= i) : (j <= i); v[q] = keep ? a[q] : 0.f; }
                *(uint2*)(AT + swz(i, j0 >> 3, 128) + (j0 & 7) * 2) = make_uint2(pack2(v[0], v[1]), pack2(v[2], v[3]));
            }
        }
        __syncthreads();
#pragma unroll
        for (int ks = 0; ks < 2; ++ks) {
            const bf16x8 xq = ldfrag(QD, 128, mi * 16, ks * 32, lane), xa = ldfrag(AT, 128, mi * 16, ks * 32, lane);
#pragma unroll
            for (int n = 0; n < 4; ++n) {
                acco[n] = mfma16(ldfrag(ST, 128, (nd0 + n) * 16, ks * 32, lane), xq, acco[n]);
                acco[n] = mfma16(ldfrag(VT, 128, (nd0 + n) * 16, ks * 32, lane), xa, acco[n]);
            }
        }
        __syncthreads();
    }
    float* OUT = (float*)lds;
    {
        const int i = mi * 16 + (lane & 15);
#pragma unroll
        for (int n = 0; n < 4; ++n) *(f32x4*)(OUT + i * 132 + (nd0 + n) * 16 + 4 * (lane >> 4)) = acco[n];
    }
    __syncthreads();
    {
        const int i = tid >> 3, seg = tid & 7;
        float o[16]; float ss = 0.f;
#pragma unroll
        for (int e = 0; e < 4; ++e) { const float4 v = *(const float4*)(OUT + i * 132 + seg * 16 + 4 * e); o[4 * e] = v.x; o[4 * e + 1] = v.y; o[4 * e + 2] = v.z; o[4 * e + 3] = v.w; }
#pragma unroll
        for (int e = 0; e < 16; ++e) ss += o[e] * o[e];
        ss += __shfl_xor(ss, 1); ss += __shfl_xor(ss, 2); ss += __shfl_xor(ss, 4);
        const float rstd = rsqrtf(ss * (1.0f / 128.0f) + EPS);
        const unsigned ga[8] = {g0.x, g0.y, g0.z, g0.w, g1.x, g1.y, g1.z, g1.w};
        unsigned pk[8];
#pragma unroll
        for (int e = 0; e < 8; ++e) {
            const float ga0 = lo_bf(ga[e]), ga1 = hi_bf(ga[e]);
            const float n0 = p.gla_norm[seg * 16 + 2 * e], n1 = p.gla_norm[seg * 16 + 2 * e + 1];
            pk[e] = pack2(o[2 * e] * rstd * n0 * (ga0 * sigmoidf_(ga0)), o[2 * e + 1] * rstd * n1 * (ga1 * sigmoidf_(ga1)));
        }
        bf16_t* mp = (bf16_t*)(p.ws + OFF_MIX) + (size_t)(r0 + i) * D + h * 128 + seg * 16;
        *(uint4*)mp = make_uint4(pk[0], pk[1], pk[2], pk[3]); *(uint4*)(mp + 8) = make_uint4(pk[4], pk[5], pk[6], pk[7]);
    }
}

template <bool FULL>
__device__ __forceinline__ void s5_item(const Params& p, int b, int c, int go, char* lds) {
    const int tid = threadIdx.x, lane = tid & 63, w = tid >> 6, g = go * 8 + w, r0 = b * SB + c * 64;
    char* HS = lds + w * 8192;
    const bf16_t* Pb = (const bf16_t*)(p.ws + OFF_PB);
    const int fr = lane & 15, fq = lane >> 4;
    bf16x8 uf[4];
#pragma unroll
    for (int m = 0; m < 4; ++m) {
        uf[m] = (bf16x8){0, 0, 0, 0, 0, 0, 0, 0};
        if (fq < 2) uf[m] = *(const bf16x8*)(Pb + (size_t)(r0 + m * 16 + fr) * PW + COL_U + g * 16 + fq * 8);
    }
    f32x4 accy[4];
#pragma unroll
    for (int m = 0; m < 4; ++m) accy[m] = (f32x4){0.f, 0.f, 0.f, 0.f};
    __syncthreads();
    for (int dir = 0; dir < 2; ++dir) {
        const int dg = dir * 32 + g, idx = dg * 64 + lane;
        const float2 a = ((const float2*)(p.ws + OFF_ABAR))[idx];
        bf16x8 bfr[8];
#pragma unroll
        for (int j = 0; j < 8; ++j) {
            bfr[j] = (bf16x8){0, 0, 0, 0, 0, 0, 0, 0};
            if (fq < 2) bfr[j] = *(const bf16x8*)((const bf16_t*)(p.ws + OFF_BBAR) + ((size_t)dg * 128 + j * 16 + fr) * 16 + fq * 8);
        }
        const int nd = dir_chunk(dir, c);
        float2* HEp = (float2*)(p.ws + OFF_HE) + ((size_t)((b * 2 + dir) * 32 + g) * NCH) * 64 + lane;
        float hr = 0.f, hi = 0.f;
        bf16x8 cfrag[4];
        if (FULL) {
            const float2 h0 = HEp[(size_t)nd * 64]; hr = h0.x; hi = h0.y;
            const bf16_t* CM = (const bf16_t*)(p.ws + OFF_CMAT) + ((size_t)(dg * 16 + fr)) * 128 + fq * 8;
#pragma unroll
            for (int ks = 0; ks < 4; ++ks) cfrag[ks] = *(const bf16x8*)(CM + ks * 32);
        }
        for (int half = 0; half < 2; ++half) {
            const int mt0 = (dir ? 1 - half : half) * 2;
#pragma unroll
            for (int mt = 0; mt < 2; ++mt) {
                const bf16x8 ua = (mt0 == 0) ? uf[mt] : uf[2 + mt];
#pragma unroll
                for (int j = 0; j < 8; ++j) {
                    const f32x4 d = mfma16(bfr[j], ua, (f32x4){0.f, 0.f, 0.f, 0.f});
                    const int row = mt * 16 + fr;
                    *(uint2*)(HS + row * 256 + ((((2 * j) | (fq >> 1)) ^ (row & 15)) << 4) + (fq & 1) * 8) = make_uint2(pack2(d[0], d[1]), pack2(d[2], d[3]));
                }
            }
            __syncthreads();
            {
                const int ch = lane >> 2, sub = (lane & 3) * 4;
#pragma unroll 8
                for (int tt = 0; tt < 32; ++tt) {
                    const int tl = dir ? 31 - tt : tt;
                    unsigned* ptr = (unsigned*)(HS + tl * 256 + ((ch ^ (tl & 15)) << 4) + sub);
                    const unsigned bu = *ptr;
                    const float nhr = a.x * hr - a.y * hi + lo_bf(bu), nhi = a.x * hi + a.y * hr + hi_bf(bu);
                    hr = nhr; hi = nhi;
                    if (FULL) *ptr = pack2(hr, hi);
                }
            }
            if (FULL) {
                __syncthreads();
#pragma unroll
                for (int mt = 0; mt < 2; ++mt)
#pragma unroll
                    for (int ks = 0; ks < 4; ++ks) {
                        const int row = mt * 16 + fr;
                        const bf16x8 hf = *(const bf16x8*)(HS + row * 256 + (((ks * 4 + fq) ^ (row & 15)) << 4));
                        if (mt0 == 0) accy[mt] = mfma16(cfrag[ks], hf, accy[mt]); else accy[2 + mt] = mfma16(cfrag[ks], hf, accy[2 + mt]);
                    }
            }
            __syncthreads();
        }
        if (!FULL) HEp[(size_t)nd * 64] = make_float2(hr, hi);
    }
    if (FULL) {
        bf16_t* Yb = (bf16_t*)(p.ws + OFF_Y);
        const int h0 = 4 * fq;
        const f32x4 dd = *(const f32x4*)(p.s5_d + g * 16 + h0);
#pragma unroll
        for (int mt = 0; mt < 4; ++mt) {
            const int tok = mt * 16 + fr;
            const uint2 uv = *(const uint2*)(Pb + (size_t)(r0 + tok) * PW + COL_U + g * 16 + h0);
            const float ua[4] = {lo_bf(uv.x), hi_bf(uv.x), lo_bf(uv.y), hi_bf(uv.y)};
            float o[4];
#pragma unroll
            for (int q = 0; q < 4; ++q) {
                const float y = accy[mt][q] + dd[q] * ua[q];
                const float z2 = 2.0f * 0.7978845608028654f * (y + 0.044715f * y * y * y);
                o[q] = y * sigmoidf_(z2);
            }
            *(uint2*)(Yb + (size_t)(r0 + tok) * 512 + g * 16 + h0) = make_uint2(pack2(o[0], o[1]), pack2(o[2], o[3]));
        }
    }
}
__device__ __forceinline__ void phase_rec_local(const Params& p, char* lds) {
    for (int it = blockIdx.x; it < 2176; it += vG()) {
        if (it < 1088) { const int b = it / 272, r = it % 272; gla_local_item(p, it, b, r >> 2, r & 3, lds); }
        else { const int j = it - 1088, b = j / 272, r = j % 272; s5_item<false>(p, b, r >> 2, r & 3, lds); }
    }
}
__device__ __forceinline__ void phase_rec_out(const Params& p, char* lds) {
    for (int it = blockIdx.x; it < 2176; it += vG()) {
        if (it < 1088) { const int b = it / 272, r = it % 272; gla_out_item(p, it, b, r >> 2, r & 3, lds); }
        else { const int j = it - 1088, b = j / 272, r = j % 272; s5_item<true>(p, b, r >> 2, r & 3, lds); }
    }
}

__device__ __forceinline__ void phase_gemm_down(const Params& p, char* lds) {
    const bf16_t* A = (const bf16_t*)(p.ws + OFF_HB); const bf16_t* Bt = (const bf16_t*)(p.ws + OFF_WDN); float* O = (float*)(p.ws + OFF_DN);
    const int nunits = (NT / 256) * 6;
    for (int u = blockIdx.x; u < nunits; u += vG()) {
        const int mt = u / 6, tn = u % 6;
        EpiF32 epi{O, DNW, mt * 256, tn * 128};
        gemm_dense<true>(A, D, mt * 256, Bt, D, tn * 128, D, lds, epi);
    }
}
__device__ __forceinline__ void phase_mla_norm(const Params& p) {
    const int lane = threadIdx.x & 63, gw = blockIdx.x * 8 + (threadIdx.x >> 6), GW = vG() * 8;
    const float* rope = (const float*)(p.ws + OFF_ROPE);
    bf16_t* CQ = (bf16_t*)(p.ws + OFF_CQ); bf16_t* CKV = (bf16_t*)(p.ws + OFF_CKV); bf16_t* KR = (bf16_t*)(p.ws + OFF_KR);
    for (int r = gw; r < NT; r += GW) {
        const bf16_t* rp = (const bf16_t*)(p.ws + OFF_DN) + (size_t)r * DNW;
        float2 q[3]; float ss = 0.f;
#pragma unroll
        for (int j = 0; j < 3; ++j) { const unsigned t = *(const unsigned*)(rp + 2 * lane + 128 * j); q[j] = make_float2(lo_bf(t), hi_bf(t)); ss += q[j].x * q[j].x + q[j].y * q[j].y; }
        ss = wave_sum(ss);
        const float rq = rsqrtf(ss * (1.0f / 384.0f) + EPS);
#pragma unroll
        for (int j = 0; j < 3; ++j) {
            const int col = 2 * lane + 128 * j;
            *(unsigned*)(CQ + (size_t)r * 384 + col) = pack2(q[j].x * rq * p.mla_q_norm[col], q[j].y * rq * p.mla_q_norm[col + 1]);
        }
        const uint2 kt = *(const uint2*)(rp + 384 + 4 * lane);
        const float4 kv = make_float4(lo_bf(kt.x), hi_bf(kt.x), lo_bf(kt.y), hi_bf(kt.y));
        float s2 = wave_sum(kv.x * kv.x + kv.y * kv.y + kv.z * kv.z + kv.w * kv.w);
        const float rk = rsqrtf(s2 * (1.0f / 256.0f) + EPS);
        const float4 gk = *(const float4*)(p.mla_kv_norm + 4 * lane);
        *(uint2*)(CKV + (size_t)r * 256 + 4 * lane) = make_uint2(pack2(kv.x * rk * gk.x, kv.y * rk * gk.y), pack2(kv.z * rk * gk.z, kv.w * rk * gk.w));
        const float v = bf2f(rp[640 + lane]);
        const float pv = __shfl_xor(v, 16);
        const int s = r % SB;
        float o = v;
        if (s >= CTXL) {
            const int sx = s - CTXL, half = lane >> 5, idx = lane & 31, fi = idx & 15;
            const int pos = half ? (sx & 63) : (sx >> 6);
            const float cs = rope[pos * 16 + fi], sn = rope[1024 + pos * 16 + fi];
            o = (idx < 16) ? (v * cs - pv * sn) : (v * cs + pv * sn);
        }
        KR[(size_t)r * 64 + lane] = (bf16_t)(pack2(o, 0.f) & 0xffffu);
    }
}
struct EpiQ {
    bf16_t* QF; const float* rope; int row0, col0;
    __device__ __forceinline__ void operator()(const f32x4 (&acc)[4][4], int wm, int wn, int lane) const {
        const float qs = 0.07216878364870322f * 1.4426950408889634f;
        const int base = (col0 + wn * 64) >> 4;
        const bool isrope = (base % 12) == 8;
#pragma unroll
        for (int m = 0; m < 4; ++m) {
            const int row = row0 + wm * 64 + m * 16 + (lane & 15);
            f32x4 o0 = acc[m][0], o1 = acc[m][1], o2 = acc[m][2], o3 = acc[m][3];
            if (isrope) {
                const int sx = (row % SB) - CTXL, gr = sx >> 6, gc = sx & 63;
                const f32x4 cr = *(const f32x4*)(rope + gr * 16 + 4 * (lane >> 4)), sr = *(const f32x4*)(rope + 1024 + gr * 16 + 4 * (lane >> 4));
                const f32x4 cc = *(const f32x4*)(rope + gc * 16 + 4 * (lane >> 4)), sc = *(const f32x4*)(rope + 1024 + gc * 16 + 4 * (lane >> 4));
                const f32x4 t0 = o0 * cr - o1 * sr, t1 = o1 * cr + o0 * sr, t2 = o2 * cc - o3 * sc, t3 = o3 * cc + o2 * sc;
                o0 = t0; o1 = t1; o2 = t2; o3 = t3;
            }
            bf16_t* rp = QF + (size_t)row * 1536 + col0 + wn * 64 + 4 * (lane >> 4);
            *(uint2*)(rp) = make_uint2(pack2(o0[0] * qs, o0[1] * qs), pack2(o0[2] * qs, o0[3] * qs));
            *(uint2*)(rp + 16) = make_uint2(pack2(o1[0] * qs, o1[1] * qs), pack2(o1[2] * qs, o1[3] * qs));
            *(uint2*)(rp + 32) = make_uint2(pack2(o2[0] * qs, o2[1] * qs), pack2(o2[2] * qs, o2[3] * qs));
            *(uint2*)(rp + 48) = make_uint2(pack2(o3[0] * qs, o3[1] * qs), pack2(o3[2] * qs, o3[3] * qs));
        }
    }
};
struct EpiKV {
    bf16_t* KN; bf16_t* VT; int row0, tn;
    __device__ __forceinline__ void operator()(const f32x4 (&acc)[4][4], int wm, int wn, int lane) const {
        const int head = tn >> 1; const bool isv = tn & 1;
        const int b = row0 / SB, s0 = row0 % SB;
#pragma unroll
        for (int m = 0; m < 4; ++m) {
            const int rl = wm * 64 + m * 16 + 4 * (lane >> 4);
#pragma unroll
            for (int n = 0; n < 4; ++n) {
                const int cw = wn * 64 + n * 16 + (lane & 15);
                if (isv) {
                    *(uint2*)(VT + ((size_t)((b * 8 + head) * 128 + cw)) * SB + s0 + rl) = make_uint2(pack2(acc[m][n][0], acc[m][n][1]), pack2(acc[m][n][2], acc[m][n][3]));
                } else {
                    const unsigned p01 = pack2(acc[m][n][0], acc[m][n][1]), p23 = pack2(acc[m][n][2], acc[m][n][3]);
                    bf16_t* kp = KN + (size_t)(row0 + rl) * D + head * 128 + cw;
                    kp[0] = (bf16_t)(p01 & 0xffffu); kp[D] = (bf16_t)(p01 >> 16); kp[2 * D] = (bf16_t)(p23 & 0xffffu); kp[3 * D] = (bf16_t)(p23 >> 16);
                }
            }
        }
    }
};
struct EpiKV8 {
    bf16_t* KN; bf16_t* VT;
    __device__ __forceinline__ void operator()(const f32x4 (&acc)[2][2][4][2], const g8::Unit& u, int wr, int wc, int fr, int fq) const {
        const int head = u.tn, b = u.row0 / SB, s0 = u.row0 % SB;
#pragma unroll
        for (int ai = 0; ai < 2; ++ai)
#pragma unroll
            for (int m = 0; m < 4; ++m) {
                const int rl = 128 * ai + 64 * wr + 16 * m + fr;
                bf16_t* kp = KN + (size_t)(u.row0 + rl) * D + head * 128 + 32 * wc + 4 * fq;
                *(uint2*)(kp) = make_uint2(pack2(acc[ai][0][m][0][0], acc[ai][0][m][0][1]), pack2(acc[ai][0][m][0][2], acc[ai][0][m][0][3]));
                *(uint2*)(kp + 16) = make_uint2(pack2(acc[ai][0][m][1][0], acc[ai][0][m][1][1]), pack2(acc[ai][0][m][1][2], acc[ai][0][m][1][3]));
#pragma unroll
                for (int n = 0; n < 2; ++n) {
                    const unsigned p01 = pack2(acc[ai][1][m][n][0], acc[ai][1][m][n][1]), p23 = pack2(acc[ai][1][m][n][2], acc[ai][1][m][n][3]);
                    bf16_t* vp = VT + ((size_t)((b * 8 + head) * 128 + 32 * wc + 16 * n + 4 * fq)) * SB + s0 + rl;
                    vp[0] = (bf16_t)(p01 & 0xffffu); vp[SB] = (bf16_t)(p01 >> 16); vp[2 * SB] = (bf16_t)(p23 & 0xffffu); vp[3 * SB] = (bf16_t)(p23 >> 16);
                }
            }
    }
};
__device__ __forceinline__ void phase_gemm_kv8(const Params& p, char* lds) {
    SchedDense8 S{p.ws + OFF_WUKV, 68 * 8, 8, 512, vG(), g8::xcd_major_block()};
    EpiKV8 E{(bf16_t*)(p.ws + OFF_KN), (bf16_t*)(p.ws + OFF_VT)};
    g8::gemm8<false>((LAS unsigned char*)lds, p.ws + OFF_CKV, 512, S, E);
}
__device__ __forceinline__ void phase_gemm_kv(const Params& p, char* lds) {
    const int nkv = 68 * 16;
    for (int v = blockIdx.x; v < nkv; v += vG()) {
        const int mt = v >> 4, tn = v & 15;
        EpiKV epi{(bf16_t*)(p.ws + OFF_KN), (bf16_t*)(p.ws + OFF_VT), mt * 256, tn};
        gemm_dense<false>((const bf16_t*)(p.ws + OFF_CKV), 256, mt * 256, (const bf16_t*)(p.ws + OFF_WUKV), 256, tn * 128, 256, lds, epi);
    }
}
__device__ __forceinline__ void phase_gemm_qkv(const Params& p, char* lds) {
    const int nq = 64 * 12, nkv = 68 * 16;
    for (int u = blockIdx.x; u < nq + nkv; u += vG()) {
        if (u < nq) {
            const int mi = u / 12, tn = u % 12, row0 = (mi >> 4) * SB + ((mi & 15) + 1) * 256;
            EpiQ epi{(bf16_t*)(p.ws + OFF_QF), (const float*)(p.ws + OFF_ROPE), row0, tn * 128};
            gemm_dense<true>((const bf16_t*)(p.ws + OFF_CQ), 384, row0, (const bf16_t*)(p.ws + OFF_WUQ), 384, tn * 128, 384, lds, epi);
        } else {
            const int v = u - nq, mt = v >> 4, tn = v & 15;
            EpiKV epi{(bf16_t*)(p.ws + OFF_KN), (bf16_t*)(p.ws + OFF_VT), mt * 256, tn};
            gemm_dense<false>((const bf16_t*)(p.ws + OFF_CKV), 256, mt * 256, (const bf16_t*)(p.ws + OFF_WUKV), 256, tn * 128, 256, lds, epi);
        }
    }
}
__device__ __forceinline__ void phase_attention(const Params& p, char* lds) {
    const int tid = threadIdx.x, lane = tid & 63, w = tid >> 6;
    const bf16_t* QF = (const bf16_t*)(p.ws + OFF_QF); const bf16_t* KN = (const bf16_t*)(p.ws + OFF_KN);
    const bf16_t* KR = (const bf16_t*)(p.ws + OFF_KR); const bf16_t* VTg = (const bf16_t*)(p.ws + OFF_VT);
    bf16_t* OB = (bf16_t*)(p.ws + OFF_OB);
    char* Ps = lds + 122880 + w * 4096;
    const FragBase fbk = fragbase(lane, 384), fbv = fragbase(lane, 128);
    for (int it = blockIdx.x; it < NB * 8 * 16; it += vG()) {
        const int b = it >> 7, h = (it >> 4) & 7, qt = it & 15;
        const int qrow0 = b * SB + CTXL + qt * 256 + w * 32;
        bf16x8 qf[2][6];
#pragma unroll
        for (int m = 0; m < 2; ++m)
#pragma unroll
            for (int ks = 0; ks < 6; ++ks) qf[m][ks] = *(const bf16x8*)(QF + (size_t)(qrow0 + m * 16 + (lane & 15)) * 1536 + h * 192 + ks * 32 + (lane >> 4) * 8);
        f32x4 acco[2][8];
#pragma unroll
        for (int m = 0; m < 2; ++m)
#pragma unroll
            for (int n = 0; n < 8; ++n) acco[m][n] = (f32x4){0.f, 0.f, 0.f, 0.f};
        float mrun[2] = {0.f, 0.f}; bool first = true;
        f32x4 lacc[2] = {(f32x4){0.f, 0.f, 0.f, 0.f}, (f32x4){0.f, 0.f, 0.f, 0.f}};
        unsigned koff[3], kstep[3], voff[2];
#pragma unroll
        for (int i = 0; i < 3; ++i) {
            const int L = (w + 8 * i) * 64 + lane, r = L / 24, q = L % 24;
            const int c = (q & ~7) | ((q & 7) ^ ((r >> 1) & 7));
            koff[i] = (c < 16) ? (unsigned)(OFF_KN + ((size_t)(b * SB + r) * D + h * 128 + c * 8) * 2) : (unsigned)(OFF_KR + ((size_t)(b * SB + r) * 64 + (c - 16) * 8) * 2);
            kstep[i] = (c < 16) ? 64u * D * 2u : 64u * 64u * 2u;
        }
#pragma unroll
        for (int i = 0; i < 2; ++i) {
            const int L = (w + 8 * i) * 64 + lane, r = L >> 3, q = L & 7, c = q ^ ((r >> 1) & 7);
            voff[i] = (unsigned)(OFF_VT + ((size_t)((b * 8 + h) * 128 + r) * SB + c * 8) * 2);
        }
        auto dma = [&](int kt, int st) {
            char* Ks = lds + st * 24576; char* Vs = lds + 73728 + st * 16384;
#pragma unroll
            for (int i = 0; i < 3; ++i)
                __builtin_amdgcn_global_load_lds((const unsigned*)(p.ws + (size_t)(koff[i] + (unsigned)kt * kstep[i])), (LAS unsigned*)(Ks + (w + 8 * i) * 1024 + lane * 16), 16, 0, 0);
#pragma unroll
            for (int i = 0; i < 2; ++i)
                __builtin_amdgcn_global_load_lds((const unsigned*)(p.ws + (size_t)(voff[i] + (unsigned)kt * 128u)), (LAS unsigned*)(Vs + (w + 8 * i) * 1024 + lane * 16), 16, 0, 0);
        };
        f32x4 s[2][4];
        auto do_S = [&](int st) {
            const char* Ks = lds + st * 24576;
#pragma unroll
            for (int m = 0; m < 2; ++m)
#pragma unroll
                for (int n = 0; n < 4; ++n) s[m][n] = (f32x4){-mrun[m], -mrun[m], -mrun[m], -mrun[m]};
            bf16x8 kf[4];
#pragma unroll
            for (int i = 0; i < 3; ++i) kf[i] = ldfrag2(Ks, fbk, 384, (i & 3) * 16, i >> 2);
#pragma unroll
            for (int i = 0; i < 24; ++i) {
                if (i + 3 < 24) kf[(i + 3) & 3] = ldfrag2(Ks, fbk, 384, ((i + 3) & 3) * 16, (i + 3) >> 2);
                __builtin_amdgcn_sched_barrier(0);
                s[0][i & 3] = mfma16(kf[i & 3], qf[0][i >> 2], s[0][i & 3]); s[1][i & 3] = mfma16(kf[i & 3], qf[1][i >> 2], s[1][i & 3]);
            }
        };
        auto do_SM_PV = [&](int st) {
            const char* Vs = lds + 73728 + st * 16384;
#pragma unroll
            for (int m = 0; m < 2; ++m) {
                float mx = s[m][0][0];
#pragma unroll
                for (int n = 0; n < 4; ++n)
#pragma unroll
                    for (int q = 0; q < 4; ++q) mx = fmaxf(mx, s[m][n][q]);
                if (__any(first || mx > 64.0f)) {
                    mx = fmaxf(mx, __shfl_xor(mx, 16)); mx = fmaxf(mx, __shfl_xor(mx, 32));
                    const float delta = first ? mx : fmaxf(mx, 0.f), alpha = first ? 1.0f : __builtin_amdgcn_exp2f(-delta);
                    lacc[m] *= alpha;
#pragma unroll
                    for (int n = 0; n < 8; ++n) acco[m][n] *= alpha;
#pragma unroll
                    for (int n = 0; n < 4; ++n) s[m][n] -= delta;
                    mrun[m] += delta;
                }
#pragma unroll
                for (int n = 0; n < 4; ++n) {
                    float pv[4];
#pragma unroll
                    for (int q = 0; q < 4; ++q) pv[q] = __builtin_amdgcn_exp2f(s[m][n][q]);
                    *(uint2*)(Ps + m * 2048 + (lane & 15) * 128 + ((((n * 2) | (lane >> 5)) ^ (((lane & 15) >> 1) & 7)) << 4) + ((lane >> 4) & 1) * 8) = make_uint2(pack2(pv[0], pv[1]), pack2(pv[2], pv[3]));
                }
            }
            first = false;
            __builtin_amdgcn_wave_barrier();
            {
                bf16x8 pf[2][2], vf[4];
#pragma unroll
                for (int ks = 0; ks < 2; ++ks) { pf[ks][0] = ldfrag2(Ps, fbv, 128, 0, ks); pf[ks][1] = ldfrag2(Ps, fbv, 128, 16, ks); }
                {
                    const bf16x8 ones = (bf16x8){16256, 16256, 16256, 16256, 16256, 16256, 16256, 16256};
#pragma unroll
                    for (int ks = 0; ks < 2; ++ks) { lacc[0] = mfma16(ones, pf[ks][0], lacc[0]); lacc[1] = mfma16(ones, pf[ks][1], lacc[1]); }
                }
#pragma unroll
                for (int i = 0; i < 3; ++i) vf[i] = ldfrag2(Vs, fbv, 128, (i & 7) * 16, i >> 3);
#pragma unroll
                for (int i = 0; i < 16; ++i) {
                    if (i + 3 < 16) vf[(i + 3) & 3] = ldfrag2(Vs, fbv, 128, ((i + 3) & 7) * 16, (i + 3) >> 3);
                    __builtin_amdgcn_sched_barrier(0);
                    acco[0][i & 7] = mfma16(vf[i & 3], pf[i >> 3][0], acco[0][i & 7]); acco[1][i & 7] = mfma16(vf[i & 3], pf[i >> 3][1], acco[1][i & 7]);
                }
            }
        };
        __syncthreads();
        dma(0, 0); dma(1, 1);
        asm volatile("s_waitcnt vmcnt(0)" ::: "memory");
        __syncthreads();
        const int nkt = SB / 64;
        const bool grpA = w < 4;
        int st = 0, stp = 2;
        for (int kt = 0; kt < nkt; ++kt) {
            const bool more2 = (kt + 2) < nkt;
            if (grpA) do_S(st); else if (kt > 0) do_SM_PV(stp);
            asm volatile("s_waitcnt lgkmcnt(0)" ::: "memory");
            __builtin_amdgcn_s_barrier();
            asm volatile("" ::: "memory");
            if (more2) dma(kt + 2, stp);
            if (grpA) do_SM_PV(st); else do_S(st);
            if (more2) asm volatile("s_waitcnt vmcnt(5)" ::: "memory"); else asm volatile("s_waitcnt vmcnt(0)" ::: "memory");
            asm volatile("s_waitcnt lgkmcnt(0)" ::: "memory");
            __builtin_amdgcn_s_barrier();
            asm volatile("" ::: "memory");
            stp = st; st = (st == 2) ? 0 : st + 1;
        }
        if (!grpA) do_SM_PV(stp);
#pragma unroll
        for (int m = 0; m < 2; ++m) {
            const float il = 1.0f / lacc[m][0];
            bf16_t* op = OB + (size_t)(qrow0 + m * 16 + (lane & 15)) * D + h * 128 + 4 * (lane >> 4);
#pragma unroll
            for (int n = 0; n < 8; ++n) *(uint2*)(op + n * 16) = make_uint2(pack2(acco[m][n][0] * il, acco[m][n][1] * il), pack2(acco[m][n][2] * il, acco[m][n][3] * il));
        }
    }
}

constexpr int LDS_BYTES = 16 + 155648 + 512;
#ifndef ONLY_PHASE
#define ONLY_PHASE -1
#endif
#define RUN_PHASE(i, call) do { if ((ONLY_PHASE < 0 || ONLY_PHASE == (i)) && p.phase_lo <= (i) && (i) < p.phase_hi) { call; } if (p.phase_lo <= (i) && (i) + 1 < p.phase_hi) xcd_barrier(bar); } while (0)

__global__ void __launch_bounds__(512, 2) hybrid_forward(Params p) {
    extern __shared__ __attribute__((aligned(16))) char smem[];
    if (threadIdx.x == 0) *(uint4*)smem = make_uint4(0u, 0u, gridDim.x, 0u);
    __syncthreads();
    char* lds = smem + 16;
    XcdBarrier bar; bar.bar = (unsigned*)(p.ws + OFF_BAR); bar.x = 0; bar.st = (volatile LAS unsigned*)smem;
    if (p.phase_hi - p.phase_lo > 1) bar = xcd_barrier_post((unsigned*)(p.ws + OFF_BAR), (volatile LAS unsigned*)smem);
    RUN_PHASE(0, { phase_prologue0(p, lds); phase_prologue1(p, lds); });
    RUN_PHASE(1, phase_prenorm(p, 0));
    const bool split = (gridDim.x == 256);
#define RUN_SPLIT(i, nc, q, base, hi, call) do { if (split && p.phase_lo <= (i) && (i) < p.phase_hi) set_vG(nc); \
        RUN_PHASE(i, { if (!split || (int)blockIdx.x < (nc)) { call; } else convert_static(p, base, (int)blockIdx.x - (nc), 256 - (nc), q, hi, lds); }); \
        if (split && p.phase_lo <= (i) && (i) < p.phase_hi) set_vG((int)gridDim.x); } while (0)
    RUN_SPLIT(3, CV3_NC, CV3_Q, CV_B3, CV_TILES_SET, phase_gemm_recin8(p, lds));
    RUN_PHASE(4, phase_rec_local(p, lds));
    RUN_PHASE(5, phase_gla_scan(p));
    RUN_PHASE(6, phase_rec_out(p, lds));
    RUN_SPLIT(7, CV7_NC, CV7_Q, CV_B7, CV_TILES_SET, phase_gemm_glu8(p, lds));
    RUN_SPLIT(8, CV8_NC, CV8_Q, CV_B8, CV_TILES_SET, phase_gemm_recout8(p, lds));
    RUN_PHASE(9, { phase_postmix(p, 0, false, lds); convert_static(p, split ? CV_B9 : 0, (int)blockIdx.x, (int)gridDim.x, 1 << 20, CV_TILES_SET, lds); });
    RUN_PHASE(10, phase_moe1_8(p, 0, lds));
    RUN_PHASE(11, phase_moe2_8(p, 0, lds));
    RUN_PHASE(12, phase_combine(p, 0, false, lds));
    RUN_SPLIT(13, CV13_NC, CV13_Q, CV_B13, 2 * CV_TILES_SET, phase_gemm_down8(p, lds));
    RUN_PHASE(14, phase_mla_norm(p));
    RUN_SPLIT(15, CV15_NC, CV15_Q, CV_B15, 2 * CV_TILES_SET, { phase_gemm_kv8(p, lds); __syncthreads(); phase_gemm_q8(p, lds); });
    RUN_PHASE(16, phase_attention(p, lds));
    RUN_PHASE(17, { phase_gemm_wo8(p, lds); convert_static(p, split ? CV_B17 : CV_TILES_SET, (int)blockIdx.x, (int)gridDim.x, 1 << 20, 2 * CV_TILES_SET, lds); });
    RUN_PHASE(18, phase_postmix(p, 1, true, lds));
    RUN_PHASE(19, phase_moe1_8(p, 1, lds));
    RUN_PHASE(20, phase_moe2_8(p, 1, lds));
    RUN_PHASE(21, phase_combine(p, 1, true, lds));
#if DBG_STOP >= 0
    if (p.phase_lo == 22) {
        float* o = p.out;
        for (size_t e = (size_t)blockIdx.x * 512 + threadIdx.x; e < (size_t)NB * SEQ * 1024; e += (size_t)gridDim.x * 512) {
            const int ri = (int)(e >> 10), c = (int)(e & 1023), r = (ri >> 12) * SB + CTXL + (ri & 4095);
            float v;
            if (DBG_SRC == 0) v = ((const float*)(p.ws + OFF_XS))[(size_t)r * 1024 + c];
            else if (DBG_SRC == 1) v = bf2f(((const bf16_t*)(p.ws + OFF_PB))[(size_t)r * PW + DBG_COL + c]);
            else if (DBG_SRC == 2) v = bf2f(((const bf16_t*)(p.ws + OFF_MIX))[(size_t)r * 1024 + (DBG_COL + c) % 1024]);
            else if (DBG_SRC == 3) v = bf2f(((const bf16_t*)(p.ws + OFF_YX))[(size_t)r * 1024 + c]);
            else if (DBG_SRC == 4) v = bf2f(((const bf16_t*)(p.ws + OFF_Y))[(size_t)r * 512 + (c & 511)]);
            else if (DBG_SRC == 5) v = bf2f(((const bf16_t*)(p.ws + OFF_HB))[(size_t)r * 1024 + c]);
            else if (DBG_SRC == 6) v = bf2f(((const bf16_t*)(p.ws + OFF_WRI))[(size_t)(ri % 2304) * 1024 + c]);
            else v = ((const float*)(p.ws + OFF_MF))[(size_t)(e % 61440)];
            if (!(fabsf(v) < 1.0e30f)) v = 1.0e4f;
            o[e] = v;
        }
    }
#endif
}

extern "C" void kernel_launch(void* const* d_in, const int* in_sizes, int n_in, void* d_out, int out_size, void* d_ws, size_t ws_size, hipStream_t stream) {
    static int grid = 0;
    if (!grid) {
        int dev = 0, cus = 0, per_cu = 0;
        hipGetDevice(&dev);
        hipDeviceGetAttribute(&cus, hipDeviceAttributeMultiprocessorCount, dev);
        hipFuncSetAttribute((const void*)hybrid_forward, hipFuncAttributeMaxDynamicSharedMemorySize, LDS_BYTES);
        hipOccupancyMaxActiveBlocksPerMultiprocessor(&per_cu, hybrid_forward, 512, LDS_BYTES);
        if (per_cu < 1) { fprintf(stderr, "occupancy query returned %d\n", per_cu); per_cu = 1; }
        grid = cus * 1;
    }
    if (ws_size < WS_TOTAL) { fprintf(stderr, "workspace too small: %zu < %zu\n", ws_size, (size_t)WS_TOTAL); return; }
    hipMemsetAsync(d_ws, 0, ZERO_BYTES, stream);
    Params p{};
    const float** f = (const float**)&p;
    for (int i = 0; i < 37; ++i) f[i] = (const float*)d_in[i];
    p.out = (float*)d_out; p.ws = (char*)d_ws;
#if DBG_STOP >= 0
    for (int i = 0; i <= DBG_STOP; ++i) { p.phase_lo = i; p.phase_hi = i + 1; hipLaunchKernelGGL(hybrid_forward, dim3(grid), dim3(512), LDS_BYTES, stream, p); }
    p.phase_lo = 22; p.phase_hi = 23; hipLaunchKernelGGL(hybrid_forward, dim3(grid), dim3(512), LDS_BYTES, stream, p);
#elif MK_MULTI
    for (int i = 0; i < NPHASE; ++i) { p.phase_lo = i; p.phase_hi = i + 1; hipLaunchKernelGGL(hybrid_forward, dim3(grid), dim3(512), LDS_BYTES, stream, p); }
#else
    p.phase_lo = 0; p.phase_hi = NPHASE;
    hipLaunchKernelGGL(hybrid_forward, dim3(grid), dim3(512), LDS_BYTES, stream, p);
#endif
}
```

```cpp
#include <hip/hip_runtime.h>
#include <stdint.h>
#include <stdio.h>

#ifndef DBG_STOP
#define DBG_STOP -1
#endif
#ifndef DBG_SRC
#define DBG_SRC 0
#endif
#ifndef DBG_COL
#define DBG_COL 0
#endif
#ifndef FP8_G1
#define FP8_G1 1
#endif
#ifndef FP8_G2
#define FP8_G2 1
#endif
#ifndef MK_MULTI
#define MK_MULTI 0
#endif

typedef unsigned short bf16_t;
typedef short bf16x8 __attribute__((ext_vector_type(8)));
typedef float f32x4 __attribute__((ext_vector_type(4)));

constexpr int D = 1024, NB = 4, SEQ = 4096, CTXL = 256;
constexpr int SB = SEQ + CTXL;
constexpr int NT = NB * SB;
constexpr int NCH = SB / 64;
constexpr int PW = 2176;
constexpr int COL_Q = 0, COL_K = 256, COL_V = 512, COL_G = 1024, COL_RF = 1536, COL_U = 1568;
constexpr int NE = 32, TOPK = 4;
constexpr int MAXPR = 78080;
constexpr int DNW = 768;
constexpr float EPS = 1e-6f;
constexpr int NPHASE = 22;

constexpr size_t al256(size_t x) { return (x + 255) & ~(size_t)255; }
constexpr size_t OFF_BAR = 0;
constexpr size_t OFF_CNT = 16384;
constexpr size_t ZERO_BYTES = 20480;
constexpr size_t OFF_MP = ZERO_BYTES;
constexpr size_t OFF_MF = OFF_MP + al256((size_t)8 * 2 * 5 * 6144 * 4);
constexpr size_t OFF_ROPE = OFF_MF + al256((size_t)2 * 5 * 6144 * 4);
constexpr size_t OFF_ABAR = OFF_ROPE + al256(2 * 1024 * 4);
constexpr size_t OFF_A64 = OFF_ABAR + al256(4096 * 8);
constexpr size_t OFF_BBAR = OFF_A64 + al256(4096 * 8);
constexpr size_t OFF_CMAT = OFF_BBAR + al256((size_t)4096 * 16 * 8);
constexpr size_t OFF_WRI = OFF_CMAT + al256((size_t)64 * 16 * 128 * 2);
constexpr size_t OFF_WRO = OFF_WRI + al256((size_t)2304 * 1024 * 2);
constexpr size_t OFF_WGLU = OFF_WRO + al256((size_t)1024 * 1024 * 2);
constexpr size_t OFF_WDN = OFF_WGLU + al256((size_t)512 * 512 * 2);
constexpr size_t OFF_WUQ = OFF_WDN + al256((size_t)DNW * 1024 * 2);
constexpr size_t OFF_WUKV = OFF_WUQ + al256((size_t)1536 * 384 * 2);
constexpr size_t OFF_WO = OFF_WUKV + al256((size_t)2048 * 256 * 2);
constexpr size_t OFF_EWI = OFF_WO + al256((size_t)1024 * 1024 * 2);
constexpr size_t OFF_EWO = OFF_EWI + al256((size_t)64 * 2048 * 1024 * 2);
constexpr size_t OFF_XS = OFF_EWO + al256((size_t)64 * 1024 * 1024 * 2);
constexpr size_t OFF_HB = OFF_XS + al256((size_t)NT * 1024 * 4);
constexpr size_t OFF_PB = OFF_HB + al256((size_t)NT * 1024 * 2);
constexpr size_t OFF_KV = OFF_PB + al256((size_t)NT * PW * 2);
constexpr size_t OFF_DL = OFF_KV + al256((size_t)32 * NCH * 64 * 128 * 4);
constexpr size_t OFF_HE = OFF_DL + al256((size_t)32 * NCH * 64 * 4);
constexpr size_t OFF_Y = OFF_HE + al256((size_t)4 * 2 * 32 * NCH * 64 * 8);
constexpr size_t OFF_MIX = OFF_Y + al256((size_t)NT * 512 * 2);
constexpr size_t OFF_YX = OFF_MIX + al256((size_t)NT * 1024 * 2);
constexpr size_t OFF_LIST = OFF_YX + al256((size_t)NT * 1024 * 4);
constexpr size_t OFF_SE = OFF_LIST + al256((size_t)NE * NT * 4);
constexpr size_t OFF_SP = OFF_SE + al256((size_t)NT * 4 * 4);
constexpr size_t OFF_GT = OFF_SP + al256((size_t)NT * 4 * 4);
constexpr size_t OFF_ACT = OFF_GT + al256((size_t)NT * 4 * 4);
constexpr size_t OFF_YR = OFF_ACT + al256((size_t)MAXPR * 1024 * 2);
constexpr size_t OFF_DN = OFF_YR + al256((size_t)MAXPR * 1024 * 2);
constexpr size_t OFF_CQ = OFF_DN + al256((size_t)NT * DNW * 4);
constexpr size_t OFF_CKV = OFF_CQ + al256((size_t)NT * 384 * 2);
constexpr size_t OFF_KR = OFF_CKV + al256((size_t)NT * 256 * 2);
constexpr size_t OFF_QF = OFF_KR + al256((size_t)NT * 64 * 2);
constexpr size_t OFF_KN = OFF_QF + al256((size_t)NT * 1536 * 2);
constexpr size_t OFF_VT = OFF_KN + al256((size_t)NT * 1024 * 2);
constexpr size_t OFF_OB = OFF_VT + al256((size_t)NT * 1024 * 2);
constexpr size_t OFF_HB8 = OFF_OB + al256((size_t)NT * 1024 * 2);
constexpr size_t OFF_CUM = OFF_HB8 + al256((size_t)NT * 1024);
constexpr size_t WS_TOTAL = OFF_CUM + al256((size_t)1088 * 8192 * 4);
static_assert(WS_TOTAL < (1ull << 31), "32-bit workspace offsets");

struct Params {
    const float *x, *c, *ctx, *c_ctx, *mod_w, *mod_b, *norm_mix_pre, *norm_mix_post, *norm_ffn_pre, *norm_ffn_post;
    const float *router_w, *router_b, *exp_w_in, *exp_b_in, *exp_w_out, *exp_b_out, *rec_w_in, *rec_w_out;
    const float *gla_gate_w, *gla_gate_b, *gla_norm, *s5_lam_re, *s5_lam_im, *s5_log_dt, *s5_b_re, *s5_b_im;
    const float *s5_c_re, *s5_c_im, *s5_d, *s5_glu_w, *s5_glu_b, *mla_w_down, *mla_q_norm, *mla_kv_norm;
    const float *mla_w_uq, *mla_w_ukv, *mla_w_o;
    float* out;
    char* ws;
    int phase_lo, phase_hi;
};

#define XB_TMO      128
#define XB_XCNT(j)  (256  + 64 * (j))
#define XB_XSUB(j)  (1280 + 64 * (j))
#define XB_XGEN(j)  (2304 + 64 * (j))
#define XB_TOP      3328
#define XB_TOPGEN   3392
#define XCD_BAR_WORDS 3456
#define XB_SPIN_CAP (1u << 22)
#define LAS __attribute__((address_space(3)))

__device__ __forceinline__ unsigned xb_ld(unsigned* p)              { return __hip_atomic_load(p, __ATOMIC_RELAXED, __HIP_MEMORY_SCOPE_AGENT); }
__device__ __forceinline__ unsigned xb_add(unsigned* p, unsigned v) { return __hip_atomic_fetch_add(p, v, __ATOMIC_RELAXED, __HIP_MEMORY_SCOPE_AGENT); }
__device__ __forceinline__ unsigned xb_xcc_id() { return (unsigned)__builtin_amdgcn_s_getreg((3 << 11) | 20) & 0xFu; }
#define XB_SPIN(cond, bar) do { unsigned _sp = 0; while (cond) { __builtin_amdgcn_s_sleep(1); \
    if ((++_sp & 255u) == 0u) { if (xb_ld(&(bar)[XB_TMO])) break; if (_sp > XB_SPIN_CAP) { atomicAdd(&(bar)[XB_TMO], 1u); break; } } } } while (0)

struct XcdBarrier { unsigned* bar; unsigned x; volatile LAS unsigned* st; };

__device__ __forceinline__ XcdBarrier xcd_barrier_post(unsigned* bar, volatile LAS unsigned* st) {
    XcdBarrier b; b.bar = bar; b.x = xb_xcc_id(); b.st = st;
    if (threadIdx.x == 0) (void)xb_add(&bar[XB_XCNT(b.x)], 1u);
    return b;
}
__device__ __forceinline__ void xcd_barrier_complete(unsigned* bar, unsigned x, unsigned& nloc, unsigned& nx) {
    const unsigned G = gridDim.x * gridDim.y * gridDim.z;
    unsigned sum, cnt, mine, sp = 0u;
    for (;;) {
        sum = 0u; cnt = 0u; mine = 0u;
#pragma unroll
        for (unsigned j = 0; j < 16; ++j) { const unsigned c = xb_ld(&bar[XB_XCNT(j)]); sum += c; cnt += (c > 0u) ? 1u : 0u; mine = (j == x) ? c : mine; }
        if (sum == G) break;
        __builtin_amdgcn_s_sleep(1);
        if ((++sp & 255u) == 0u) { if (xb_ld(&bar[XB_TMO])) break; if (sp > XB_SPIN_CAP) { atomicAdd(&bar[XB_TMO], 1u); break; } }
    }
    nloc = mine > 0u ? mine : 1u; nx = cnt > 0u ? cnt : 1u;
}
__device__ __forceinline__ void xcd_barrier(const XcdBarrier& b) {
    asm volatile("s_waitcnt vmcnt(0)" ::: "memory");
    __syncthreads();
    if (threadIdx.x == 0) {
        unsigned* bar = b.bar;
        __builtin_amdgcn_s_waitcnt(0);
        unsigned nloc = b.st[0], nx = b.st[1];
        if (nloc == 0u) { xcd_barrier_complete(bar, b.x, nloc, nx); b.st[0] = nloc; b.st[1] = nx; }
        const unsigned old = xb_add(&bar[XB_XSUB(b.x)], 1u);
        const unsigned gen = old / nloc;
        if (old + 1u == (gen + 1u) * nloc) {
            __builtin_amdgcn_fence(__ATOMIC_RELEASE, "agent");
            asm volatile("s_waitcnt vmcnt(0)" ::: "memory");
            const unsigned og = xb_add(&bar[XB_TOP], 1u);
            const unsigned tg = og / nx;
            if (og + 1u == (tg + 1u) * nx) xb_add(&bar[XB_TOPGEN], 1u);
            else XB_SPIN(xb_ld(&bar[XB_TOPGEN]) == tg, bar);
            __builtin_amdgcn_fence(__ATOMIC_ACQUIRE, "agent");
            xb_add(&bar[XB_XGEN(b.x)], 1u);
            asm volatile("s_waitcnt vmcnt(0)" ::: "memory");
        } else {
            XB_SPIN(xb_ld(&bar[XB_XGEN(b.x)]) == gen, bar);
            __builtin_amdgcn_fence(__ATOMIC_ACQUIRE, "agent");
            asm volatile("s_waitcnt vmcnt(0)" ::: "memory");
        }
    }
    __syncthreads();
}

__device__ __forceinline__ int vG() { extern __shared__ __attribute__((aligned(16))) char smem_hdr[]; return __builtin_amdgcn_readfirstlane(*(volatile int*)(smem_hdr + 8)); }
__device__ __forceinline__ void set_vG(int v) { extern __shared__ __attribute__((aligned(16))) char smem_hdr[]; __syncthreads(); if (threadIdx.x == 0) *(volatile int*)(smem_hdr + 8) = v; __syncthreads(); }

__device__ __forceinline__ int fresh_tid() { int t = threadIdx.x; asm volatile("" : "+v"(t)); return t; }
__device__ __forceinline__ float bf2f(bf16_t h) { return __uint_as_float(((unsigned)h) << 16); }
typedef float f32x2_t __attribute__((ext_vector_type(2)));
typedef __bf16 bf16x2_t __attribute__((ext_vector_type(2)));
__device__ __forceinline__ unsigned pack2(float lo, float hi) { const f32x2_t v = {lo, hi}; const bf16x2_t b = __builtin_convertvector(v, bf16x2_t); return __builtin_bit_cast(unsigned, b); }
__device__ __forceinline__ unsigned pack4_fp8(float a, float b, float c, float d) {
    int r = __builtin_amdgcn_cvt_pk_fp8_f32(a, b, 0, false); r = __builtin_amdgcn_cvt_pk_fp8_f32(c, d, r, true); return (unsigned)r;
}
__device__ __forceinline__ float lo_bf(unsigned u) { return __uint_as_float(u << 16); }
__device__ __forceinline__ float hi_bf(unsigned u) { return __uint_as_float(u & 0xffff0000u); }
__device__ __forceinline__ float wave_sum(float v) {
#pragma unroll
    for (int o = 32; o >= 1; o >>= 1) v += __shfl_xor(v, o);
    return v;
}
__device__ __forceinline__ float sigmoidf_(float x) { return __builtin_amdgcn_rcpf(1.0f + __builtin_amdgcn_exp2f(-1.4426950408889634f * x)); }
__device__ __forceinline__ int swz(int r, int c, int RS) { return r * RS + ((c ^ ((r >> 1) & 7)) << 4); }
__device__ __forceinline__ int swz256(int r, int c) { return r * 256 + ((c ^ (r & 15)) << 4); }
__device__ __forceinline__ f32x4 mfma16(bf16x8 a, bf16x8 b, f32x4 c) { return __builtin_amdgcn_mfma_f32_16x16x32_bf16(a, b, c, 0, 0, 0); }
__device__ __forceinline__ bf16x8 ldfrag(const char* tile, int RS, int row0, int k0, int lane) {
    return *(const bf16x8*)(tile + swz(row0 + (lane & 15), (k0 >> 3) + (lane >> 4), RS));
}

struct FragBase { int b0, b1; };
__device__ __forceinline__ FragBase fragbase(int lane, int RS) {
    const int r = lane & 15, t = (lane >> 4) ^ ((r >> 1) & 7);
    FragBase f; f.b0 = r * RS + (t << 4); f.b1 = r * RS + ((t ^ 4) << 4); return f;
}
__device__ __forceinline__ bf16x8 ldfrag2(const char* tile, const FragBase& fb, int RS, int row0, int ks) {
    return *(const bf16x8*)(tile + ((ks & 1) ? fb.b1 : fb.b0) + row0 * RS + (ks >> 1) * 128);
}

constexpr int G_ABYTES = 256 * 128, G_BBYTES = 128 * 128, G_STAGE = G_ABYTES + G_BBYTES;
template <bool TRANS, class Epi>
__device__ __forceinline__ void gemm_tile(const bf16_t* a0, const bf16_t* a1, const bf16_t* a2, const bf16_t* a3,
                                          const bf16_t* b0, const bf16_t* b1, int K, char* lds, const Epi& epi) {
    const int tid = threadIdx.x, lane = tid & 63, w = tid >> 6, wm = w >> 1, wn = w & 1;
    const int srow = tid >> 3, sch = tid & 7, soff = swz(srow, sch, 128);
    const FragBase fb = fragbase(lane, 128);
    f32x4 acc[4][4];
#pragma unroll
    for (int m = 0; m < 4; ++m)
#pragma unroll
        for (int n = 0; n < 4; ++n) acc[m][n] = (f32x4){0.f, 0.f, 0.f, 0.f};
    uint4 ra0 = *(const uint4*)a0, ra1 = *(const uint4*)a1, ra2 = *(const uint4*)a2, ra3 = *(const uint4*)a3;
    uint4 rb0 = *(const uint4*)b0, rb1 = *(const uint4*)b1;
    {
        char* As = lds; char* Bs = lds + G_ABYTES;
        *(uint4*)(As + soff) = ra0; *(uint4*)(As + soff + 8192) = ra1; *(uint4*)(As + soff + 16384) = ra2; *(uint4*)(As + soff + 24576) = ra3;
        *(uint4*)(Bs + soff) = rb0; *(uint4*)(Bs + soff + 8192) = rb1;
    }
    __syncthreads();
    const int nk = K >> 6;
    for (int kt = 0; kt < nk; ++kt) {
        const bool more = (kt + 1) < nk;
        if (more) {
            const int ko = (kt + 1) * 64;
            ra0 = *(const uint4*)(a0 + ko); ra1 = *(const uint4*)(a1 + ko); ra2 = *(const uint4*)(a2 + ko); ra3 = *(const uint4*)(a3 + ko);
            rb0 = *(const uint4*)(b0 + ko); rb1 = *(const uint4*)(b1 + ko);
        }
        const char* As = lds + (kt & 1) * G_STAGE; const char* Bs = As + G_ABYTES;
#pragma unroll
        for (int ks = 0; ks < 2; ++ks) {
            bf16x8 af[4], bfr[4];
#pragma unroll
            for (int m = 0; m < 4; ++m) af[m] = ldfrag2(As + wm * 8192, fb, 128, m * 16, ks);
#pragma unroll
            for (int n = 0; n < 4; ++n) bfr[n] = ldfrag2(Bs + wn * 8192, fb, 128, n * 16, ks);
#pragma unroll
            for (int m = 0; m < 4; ++m)
#pragma unroll
                for (int n = 0; n < 4; ++n) acc[m][n] = TRANS ? mfma16(bfr[n], af[m], acc[m][n]) : mfma16(af[m], bfr[n], acc[m][n]);
        }
        if (more) {
            char* As2 = lds + ((kt + 1) & 1) * G_STAGE; char* Bs2 = As2 + G_ABYTES;
            *(uint4*)(As2 + soff) = ra0; *(uint4*)(As2 + soff + 8192) = ra1; *(uint4*)(As2 + soff + 16384) = ra2; *(uint4*)(As2 + soff + 24576) = ra3;
            *(uint4*)(Bs2 + soff) = rb0; *(uint4*)(Bs2 + soff + 8192) = rb1;
        }
        __syncthreads();
    }
    epi(acc, wm, wn, lane);
}
template <bool TRANS, class Epi>
__device__ __forceinline__ void gemm_dense(const bf16_t* A, int lda, int row0, const bf16_t* Bt, int ldb, int col0, int K, char* lds, const Epi& epi) {
    const int tid = threadIdx.x, srow = tid >> 3, sch = (tid & 7) * 8;
    const bf16_t* a = A + (size_t)(row0 + srow) * lda + sch;
    const bf16_t* b = Bt + (size_t)(col0 + srow) * ldb + sch;
    gemm_tile<TRANS>(a, a + (size_t)64 * lda, a + (size_t)128 * lda, a + (size_t)192 * lda, b, b + (size_t)64 * ldb, K, lds, epi);
}

namespace g8 {
constexpr int BK = 64, HALF = 128, HTB = HALF * BK * 2, STAGE_BYTES = 8 * HTB;
__device__ __forceinline__ void stage_rc(int b, int& R, int& C) { R = b >> 7; const int q = (b >> 4) & 7; C = (q ^ ((R >> 1) & 7)) * 8; }
struct Unit { const char* B; int row0, tn, e, slot; };

typedef int i32x8 __attribute__((ext_vector_type(8)));
typedef int i32x4_t __attribute__((ext_vector_type(4)));
__device__ __forceinline__ bf16x8 lo8(i32x8 v) { return __builtin_bit_cast(bf16x8, __builtin_shufflevector(v, v, 0, 1, 2, 3)); }
__device__ __forceinline__ bf16x8 hi8(i32x8 v) { return __builtin_bit_cast(bf16x8, __builtin_shufflevector(v, v, 4, 5, 6, 7)); }
template <bool FP8, class Epi, class Sched>
__device__ __forceinline__ void gemm8(LAS unsigned char* lds, const char* Abase, int rowB, const Sched& S, const Epi& E) {
    const int tid = threadIdx.x, wid = __builtin_amdgcn_readfirstlane(tid >> 6), lane = tid & 63, wr = wid >> 2, wc = wid & 3, fr = lane & 15, fq = lane >> 4;
    const int nt = rowB / 128;
    int R[2], C[2]; unsigned voffB[2];
#pragma unroll
    for (int i = 0; i < 2; ++i) { stage_rc(tid * 16 + i * 8192, R[i], C[i]); voffB[i] = (unsigned)(R[i] * rowB + C[i] * 2); }
    const size_t kstep = (size_t)(BK * 2);
    const size_t hstep = (size_t)HALF * rowB;
    const unsigned ldsw = (unsigned)wid * 1024u;
    const int fsw = fq ^ ((fr >> 1) & 7);
    const int aoff = (wr * 64 + fr) * 128 + (fsw << 4), aoff1 = (wr * 64 + fr) * 128 + ((fsw ^ 4) << 4);
    const int boff = (wc * 32 + fr) * 128 + (fsw << 4), boff1 = (wc * 32 + fr) * 128 + ((fsw ^ 4) << 4);
#define G8_SA(b, h) (((b) * 2 + (h)) * HTB)
#define G8_SB(b, h) ((4 + (b) * 2 + (h)) * HTB)
#define G8_STAGE(bufoff, gbase, voff) do { _Pragma("unroll") for (int _i = 0; _i < 2; ++_i) \
        __builtin_amdgcn_global_load_lds((const unsigned*)((const char*)(gbase) + (voff)[_i]), (LAS unsigned*)(lds + (bufoff) + ldsw + _i * 8192), 16, 0, 0); } while (0)
#define G8_LD2(a0, a1) __builtin_shufflevector(*(const LAS i32x4_t*)(a0), *(const LAS i32x4_t*)(a1), 0, 1, 2, 3, 4, 5, 6, 7)
#define G8_LDA(dst, b, h) do { _Pragma("unroll") for (int m = 0; m < 4; ++m) dst[m] = G8_LD2(lds + G8_SA(b, h) + aoff + m * 2048, lds + G8_SA(b, h) + aoff1 + m * 2048); } while (0)
#define G8_LDB(dst, b, h) do { _Pragma("unroll") for (int n = 0; n < 2; ++n) dst[n] = G8_LD2(lds + G8_SB(b, h) + boff + n * 2048, lds + G8_SB(b, h) + boff1 + n * 2048); } while (0)
#define G8_MMA(ai, bj, At, Bt) do { __builtin_amdgcn_s_setprio(1); _Pragma("unroll") for (int m = 0; m < 4; ++m) _Pragma("unroll") for (int n = 0; n < 2; ++n) { \
        if constexpr (FP8) asm volatile("s_nop 1\n\tv_mfma_scale_f32_16x16x128_f8f6f4 %0, %1, %2, %0, %3, %3 op_sel_hi:[0,0,0]" : "+v"(acc[ai][bj][m][n]) : "v"(Bt[n]), "v"(At[m]), "v"(scl)); \
        else { acc[ai][bj][m][n] = __builtin_amdgcn_mfma_f32_16x16x32_bf16(lo8(Bt[n]), lo8(At[m]), acc[ai][bj][m][n], 0, 0, 0); \
               acc[ai][bj][m][n] = __builtin_amdgcn_mfma_f32_16x16x32_bf16(hi8(Bt[n]), hi8(At[m]), acc[ai][bj][m][n], 0, 0, 0); } } \
        __builtin_amdgcn_s_setprio(0); } while (0)
#define G8_WAIT_V(n) asm volatile("s_waitcnt vmcnt(" #n ")" ::: "memory")
#define G8_WAIT_L(n) asm volatile("s_waitcnt lgkmcnt(" #n ")" ::: "memory")
#define G8_BAR __builtin_amdgcn_s_barrier()
#define G8_SCHED __builtin_amdgcn_sched_barrier(0)
    Unit cur, nxt; int ui = 0;
    if (!S.next(0, cur)) return;
    f32x4 acc[2][2][4][2];
#pragma unroll
    for (int a = 0; a < 2; ++a)
#pragma unroll
        for (int b = 0; b < 2; ++b)
#pragma unroll
            for (int m = 0; m < 4; ++m)
#pragma unroll
                for (int n = 0; n < 2; ++n) acc[a][b][m][n] = (f32x4){0.f, 0.f, 0.f, 0.f};
    i32x8 At[4], B0[2], B1[2];
    const int scl = 0x7F7F7F7F;
    unsigned co[2][2], no[2][2];
    S.aoff(cur, R, C, co);
    const char* cB = cur.B;
    G8_STAGE(G8_SB(0, 0), cB, voffB); G8_STAGE(G8_SA(0, 0), Abase, co[0]); G8_STAGE(G8_SB(0, 1), cB + hstep, voffB); G8_STAGE(G8_SA(0, 1), Abase, co[1]);
    if (wr == 1) G8_BAR;
    G8_WAIT_V(4); G8_BAR;
    G8_STAGE(G8_SB(1, 0), cB + kstep, voffB); G8_STAGE(G8_SA(1, 0), Abase + kstep, co[0]); G8_STAGE(G8_SB(1, 1), cB + hstep + kstep, voffB);
    G8_WAIT_V(6); G8_BAR;
    for (;;) {
        const bool has_next = S.next(ui + 1, nxt);
        unsigned adelta = 0u;
        if constexpr (Sched::AFFINE) { adelta = has_next ? (unsigned)((nxt.row0 - cur.row0) * rowB) : 0u; }
        else { if (has_next) { int tz = tid; asm volatile("" : "+v"(tz)); int R2[2], C2[2]; stage_rc(tz * 16, R2[0], C2[0]); stage_rc(tz * 16 + 8192, R2[1], C2[1]); S.aoff(nxt, R2, C2, no); } else { no[0][0] = co[0][0]; no[0][1] = co[0][1]; no[1][0] = co[1][0]; no[1][1] = co[1][1]; } }
        const char* nB = has_next ? nxt.B : cB;
#pragma nounroll
        for (int t = 0; t < nt; t += 2) {
            const bool last = (t == nt - 2);
            const char* a1 = Abase + (size_t)(t + 1) * kstep;
            const char* a2 = last ? Abase : Abase + (size_t)(t + 2) * kstep; const char* b2 = last ? nB : cB + (size_t)(t + 2) * kstep;
            const char* a3 = a2 + kstep; const char* b3 = b2 + kstep;
            unsigned o2[2][2];
            if constexpr (Sched::AFFINE) { const unsigned dd = last ? adelta : 0u; o2[0][0] = co[0][0] + dd; o2[0][1] = co[0][1] + dd; o2[1][0] = co[1][0] + dd; o2[1][1] = co[1][1] + dd; }
            else { o2[0][0] = last ? no[0][0] : co[0][0]; o2[0][1] = last ? no[0][1] : co[0][1]; o2[1][0] = last ? no[1][0] : co[1][0]; o2[1][1] = last ? no[1][1] : co[1][1]; }
            G8_LDB(B0, 0, 0); G8_SCHED; G8_LDA(At, 0, 0); G8_STAGE(G8_SA(1, 1), a1, co[1]);
            G8_WAIT_L(8); G8_BAR; G8_WAIT_L(0); G8_MMA(0, 0, At, B0); G8_BAR; G8_SCHED;
            G8_LDB(B1, 0, 1); G8_STAGE(G8_SB(0, 0), b2, voffB);
            G8_BAR; G8_WAIT_L(0); G8_MMA(0, 1, At, B1); G8_BAR;
            G8_LDA(At, 0, 1); G8_STAGE(G8_SA(0, 0), a2, o2[0]);
            G8_BAR; G8_WAIT_L(0); G8_MMA(1, 0, At, B0); G8_BAR; G8_SCHED;
            G8_STAGE(G8_SB(0, 1), b2 + hstep, voffB);
            G8_WAIT_V(6); G8_BAR; G8_MMA(1, 1, At, B1); G8_BAR;
            G8_LDB(B0, 1, 0); G8_SCHED; G8_LDA(At, 1, 0); G8_STAGE(G8_SA(0, 1), a2, o2[1]);
            G8_WAIT_L(8); G8_BAR; G8_WAIT_L(0); G8_MMA(0, 0, At, B0); G8_BAR; G8_SCHED;
            G8_LDB(B1, 1, 1); G8_STAGE(G8_SB(1, 0), b3, voffB);
            G8_BAR; G8_WAIT_L(0); G8_MMA(0, 1, At, B1); G8_BAR;
            G8_LDA(At, 1, 1); G8_STAGE(G8_SA(1, 0), a3, o2[0]);
            G8_BAR; G8_WAIT_L(0); G8_MMA(1, 0, At, B0); G8_BAR; G8_SCHED;
            G8_STAGE(G8_SB(1, 1), b3 + hstep, voffB);
            G8_WAIT_V(6); G8_BAR; G8_MMA(1, 1, At, B1); G8_BAR;
        }
        if constexpr (FP8) { __builtin_amdgcn_sched_barrier(0); asm volatile("s_nop 15\n\ts_nop 15" ::: "memory"); __builtin_amdgcn_sched_barrier(0); }
        { int fr2 = fr, fq2 = fq; asm volatile("" : "+v"(fr2), "+v"(fq2)); E(acc, cur, wr, wc, fr2, fq2); }
        if (!has_next) break;
#pragma unroll
        for (int a = 0; a < 2; ++a)
#pragma unroll
            for (int b = 0; b < 2; ++b)
#pragma unroll
                for (int m = 0; m < 4; ++m)
#pragma unroll
                    for (int n = 0; n < 2; ++n) acc[a][b][m][n] = (f32x4){0.f, 0.f, 0.f, 0.f};
        cur = nxt; cB = nB; ++ui;
        if constexpr (Sched::AFFINE) { co[0][0] += adelta; co[0][1] += adelta; co[1][0] += adelta; co[1][1] += adelta; }
        else { co[0][0] = no[0][0]; co[0][1] = no[0][1]; co[1][0] = no[1][0]; co[1][1] = no[1][1]; }
    }
    G8_WAIT_V(0);
    if (wr == 0) G8_BAR;
    G8_BAR;
#undef G8_SA
#undef G8_SB
#undef G8_STAGE
#undef G8_LD2
#undef G8_LDA
#undef G8_LDB
#undef G8_MMA
#undef G8_WAIT_V
#undef G8_WAIT_L
#undef G8_BAR
#undef G8_SCHED
}
__device__ __forceinline__ int xcd_major_block() { const int b = blockIdx.x, G = vG(); return ((G & 7) == 0) ? ((b & 7) * (G >> 3) + (b >> 3)) : b; }
}

__device__ __forceinline__ void phase_prologue0(const Params& p, char* lds) {
    const int tid = threadIdx.x, G = vG();
    {
        float* act = (float*)lds;
        float* part = (float*)(lds + 20480);
        float* MF = (float*)(p.ws + OFF_MF);
        for (int e = tid; e < 5 * 1024; e += 512) {
            const int v = e >> 10, kk = e & 1023;
            const float cv = (v < 4) ? p.c[v * D + kk] : p.c_ctx[kk];
            act[e] = cv / (1.0f + __expf(-cv));
        }
        __syncthreads();
        for (int it = blockIdx.x; it < 192; it += G) {
            const int i = it / 96, n0 = (it % 96) * 64, cg = tid & 15, kq = tid >> 4;
            const float* wp = p.mod_w + ((size_t)i * D + kq * 32) * 6144 + n0 + cg * 4;
            f32x4 a0 = {0.f, 0.f, 0.f, 0.f}, a1 = a0, a2 = a0, a3 = a0, a4 = a0;
#pragma unroll 8
            for (int kk = 0; kk < 32; ++kk) {
                const f32x4 wv = *(const f32x4*)(wp + (size_t)kk * 6144);
                const int k = kq * 32 + kk;
                a0 += act[k] * wv; a1 += act[1024 + k] * wv; a2 += act[2048 + k] * wv; a3 += act[3072 + k] * wv; a4 += act[4096 + k] * wv;
            }
            __syncthreads();
            *(f32x4*)(part + (kq * 5 + 0) * 64 + cg * 4) = a0; *(f32x4*)(part + (kq * 5 + 1) * 64 + cg * 4) = a1; *(f32x4*)(part + (kq * 5 + 2) * 64 + cg * 4) = a2;
            *(f32x4*)(part + (kq * 5 + 3) * 64 + cg * 4) = a3; *(f32x4*)(part + (kq * 5 + 4) * 64 + cg * 4) = a4;
            __syncthreads();
            if (tid < 320) {
                const int v = tid >> 6, c = tid & 63;
                float sum = p.mod_b[i * 6144 + n0 + c];
#pragma unroll 8
                for (int q = 0; q < 32; ++q) sum += part[(q * 5 + v) * 64 + c];
                MF[(size_t)(i * 5 + v) * 6144 + n0 + c] = sum;
            }
        }
    }
    {
        float* rope = (float*)(p.ws + OFF_ROPE);
        for (int e = blockIdx.x * 512 + tid; e < 1024; e += G * 512) {
            const int pos = e >> 4, i = e & 15;
            const float inv = powf(10000.0f, -(float)i / 16.0f);
            const float ang = (float)pos * inv;
            rope[e] = cosf(ang); rope[1024 + e] = sinf(ang);
        }
        float2* ABAR = (float2*)(p.ws + OFF_ABAR); float2* A64 = (float2*)(p.ws + OFF_A64);
        bf16_t* CM = (bf16_t*)(p.ws + OFF_CMAT);
        for (int e = blockIdx.x * 512 + tid; e < 4096; e += G * 512) {
            const int dg = e >> 6;
            const float lre = p.s5_lam_re[e], lim = p.s5_lam_im[e];
            const float dt = expf(p.s5_log_dt[dg]);
            const float mag = expf(lre * dt);
            float sn, cs; sincosf(lim * dt, &sn, &cs);
            const float ar = mag * cs, ai = mag * sn;
            ABAR[e] = make_float2(ar, ai);
            float pr = ar, pi = ai;
#pragma unroll
            for (int q = 0; q < 6; ++q) { const float nr = pr * pr - pi * pi, ni = 2.0f * pr * pi; pr = nr; pi = ni; }
            A64[e] = make_float2(pr, pi);
            const float nr = ar - 1.0f, ni = ai, den = lre * lre + lim * lim;
            const float cr = (nr * lre + ni * lim) / den, ci = (ni * lre - nr * lim) / den;
            const int pidx = e & 63;
            bf16_t* bt = (bf16_t*)(p.ws + OFF_BBAR) + ((size_t)dg * 128 + 2 * pidx) * 16;
#pragma unroll
            for (int h = 0; h < 16; ++h) {
                const float br = p.s5_b_re[(size_t)e * 16 + h], bi = p.s5_b_im[(size_t)e * 16 + h];
                const unsigned pk = pack2(cr * br - ci * bi, cr * bi + ci * br);
                bt[h] = (bf16_t)(pk & 0xffffu); bt[16 + h] = (bf16_t)(pk >> 16);
            }
        }
        for (int e = blockIdx.x * 512 + tid; e < 64 * 16 * 128; e += G * 512) {
            const int k = e & 127, dgh = e >> 7, pp = k >> 1;
            const float v = (k & 1) ? -p.s5_c_im[(size_t)dgh * 64 + pp] : p.s5_c_re[(size_t)dgh * 64 + pp];
            CM[e] = (bf16_t)(pack2(v, 0.f) & 0xffffu);
        }
    }
}

template <bool FP8>
__device__ __forceinline__ void conv_matrices(const float* src, int nmat, int K, int N, int Npad, bf16_t* dst, bool perm, int& base, char* lds) {
    const int tid = threadIdx.x, G = vG();
    const int tk = K >> 6, tn = Npad >> 8, per = tk * tn, total = nmat * per;
    float* T = (float*)lds;
    int start = (int)(((long)blockIdx.x - (long)(base % G) + G) % G);
    f32x4 rv[8];
    auto issue = [&](int ti) {
        const int mat = ti / per, r = ti % per, kt = r / tn, nt = r % tn;
        const float* S = src + (size_t)mat * K * N + (size_t)(kt * 64) * N + nt * 256 + (tid & 63) * 4;
        const bool ok = nt * 256 + (tid & 63) * 4 < N;
#pragma unroll
        for (int i = 0; i < 8; ++i) {
            rv[i] = (f32x4){0.f, 0.f, 0.f, 0.f};
            if (ok) rv[i] = __builtin_nontemporal_load((const f32x4*)(S + (size_t)((tid >> 6) + 8 * i) * N));
        }
    };
    if (start < total) issue(start);
    for (int ti = start; ti < total; ti += G) {
        const int mat = ti / per, r = ti % per, kt = r / tn, nt = r % tn;
        bf16_t* Dm = dst + (size_t)mat * Npad * K;
        const int k0 = kt * 64, n0 = nt * 256;
        __syncthreads();
#pragma unroll
        for (int i = 0; i < 8; ++i) *(f32x4*)(T + ((tid >> 6) + 8 * i) * 260 + (tid & 63) * 4) = rv[i];
        __syncthreads();
        if (ti + G < total) issue(ti + G);
        const int n = tid >> 1, kh = tid & 1;
        int drow = n0 + n;
        if (perm) { const int up = drow >> 10, jj = drow & 1023; drow = ((jj >> 4) << 5) + (up << 4) + (jj & 15); }
        if constexpr (FP8) {
            unsigned pk[8];
#pragma unroll
            for (int j = 0; j < 8; ++j) pk[j] = pack4_fp8(64.f * T[(kh * 32 + 4 * j) * 260 + n], 64.f * T[(kh * 32 + 4 * j + 1) * 260 + n], 64.f * T[(kh * 32 + 4 * j + 2) * 260 + n], 64.f * T[(kh * 32 + 4 * j + 3) * 260 + n]);
            uint4* dp = (uint4*)((char*)dst + (size_t)mat * Npad * K + (size_t)drow * K + k0 + kh * 32);
            dp[0] = make_uint4(pk[0], pk[1], pk[2], pk[3]); dp[1] = make_uint4(pk[4], pk[5], pk[6], pk[7]);
        } else {
            unsigned pk[16];
#pragma unroll
            for (int j = 0; j < 16; ++j) pk[j] = pack2(T[(kh * 32 + 2 * j) * 260 + n], T[(kh * 32 + 2 * j + 1) * 260 + n]);
            uint4* dp = (uint4*)(Dm + (size_t)drow * K + k0 + kh * 32);
            dp[0] = make_uint4(pk[0], pk[1], pk[2], pk[3]); dp[1] = make_uint4(pk[4], pk[5], pk[6], pk[7]);
            dp[2] = make_uint4(pk[8], pk[9], pk[10], pk[11]); dp[3] = make_uint4(pk[12], pk[13], pk[14], pk[15]);
        }
    }
    base += total;
}
__device__ __forceinline__ void phase_prologue1(const Params& p, char* lds) {
    const int tid = threadIdx.x, G = vG();
    int base = 0;
    conv_matrices<false>(p.rec_w_in, 1, 1024, 2080, 2304, (bf16_t*)(p.ws + OFF_WRI), false, base, lds);
    conv_matrices<false>(p.rec_w_out, 1, 1024, 1024, 1024, (bf16_t*)(p.ws + OFF_WRO), false, base, lds);
    conv_matrices<false>(p.s5_glu_w, 1, 512, 512, 512, (bf16_t*)(p.ws + OFF_WGLU), false, base, lds);
    conv_matrices<false>(p.mla_w_down, 1, 1024, 704, DNW, (bf16_t*)(p.ws + OFF_WDN), false, base, lds);
    conv_matrices<false>(p.mla_w_uq, 1, 384, 1536, 1536, (bf16_t*)(p.ws + OFF_WUQ), false, base, lds);
    conv_matrices<false>(p.mla_w_ukv, 1, 256, 2048, 2048, (bf16_t*)(p.ws + OFF_WUKV), false, base, lds);
    conv_matrices<false>(p.mla_w_o, 1, 1024, 1024, 1024, (bf16_t*)(p.ws + OFF_WO), false, base, lds);
}

constexpr int CV_TILES_IN = 32 * 16 * 8, CV_TILES_OUT = 32 * 16 * 4, CV_TILES_SET = CV_TILES_IN + CV_TILES_OUT;
constexpr size_t OFF_TICKET = OFF_CNT + 1024;
constexpr int N_COMPUTE = 208;
struct CvTile { const float* S; char* dst; int N, k0, drow, f8; };
__device__ __forceinline__ CvTile cv_decode(const Params& p, int tg) {
    const int tid = threadIdx.x, set = tg / CV_TILES_SET, t = tg % CV_TILES_SET;
    const bool is_in = t < CV_TILES_IN; const int tt = is_in ? t : t - CV_TILES_IN;
    const int N = is_in ? 2048 : 1024, tn = N >> 8, per = 16 * tn;
    const int mat = set * NE + tt / per, r = tt % per, kt = r / tn, nt = r % tn, k0 = kt * 64, n0 = nt * 256;
    CvTile c; c.N = N; c.k0 = k0;
    c.S = (is_in ? p.exp_w_in : p.exp_w_out) + (size_t)mat * 1024 * N + (size_t)k0 * N + n0 + (tid & 63) * 4;
    int drow = n0 + (tid >> 1);
    if (is_in) { const int up = drow >> 10, jj = drow & 1023; drow = ((jj >> 4) << 5) + (up << 4) + (jj & 15); }
    c.drow = drow; c.f8 = is_in ? (FP8_G1 != 0) : (FP8_G2 != 0);
    c.dst = p.ws + (is_in ? OFF_EWI : OFF_EWO) + (size_t)mat * N * 1024 * (c.f8 ? 1 : 2);
    return c;
}
__device__ __forceinline__ void cv_load(const CvTile& c, f32x4 (&rv)[8]) {
#pragma unroll
    for (int i = 0; i < 8; ++i) rv[i] = __builtin_nontemporal_load((const f32x4*)(c.S + (size_t)((threadIdx.x >> 6) + 8 * i) * c.N));
}
__device__ __forceinline__ void cv_to_lds(const f32x4 (&rv)[8], float* T) {
#pragma unroll
    for (int i = 0; i < 8; ++i) *(f32x4*)(T + ((threadIdx.x >> 6) + 8 * i) * 260 + (threadIdx.x & 63) * 4) = rv[i];
}
__device__ __forceinline__ void cv_store(const CvTile& c, const float* T) {
    const int n = threadIdx.x >> 1, kh = threadIdx.x & 1;
    if (c.f8) {
        unsigned pk[8];
#pragma unroll
        for (int j = 0; j < 8; ++j) pk[j] = pack4_fp8(64.f * T[(kh * 32 + 4 * j) * 260 + n], 64.f * T[(kh * 32 + 4 * j + 1) * 260 + n], 64.f * T[(kh * 32 + 4 * j + 2) * 260 + n], 64.f * T[(kh * 32 + 4 * j + 3) * 260 + n]);
        uint4* dp = (uint4*)(c.dst + (size_t)c.drow * 1024 + c.k0 + kh * 32);
        dp[0] = make_uint4(pk[0], pk[1], pk[2], pk[3]); dp[1] = make_uint4(pk[4], pk[5], pk[6], pk[7]);
    } else {
        unsigned pk[16];
#pragma unroll
        for (int j = 0; j < 16; ++j) pk[j] = pack2(T[(kh * 32 + 2 * j) * 260 + n], T[(kh * 32 + 2 * j + 1) * 260 + n]);
        uint4* dp = (uint4*)(c.dst + ((size_t)c.drow * 1024 + c.k0 + kh * 32) * 2);
        dp[0] = make_uint4(pk[0], pk[1], pk[2], pk[3]); dp[1] = make_uint4(pk[4], pk[5], pk[6], pk[7]);
        dp[2] = make_uint4(pk[8], pk[9], pk[10], pk[11]); dp[3] = make_uint4(pk[12], pk[13], pk[14], pk[15]);
    }
}
__device__ __forceinline__ void convert_static(const Params& p, int base, int c, int stride, int count, int hi, char* lds) {
    float* T = (float*)lds;
    __syncthreads();
    int t = base + c;
    if (count <= 0 || t >= hi) return;
    f32x4 rv[8];
    CvTile cur = cv_decode(p, t);
    cv_load(cur, rv);
    for (int i = 0; i < count; ++i) {
        const int tn = t + stride;
        const bool more = (i + 1 < count) && (tn < hi);
        cv_to_lds(rv, T);
        __syncthreads();
        CvTile nxt = cur;
        if (more) { nxt = cv_decode(p, tn); cv_load(nxt, rv); }
        cv_store(cur, T);
        if (!more) break;
        cur = nxt; t = tn;
        __syncthreads();
    }
}
constexpr int CV3_NC = 204, CV3_Q = 26, CV7_NC = 136, CV7_Q = 4, CV8_NC = 136, CV8_Q = 18, CV13_NC = 204, CV13_Q = 8, CV15_NC = 192, CV15_Q = 14;
constexpr int CV_B3 = 0, CV_B7 = CV_B3 + (256 - CV3_NC) * CV3_Q, CV_B8 = CV_B7 + (256 - CV7_NC) * CV7_Q, CV_B9 = CV_B8 + (256 - CV8_NC) * CV8_Q;
constexpr int CV_B13 = CV_TILES_SET, CV_B15 = CV_B13 + (256 - CV13_NC) * CV13_Q, CV_B17 = CV_B15 + (256 - CV15_NC) * CV15_Q;
static_assert(CV_B9 <= CV_TILES_SET && CV_B17 <= 2 * CV_TILES_SET, "conversion quotas exceed the tile sets");

__device__ __forceinline__ void load_row(const float* rp, int lane, float4 (&v)[4]) {
#pragma unroll
    for (int j = 0; j < 4; ++j) v[j] = *(const float4*)(rp + 4 * lane + 256 * j);
}
__device__ __forceinline__ float row_rstd(const float4 (&v)[4]) {
    float ss = 0.f;
#pragma unroll
    for (int j = 0; j < 4; ++j) ss += v[j].x * v[j].x + v[j].y * v[j].y + v[j].z * v[j].z + v[j].w * v[j].w;
    ss = wave_sum(ss);
    return rsqrtf(ss * (1.0f / 1024.0f) + EPS);
}
__device__ __forceinline__ void modulate_store(const float4 (&v)[4], float rstd, const float* g, const float* shift, const float* scale,
                                               bf16_t* dst, int lane, float4 (&o)[4]) {
#pragma unroll
    for (int j = 0; j < 4; ++j) {
        const int col = 4 * lane + 256 * j;
        const float4 gg = *(const float4*)(g + col), sh = *(const float4*)(shift + col), sc = *(const float4*)(scale + col);
        o[j].x = v[j].x * rstd * gg.x * (1.0f + sc.x) + sh.x; o[j].y = v[j].y * rstd * gg.y * (1.0f + sc.y) + sh.y;
        o[j].z = v[j].z * rstd * gg.z * (1.0f + sc.z) + sh.z; o[j].w = v[j].w * rstd * gg.w * (1.0f + sc.w) + sh.w;
        *(uint2*)(dst + col) = make_uint2(pack2(o[j].x, o[j].y), pack2(o[j].z, o[j].w));
    }
}
__device__ __forceinline__ const float* input_row(const Params& p, int r) { const int b = r / SB, s = r % SB; return (s < CTXL) ? p.ctx + ((size_t)b * CTXL + s) * D : p.x + ((size_t)b * SEQ + (s - CTXL)) * D; }
__device__ __forceinline__ int row_modv(int r) { const int b = r / SB, s = r % SB; return (s < CTXL) ? 4 : b; }

__device__ __forceinline__ void phase_prenorm(const Params& p, int L) {
    const int lane = threadIdx.x & 63, gw = blockIdx.x * 8 + (threadIdx.x >> 6), GW = vG() * 8;
    const float* xs = (const float*)(p.ws + OFF_XS); bf16_t* HB = (bf16_t*)(p.ws + OFF_HB);
    const float* MF = (const float*)(p.ws + OFF_MF);
    for (int r = gw; r < NT; r += GW) {
        float4 v[4], o[4]; load_row(L == 0 ? input_row(p, r) : xs + (size_t)r * D, lane, v);
        const float rstd = row_rstd(v);
        const float* mv = MF + (size_t)(L * 5 + row_modv(r)) * 6144;
        modulate_store(v, rstd, p.norm_mix_pre + L * D, mv, mv + 1024, HB + (size_t)r * D, lane, o);
    }
}

struct EpiBf16 {
    bf16_t* O; int ld; int row0, col0;
    __device__ __forceinline__ void operator()(const f32x4 (&acc)[4][4], int wm, int wn, int lane) const {
#pragma unroll
        for (int m = 0; m < 4; ++m) {
            bf16_t* rp = O + (size_t)(row0 + wm * 64 + m * 16 + (lane & 15)) * ld + col0 + wn * 64 + 4 * (lane >> 4);
#pragma unroll
            for (int n = 0; n < 4; ++n) *(uint2*)(rp + n * 16) = make_uint2(pack2(acc[m][n][0], acc[m][n][1]), pack2(acc[m][n][2], acc[m][n][3]));
        }
    }
};
struct EpiF32 {
    float* O; int ld; int row0, col0;
    __device__ __forceinline__ void operator()(const f32x4 (&acc)[4][4], int wm, int wn, int lane) const {
#pragma unroll
        for (int m = 0; m < 4; ++m) {
            float* rp = O + (size_t)(row0 + wm * 64 + m * 16 + (lane & 15)) * ld + col0 + wn * 64 + 4 * (lane >> 4);
#pragma unroll
            for (int n = 0; n < 4; ++n) *(f32x4*)(rp + n * 16) = acc[m][n];
        }
    }
};
struct EpiGlu {
    bf16_t* MIX; const bf16_t* Y; const float* bias; int row0, col0;
    __device__ __forceinline__ void operator()(const f32x4 (&acc)[4][4], int wm, int wn, int lane) const {
#pragma unroll
        for (int m = 0; m < 4; ++m) {
            const int row = row0 + wm * 64 + m * 16 + (lane & 15);
#pragma unroll
            for (int n = 0; n < 4; ++n) {
                const int col = col0 + wn * 64 + n * 16 + 4 * (lane >> 4);
                const uint2 yv = *(const uint2*)(Y + (size_t)row * 512 + col);
                const f32x4 bb = *(const f32x4*)(bias + col);
                const float y0 = lo_bf(yv.x), y1 = hi_bf(yv.x), y2 = lo_bf(yv.y), y3 = hi_bf(yv.y);
                const float o0 = y0 * sigmoidf_(acc[m][n][0] + bb[0]), o1 = y1 * sigmoidf_(acc[m][n][1] + bb[1]);
                const float o2 = y2 * sigmoidf_(acc[m][n][2] + bb[2]), o3 = y3 * sigmoidf_(acc[m][n][3] + bb[3]);
                *(uint2*)(MIX + (size_t)row * D + 512 + col) = make_uint2(pack2(o0, o1), pack2(o2, o3));
            }
        }
    }
};
struct EpiMoe1 {
    bf16_t* ACT; const float* bin; int prow0, tn;
    __device__ __forceinline__ void operator()(const f32x4 (&acc)[4][4], int wm, int wn, int lane) const {
#pragma unroll
        for (int m = 0; m < 4; ++m) {
            const int row = prow0 + wm * 64 + m * 16 + (lane & 15);
#pragma unroll
            for (int h = 0; h < 2; ++h) {
                const int j0 = 64 * tn + 32 * wn + 16 * h + 4 * (lane >> 4);
                const f32x4 bg = *(const f32x4*)(bin + j0), bu = *(const f32x4*)(bin + 1024 + j0);
                float o[4];
#pragma unroll
                for (int q = 0; q < 4; ++q) {
                    float gt = acc[m][2 * h][q] + bg[q], up = acc[m][2 * h + 1][q] + bu[q];
                    gt = fminf(gt, 7.0f); up = fminf(fmaxf(up, -7.0f), 7.0f);
                    o[q] = (up + 1.0f) * gt * sigmoidf_(1.702f * gt);
                }
                *(uint2*)(ACT + (size_t)row * D + j0) = make_uint2(pack2(o[0], o[1]), pack2(o[2], o[3]));
            }
        }
    }
};
struct EpiBf16Bias {
    bf16_t* O; const float* bias; int row0, col0;
    __device__ __forceinline__ void operator()(const f32x4 (&acc)[4][4], int wm, int wn, int lane) const {
#pragma unroll
        for (int m = 0; m < 4; ++m) {
            bf16_t* rp = O + (size_t)(row0 + wm * 64 + m * 16 + (lane & 15)) * D;
#pragma unroll
            for (int n = 0; n < 4; ++n) {
                const int col = col0 + wn * 64 + n * 16 + 4 * (lane >> 4);
                const f32x4 bb = *(const f32x4*)(bias + col);
                *(uint2*)(rp + col) = make_uint2(pack2(acc[m][n][0] + bb[0], acc[m][n][1] + bb[1]), pack2(acc[m][n][2] + bb[2], acc[m][n][3] + bb[3]));
            }
        }
    }
};

__device__ __forceinline__ void phase_gemm_recin(const Params& p, char* lds) {
    const bf16_t* A = (const bf16_t*)(p.ws + OFF_HB); const bf16_t* Bt = (const bf16_t*)(p.ws + OFF_WRI); bf16_t* O = (bf16_t*)(p.ws + OFF_PB);
    const int nN = PW / 128, nunits = (NT / 256) * nN;
    for (int u = blockIdx.x; u < nunits; u += vG()) {
        const int mt = u / nN, tn = u % nN;
        EpiBf16 epi{O, PW, mt * 256, tn * 128};
        gemm_dense<true>(A, D, mt * 256, Bt, D, tn * 128, D, lds, epi);
    }
}
__device__ __forceinline__ void phase_gemm_glu(const Params& p, char* lds) {
    const bf16_t* A = (const bf16_t*)(p.ws + OFF_Y); const bf16_t* Bt = (const bf16_t*)(p.ws + OFF_WGLU);
    const int nunits = (NT / 256) * 4;
    for (int u = blockIdx.x; u < nunits; u += vG()) {
        const int mt = u >> 2, tn = u & 3;
        EpiGlu epi{(bf16_t*)(p.ws + OFF_MIX), A, p.s5_glu_b, mt * 256, tn * 128};
        gemm_dense<true>(A, 512, mt * 256, Bt, 512, tn * 128, 512, lds, epi);
    }
}
__device__ __forceinline__ void phase_gemm_out(const Params& p, size_t offA, size_t offW, bool xonly, char* lds) {
    const bf16_t* A = (const bf16_t*)(p.ws + offA); const bf16_t* Bt = (const bf16_t*)(p.ws + offW); float* O = (float*)(p.ws + OFF_YX);
    const int nmt = xonly ? 64 : 68, nunits = nmt * 8;
    for (int u = blockIdx.x; u < nunits; u += vG()) {
        const int mi = u >> 3, tn = u & 7;
        const int row0 = xonly ? ((mi >> 4) * SB + ((mi & 15) + 1) * 256) : mi * 256;
        EpiF32 epi{O, D, row0, tn * 128};
        gemm_dense<true>(A, D, row0, Bt, D, tn * 128, D, lds, epi);
    }
}

__device__ __forceinline__ void phase_postmix(const Params& p, int L, bool xonly, char* lds) {
    const int tid = fresh_tid(), lane = tid & 63, gw = blockIdx.x * 8 + (tid >> 6), GW = vG() * 8;
    float* rwT = (float*)lds;
    const float* rw = p.router_w + (size_t)L * D * NE;
    for (int e = tid; e < D * NE; e += 512) rwT[(e & 31) * 1024 + (e >> 5)] = rw[e];
    __syncthreads();
    float* __restrict__ xs = (float*)(p.ws + OFF_XS); bf16_t* __restrict__ HB = (bf16_t*)(p.ws + OFF_HB);
    const float* __restrict__ MF = (const float*)(p.ws + OFF_MF);
    int* CNT = (int*)(p.ws + OFF_CNT) + L * NE; int* __restrict__ LIST = (int*)(p.ws + OFF_LIST);
    int* SE = (int*)(p.ws + OFF_SE); int* SP = (int*)(p.ws + OFF_SP); float* GT = (float*)(p.ws + OFF_GT);
    const float* gpost = p.norm_mix_post + L * D; const float* gpre = p.norm_ffn_pre + L * D;
    const float rbias = p.router_b[L * NE + ((lane >> 1) & 31)];
    const int nrows = xonly ? NB * SEQ : NT;
#pragma unroll 1
    for (int ri = gw; ri < nrows; ri += GW) {
        const int r = xonly ? ((ri >> 12) * SB + CTXL + (ri & 4095)) : ri;
        const float* mv = MF + (size_t)(L * 5 + row_modv(r)) * 6144;
        float4 y[4], xv[4], f[4];
        {
            const bf16_t* yp = (const bf16_t*)(p.ws + OFF_YX) + (size_t)r * D;
#pragma unroll
            for (int j = 0; j < 4; ++j) { const uint2 t = *(const uint2*)(yp + 4 * lane + 256 * j); y[j] = make_float4(lo_bf(t.x), hi_bf(t.x), lo_bf(t.y), hi_bf(t.y)); }
        }
        load_row(L == 0 ? input_row(p, r) : xs + (size_t)r * D, lane, xv);
        const float rs1 = row_rstd(y);
#pragma unroll
        for (int j = 0; j < 4; ++j) {
            const int col = 4 * lane + 256 * j;
            const float4 gg = *(const float4*)(gpost + col), g2 = *(const float4*)(mv + 2048 + col);
            xv[j].x += g2.x * (y[j].x * rs1 * gg.x); xv[j].y += g2.y * (y[j].y * rs1 * gg.y);
            xv[j].z += g2.z * (y[j].z * rs1 * gg.z); xv[j].w += g2.w * (y[j].w * rs1 * gg.w);
            *(float4*)(xs + (size_t)r * D + col) = xv[j];
        }
        const float rs2 = row_rstd(xv);
        modulate_store(xv, rs2, gpre, mv + 3 * 1024, mv + 4 * 1024, HB + (size_t)r * D, lane, f);
        if (FP8_G1) {
#pragma unroll
            for (int j = 0; j < 4; ++j) *(unsigned*)(p.ws + OFF_HB8 + (size_t)r * D + 4 * lane + 256 * j) = pack4_fp8(f[j].x, f[j].y, f[j].z, f[j].w);
        }
        float pl[32];
#pragma unroll
        for (int e = 0; e < NE; ++e) {
            float s = 0.f;
#pragma unroll
            for (int j = 0; j < 4; ++j) {
                const float4 wv = *(const float4*)(rwT + e * 1024 + 4 * lane + 256 * j);
                s += f[j].x * wv.x + f[j].y * wv.y + f[j].z * wv.z + f[j].w * wv.w;
            }
            pl[e] = s;
            asm volatile("" ::: "memory");
        }
#pragma unroll
        for (int i = 0; i < 16; ++i) { const bool up = (lane & 32) != 0; const float snd = up ? pl[i] : pl[i + 16], kp = up ? pl[i + 16] : pl[i]; pl[i] = kp + __shfl_xor(snd, 32); }
#pragma unroll
        for (int i = 0; i < 8; ++i) { const bool up = (lane & 16) != 0; const float snd = up ? pl[i] : pl[i + 8], kp = up ? pl[i + 8] : pl[i]; pl[i] = kp + __shfl_xor(snd, 16); }
#pragma unroll
        for (int i = 0; i < 4; ++i) { const bool up = (lane & 8) != 0; const float snd = up ? pl[i] : pl[i + 4], kp = up ? pl[i + 4] : pl[i]; pl[i] = kp + __shfl_xor(snd, 8); }
#pragma unroll
        for (int i = 0; i < 2; ++i) { const bool up = (lane & 4) != 0; const float snd = up ? pl[i] : pl[i + 2], kp = up ? pl[i + 2] : pl[i]; pl[i] = kp + __shfl_xor(snd, 4); }
        { const bool up = (lane & 2) != 0; const float snd = up ? pl[0] : pl[1], kp = up ? pl[1] : pl[0]; pl[0] = kp + __shfl_xor(snd, 2); }
        const int myexp = (lane >> 1) & 31;
        float mylogit = pl[0] + __shfl_xor(pl[0], 1) + rbias;
        float tv[4]; int tix[4];
#pragma unroll
        for (int k = 0; k < 4; ++k) {
            float v = mylogit; int idx = myexp;
#pragma unroll
            for (int o = 32; o >= 2; o >>= 1) {
                const float ov = __shfl_xor(v, o); const int oi = __shfl_xor(idx, o);
                if (ov > v || (ov == v && oi < idx)) { v = ov; idx = oi; }
            }
            tv[k] = v; tix[k] = idx;
            if (myexp == idx) mylogit = -3.0e38f;
        }
        const float e1 = __expf(tv[1] - tv[0]), e2 = __expf(tv[2] - tv[0]), e3 = __expf(tv[3] - tv[0]);
        const float inv = 1.0f / (1.0f + e1 + e2 + e3);
        if (lane < 4) {
            const int ex = lane == 0 ? tix[0] : lane == 1 ? tix[1] : lane == 2 ? tix[2] : tix[3];
            const float gtv = (lane == 0 ? 1.0f : lane == 1 ? e1 : lane == 2 ? e2 : e3) * inv;
            const int pos = atomicAdd(&CNT[ex], 1);
            LIST[(size_t)ex * NT + pos] = r;
            SE[r * 4 + lane] = ex; SP[r * 4 + lane] = pos; GT[r * 4 + lane] = gtv;
        }
    }
}

__device__ __forceinline__ void moe_prefix(const Params& p, int L, int* tp) {
    if (threadIdx.x == 0) {
        unsigned* CNT = (unsigned*)(p.ws + OFF_CNT) + L * NE;
        int s = 0; tp[0] = 0;
        for (int e = 0; e < NE; ++e) { const int c = (int)xb_ld(&CNT[e]); tp[33 + e] = c; s += (c + 255) >> 8; tp[e + 1] = s; }
    }
    __syncthreads();
}
__device__ __forceinline__ void phase_moe1(const Params& p, int L, char* lds) {
    int* tp = (int*)(lds + 2 * G_STAGE);
    moe_prefix(p, L, tp);
    const int tid = threadIdx.x, srow = tid >> 3, sch = (tid & 7) * 8;
    const bf16_t* HB = (const bf16_t*)(p.ws + OFF_HB); const int* LIST = (const int*)(p.ws + OFF_LIST);
    const int nunits = tp[32] * 16;
    for (int u = blockIdx.x; u < nunits; u += vG()) {
        const int mtg = u >> 4, tn = u & 15;
        int e = 0; while (tp[e + 1] <= mtg) ++e;
        const int mt = mtg - tp[e], cnt = tp[33 + e];
        const int* le = LIST + (size_t)e * NT;
        const bf16_t* ap[4];
#pragma unroll
        for (int j = 0; j < 4; ++j) { const int pos = mt * 256 + srow + 64 * j; const int tok = le[pos < cnt ? pos : 0]; ap[j] = HB + (size_t)tok * D + sch; }
        const bf16_t* b = (const bf16_t*)(p.ws + OFF_EWI) + ((size_t)(L * NE + e) * 2048 + tn * 128 + srow) * D + sch;
        EpiMoe1 epi{(bf16_t*)(p.ws + OFF_ACT), p.exp_b_in + (size_t)(L * NE + e) * 2048, mtg * 256, tn};
        gemm_tile<true>(ap[0], ap[1], ap[2], ap[3], b, b + (size_t)64 * D, D, lds, epi);
    }
}
__device__ __forceinline__ void phase_moe2(const Params& p, int L, char* lds) {
    int* tp = (int*)(lds + 2 * G_STAGE);
    moe_prefix(p, L, tp);
    const int nunits = tp[32] * 8;
    for (int u = blockIdx.x; u < nunits; u += vG()) {
        const int mtg = u >> 3, tn = u & 7;
        int e = 0; while (tp[e + 1] <= mtg) ++e;
        EpiBf16Bias epi{(bf16_t*)(p.ws + OFF_YR), p.exp_b_out + (size_t)(L * NE + e) * D, mtg * 256, tn * 128};
        gemm_dense<true>((const bf16_t*)(p.ws + OFF_ACT), D, mtg * 256, (const bf16_t*)(p.ws + OFF_EWO) + (size_t)(L * NE + e) * D * D, D, tn * 128, D, lds, epi);
    }
}
constexpr int G8_TAB = g8::STAGE_BYTES, G8_TP = g8::STAGE_BYTES + 16384;
constexpr int G8_NSLOT = 16;
template <bool GATHER>
struct SchedMoe8 {
    static constexpr bool AFFINE = !GATHER;
    const int* tp; const unsigned* tab; const int* list; const char* Bbase; size_t bexp; int ntn_sh, rowB, x, j, bpx; int tx1, tx2, tx3, tx4;
    __device__ __forceinline__ void init(const int* tp_, const unsigned* tab_, const int* list_, const char* Bbase_, size_t bexp_, int ntn_sh_, int rowB_) {
        tp = tp_; tab = tab_; list = list_; Bbase = Bbase_; bexp = bexp_; ntn_sh = ntn_sh_; rowB = rowB_;
        const int cblk = g8::xcd_major_block(); bpx = vG() >> 3; x = cblk / bpx; j = cblk % bpx;
        tx1 = tp[x + 1] - tp[x]; tx2 = tx1 + tp[x + 9] - tp[x + 8]; tx3 = tx2 + tp[x + 17] - tp[x + 16]; tx4 = tx3 + tp[x + 25] - tp[x + 24];
    }
    __device__ __forceinline__ bool next(int i, g8::Unit& u) const {
        const int l = i * bpx + j, tl = l >> ntn_sh, tn = l & ((1 << ntn_sh) - 1);
        if (tl >= tx4) return false;
        const int k = (tl >= tx1) + (tl >= tx2) + (tl >= tx3), e = x + 8 * k;
        const int mt = tl - (k == 0 ? 0 : k == 1 ? tx1 : k == 2 ? tx2 : tx3);
        u.B = Bbase + (size_t)e * bexp + (size_t)tn * 256 * rowB; u.row0 = (tp[e] + mt) * 256; u.tn = tn; u.e = e; u.slot = i; return true;
    }
    __device__ __forceinline__ void aoff(const g8::Unit& u, const int (&R)[2], const int (&C)[2], unsigned (&o)[2][2]) const {
#pragma unroll
        for (int h = 0; h < 2; ++h)
#pragma unroll
            for (int i = 0; i < 2; ++i) {
                if (GATHER) {
                    unsigned ro;
                    if (u.slot < G8_NSLOT) ro = tab[u.slot * 256 + h * 128 + R[i]];
                    else { const int pos = u.row0 - tp[u.e] * 256 + h * 128 + R[i]; ro = (unsigned)list[(size_t)u.e * NT + (pos < tp[33 + u.e] ? pos : 0)] * (unsigned)rowB; }
                    o[h][i] = ro + (unsigned)C[i] * 2u;
                } else o[h][i] = (unsigned)((u.row0 + h * 128 + R[i]) * rowB + C[i] * 2);
            }
    }
};
struct SchedDense8 {
    static constexpr bool AFFINE = true;
    const char* Bbase; int nunits, ntn, rowB, G, cblk;
    __device__ __forceinline__ bool next(int i, g8::Unit& u) const {
        const int L = i * G + cblk; if (L >= nunits) return false;
        const int mt = L / ntn, tn = L % ntn;
        u.B = Bbase + (size_t)tn * 256 * rowB; u.row0 = mt * 256; u.tn = tn; u.e = 0; u.slot = i; return true;
    }
    __device__ __forceinline__ void aoff(const g8::Unit& u, const int (&R)[2], const int (&C)[2], unsigned (&o)[2][2]) const {
#pragma unroll
        for (int h = 0; h < 2; ++h)
#pragma unroll
            for (int i = 0; i < 2; ++i) o[h][i] = (unsigned)((u.row0 + h * 128 + R[i]) * rowB + C[i] * 2);
    }
};
template <bool OUT8>
struct EpiMoe1_8 {
    bf16_t* ACT; const float* bin_all; float sc;
    __device__ __forceinline__ void operator()(const f32x4 (&acc)[2][2][4][2], const g8::Unit& u, int wr, int wc, int fr, int fq) const {
        const float* bin = bin_all + (size_t)u.e * 2048;
#pragma unroll
        for (int bj = 0; bj < 2; ++bj) {
            const int j0 = 128 * u.tn + 64 * bj + 16 * wc + 4 * fq;
            const f32x4 bg = *(const f32x4*)(bin + j0), bu = *(const f32x4*)(bin + 1024 + j0);
#pragma unroll
            for (int ai = 0; ai < 2; ++ai)
#pragma unroll
                for (int m = 0; m < 4; ++m) {
                    const int row = u.row0 + 128 * ai + 64 * wr + 16 * m + fr;
                    float o[4];
#pragma unroll
                    for (int q = 0; q < 4; ++q) {
                        float gt = acc[ai][bj][m][0][q] * sc + bg[q], up = acc[ai][bj][m][1][q] * sc + bu[q];
                        gt = fminf(gt, 7.0f); up = fminf(fmaxf(up, -7.0f), 7.0f);
                        o[q] = (up + 1.0f) * gt * sigmoidf_(1.702f * gt);
                    }
                    if constexpr (OUT8) *(unsigned*)((char*)ACT + (size_t)row * D + j0) = pack4_fp8(o[0], o[1], o[2], o[3]);
                    else *(uint2*)(ACT + (size_t)row * D + j0) = make_uint2(pack2(o[0], o[1]), pack2(o[2], o[3]));
                }
        }
    }
};
struct EpiBias8 {
    bf16_t* O; const float* bias_all; float sc;
    __device__ __forceinline__ void operator()(const f32x4 (&acc)[2][2][4][2], const g8::Unit& u, int wr, int wc, int fr, int fq) const {
        const float* bias = bias_all + (size_t)u.e * D;
#pragma unroll
        for (int bj = 0; bj < 2; ++bj)
#pragma unroll
            for (int n = 0; n < 2; ++n) {
                const int col = 256 * u.tn + 128 * bj + 32 * wc + 16 * n + 4 * fq;
                const f32x4 bb = *(const f32x4*)(bias + col);
#pragma unroll
                for (int ai = 0; ai < 2; ++ai)
#pragma unroll
                    for (int m = 0; m < 4; ++m) {
                        const int row = u.row0 + 128 * ai + 64 * wr + 16 * m + fr;
                        const f32x4 v = acc[ai][bj][m][n] * sc + bb;
                        *(uint2*)(O + (size_t)row * D + col) = make_uint2(pack2(v[0], v[1]), pack2(v[2], v[3]));
                    }
            }
    }
};
struct EpiBf16_8 {
    bf16_t* O; int ld, ncols;
    __device__ __forceinline__ void operator()(const f32x4 (&acc)[2][2][4][2], const g8::Unit& u, int wr, int wc, int fr, int fq) const {
#pragma unroll
        for (int bj = 0; bj < 2; ++bj)
#pragma unroll
            for (int n = 0; n < 2; ++n) {
                const int col = 256 * u.tn + 128 * bj + 32 * wc + 16 * n + 4 * fq;
                if (col < ncols) {
#pragma unroll
                    for (int ai = 0; ai < 2; ++ai)
#pragma unroll
                        for (int m = 0; m < 4; ++m) {
                            const int row = u.row0 + 128 * ai + 64 * wr + 16 * m + fr;
                            *(uint2*)(O + (size_t)row * ld + col) = make_uint2(pack2(acc[ai][bj][m][n][0], acc[ai][bj][m][n][1]), pack2(acc[ai][bj][m][n][2], acc[ai][bj][m][n][3]));
                        }
                }
            }
    }
};
__device__ __forceinline__ void phase_gemm_recin8(const Params& p, char* lds) {
    SchedDense8 S{p.ws + OFF_WRI, 68 * 9, 9, 2 * D, vG(), g8::xcd_major_block()};
    EpiBf16_8 E{(bf16_t*)(p.ws + OFF_PB), PW, PW};
    g8::gemm8<false>((LAS unsigned char*)lds, p.ws + OFF_HB, 2 * D, S, E);
}
__device__ __forceinline__ void phase_moe1_8(const Params& p, int L, char* lds) {
    int* tp = (int*)(lds + G8_TP); unsigned* tab = (unsigned*)(lds + G8_TAB);
    moe_prefix(p, L, tp);
    const int tid = threadIdx.x;
    const int* LIST = (const int*)(p.ws + OFF_LIST);
    constexpr int EB = FP8_G1 ? 1 : 2;
    SchedMoe8<true> S; S.init(tp, tab, LIST, p.ws + OFF_EWI + (size_t)L * NE * 2048 * D * EB, (size_t)2048 * D * EB, 3, D * EB);
    for (int slot = 0; slot < G8_NSLOT; ++slot) {
        g8::Unit u; if (!S.next(slot, u)) break;
        const int cnt = tp[33 + u.e];
        if (tid < 256) { const int pos = u.row0 - tp[u.e] * 256 + tid; tab[slot * 256 + tid] = (unsigned)LIST[(size_t)u.e * NT + (pos < cnt ? pos : 0)] * (unsigned)(D * EB); }
    }
    __syncthreads();
    EpiMoe1_8<FP8_G2 != 0> E{(bf16_t*)(p.ws + OFF_ACT), p.exp_b_in + (size_t)L * NE * 2048, FP8_G1 ? (1.0f / 64.0f) : 1.0f};
    g8::gemm8<FP8_G1 != 0>((LAS unsigned char*)lds, p.ws + (FP8_G1 ? OFF_HB8 : OFF_HB), D * EB, S, E);
}
__device__ __forceinline__ void phase_moe2_8(const Params& p, int L, char* lds) {
    int* tp = (int*)(lds + G8_TP);
    moe_prefix(p, L, tp);
    constexpr int EB = FP8_G2 ? 1 : 2;
    SchedMoe8<false> S; S.init(tp, nullptr, nullptr, p.ws + OFF_EWO + (size_t)L * NE * D * D * EB, (size_t)D * D * EB, 2, D * EB);
    EpiBias8 E{(bf16_t*)(p.ws + OFF_YR), p.exp_b_out + (size_t)L * NE * D, FP8_G2 ? (1.0f / 64.0f) : 1.0f};
    g8::gemm8<FP8_G2 != 0>((LAS unsigned char*)lds, p.ws + OFF_ACT, D * EB, S, E);
}
struct EpiF32_8 {
    float* O; int ld;
    __device__ __forceinline__ void operator()(const f32x4 (&acc)[2][2][4][2], const g8::Unit& u, int wr, int wc, int fr, int fq) const {
#pragma unroll
        for (int ai = 0; ai < 2; ++ai)
#pragma unroll
            for (int m = 0; m < 4; ++m) {
                float* rp = O + (size_t)(u.row0 + 128 * ai + 64 * wr + 16 * m + fr) * ld + 256 * u.tn + 32 * wc + 4 * fq;
#pragma unroll
                for (int bj = 0; bj < 2; ++bj)
#pragma unroll
                    for (int n = 0; n < 2; ++n) *(f32x4*)(rp + 128 * bj + 16 * n) = acc[ai][bj][m][n];
            }
    }
};
struct SchedX8 {
    static constexpr bool AFFINE = true;
    const char* Bbase; int nunits, ntn, rowB, G, cblk;
    __device__ __forceinline__ bool next(int i, g8::Unit& u) const {
        const int L = i * G + cblk; if (L >= nunits) return false;
        const int mi = L / ntn, tn = L % ntn;
        u.B = Bbase + (size_t)tn * 256 * rowB; u.row0 = (mi >> 4) * SB + ((mi & 15) + 1) * 256; u.tn = tn; u.e = 0; u.slot = i; return true;
    }
    __device__ __forceinline__ void aoff(const g8::Unit& u, const int (&R)[2], const int (&C)[2], unsigned (&o)[2][2]) const {
#pragma unroll
        for (int h = 0; h < 2; ++h)
#pragma unroll
            for (int i = 0; i < 2; ++i) o[h][i] = (unsigned)((u.row0 + h * 128 + R[i]) * rowB + C[i] * 2);
    }
};
struct EpiQ8 {
    bf16_t* QF; const float* rope;
    __device__ __forceinline__ void operator()(const f32x4 (&acc)[2][2][4][2], const g8::Unit& u, int wr, int wc, int fr, int fq) const {
        const float qs = 0.07216878364870322f * 1.4426950408889634f;
        const int sx0 = (u.row0 % SB) - CTXL + 64 * wr + fr;
        const int c0 = 256 * u.tn + 32 * wc;
        const int ta = (c0 >> 4) % 12, tb = ((c0 + 128) >> 4) % 12;
#pragma unroll
        for (int ai = 0; ai < 2; ++ai)
#pragma unroll
            for (int m = 0; m < 4; ++m) {
                const int sx = sx0 + 128 * ai + 16 * m;
                bf16_t* rp = QF + (size_t)(u.row0 + 128 * ai + 64 * wr + 16 * m + fr) * 1536 + c0 + 4 * fq;
#pragma unroll
                for (int bj = 0; bj < 2; ++bj) {
                    const int t12 = bj ? tb : ta;
                    f32x4 o0 = acc[ai][bj][m][0], o1 = acc[ai][bj][m][1];
                    if (t12 >= 8) {
                        const float* rr = rope + ((t12 == 8) ? (sx >> 6) : (sx & 63)) * 16 + 4 * fq;
                        const f32x4 cs = *(const f32x4*)rr, sn = *(const f32x4*)(rr + 1024);
                        const f32x4 t0 = o0 * cs - o1 * sn, t1 = o1 * cs + o0 * sn; o0 = t0; o1 = t1;
                    }
                    *(uint2*)(rp + 128 * bj) = make_uint2(pack2(o0[0] * qs, o0[1] * qs), pack2(o0[2] * qs, o0[3] * qs));
                    *(uint2*)(rp + 128 * bj + 16) = make_uint2(pack2(o1[0] * qs, o1[1] * qs), pack2(o1[2] * qs, o1[3] * qs));
                }
            }
    }
};
struct EpiGlu8 {
    bf16_t* MIX; const bf16_t* Y; const float* bias;
    __device__ __forceinline__ void operator()(const f32x4 (&acc)[2][2][4][2], const g8::Unit& u, int wr, int wc, int fr, int fq) const {
#pragma unroll
        for (int bj = 0; bj < 2; ++bj)
#pragma unroll
            for (int n = 0; n < 2; ++n) {
                const int col = 256 * u.tn + 128 * bj + 32 * wc + 16 * n + 4 * fq;
                const f32x4 bb = *(const f32x4*)(bias + col);
#pragma unroll
                for (int ai = 0; ai < 2; ++ai)
#pragma unroll
                    for (int m = 0; m < 4; ++m) {
                        const int row = u.row0 + 128 * ai + 64 * wr + 16 * m + fr;
                        const uint2 yv = *(const uint2*)(Y + (size_t)row * 512 + col);
                        const f32x4 a = acc[ai][bj][m][n] + bb;
                        const float o0 = lo_bf(yv.x) * sigmoidf_(a[0]), o1 = hi_bf(yv.x) * sigmoidf_(a[1]), o2 = lo_bf(yv.y) * sigmoidf_(a[2]), o3 = hi_bf(yv.y) * sigmoidf_(a[3]);
                        *(uint2*)(MIX + (size_t)row * D + 512 + col) = make_uint2(pack2(o0, o1), pack2(o2, o3));
                    }
            }
    }
};
__device__ __forceinline__ void phase_gemm_glu8(const Params& p, char* lds) {
    SchedDense8 S{p.ws + OFF_WGLU, 68 * 2, 2, 1024, vG(), g8::xcd_major_block()};
    EpiGlu8 E{(bf16_t*)(p.ws + OFF_MIX), (const bf16_t*)(p.ws + OFF_Y), p.s5_glu_b};
    g8::gemm8<false>((LAS unsigned char*)lds, p.ws + OFF_Y, 1024, S, E);
}
__device__ __forceinline__ void phase_gemm_recout8(const Params& p, char* lds) {
    SchedDense8 S{p.ws + OFF_WRO, 68 * 4, 4, 2 * D, vG(), g8::xcd_major_block()};
    EpiBf16_8 E{(bf16_t*)(p.ws + OFF_YX), D, D};
    g8::gemm8<false>((LAS unsigned char*)lds, p.ws + OFF_MIX, 2 * D, S, E);
}
__device__ __forceinline__ void phase_gemm_down8(const Params& p, char* lds) {
    SchedDense8 S{p.ws + OFF_WDN, 68 * 3, 3, 2 * D, vG(), g8::xcd_major_block()};
    EpiBf16_8 E{(bf16_t*)(p.ws + OFF_DN), DNW, DNW};
    g8::gemm8<false>((LAS unsigned char*)lds, p.ws + OFF_HB, 2 * D, S, E);
}
__device__ __forceinline__ void phase_gemm_wo8(const Params& p, char* lds) {
    SchedX8 S{p.ws + OFF_WO, 64 * 4, 4, 2 * D, vG(), g8::xcd_major_block()};
    EpiBf16_8 E{(bf16_t*)(p.ws + OFF_YX), D, D};
    g8::gemm8<false>((LAS unsigned char*)lds, p.ws + OFF_OB, 2 * D, S, E);
}
__device__ __forceinline__ void phase_gemm_q8(const Params& p, char* lds) {
    SchedX8 S{p.ws + OFF_WUQ, 64 * 6, 6, 768, vG(), g8::xcd_major_block()};
    EpiQ8 E{(bf16_t*)(p.ws + OFF_QF), (const float*)(p.ws + OFF_ROPE)};
    g8::gemm8<false>((LAS unsigned char*)lds, p.ws + OFF_CQ, 768, S, E);
}
__device__ __forceinline__ void phase_combine(const Params& p, int L, bool last, char* lds) {
    int* tp = (int*)lds;
    moe_prefix(p, L, tp);
    const int tid = fresh_tid(), lane = tid & 63, gw = blockIdx.x * 8 + (tid >> 6), GW = vG() * 8;
    float* xs = (float*)(p.ws + OFF_XS); const bf16_t* YR = (const bf16_t*)(p.ws + OFF_YR); bf16_t* HB = (bf16_t*)(p.ws + OFF_HB);
    const float* MF = (const float*)(p.ws + OFF_MF);
    const int* SE = (const int*)(p.ws + OFF_SE); const int* SP = (const int*)(p.ws + OFF_SP); const float* GT = (const float*)(p.ws + OFF_GT);
    const float* gpost = p.norm_ffn_post + L * D;
    const int nrows = last ? NB * SEQ : NT;
    auto rowof = [&](int ri) { return last ? ((ri >> 12) * SB + CTXL + (ri & 4095)) : ri; };
    int ne[4], npos[4]; float ng[4];
    uint2 nyv[4][4]; f32x4 nxv[4]; float dg[4];
    auto fetch_idx = [&](int ri) {
        const int r = rowof(ri);
#pragma unroll
        for (int k = 0; k < 4; ++k) { ne[k] = SE[r * 4 + k]; npos[k] = SP[r * 4 + k]; ng[k] = GT[r * 4 + k]; }
    };
    auto fetch_data = [&](int ri) {
        const int r = rowof(ri);
#pragma unroll
        for (int k = 0; k < 4; ++k) {
            const bf16_t* yr = YR + (size_t)(tp[ne[k]] * 256 + npos[k]) * D;
#pragma unroll
            for (int j = 0; j < 4; ++j) nyv[k][j] = *(const uint2*)(yr + 4 * lane + 256 * j);
            dg[k] = ng[k];
        }
#pragma unroll
        for (int j = 0; j < 4; ++j) nxv[j] = *(const f32x4*)(xs + (size_t)r * D + 4 * lane + 256 * j);
    };
    if (gw < nrows) { fetch_idx(gw); fetch_data(gw); }
    if (gw + GW < nrows) fetch_idx(gw + GW);
    for (int ri = gw; ri < nrows; ri += GW) {
        const int r = rowof(ri);
        const float* mv = MF + (size_t)(L * 5 + row_modv(r)) * 6144;
        float4 f[4], xv[4];
#pragma unroll
        for (int j = 0; j < 4; ++j) {
            f[j] = make_float4(0.f, 0.f, 0.f, 0.f);
#pragma unroll
            for (int k = 0; k < 4; ++k) { f[j].x += dg[k] * lo_bf(nyv[k][j].x); f[j].y += dg[k] * hi_bf(nyv[k][j].x); f[j].z += dg[k] * lo_bf(nyv[k][j].y); f[j].w += dg[k] * hi_bf(nyv[k][j].y); }
            xv[j] = make_float4(nxv[j][0], nxv[j][1], nxv[j][2], nxv[j][3]);
        }
        if (ri + GW < nrows) fetch_data(ri + GW);
        if (ri + 2 * GW < nrows) fetch_idx(ri + 2 * GW);
        __builtin_amdgcn_sched_barrier(0);
        const float rs = row_rstd(f);
#pragma unroll
        for (int j = 0; j < 4; ++j) {
            const int col = 4 * lane + 256 * j;
            const float4 gg = *(const float4*)(gpost + col), g5 = *(const float4*)(mv + 5 * 1024 + col);
            xv[j].x += g5.x * (f[j].x * rs * gg.x); xv[j].y += g5.y * (f[j].y * rs * gg.y);
            xv[j].z += g5.z * (f[j].z * rs * gg.z); xv[j].w += g5.w * (f[j].w * rs * gg.w);
            if (last) *(float4*)(p.out + (size_t)ri * D + col) = xv[j];
            else *(float4*)(xs + (size_t)r * D + col) = xv[j];
        }
        if (!last) {
            const float rs2 = row_rstd(xv);
            const float* mv1 = MF + (size_t)((L + 1) * 5 + row_modv(r)) * 6144;
            float4 o[4];
            modulate_store(xv, rs2, p.norm_mix_pre + (L + 1) * D, mv1, mv1 + 1024, HB + (size_t)r * D, lane, o);
        }
    }
}

__device__ __forceinline__ void gla_cum(const Params& p, uint2 v, int h, char* lds) {
    const int tid = threadIdx.x;
    float* Gm = (float*)lds; float* RF = (float*)(lds + 32768);
    {
        const int row = tid >> 3, c4 = (tid & 7) * 4;
        *(float4*)(RF + row * 32 + c4) = make_float4(lo_bf(v.x), hi_bf(v.x), lo_bf(v.y), hi_bf(v.y));
    }
    __syncthreads();
    const int d = tid & 63, dir = (tid >> 6) & 1, tg = tid >> 7;
    {
        float wv[16];
#pragma unroll
        for (int r = 0; r < 16; ++r) wv[r] = p.gla_gate_w[(dir * 16 + r) * 256 + h * 64 + d];
        const float bias = p.gla_gate_b[dir * 256 + h * 64 + d];
        for (int tt = 0; tt < 16; ++tt) {
            const int tok = tg * 16 + tt;
            float x = bias;
#pragma unroll
            for (int r = 0; r < 16; ++r) x += RF[tok * 32 + dir * 16 + r] * wv[r];
            const float ls = fminf(x, 0.f) - 0.6931471805599453f * __builtin_amdgcn_logf(1.0f + __builtin_amdgcn_exp2f(-1.4426950408889634f * fabsf(x)));
            Gm[(dir * 64 + tok) * 64 + d] = ls * (1.0f / 16.0f);
        }
    }
    __syncthreads();
    {
        float* gp = Gm + (dir * 64 + (dir ? 63 - tg * 16 : tg * 16)) * 64 + d;
        const int st = dir ? -64 : 64;
        float v[16];
#pragma unroll
        for (int i = 0; i < 16; ++i) v[i] = gp[i * st];
#pragma unroll
        for (int i = 1; i < 16; ++i) v[i] += v[i - 1];
        RF[(dir * 4 + tg) * 64 + d] = v[15];
        __syncthreads();
        float off = 0.f;
        for (int q = 0; q < tg; ++q) off += RF[(dir * 4 + q) * 64 + d];
#pragma unroll
        for (int i = 0; i < 16; ++i) gp[i * st] = v[i] + off;
    }
    __syncthreads();
}
__device__ __forceinline__ void gla_load_v(const Params& p, int r0, int h, uint2 (&vr)[4]) {
    const int tid = threadIdx.x;
    const bf16_t* Pb = (const bf16_t*)(p.ws + OFF_PB) + (size_t)(r0 + (tid >> 5)) * PW + COL_V + h * 128 + (tid & 31) * 4;
#pragma unroll
    for (int i = 0; i < 4; ++i) vr[i] = *(const uint2*)(Pb + (size_t)(16 * i) * PW);
}
__device__ __forceinline__ void gla_stage_vt(const uint2 (&vr)[4], char* VT) {
    const int tid = threadIdx.x, dv0 = (tid & 31) * 4;
#pragma unroll
    for (int i = 0; i < 4; ++i) {
        const int j = (tid >> 5) + 16 * i, cj = j >> 3, bo = (j & 7) * 2;
        *(bf16_t*)(VT + swz(dv0 + 0, cj, 128) + bo) = (bf16_t)(vr[i].x & 0xffffu); *(bf16_t*)(VT + swz(dv0 + 1, cj, 128) + bo) = (bf16_t)(vr[i].x >> 16);
        *(bf16_t*)(VT + swz(dv0 + 2, cj, 128) + bo) = (bf16_t)(vr[i].y & 0xffffu); *(bf16_t*)(VT + swz(dv0 + 3, cj, 128) + bo) = (bf16_t)(vr[i].y >> 16);
    }
}
__device__ __forceinline__ int dir_chunk(int dir, int c) { return dir ? (c < 4 ? 3 - c : 71 - c) : c; }

__device__ __forceinline__ void gla_local_item(const Params& p, int item, int b, int c, int h, char* lds) {
    const int tid = threadIdx.x, lane = tid & 63, w = tid >> 6, r0 = b * SB + c * 64;
    const bf16_t* Pb = (const bf16_t*)(p.ws + OFF_PB);
    const uint2 rfv = *(const uint2*)(Pb + (size_t)(r0 + (tid >> 3)) * PW + COL_RF + (tid & 7) * 4);
    const uint4 kraw = *(const uint4*)(Pb + (size_t)(r0 + (tid >> 3)) * PW + COL_K + h * 64 + (tid & 7) * 8);
    uint2 vr[4]; gla_load_v(p, r0, h, vr);
    __syncthreads();
    gla_cum(p, rfv, h, lds);
    const float* Gm = (const float*)lds;
    char* KE = lds + 40960; char* VT = lds + 57344;
    {
        float4* cg = (float4*)(p.ws + OFF_CUM) + (size_t)item * 2048;
#pragma unroll
        for (int i = 0; i < 4; ++i) cg[tid + 512 * i] = *(const float4*)(Gm + (tid + 512 * i) * 4);
    }
    {
        const int j = tid >> 3, dgp = tid & 7, cj = j >> 3, bo = (j & 7) * 2;
        const unsigned ka[4] = {kraw.x, kraw.y, kraw.z, kraw.w};
#pragma unroll
        for (int dir = 0; dir < 2; ++dir) {
#pragma unroll
            for (int e = 0; e < 4; ++e) {
                const int d0 = dgp * 8 + 2 * e;
                const float cl0 = dir ? Gm[64 * 64 + d0] : Gm[63 * 64 + d0], cl1 = dir ? Gm[64 * 64 + d0 + 1] : Gm[63 * 64 + d0 + 1];
                const unsigned pk = pack2(lo_bf(ka[e]) * __expf(cl0 - Gm[(dir * 64 + j) * 64 + d0]), hi_bf(ka[e]) * __expf(cl1 - Gm[(dir * 64 + j) * 64 + d0 + 1]));
                *(bf16_t*)(KE + dir * 8192 + swz(d0, cj, 128) + bo) = (bf16_t)(pk & 0xffffu);
                *(bf16_t*)(KE + dir * 8192 + swz(d0 + 1, cj, 128) + bo) = (bf16_t)(pk >> 16);
            }
        }
    }
    gla_stage_vt(vr, VT);
    __syncthreads();
    {
        const int dir = w >> 2, nq = w & 3;
        f32x4 acc[4][2];
#pragma unroll
        for (int m = 0; m < 4; ++m) { acc[m][0] = (f32x4){0.f, 0.f, 0.f, 0.f}; acc[m][1] = (f32x4){0.f, 0.f, 0.f, 0.f}; }
#pragma unroll
        for (int ks = 0; ks < 2; ++ks) {
            bf16x8 bfr[2];
#pragma unroll
            for (int n = 0; n < 2; ++n) bfr[n] = ldfrag(VT, 128, nq * 32 + n * 16, ks * 32, lane);
#pragma unroll
            for (int m = 0; m < 4; ++m) {
                const bf16x8 af = ldfrag(KE + dir * 8192, 128, m * 16, ks * 32, lane);
#pragma unroll
                for (int n = 0; n < 2; ++n) acc[m][n] = mfma16(bfr[n], af, acc[m][n]);
            }
        }
        const int nd = dir_chunk(dir, c);
        float* KVb = (float*)(p.ws + OFF_KV) + ((size_t)(((b * 2 + dir) * 4 + h) * NCH + nd)) * 8192;
#pragma unroll
        for (int m = 0; m < 4; ++m)
#pragma unroll
            for (int n = 0; n < 2; ++n) *(f32x4*)(KVb + (m * 16 + (lane & 15)) * 128 + nq * 32 + n * 16 + 4 * (lane >> 4)) = acc[m][n];
    }
    if (tid < 128) {
        const int dir = tid >> 6, d = tid & 63, nd = dir_chunk(dir, c);
        const float cl = dir ? Gm[(64 + 0) * 64 + d] : Gm[63 * 64 + d];
        ((float*)(p.ws + OFF_DL))[((size_t)(((b * 2 + dir) * 4 + h) * NCH + nd)) * 64 + d] = __expf(cl);
    }
}

__device__ __forceinline__ void phase_gla_scan(const Params& p) {
    const int tid = threadIdx.x;
    for (int it = blockIdx.x; it < 512; it += vG()) {
        const int combo = it >> 4, el = (it & 15) * 512 + tid, d = el >> 7;
        float* base = (float*)(p.ws + OFF_KV) + (size_t)combo * NCH * 8192 + el;
        const float* dl = (const float*)(p.ws + OFF_DL) + (size_t)combo * NCH * 64 + d;
        float s = 0.f;
#pragma unroll 4
        for (int n = 0; n < NCH; ++n) {
            const float kv = base[(size_t)n * 8192], dec = dl[n * 64];
            base[(size_t)n * 8192] = s;
            s = dec * s + kv;
        }
    }
    for (int it = blockIdx.x; it < 32; it += vG()) {
        const int idx = it * 512 + tid, pp = idx & 63, g = (idx >> 6) & 31, dir = (idx >> 11) & 1, b = idx >> 12;
        float2* he = (float2*)(p.ws + OFF_HE) + ((size_t)((b * 2 + dir) * 32 + g) * NCH) * 64 + pp;
        const float2 a64 = ((const float2*)(p.ws + OFF_A64))[(dir * 32 + g) * 64 + pp];
        float hr = 0.f, hi = 0.f;
#pragma unroll 4
        for (int n = 0; n < NCH; ++n) {
            const float2 e = he[(size_t)n * 64];
            he[(size_t)n * 64] = make_float2(hr, hi);
            const float nr = a64.x * hr - a64.y * hi + e.x, ni = a64.x * hi + a64.y * hr + e.y;
            hr = nr; hi = ni;
        }
    }
}

__device__ __forceinline__ void gla_out_item(const Params& p, int item, int b, int c, int h, char* lds) {
    const int tid = threadIdx.x, lane = tid & 63, w = tid >> 6, r0 = b * SB + c * 64;
    float* Gw = (float*)lds; const float* Gm = (const float*)lds;
    char* QD = lds + 40960; char* KI = lds + 49152; char* AT = lds + 57344; char* VT = lds + 65536; char* ST = lds + 81920;
    const bf16_t* Pb = (const bf16_t*)(p.ws + OFF_PB);
    const f32x4* cg = (const f32x4*)(p.ws + OFF_CUM) + (size_t)item * 2048;
    const f32x4 cum0 = cg[tid], cum1 = cg[tid + 512], cum2 = cg[tid + 1024], cum3 = cg[tid + 1536];
    const uint4 qraw = *(const uint4*)(Pb + (size_t)(r0 + (tid >> 3)) * PW + COL_Q + h * 64 + (tid & 7) * 8);
    const uint4 kraw = *(const uint4*)(Pb + (size_t)(r0 + (tid >> 3)) * PW + COL_K + h * 64 + (tid & 7) * 8);
    uint2 vr[4]; gla_load_v(p, r0, h, vr);
    const uint4 g0 = *(const uint4*)(Pb + (size_t)(r0 + (tid >> 3)) * PW + COL_G + h * 128 + (tid & 7) * 16);
    const uint4 g1 = *(const uint4*)(Pb + (size_t)(r0 + (tid >> 3)) * PW + COL_G + h * 128 + (tid & 7) * 16 + 8);
    float sv[2][16];
#pragma unroll
    for (int dir = 0; dir < 2; ++dir) {
        const int dv = tid & 127, dq = tid >> 7, nd = dir_chunk(dir, c);
        const float* S = (const float*)(p.ws + OFF_KV) + ((size_t)(((b * 2 + dir) * 4 + h) * NCH + nd)) * 8192 + (dq * 16) * 128 + dv;
#pragma unroll
        for (int e = 0; e < 16; ++e) sv[dir][e] = S[e * 128];
    }
    __syncthreads();
    *(f32x4*)(Gw + tid * 4) = cum0; *(f32x4*)(Gw + (tid + 512) * 4) = cum1; *(f32x4*)(Gw + (tid + 1024) * 4) = cum2; *(f32x4*)(Gw + (tid + 1536) * 4) = cum3;
    gla_stage_vt(vr, VT);
    __syncthreads();
    f32x4 acco[4];
#pragma unroll
    for (int n = 0; n < 4; ++n) acco[n] = (f32x4){0.f, 0.f, 0.f, 0.f};
    const int mi = w & 3, nd0 = (w >> 2) * 4;
    for (int dir = 0; dir < 2; ++dir) {
        {
            const int i = tid >> 3, dg = tid & 7;
            const unsigned qa[4] = {qraw.x, qraw.y, qraw.z, qraw.w}, ka[4] = {kraw.x, kraw.y, kraw.z, kraw.w};
            unsigned qo[4], ko[4];
#pragma unroll
            for (int e = 0; e < 4; ++e) {
                const float c0 = Gm[(dir * 64 + i) * 64 + dg * 8 + 2 * e], c1 = Gm[(dir * 64 + i) * 64 + dg * 8 + 2 * e + 1];
                qo[e] = pack2(lo_bf(qa[e]) * 0.125f * __expf(c0), hi_bf(qa[e]) * 0.125f * __expf(c1));
                ko[e] = pack2(lo_bf(ka[e]) * __expf(-c0), hi_bf(ka[e]) * __expf(-c1));
            }
            *(uint4*)(QD + swz(i, dg, 128)) = make_uint4(qo[0], qo[1], qo[2], qo[3]);
            *(uint4*)(KI + swz(i, dg, 128)) = make_uint4(ko[0], ko[1], ko[2], ko[3]);
        }
        {
            const int dv = tid & 127, dq = tid >> 7;
            unsigned pk[8];
#pragma unroll
            for (int e = 0; e < 8; ++e) pk[e] = dir ? pack2(sv[1][2 * e], sv[1][2 * e + 1]) : pack2(sv[0][2 * e], sv[0][2 * e + 1]);
            *(uint4*)(ST + swz(dv, dq * 2, 128)) = make_uint4(pk[0], pk[1], pk[2], pk[3]);
            *(uint4*)(ST + swz(dv, dq * 2 + 1, 128)) = make_uint4(pk[4], pk[5], pk[6], pk[7]);
        }
        __syncthreads();
        {
            const int mi2 = w >> 1, nj0 = (w & 1) * 2;
#pragma unroll
            for (int t = 0; t < 2; ++t) {
                const int nj = nj0 + t;
                f32x4 a = (f32x4){0.f, 0.f, 0.f, 0.f};
#pragma unroll
                for (int ks = 0; ks < 2; ++ks) a = mfma16(ldfrag(KI, 128, nj * 16, ks * 32, lane), ldfrag(QD, 128, mi2 * 16, ks * 32, lane), a);
                const int i = mi2 * 16 + (lane & 15), j0 = nj * 16 + 4 * (lane >> 4);
                float v[4];
#pragma unroll
                for (int q = 0; q < 4; ++q) { const int j = j0 + q; const bool keep = dir ? (j >= i) : (j <= i); v[q] = keep ? a[q] : 0.f; }
                *(uint2*)(AT + swz(i, j0 >> 3, 128) + (j0 & 7) * 2) = make_uint2(pack2(v[0], v[1]), pack2(v[2], v[3]));
            }
        }
        __syncthreads();
#pragma unroll
        for (int ks = 0; ks < 2; ++ks) {
            const bf16x8 xq = ldfrag(QD, 128, mi * 16, ks * 32, lane), xa = ldfrag(AT, 128, mi * 16, ks * 32, lane);
#pragma unroll
            for (int n = 0; n < 4; ++n) {
                acco[n] = mfma16(ldfrag(ST, 128, (nd0 + n) * 16, ks * 32, lane), xq, acco[n]);
                acco[n] = mfma16(ldfrag(VT, 128, (nd0 + n) * 16, ks * 32, lane), xa, acco[n]);
            }
        }
        __syncthreads();
    }
    float* OUT = (float*)lds;
    {
        const int i = mi * 16 + (lane & 15);
#pragma unroll
        for (int n = 0; n < 4; ++n) *(f32x4*)(OUT + i * 132 + (nd0 + n) * 16 + 4 * (lane >> 4)) = acco[n];
    }
    __syncthreads();
    {
        const int i = tid >> 3, seg = tid & 7;
        float o[16]; float ss = 0.f;
#pragma unroll
        for (int e = 0; e < 4; ++e) { const float4 v = *(const float4*)(OUT + i * 132 + seg * 16 + 4 * e); o[4 * e] = v.x; o[4 * e + 1] = v.y; o[4 * e + 2] = v.z; o[4 * e + 3] = v.w; }
#pragma unroll
        for (int e = 0; e < 16; ++e) ss += o[e] * o[e];
        ss += __shfl_xor(ss, 1); ss += __shfl_xor(ss, 2); ss += __shfl_xor(ss, 4);
        const float rstd = rsqrtf(ss * (1.0f / 128.0f) + EPS);
        const unsigned ga[8] = {g0.x, g0.y, g0.z, g0.w, g1.x, g1.y, g1.z, g1.w};
        unsigned pk[8];
#pragma unroll
        for (int e = 0; e < 8; ++e) {
            const float ga0 = lo_bf(ga[e]), ga1 = hi_bf(ga[e]);
            const float n0 = p.gla_norm[seg * 16 + 2 * e], n1 = p.gla_norm[seg * 16 + 2 * e + 1];
            pk[e] = pack2(o[2 * e] * rstd * n0 * (ga0 * sigmoidf_(ga0)), o[2 * e + 1] * rstd * n1 * (ga1 * sigmoidf_(ga1)));
        }
        bf16_t* mp = (bf16_t*)(p.ws + OFF_MIX) + (size_t)(r0 + i) * D + h * 128 + seg * 16;
        *(uint4*)mp = make_uint4(pk[0], pk[1], pk[2], pk[3]); *(uint4*)(mp + 8) = make_uint4(pk[4], pk[5], pk[6], pk[7]);
    }
}

template <bool FULL>
__device__ __forceinline__ void s5_item(const Params& p, int b, int c, int go, char* lds) {
    const int tid = threadIdx.x, lane = tid & 63, w = tid >> 6, g = go * 8 + w, r0 = b * SB + c * 64;
    char* HS = lds + w * 8192;
    const bf16_t* Pb = (const bf16_t*)(p.ws + OFF_PB);
    const int fr = lane & 15, fq = lane >> 4;
    bf16x8 uf[4];
#pragma unroll
    for (int m = 0; m < 4; ++m) {
        uf[m] = (bf16x8){0, 0, 0, 0, 0, 0, 0, 0};
        if (fq < 2) uf[m] = *(const bf16x8*)(Pb + (size_t)(r0 + m * 16 + fr) * PW + COL_U + g * 16 + fq * 8);
    }
    f32x4 accy[4];
#pragma unroll
    for (int m = 0; m < 4; ++m) accy[m] = (f32x4){0.f, 0.f, 0.f, 0.f};
    __syncthreads();
    for (int dir = 0; dir < 2; ++dir) {
        const int dg = dir * 32 + g, idx = dg * 64 + lane;
        const float2 a = ((const float2*)(p.ws + OFF_ABAR))[idx];
        bf16x8 bfr[8];
#pragma unroll
        for (int j = 0; j < 8; ++j) {
            bfr[j] = (bf16x8){0, 0, 0, 0, 0, 0, 0, 0};
            if (fq < 2) bfr[j] = *(const bf16x8*)((const bf16_t*)(p.ws + OFF_BBAR) + ((size_t)dg * 128 + j * 16 + fr) * 16 + fq * 8);
        }
        const int nd = dir_chunk(dir, c);
        float2* HEp = (float2*)(p.ws + OFF_HE) + ((size_t)((b * 2 + dir) * 32 + g) * NCH) * 64 + lane;
        float hr = 0.f, hi = 0.f;
        bf16x8 cfrag[4];
        if (FULL) {
            const float2 h0 = HEp[(size_t)nd * 64]; hr = h0.x; hi = h0.y;
            const bf16_t* CM = (const bf16_t*)(p.ws + OFF_CMAT) + ((size_t)(dg * 16 + fr)) * 128 + fq * 8;
#pragma unroll
            for (int ks = 0; ks < 4; ++ks) cfrag[ks] = *(const bf16x8*)(CM + ks * 32);
        }
        for (int half = 0; half < 2; ++half) {
            const int mt0 = (dir ? 1 - half : half) * 2;
#pragma unroll
            for (int mt = 0; mt < 2; ++mt) {
                const bf16x8 ua = (mt0 == 0) ? uf[mt] : uf[2 + mt];
#pragma unroll
                for (int j = 0; j < 8; ++j) {
                    const f32x4 d = mfma16(bfr[j], ua, (f32x4){0.f, 0.f, 0.f, 0.f});
                    const int row = mt * 16 + fr;
                    *(uint2*)(HS + row * 256 + ((((2 * j) | (fq >> 1)) ^ (row & 15)) << 4) + (fq & 1) * 8) = make_uint2(pack2(d[0], d[1]), pack2(d[2], d[3]));
                }
            }
            __syncthreads();
            {
                const int ch = lane >> 2, sub = (lane & 3) * 4;
#pragma unroll 8
                for (int tt = 0; tt < 32; ++tt) {
                    const int tl = dir ? 31 - tt : tt;
                    unsigned* ptr = (unsigned*)(HS + tl * 256 + ((ch ^ (tl & 15)) << 4) + sub);
                    const unsigned bu = *ptr;
                    const float nhr = a.x * hr - a.y * hi + lo_bf(bu), nhi = a.x * hi + a.y * hr + hi_bf(bu);
                    hr = nhr; hi = nhi;
                    if (FULL) *ptr = pack2(hr, hi);
                }
            }
            if (FULL) {
                __syncthreads();
#pragma unroll
                for (int mt = 0; mt < 2; ++mt)
#pragma unroll
                    for (int ks = 0; ks < 4; ++ks) {
                        const int row = mt * 16 + fr;
                        const bf16x8 hf = *(const bf16x8*)(HS + row * 256 + (((ks * 4 + fq) ^ (row & 15)) << 4));
                        if (mt0 == 0) accy[mt] = mfma16(cfrag[ks], hf, accy[mt]); else accy[2 + mt] = mfma16(cfrag[ks], hf, accy[2 + mt]);
                    }
            }
            __syncthreads();
        }
        if (!FULL) HEp[(size_t)nd * 64] = make_float2(hr, hi);
    }
    if (FULL) {
        bf16_t* Yb = (bf16_t*)(p.ws + OFF_Y);
        const int h0 = 4 * fq;
        const f32x4 dd = *(const f32x4*)(p.s5_d + g * 16 + h0);
#pragma unroll
        for (int mt = 0; mt < 4; ++mt) {
            const int tok = mt * 16 + fr;
            const uint2 uv = *(const uint2*)(Pb + (size_t)(r0 + tok) * PW + COL_U + g * 16 + h0);
            const float ua[4] = {lo_bf(uv.x), hi_bf(uv.x), lo_bf(uv.y), hi_bf(uv.y)};
            float o[4];
#pragma unroll
            for (int q = 0; q < 4; ++q) {
                const float y = accy[mt][q] + dd[q] * ua[q];
                const float z2 = 2.0f * 0.7978845608028654f * (y + 0.044715f * y * y * y);
                o[q] = y * sigmoidf_(z2);
            }
            *(uint2*)(Yb + (size_t)(r0 + tok) * 512 + g * 16 + h0) = make_uint2(pack2(o[0], o[1]), pack2(o[2], o[3]));
        }
    }
}
__device__ __forceinline__ void phase_rec_local(const Params& p, char* lds) {
    for (int it = blockIdx.x; it < 2176; it += vG()) {
        if (it < 1088) { const int b = it / 272, r = it % 272; gla_local_item(p, it, b, r >> 2, r & 3, lds); }
        else { const int j = it - 1088, b = j / 272, r = j % 272; s5_item<false>(p, b, r >> 2, r & 3, lds); }
    }
}
__device__ __forceinline__ void phase_rec_out(const Params& p, char* lds) {
    for (int it = blockIdx.x; it < 2176; it += vG()) {
        if (it < 1088) { const int b = it / 272, r = it % 272; gla_out_item(p, it, b, r >> 2, r & 3, lds); }
        else { const int j = it - 1088, b = j / 272, r = j % 272; s5_item<true>(p, b, r >> 2, r & 3, lds); }
    }
}

__device__ __forceinline__ void phase_gemm_down(const Params& p, char* lds) {
    const bf16_t* A = (const bf16_t*)(p.ws + OFF_HB); const bf16_t* Bt = (const bf16_t*)(p.ws + OFF_WDN); float* O = (float*)(p.ws + OFF_DN);
    const int nunits = (NT / 256) * 6;
    for (int u = blockIdx.x; u < nunits; u += vG()) {
        const int mt = u / 6, tn = u % 6;
        EpiF32 epi{O, DNW, mt * 256, tn * 128};
        gemm_dense<true>(A, D, mt * 256, Bt, D, tn * 128, D, lds, epi);
    }
}
__device__ __forceinline__ void phase_mla_norm(const Params& p) {
    const int lane = threadIdx.x & 63, gw = blockIdx.x * 8 + (threadIdx.x >> 6), GW = vG() * 8;
    const float* rope = (const float*)(p.ws + OFF_ROPE);
    bf16_t* CQ = (bf16_t*)(p.ws + OFF_CQ); bf16_t* CKV = (bf16_t*)(p.ws + OFF_CKV); bf16_t* KR = (bf16_t*)(p.ws + OFF_KR);
    for (int r = gw; r < NT; r += GW) {
        const bf16_t* rp = (const bf16_t*)(p.ws + OFF_DN) + (size_t)r * DNW;
        float2 q[3]; float ss = 0.f;
#pragma unroll
        for (int j = 0; j < 3; ++j) { const unsigned t = *(const unsigned*)(rp + 2 * lane + 128 * j); q[j] = make_float2(lo_bf(t), hi_bf(t)); ss += q[j].x * q[j].x + q[j].y * q[j].y; }
        ss = wave_sum(ss);
        const float rq = rsqrtf(ss * (1.0f / 384.0f) + EPS);
#pragma unroll
        for (int j = 0; j < 3; ++j) {
            const int col = 2 * lane + 128 * j;
            *(unsigned*)(CQ + (size_t)r * 384 + col) = pack2(q[j].x * rq * p.mla_q_norm[col], q[j].y * rq * p.mla_q_norm[col + 1]);
        }
        const uint2 kt = *(const uint2*)(rp + 384 + 4 * lane);
        const float4 kv = make_float4(lo_bf(kt.x), hi_bf(kt.x), lo_bf(kt.y), hi_bf(kt.y));
        float s2 = wave_sum(kv.x * kv.x + kv.y * kv.y + kv.z * kv.z + kv.w * kv.w);
        const float rk = rsqrtf(s2 * (1.0f / 256.0f) + EPS);
        const float4 gk = *(const float4*)(p.mla_kv_norm + 4 * lane);
        *(uint2*)(CKV + (size_t)r * 256 + 4 * lane) = make_uint2(pack2(kv.x * rk * gk.x, kv.y * rk * gk.y), pack2(kv.z * rk * gk.z, kv.w * rk * gk.w));
        const float v = bf2f(rp[640 + lane]);
        const float pv = __shfl_xor(v, 16);
        const int s = r % SB;
        float o = v;
        if (s >= CTXL) {
            const int sx = s - CTXL, half = lane >> 5, idx = lane & 31, fi = idx & 15;
            const int pos = half ? (sx & 63) : (sx >> 6);
            const float cs = rope[pos * 16 + fi], sn = rope[1024 + pos * 16 + fi];
            o = (idx < 16) ? (v * cs - pv * sn) : (v * cs + pv * sn);
        }
        KR[(size_t)r * 64 + lane] = (bf16_t)(pack2(o, 0.f) & 0xffffu);
    }
}
struct EpiQ {
    bf16_t* QF; const float* rope; int row0, col0;
    __device__ __forceinline__ void operator()(const f32x4 (&acc)[4][4], int wm, int wn, int lane) const {
        const float qs = 0.07216878364870322f * 1.4426950408889634f;
        const int base = (col0 + wn * 64) >> 4;
        const bool isrope = (base % 12) == 8;
#pragma unroll
        for (int m = 0; m < 4; ++m) {
            const int row = row0 + wm * 64 + m * 16 + (lane & 15);
            f32x4 o0 = acc[m][0], o1 = acc[m][1], o2 = acc[m][2], o3 = acc[m][3];
            if (isrope) {
                const int sx = (row % SB) - CTXL, gr = sx >> 6, gc = sx & 63;
                const f32x4 cr = *(const f32x4*)(rope + gr * 16 + 4 * (lane >> 4)), sr = *(const f32x4*)(rope + 1024 + gr * 16 + 4 * (lane >> 4));
                const f32x4 cc = *(const f32x4*)(rope + gc * 16 + 4 * (lane >> 4)), sc = *(const f32x4*)(rope + 1024 + gc * 16 + 4 * (lane >> 4));
                const f32x4 t0 = o0 * cr - o1 * sr, t1 = o1 * cr + o0 * sr, t2 = o2 * cc - o3 * sc, t3 = o3 * cc + o2 * sc;
                o0 = t0; o1 = t1; o2 = t2; o3 = t3;
            }
            bf16_t* rp = QF + (size_t)row * 1536 + col0 + wn * 64 + 4 * (lane >> 4);
            *(uint2*)(rp) = make_uint2(pack2(o0[0] * qs, o0[1] * qs), pack2(o0[2] * qs, o0[3] * qs));
            *(uint2*)(rp + 16) = make_uint2(pack2(o1[0] * qs, o1[1] * qs), pack2(o1[2] * qs, o1[3] * qs));
            *(uint2*)(rp + 32) = make_uint2(pack2(o2[0] * qs, o2[1] * qs), pack2(o2[2] * qs, o2[3] * qs));
            *(uint2*)(rp + 48) = make_uint2(pack2(o3[0] * qs, o3[1] * qs), pack2(o3[2] * qs, o3[3] * qs));
        }
    }
};
struct EpiKV {
    bf16_t* KN; bf16_t* VT; int row0, tn;
    __device__ __forceinline__ void operator()(const f32x4 (&acc)[4][4], int wm, int wn, int lane) const {
        const int head = tn >> 1; const bool isv = tn & 1;
        const int b = row0 / SB, s0 = row0 % SB;
#pragma unroll
        for (int m = 0; m < 4; ++m) {
            const int rl = wm * 64 + m * 16 + 4 * (lane >> 4);
#pragma unroll
            for (int n = 0; n < 4; ++n) {
                const int cw = wn * 64 + n * 16 + (lane & 15);
                if (isv) {
                    *(uint2*)(VT + ((size_t)((b * 8 + head) * 128 + cw)) * SB + s0 + rl) = make_uint2(pack2(acc[m][n][0], acc[m][n][1]), pack2(acc[m][n][2], acc[m][n][3]));
                } else {
                    const unsigned p01 = pack2(acc[m][n][0], acc[m][n][1]), p23 = pack2(acc[m][n][2], acc[m][n][3]);
                    bf16_t* kp = KN + (size_t)(row0 + rl) * D + head * 128 + cw;
                    kp[0] = (bf16_t)(p01 & 0xffffu); kp[D] = (bf16_t)(p01 >> 16); kp[2 * D] = (bf16_t)(p23 & 0xffffu); kp[3 * D] = (bf16_t)(p23 >> 16);
                }
            }
        }
    }
};
struct EpiKV8 {
    bf16_t* KN; bf16_t* VT;
    __device__ __forceinline__ void operator()(const f32x4 (&acc)[2][2][4][2], const g8::Unit& u, int wr, int wc, int fr, int fq) const {
        const int head = u.tn, b = u.row0 / SB, s0 = u.row0 % SB;
#pragma unroll
        for (int ai = 0; ai < 2; ++ai)
#pragma unroll
            for (int m = 0; m < 4; ++m) {
                const int rl = 128 * ai + 64 * wr + 16 * m + fr;
                bf16_t* kp = KN + (size_t)(u.row0 + rl) * D + head * 128 + 32 * wc + 4 * fq;
                *(uint2*)(kp) = make_uint2(pack2(acc[ai][0][m][0][0], acc[ai][0][m][0][1]), pack2(acc[ai][0][m][0][2], acc[ai][0][m][0][3]));
                *(uint2*)(kp + 16) = make_uint2(pack2(acc[ai][0][m][1][0], acc[ai][0][m][1][1]), pack2(acc[ai][0][m][1][2], acc[ai][0][m][1][3]));
#pragma unroll
                for (int n = 0; n < 2; ++n) {
                    const unsigned p01 = pack2(acc[ai][1][m][n][0], acc[ai][1][m][n][1]), p23 = pack2(acc[ai][1][m][n][2], acc[ai][1][m][n][3]);
                    bf16_t* vp = VT + ((size_t)((b * 8 + head) * 128 + 32 * wc + 16 * n + 4 * fq)) * SB + s0 + rl;
                    vp[0] = (bf16_t)(p01 & 0xffffu); vp[SB] = (bf16_t)(p01 >> 16); vp[2 * SB] = (bf16_t)(p23 & 0xffffu); vp[3 * SB] = (bf16_t)(p23 >> 16);
                }
            }
    }
};
__device__ __forceinline__ void phase_gemm_kv8(const Params& p, char* lds) {
    SchedDense8 S{p.ws + OFF_WUKV, 68 * 8, 8, 512, vG(), g8::xcd_major_block()};
    EpiKV8 E{(bf16_t*)(p.ws + OFF_KN), (bf16_t*)(p.ws + OFF_VT)};
    g8::gemm8<false>((LAS unsigned char*)lds, p.ws + OFF_CKV, 512, S, E);
}
__device__ __forceinline__ void phase_gemm_kv(const Params& p, char* lds) {
    const int nkv = 68 * 16;
    for (int v = blockIdx.x; v < nkv; v += vG()) {
        const int mt = v >> 4, tn = v & 15;
        EpiKV epi{(bf16_t*)(p.ws + OFF_KN), (bf16_t*)(p.ws + OFF_VT), mt * 256, tn};
        gemm_dense<false>((const bf16_t*)(p.ws + OFF_CKV), 256, mt * 256, (const bf16_t*)(p.ws + OFF_WUKV), 256, tn * 128, 256, lds, epi);
    }
}
__device__ __forceinline__ void phase_gemm_qkv(const Params& p, char* lds) {
    const int nq = 64 * 12, nkv = 68 * 16;
    for (int u = blockIdx.x; u < nq + nkv; u += vG()) {
        if (u < nq) {
            const int mi = u / 12, tn = u % 12, row0 = (mi >> 4) * SB + ((mi & 15) + 1) * 256;
            EpiQ epi{(bf16_t*)(p.ws + OFF_QF), (const float*)(p.ws + OFF_ROPE), row0, tn * 128};
            gemm_dense<true>((const bf16_t*)(p.ws + OFF_CQ), 384, row0, (const bf16_t*)(p.ws + OFF_WUQ), 384, tn * 128, 384, lds, epi);
        } else {
            const int v = u - nq, mt = v >> 4, tn = v & 15;
            EpiKV epi{(bf16_t*)(p.ws + OFF_KN), (bf16_t*)(p.ws + OFF_VT), mt * 256, tn};
            gemm_dense<false>((const bf16_t*)(p.ws + OFF_CKV), 256, mt * 256, (const bf16_t*)(p.ws + OFF_WUKV), 256, tn * 128, 256, lds, epi);
        }
    }
}
__device__ __forceinline__ void phase_attention(const Params& p, char* lds) {
    const int tid = threadIdx.x, lane = tid & 63, w = tid >> 6;
    const bf16_t* QF = (const bf16_t*)(p.ws + OFF_QF); const bf16_t* KN = (const bf16_t*)(p.ws + OFF_KN);
    const bf16_t* KR = (const bf16_t*)(p.ws + OFF_KR); const bf16_t* VTg = (const bf16_t*)(p.ws + OFF_VT);
    bf16_t* OB = (bf16_t*)(p.ws + OFF_OB);
    char* Ps = lds + 122880 + w * 4096;
    const FragBase fbk = fragbase(lane, 384), fbv = fragbase(lane, 128);
    for (int it = blockIdx.x; it < NB * 8 * 16; it += vG()) {
        const int b = it >> 7, h = (it >> 4) & 7, qt = it & 15;
        const int qrow0 = b * SB + CTXL + qt * 256 + w * 32;
        bf16x8 qf[2][6];
#pragma unroll
        for (int m = 0; m < 2; ++m)
#pragma unroll
            for (int ks = 0; ks < 6; ++ks) qf[m][ks] = *(const bf16x8*)(QF + (size_t)(qrow0 + m * 16 + (lane & 15)) * 1536 + h * 192 + ks * 32 + (lane >> 4) * 8);
        f32x4 acco[2][8];
#pragma unroll
        for (int m = 0; m < 2; ++m)
#pragma unroll
            for (int n = 0; n < 8; ++n) acco[m][n] = (f32x4){0.f, 0.f, 0.f, 0.f};
        float mrun[2] = {0.f, 0.f}; bool first = true;
        f32x4 lacc[2] = {(f32x4){0.f, 0.f, 0.f, 0.f}, (f32x4){0.f, 0.f, 0.f, 0.f}};
        unsigned koff[3], kstep[3], voff[2];
#pragma unroll
        for (int i = 0; i < 3; ++i) {
            const int L = (w + 8 * i) * 64 + lane, r = L / 24, q = L % 24;
            const int c = (q & ~7) | ((q & 7) ^ ((r >> 1) & 7));
            koff[i] = (c < 16) ? (unsigned)(OFF_KN + ((size_t)(b * SB + r) * D + h * 128 + c * 8) * 2) : (unsigned)(OFF_KR + ((size_t)(b * SB + r) * 64 + (c - 16) * 8) * 2);
            kstep[i] = (c < 16) ? 64u * D * 2u : 64u * 64u * 2u;
        }
#pragma unroll
        for (int i = 0; i < 2; ++i) {
            const int L = (w + 8 * i) * 64 + lane, r = L >> 3, q = L & 7, c = q ^ ((r >> 1) & 7);
            voff[i] = (unsigned)(OFF_VT + ((size_t)((b * 8 + h) * 128 + r) * SB + c * 8) * 2);
        }
        auto dma = [&](int kt, int st) {
            char* Ks = lds + st * 24576; char* Vs = lds + 73728 + st * 16384;
#pragma unroll
            for (int i = 0; i < 3; ++i)
                __builtin_amdgcn_global_load_lds((const unsigned*)(p.ws + (size_t)(koff[i] + (unsigned)kt * kstep[i])), (LAS unsigned*)(Ks + (w + 8 * i) * 1024 + lane * 16), 16, 0, 0);
#pragma unroll
            for (int i = 0; i < 2; ++i)
                __builtin_amdgcn_global_load_lds((const unsigned*)(p.ws + (size_t)(voff[i] + (unsigned)kt * 128u)), (LAS unsigned*)(Vs + (w + 8 * i) * 1024 + lane * 16), 16, 0, 0);
        };
        f32x4 s[2][4];
        auto do_S = [&](int st) {
            const char* Ks = lds + st * 24576;
#pragma unroll
            for (int m = 0; m < 2; ++m)
#pragma unroll
                for (int n = 0; n < 4; ++n) s[m][n] = (f32x4){-mrun[m], -mrun[m], -mrun[m], -mrun[m]};
            bf16x8 kf[4];
#pragma unroll
            for (int i = 0; i < 3; ++i) kf[i] = ldfrag2(Ks, fbk, 384, (i & 3) * 16, i >> 2);
#pragma unroll
            for (int i = 0; i < 24; ++i) {
                if (i + 3 < 24) kf[(i + 3) & 3] = ldfrag2(Ks, fbk, 384, ((i + 3) & 3) * 16, (i + 3) >> 2);
                __builtin_amdgcn_sched_barrier(0);
                s[0][i & 3] = mfma16(kf[i & 3], qf[0][i >> 2], s[0][i & 3]); s[1][i & 3] = mfma16(kf[i & 3], qf[1][i >> 2], s[1][i & 3]);
            }
        };
        auto do_SM_PV = [&](int st) {
            const char* Vs = lds + 73728 + st * 16384;
#pragma unroll
            for (int m = 0; m < 2; ++m) {
                float mx = s[m][0][0];
#pragma unroll
                for (int n = 0; n < 4; ++n)
#pragma unroll
                    for (int q = 0; q < 4; ++q) mx = fmaxf(mx, s[m][n][q]);
                if (__any(first || mx > 64.0f)) {
                    mx = fmaxf(mx, __shfl_xor(mx, 16)); mx = fmaxf(mx, __shfl_xor(mx, 32));
                    const float delta = first ? mx : fmaxf(mx, 0.f), alpha = first ? 1.0f : __builtin_amdgcn_exp2f(-delta);
                    lacc[m] *= alpha;
#pragma unroll
                    for (int n = 0; n < 8; ++n) acco[m][n] *= alpha;
#pragma unroll
                    for (int n = 0; n < 4; ++n) s[m][n] -= delta;
                    mrun[m] += delta;
                }
#pragma unroll
                for (int n = 0; n < 4; ++n) {
                    float pv[4];
#pragma unroll
                    for (int q = 0; q < 4; ++q) pv[q] = __builtin_amdgcn_exp2f(s[m][n][q]);
                    *(uint2*)(Ps + m * 2048 + (lane & 15) * 128 + ((((n * 2) | (lane >> 5)) ^ (((lane & 15) >> 1) & 7)) << 4) + ((lane >> 4) & 1) * 8) = make_uint2(pack2(pv[0], pv[1]), pack2(pv[2], pv[3]));
                }
            }
            first = false;
            __builtin_amdgcn_wave_barrier();
            {
                bf16x8 pf[2][2], vf[4];
#pragma unroll
                for (int ks = 0; ks < 2; ++ks) { pf[ks][0] = ldfrag2(Ps, fbv, 128, 0, ks); pf[ks][1] = ldfrag2(Ps, fbv, 128, 16, ks); }
                {
                    const bf16x8 ones = (bf16x8){16256, 16256, 16256, 16256, 16256, 16256, 16256, 16256};
#pragma unroll
                    for (int ks = 0; ks < 2; ++ks) { lacc[0] = mfma16(ones, pf[ks][0], lacc[0]); lacc[1] = mfma16(ones, pf[ks][1], lacc[1]); }
                }
#pragma unroll
                for (int i = 0; i < 3; ++i) vf[i] = ldfrag2(Vs, fbv, 128, (i & 7) * 16, i >> 3);
#pragma unroll
                for (int i = 0; i < 16; ++i) {
                    if (i + 3 < 16) vf[(i + 3) & 3] = ldfrag2(Vs, fbv, 128, ((i + 3) & 7) * 16, (i + 3) >> 3);
                    __builtin_amdgcn_sched_barrier(0);
                    acco[0][i & 7] = mfma16(vf[i & 3], pf[i >> 3][0], acco[0][i & 7]); acco[1][i & 7] = mfma16(vf[i & 3], pf[i >> 3][1], acco[1][i & 7]);
                }
            }
        };
        __syncthreads();
        dma(0, 0); dma(1, 1);
        asm volatile("s_waitcnt vmcnt(0)" ::: "memory");
        __syncthreads();
        const int nkt = SB / 64;
        const bool grpA = w < 4;
        int st = 0, stp = 2;
        for (int kt = 0; kt < nkt; ++kt) {
            const bool more2 = (kt + 2) < nkt;
            if (grpA) do_S(st); else if (kt > 0) do_SM_PV(stp);
            asm volatile("s_waitcnt lgkmcnt(0)" ::: "memory");
            __builtin_amdgcn_s_barrier();
            asm volatile("" ::: "memory");
            if (more2) dma(kt + 2, stp);
            if (grpA) do_SM_PV(st); else do_S(st);
            if (more2) asm volatile("s_waitcnt vmcnt(5)" ::: "memory"); else asm volatile("s_waitcnt vmcnt(0)" ::: "memory");
            asm volatile("s_waitcnt lgkmcnt(0)" ::: "memory");
            __builtin_amdgcn_s_barrier();
            asm volatile("" ::: "memory");
            stp = st; st = (st == 2) ? 0 : st + 1;
        }
        if (!grpA) do_SM_PV(stp);
#pragma unroll
        for (int m = 0; m < 2; ++m) {
            const float il = 1.0f / lacc[m][0];
            bf16_t* op = OB + (size_t)(qrow0 + m * 16 + (lane & 15)) * D + h * 128 + 4 * (lane >> 4);
#pragma unroll
            for (int n = 0; n < 8; ++n) *(uint2*)(op + n * 16) = make_uint2(pack2(acco[m][n][0] * il, acco[m][n][1] * il), pack2(acco[m][n][2] * il, acco[m][n][3] * il));
        }
    }
}

constexpr int LDS_BYTES = 16 + 155648 + 512;
#ifndef ONLY_PHASE
#define ONLY_PHASE -1
#endif
#define RUN_PHASE(i, call) do { if ((ONLY_PHASE < 0 || ONLY_PHASE == (i)) && p.phase_lo <= (i) && (i) < p.phase_hi) { call; } if (p.phase_lo <= (i) && (i) + 1 < p.phase_hi) xcd_barrier(bar); } while (0)

__global__ void __launch_bounds__(512, 2) hybrid_forward(Params p) {
    extern __shared__ __attribute__((aligned(16))) char smem[];
    if (threadIdx.x == 0) *(uint4*)smem = make_uint4(0u, 0u, gridDim.x, 0u);
    __syncthreads();
    char* lds = smem + 16;
    XcdBarrier bar; bar.bar = (unsigned*)(p.ws + OFF_BAR); bar.x = 0; bar.st = (volatile LAS unsigned*)smem;
    if (p.phase_hi - p.phase_lo > 1) bar = xcd_barrier_post((unsigned*)(p.ws + OFF_BAR), (volatile LAS unsigned*)smem);
    RUN_PHASE(0, { phase_prologue0(p, lds); phase_prologue1(p, lds); });
    RUN_PHASE(1, phase_prenorm(p, 0));
    const bool split = (gridDim.x == 256);
#define RUN_SPLIT(i, nc, q, base, hi, call) do { if (split && p.phase_lo <= (i) && (i) < p.phase_hi) set_vG(nc); \
        RUN_PHASE(i, { if (!split || (int)blockIdx.x < (nc)) { call; } else convert_static(p, base, (int)blockIdx.x - (nc), 256 - (nc), q, hi, lds); }); \
        if (split && p.phase_lo <= (i) && (i) < p.phase_hi) set_vG((int)gridDim.x); } while (0)
    RUN_SPLIT(3, CV3_NC, CV3_Q, CV_B3, CV_TILES_SET, phase_gemm_recin8(p, lds));
    RUN_PHASE(4, phase_rec_local(p, lds));
    RUN_PHASE(5, phase_gla_scan(p));
    RUN_PHASE(6, phase_rec_out(p, lds));
    RUN_SPLIT(7, CV7_NC, CV7_Q, CV_B7, CV_TILES_SET, phase_gemm_glu8(p, lds));
    RUN_SPLIT(8, CV8_NC, CV8_Q, CV_B8, CV_TILES_SET, phase_gemm_recout8(p, lds));
    RUN_PHASE(9, { phase_postmix(p, 0, false, lds); convert_static(p, split ? CV_B9 : 0, (int)blockIdx.x, (int)gridDim.x, 1 << 20, CV_TILES_SET, lds); });
    RUN_PHASE(10, phase_moe1_8(p, 0, lds));
    RUN_PHASE(11, phase_moe2_8(p, 0, lds));
    RUN_PHASE(12, phase_combine(p, 0, false, lds));
    RUN_SPLIT(13, CV13_NC, CV13_Q, CV_B13, 2 * CV_TILES_SET, phase_gemm_down8(p, lds));
    RUN_PHASE(14, phase_mla_norm(p));
    RUN_SPLIT(15, CV15_NC, CV15_Q, CV_B15, 2 * CV_TILES_SET, { phase_gemm_kv8(p, lds); __syncthreads(); phase_gemm_q8(p, lds); });
    RUN_PHASE(16, phase_attention(p, lds));
    RUN_PHASE(17, { phase_gemm_wo8(p, lds); convert_static(p, split ? CV_B17 : CV_TILES_SET, (int)blockIdx.x, (int)gridDim.x, 1 << 20, 2 * CV_TILES_SET, lds); });
    RUN_PHASE(18, phase_postmix(p, 1, true, lds));
    RUN_PHASE(19, phase_moe1_8(p, 1, lds));
    RUN_PHASE(20, phase_moe2_8(p, 1, lds));
    RUN_PHASE(21, phase_combine(p, 1, true, lds));
#if DBG_STOP >= 0
    if (p.phase_lo == 22) {
        float* o = p.out;
        for (size_t e = (size_t)blockIdx.x * 512 + threadIdx.x; e < (size_t)NB * SEQ * 1024; e += (size_t)gridDim.x * 512) {
            const int ri = (int)(e >> 10), c = (int)(e & 1023), r = (ri >> 12) * SB + CTXL + (ri & 4095);
            float v;
            if (DBG_SRC == 0) v = ((const float*)(p.ws + OFF_XS))[(size_t)r * 1024 + c];
            else if (DBG_SRC == 1) v = bf2f(((const bf16_t*)(p.ws + OFF_PB))[(size_t)r * PW + DBG_COL + c]);
            else if (DBG_SRC == 2) v = bf2f(((const bf16_t*)(p.ws + OFF_MIX))[(size_t)r * 1024 + (DBG_COL + c) % 1024]);
            else if (DBG_SRC == 3) v = bf2f(((const bf16_t*)(p.ws + OFF_YX))[(size_t)r * 1024 + c]);
            else if (DBG_SRC == 4) v = bf2f(((const bf16_t*)(p.ws + OFF_Y))[(size_t)r * 512 + (c & 511)]);
            else if (DBG_SRC == 5) v = bf2f(((const bf16_t*)(p.ws + OFF_HB))[(size_t)r * 1024 + c]);
            else if (DBG_SRC == 6) v = bf2f(((const bf16_t*)(p.ws + OFF_WRI))[(size_t)(ri % 2304) * 1024 + c]);
            else v = ((const float*)(p.ws + OFF_MF))[(size_t)(e % 61440)];
            if (!(fabsf(v) < 1.0e30f)) v = 1.0e4f;
            o[e] = v;
        }
    }
#endif
}

extern "C" void kernel_launch(void* const* d_in, const int* in_sizes, int n_in, void* d_out, int out_size, void* d_ws, size_t ws_size, hipStream_t stream) {
    static int grid = 0;
    if (!grid) {
        int dev = 0, cus = 0, per_cu = 0;
        hipGetDevice(&dev);
        hipDeviceGetAttribute(&cus, hipDeviceAttributeMultiprocessorCount, dev);
        hipFuncSetAttribute((const void*)hybrid_forward, hipFuncAttributeMaxDynamicSharedMemorySize, LDS_BYTES);
        hipOccupancyMaxActiveBlocksPerMultiprocessor(&per_cu, hybrid_forward, 512, LDS_BYTES);
        if (per_cu < 1) { fprintf(stderr, "occupancy query returned %d\n", per_cu); per_cu = 1; }
        grid = cus * 1;
    }
    if (ws_size < WS_TOTAL) { fprintf(stderr, "workspace too small: %zu < %zu\n", ws_size, (size_t)WS_TOTAL); return; }
    hipMemsetAsync(d_ws, 0, ZERO_BYTES, stream);
    Params p{};
    const float** f = (const float**)&p;
    for (int i = 0; i < 37; ++i) f[i] = (const float*)d_in[i];
    p.out = (float*)d_out; p.ws = (char*)d_ws;
#if DBG_STOP >= 0
    for (int i = 0; i <= DBG_STOP; ++i) { p.phase_lo = i; p.phase_hi = i + 1; hipLaunchKernelGGL(hybrid_forward, dim3(grid), dim3(512), LDS_BYTES, stream, p); }
    p.phase_lo = 22; p.phase_hi = 23; hipLaunchKernelGGL(hybrid_forward, dim3(grid), dim3(512), LDS_BYTES, stream, p);
#elif MK_MULTI
    for (int i = 0; i < NPHASE; ++i) { p.phase_lo = i; p.phase_hi = i + 1; hipLaunchKernelGGL(hybrid_forward, dim3(grid), dim3(512), LDS_BYTES, stream, p); }
#else
    p.phase_lo = 0; p.phase_hi = NPHASE;
    hipLaunchKernelGGL(hybrid_forward, dim3(grid), dim3(512), LDS_BYTES, stream, p);
#endif
}
```

```cpp
#include <hip/hip_runtime.h>
#include <stdint.h>
#include <stdio.h>

#ifndef DBG_STOP
#define DBG_STOP -1
#endif
#ifndef DBG_SRC
#define DBG_SRC 0
#endif
#ifndef DBG_COL
#define DBG_COL 0
#endif
#ifndef FP8_G1
#define FP8_G1 1
#endif
#ifndef FP8_G2
#define FP8_G2 1
#endif
#ifndef FP8_QK
#define FP8_QK 1
#endif
#ifndef MK_MULTI
#define MK_MULTI 0
#endif

typedef unsigned short bf16_t;
typedef short bf16x8 __attribute__((ext_vector_type(8)));
typedef float f32x4 __attribute__((ext_vector_type(4)));

constexpr int D = 1024, NB = 4, SEQ = 4096, CTXL = 256;
constexpr int SB = SEQ + CTXL;
constexpr int NT = NB * SB;
constexpr int NCH = SB / 64;
constexpr int PW = 2176;
constexpr int COL_Q = 0, COL_K = 256, COL_V = 512, COL_G = 1024, COL_RF = 1536, COL_U = 1568;
constexpr int NE = 32, TOPK = 4;
constexpr int MAXPR = 78080;
constexpr int DNW = 768;
constexpr float EPS = 1e-6f;
constexpr int NPHASE = 22;

constexpr size_t al256(size_t x) { return (x + 255) & ~(size_t)255; }
constexpr size_t OFF_BAR = 0;
constexpr size_t OFF_CNT = 16384;
constexpr size_t ZERO_BYTES = 20480;
constexpr size_t OFF_MP = ZERO_BYTES;
constexpr size_t OFF_MF = OFF_MP + al256((size_t)8 * 2 * 5 * 6144 * 4);
constexpr size_t OFF_ROPE = OFF_MF + al256((size_t)2 * 5 * 6144 * 4);
constexpr size_t OFF_ABAR = OFF_ROPE + al256(2 * 1024 * 4);
constexpr size_t OFF_A64 = OFF_ABAR + al256(4096 * 8);
constexpr size_t OFF_BBAR = OFF_A64 + al256(4096 * 8);
constexpr size_t OFF_CMAT = OFF_BBAR + al256((size_t)4096 * 16 * 8);
constexpr size_t OFF_WRI = OFF_CMAT + al256((size_t)64 * 16 * 128 * 2);
constexpr size_t OFF_WRO = OFF_WRI + al256((size_t)2304 * 1024 * 2);
constexpr size_t OFF_WGLU = OFF_WRO + al256((size_t)1024 * 1024 * 2);
constexpr size_t OFF_WDN = OFF_WGLU + al256((size_t)512 * 512 * 2);
constexpr size_t OFF_WUQ = OFF_WDN + al256((size_t)DNW * 1024 * 2);
constexpr size_t OFF_WUKV = OFF_WUQ + al256((size_t)1536 * 384 * 2);
constexpr size_t OFF_WO = OFF_WUKV + al256((size_t)2048 * 256 * 2);
constexpr size_t OFF_EWI = OFF_WO + al256((size_t)1024 * 1024 * 2);
constexpr size_t OFF_EWO = OFF_EWI + al256((size_t)64 * 2048 * 1024 * 2);
constexpr size_t OFF_XS = OFF_EWO + al256((size_t)64 * 1024 * 1024 * 2);
constexpr size_t OFF_HB = OFF_XS + al256((size_t)NT * 1024 * 4);
constexpr size_t OFF_PB = OFF_HB + al256((size_t)NT * 1024 * 2);
constexpr size_t OFF_KV = OFF_PB + al256((size_t)NT * PW * 2);
constexpr size_t OFF_DL = OFF_KV + al256((size_t)32 * NCH * 64 * 128 * 4);
constexpr size_t OFF_HE = OFF_DL + al256((size_t)32 * NCH * 64 * 4);
constexpr size_t OFF_Y = OFF_HE + al256((size_t)4 * 2 * 32 * NCH * 64 * 8);
constexpr size_t OFF_MIX = OFF_Y + al256((size_t)NT * 512 * 2);
constexpr size_t OFF_YX = OFF_MIX + al256((size_t)NT * 1024 * 2);
constexpr size_t OFF_LIST = OFF_YX + al256((size_t)NT * 1024 * 4);
constexpr size_t OFF_SE = OFF_LIST + al256((size_t)NE * NT * 4);
constexpr size_t OFF_SP = OFF_SE + al256((size_t)NT * 4 * 4);
constexpr size_t OFF_GT = OFF_SP + al256((size_t)NT * 4 * 4);
constexpr size_t OFF_ACT = OFF_GT + al256((size_t)NT * 4 * 4);
constexpr size_t OFF_YR = OFF_ACT + al256((size_t)MAXPR * 1024 * 2);
constexpr size_t OFF_DN = OFF_YR + al256((size_t)MAXPR * 1024 * 2);
constexpr size_t OFF_CQ = OFF_DN + al256((size_t)NT * DNW * 4);
constexpr size_t OFF_CKV = OFF_CQ + al256((size_t)NT * 384 * 2);
constexpr size_t OFF_KR = OFF_CKV + al256((size_t)NT * 256 * 2);
constexpr size_t OFF_QF = OFF_KR + al256((size_t)NT * 64 * 2);
constexpr size_t OFF_KN = OFF_QF + al256((size_t)NT * 1536 * 2);
constexpr size_t OFF_VT = OFF_KN + al256((size_t)NT * 1024 * 2);
constexpr size_t OFF_OB = OFF_VT + al256((size_t)NT * 1024 * 2);
constexpr size_t OFF_HB8 = OFF_OB + al256((size_t)NT * 1024 * 2);
constexpr size_t OFF_CUM = OFF_HB8 + al256((size_t)NT * 1024);
constexpr size_t WS_TOTAL = OFF_CUM + al256((size_t)1088 * 8192 * 4);
static_assert(WS_TOTAL < (1ull << 31), "32-bit workspace offsets");

struct Params {
    const float *x, *c, *ctx, *c_ctx, *mod_w, *mod_b, *norm_mix_pre, *norm_mix_post, *norm_ffn_pre, *norm_ffn_post;
    const float *router_w, *router_b, *exp_w_in, *exp_b_in, *exp_w_out, *exp_b_out, *rec_w_in, *rec_w_out;
    const float *gla_gate_w, *gla_gate_b, *gla_norm, *s5_lam_re, *s5_lam_im, *s5_log_dt, *s5_b_re, *s5_b_im;
    const float *s5_c_re, *s5_c_im, *s5_d, *s5_glu_w, *s5_glu_b, *mla_w_down, *mla_q_norm, *mla_kv_norm;
    const float *mla_w_uq, *mla_w_ukv, *mla_w_o;
    float* out;
    char* ws;
    int phase_lo, phase_hi;
};

#define XB_TMO      128
#define XB_XCNT(j)  (256  + 64 * (j))
#define XB_XSUB(j)  (1280 + 64 * (j))
#define XB_XGEN(j)  (2304 + 64 * (j))
#define XB_TOP      3328
#define XB_TOPGEN   3392
#define XCD_BAR_WORDS 3456
#define XB_SPIN_CAP (1u << 22)
#define LAS __attribute__((address_space(3)))

__device__ __forceinline__ unsigned xb_ld(unsigned* p)              { return __hip_atomic_load(p, __ATOMIC_RELAXED, __HIP_MEMORY_SCOPE_AGENT); }
__device__ __forceinline__ unsigned xb_add(unsigned* p, unsigned v) { return __hip_atomic_fetch_add(p, v, __ATOMIC_RELAXED, __HIP_MEMORY_SCOPE_AGENT); }
__device__ __forceinline__ unsigned xb_xcc_id() { return (unsigned)__builtin_amdgcn_s_getreg((3 << 11) | 20) & 0xFu; }
#define XB_SPIN(cond, bar) do { unsigned _sp = 0; while (cond) { __builtin_amdgcn_s_sleep(1); \
    if ((++_sp & 255u) == 0u) { if (xb_ld(&(bar)[XB_TMO])) break; if (_sp > XB_SPIN_CAP) { atomicAdd(&(bar)[XB_TMO], 1u); break; } } } } while (0)

struct XcdBarrier { unsigned* bar; unsigned x; volatile LAS unsigned* st; };

__device__ __forceinline__ XcdBarrier xcd_barrier_post(unsigned* bar, volatile LAS unsigned* st) {
    XcdBarrier b; b.bar = bar; b.x = xb_xcc_id(); b.st = st;
    if (threadIdx.x == 0) (void)xb_add(&bar[XB_XCNT(b.x)], 1u);
    return b;
}
__device__ __forceinline__ void xcd_barrier_complete(unsigned* bar, unsigned x, unsigned& nloc, unsigned& nx) {
    const unsigned G = gridDim.x * gridDim.y * gridDim.z;
    unsigned sum, cnt, mine, sp = 0u;
    for (;;) {
        sum = 0u; cnt = 0u; mine = 0u;
#pragma unroll
        for (unsigned j = 0; j < 16; ++j) { const unsigned c = xb_ld(&bar[XB_XCNT(j)]); sum += c; cnt += (c > 0u) ? 1u : 0u; mine = (j == x) ? c : mine; }
        if (sum == G) break;
        __builtin_amdgcn_s_sleep(1);
        if ((++sp & 255u) == 0u) { if (xb_ld(&bar[XB_TMO])) break; if (sp > XB_SPIN_CAP) { atomicAdd(&bar[XB_TMO], 1u); break; } }
    }
    nloc = mine > 0u ? mine : 1u; nx = cnt > 0u ? cnt : 1u;
}
__device__ __forceinline__ void xcd_barrier(const XcdBarrier& b) {
    asm volatile("s_waitcnt vmcnt(0)" ::: "memory");
    __syncthreads();
    if (threadIdx.x == 0) {
        unsigned* bar = b.bar;
        __builtin_amdgcn_s_waitcnt(0);
        unsigned nloc = b.st[0], nx = b.st[1];
        if (nloc == 0u) { xcd_barrier_complete(bar, b.x, nloc, nx); b.st[0] = nloc; b.st[1] = nx; }
        const unsigned old = xb_add(&bar[XB_XSUB(b.x)], 1u);
        const unsigned gen = old / nloc;
        if (old + 1u == (gen + 1u) * nloc) {
            __builtin_amdgcn_fence(__ATOMIC_RELEASE, "agent");
            asm volatile("s_waitcnt vmcnt(0)" ::: "memory");
            const unsigned og = xb_add(&bar[XB_TOP], 1u);
            const unsigned tg = og / nx;
            if (og + 1u == (tg + 1u) * nx) xb_add(&bar[XB_TOPGEN], 1u);
            else XB_SPIN(xb_ld(&bar[XB_TOPGEN]) == tg, bar);
            __builtin_amdgcn_fence(__ATOMIC_ACQUIRE, "agent");
            xb_add(&bar[XB_XGEN(b.x)], 1u);
            asm volatile("s_waitcnt vmcnt(0)" ::: "memory");
        } else {
            XB_SPIN(xb_ld(&bar[XB_XGEN(b.x)]) == gen, bar);
            __builtin_amdgcn_fence(__ATOMIC_ACQUIRE, "agent");
            asm volatile("s_waitcnt vmcnt(0)" ::: "memory");
        }
    }
    __syncthreads();
}

__device__ __forceinline__ int vG() { extern __shared__ __attribute__((aligned(16))) char smem_hdr[]; return __builtin_amdgcn_readfirstlane(*(volatile int*)(smem_hdr + 8)); }
__device__ __forceinline__ void set_vG(int v) { extern __shared__ __attribute__((aligned(16))) char smem_hdr[]; __syncthreads(); if (threadIdx.x == 0) *(volatile int*)(smem_hdr + 8) = v; __syncthreads(); }

__device__ __forceinline__ int fresh_tid() { int t = threadIdx.x; asm volatile("" : "+v"(t)); return t; }
__device__ __forceinline__ float bf2f(bf16_t h) { return __uint_as_float(((unsigned)h) << 16); }
typedef float f32x2_t __attribute__((ext_vector_type(2)));
typedef __bf16 bf16x2_t __attribute__((ext_vector_type(2)));
__device__ __forceinline__ unsigned pack2(float lo, float hi) { const f32x2_t v = {lo, hi}; const bf16x2_t b = __builtin_convertvector(v, bf16x2_t); return __builtin_bit_cast(unsigned, b); }
__device__ __forceinline__ unsigned pack4_fp8(float a, float b, float c, float d) {
    int r = __builtin_amdgcn_cvt_pk_fp8_f32(a, b, 0, false); r = __builtin_amdgcn_cvt_pk_fp8_f32(c, d, r, true); return (unsigned)r;
}
__device__ __forceinline__ float lo_bf(unsigned u) { return __uint_as_float(u << 16); }
__device__ __forceinline__ float hi_bf(unsigned u) { return __uint_as_float(u & 0xffff0000u); }
__device__ __forceinline__ float wave_sum(float v) {
#pragma unroll
    for (int o = 32; o >= 1; o >>= 1) v += __shfl_xor(v, o);
    return v;
}
__device__ __forceinline__ float sigmoidf_(float x) { return __builtin_amdgcn_rcpf(1.0f + __builtin_amdgcn_exp2f(-1.4426950408889634f * x)); }
__device__ __forceinline__ int swz(int r, int c, int RS) { return r * RS + ((c ^ ((r >> 1) & 7)) << 4); }
__device__ __forceinline__ int swz256(int r, int c) { return r * 256 + ((c ^ (r & 15)) << 4); }
__device__ __forceinline__ f32x4 mfma16(bf16x8 a, bf16x8 b, f32x4 c) { return __builtin_amdgcn_mfma_f32_16x16x32_bf16(a, b, c, 0, 0, 0); }
__device__ __forceinline__ bf16x8 ldfrag(const char* tile, int RS, int row0, int k0, int lane) {
    return *(const bf16x8*)(tile + swz(row0 + (lane & 15), (k0 >> 3) + (lane >> 4), RS));
}

struct FragBase { int b0, b1; };
__device__ __forceinline__ FragBase fragbase(int lane, int RS) {
    const int r = lane & 15, t = (lane >> 4) ^ ((r >> 1) & 7);
    FragBase f; f.b0 = r * RS + (t << 4); f.b1 = r * RS + ((t ^ 4) << 4); return f;
}
__device__ __forceinline__ bf16x8 ldfrag2(const char* tile, const FragBase& fb, int RS, int row0, int ks) {
    return *(const bf16x8*)(tile + ((ks & 1) ? fb.b1 : fb.b0) + row0 * RS + (ks >> 1) * 128);
}

constexpr int G_ABYTES = 256 * 128, G_BBYTES = 128 * 128, G_STAGE = G_ABYTES + G_BBYTES;
template <bool TRANS, class Epi>
__device__ __forceinline__ void gemm_tile(const bf16_t* a0, const bf16_t* a1, const bf16_t* a2, const bf16_t* a3,
                                          const bf16_t* b0, const bf16_t* b1, int K, char* lds, const Epi& epi) {
    const int tid = threadIdx.x, lane = tid & 63, w = tid >> 6, wm = w >> 1, wn = w & 1;
    const int srow = tid >> 3, sch = tid & 7, soff = swz(srow, sch, 128);
    const FragBase fb = fragbase(lane, 128);
    f32x4 acc[4][4];
#pragma unroll
    for (int m = 0; m < 4; ++m)
#pragma unroll
        for (int n = 0; n < 4; ++n) acc[m][n] = (f32x4){0.f, 0.f, 0.f, 0.f};
    uint4 ra0 = *(const uint4*)a0, ra1 = *(const uint4*)a1, ra2 = *(const uint4*)a2, ra3 = *(const uint4*)a3;
    uint4 rb0 = *(const uint4*)b0, rb1 = *(const uint4*)b1;
    {
        char* As = lds; char* Bs = lds + G_ABYTES;
        *(uint4*)(As + soff) = ra0; *(uint4*)(As + soff + 8192) = ra1; *(uint4*)(As + soff + 16384) = ra2; *(uint4*)(As + soff + 24576) = ra3;
        *(uint4*)(Bs + soff) = rb0; *(uint4*)(Bs + soff + 8192) = rb1;
    }
    __syncthreads();
    const int nk = K >> 6;
    for (int kt = 0; kt < nk; ++kt) {
        const bool more = (kt + 1) < nk;
        if (more) {
            const int ko = (kt + 1) * 64;
            ra0 = *(const uint4*)(a0 + ko); ra1 = *(const uint4*)(a1 + ko); ra2 = *(const uint4*)(a2 + ko); ra3 = *(const uint4*)(a3 + ko);
            rb0 = *(const uint4*)(b0 + ko); rb1 = *(const uint4*)(b1 + ko);
        }
        const char* As = lds + (kt & 1) * G_STAGE; const char* Bs = As + G_ABYTES;
#pragma unroll
        for (int ks = 0; ks < 2; ++ks) {
            bf16x8 af[4], bfr[4];
#pragma unroll
            for (int m = 0; m < 4; ++m) af[m] = ldfrag2(As + wm * 8192, fb, 128, m * 16, ks);
#pragma unroll
            for (int n = 0; n < 4; ++n) bfr[n] = ldfrag2(Bs + wn * 8192, fb, 128, n * 16, ks);
#pragma unroll
            for (int m = 0; m < 4; ++m)
#pragma unroll
                for (int n = 0; n < 4; ++n) acc[m][n] = TRANS ? mfma16(bfr[n], af[m], acc[m][n]) : mfma16(af[m], bfr[n], acc[m][n]);
        }
        if (more) {
            char* As2 = lds + ((kt + 1) & 1) * G_STAGE; char* Bs2 = As2 + G_ABYTES;
            *(uint4*)(As2 + soff) = ra0; *(uint4*)(As2 + soff + 8192) = ra1; *(uint4*)(As2 + soff + 16384) = ra2; *(uint4*)(As2 + soff + 24576) = ra3;
            *(uint4*)(Bs2 + soff) = rb0; *(uint4*)(Bs2 + soff + 8192) = rb1;
        }
        __syncthreads();
    }
    epi(acc, wm, wn, lane);
}
template <bool TRANS, class Epi>
__device__ __forceinline__ void gemm_dense(const bf16_t* A, int lda, int row0, const bf16_t* Bt, int ldb, int col0, int K, char* lds, const Epi& epi) {
    const int tid = threadIdx.x, srow = tid >> 3, sch = (tid & 7) * 8;
    const bf16_t* a = A + (size_t)(row0 + srow) * lda + sch;
    const bf16_t* b = Bt + (size_t)(col0 + srow) * ldb + sch;
    gemm_tile<TRANS>(a, a + (size_t)64 * lda, a + (size_t)128 * lda, a + (size_t)192 * lda, b, b + (size_t)64 * ldb, K, lds, epi);
}

namespace g8 {
constexpr int BK = 64, HALF = 128, HTB = HALF * BK * 2, STAGE_BYTES = 8 * HTB;
__device__ __forceinline__ void stage_rc(int b, int& R, int& C) { R = b >> 7; const int q = (b >> 4) & 7; C = (q ^ ((R >> 1) & 7)) * 8; }
struct Unit { const char* B; int row0, tn, e, slot; };

typedef int i32x8 __attribute__((ext_vector_type(8)));
typedef int i32x4_t __attribute__((ext_vector_type(4)));
__device__ __forceinline__ bf16x8 lo8(i32x8 v) { return __builtin_bit_cast(bf16x8, __builtin_shufflevector(v, v, 0, 1, 2, 3)); }
__device__ __forceinline__ bf16x8 hi8(i32x8 v) { return __builtin_bit_cast(bf16x8, __builtin_shufflevector(v, v, 4, 5, 6, 7)); }
template <bool FP8, class Epi, class Sched>
__device__ __forceinline__ void gemm8(LAS unsigned char* lds, const char* Abase, int rowB, const Sched& S, const Epi& E) {
    const int tid = threadIdx.x, wid = __builtin_amdgcn_readfirstlane(tid >> 6), lane = tid & 63, wr = wid >> 2, wc = wid & 3, fr = lane & 15, fq = lane >> 4;
    const int nt = rowB / 128;
    int R[2], C[2]; unsigned voffB[2];
#pragma unroll
    for (int i = 0; i < 2; ++i) { stage_rc(tid * 16 + i * 8192, R[i], C[i]); voffB[i] = (unsigned)(R[i] * rowB + C[i] * 2); }
    const size_t kstep = (size_t)(BK * 2);
    const size_t hstep = (size_t)HALF * rowB;
    const unsigned ldsw = (unsigned)wid * 1024u;
    const int fsw = fq ^ ((fr >> 1) & 7);
    const int aoff = (wr * 64 + fr) * 128 + (fsw << 4), aoff1 = (wr * 64 + fr) * 128 + ((fsw ^ 4) << 4);
    const int boff = (wc * 32 + fr) * 128 + (fsw << 4), boff1 = (wc * 32 + fr) * 128 + ((fsw ^ 4) << 4);
#define G8_SA(b, h) (((b) * 2 + (h)) * HTB)
#define G8_SB(b, h) ((4 + (b) * 2 + (h)) * HTB)
#define G8_STAGE(bufoff, gbase, voff) do { _Pragma("unroll") for (int _i = 0; _i < 2; ++_i) \
        __builtin_amdgcn_global_load_lds((const unsigned*)((const char*)(gbase) + (voff)[_i]), (LAS unsigned*)(lds + (bufoff) + ldsw + _i * 8192), 16, 0, 0); } while (0)
#define G8_LD2(a0, a1) __builtin_shufflevector(*(const LAS i32x4_t*)(a0), *(const LAS i32x4_t*)(a1), 0, 1, 2, 3, 4, 5, 6, 7)
#define G8_LDA(dst, b, h) do { _Pragma("unroll") for (int m = 0; m < 4; ++m) dst[m] = G8_LD2(lds + G8_SA(b, h) + aoff + m * 2048, lds + G8_SA(b, h) + aoff1 + m * 2048); } while (0)
#define G8_LDB(dst, b, h) do { _Pragma("unroll") for (int n = 0; n < 2; ++n) dst[n] = G8_LD2(lds + G8_SB(b, h) + boff + n * 2048, lds + G8_SB(b, h) + boff1 + n * 2048); } while (0)
#define G8_MMA(ai, bj, At, Bt) do { __builtin_amdgcn_s_setprio(1); _Pragma("unroll") for (int m = 0; m < 4; ++m) _Pragma("unroll") for (int n = 0; n < 2; ++n) { \
        if constexpr (FP8) asm volatile("s_nop 1\n\tv_mfma_scale_f32_16x16x128_f8f6f4 %0, %1, %2, %0, %3, %3 op_sel_hi:[0,0,0]" : "+v"(acc[ai][bj][m][n]) : "v"(Bt[n]), "v"(At[m]), "v"(scl)); \
        else { acc[ai][bj][m][n] = __builtin_amdgcn_mfma_f32_16x16x32_bf16(lo8(Bt[n]), lo8(At[m]), acc[ai][bj][m][n], 0, 0, 0); \
               acc[ai][bj][m][n] = __builtin_amdgcn_mfma_f32_16x16x32_bf16(hi8(Bt[n]), hi8(At[m]), acc[ai][bj][m][n], 0, 0, 0); } } \
        __builtin_amdgcn_s_setprio(0); } while (0)
#define G8_WAIT_V(n) asm volatile("s_waitcnt vmcnt(" #n ")" ::: "memory")
#define G8_WAIT_L(n) asm volatile("s_waitcnt lgkmcnt(" #n ")" ::: "memory")
#define G8_BAR __builtin_amdgcn_s_barrier()
#define G8_SCHED __builtin_amdgcn_sched_barrier(0)
    Unit cur, nxt; int ui = 0;
    if (!S.next(0, cur)) return;
    f32x4 acc[2][2][4][2];
#pragma unroll
    for (int a = 0; a < 2; ++a)
#pragma unroll
        for (int b = 0; b < 2; ++b)
#pragma unroll
            for (int m = 0; m < 4; ++m)
#pragma unroll
                for (int n = 0; n < 2; ++n) acc[a][b][m][n] = (f32x4){0.f, 0.f, 0.f, 0.f};
    i32x8 At[4], B0[2], B1[2];
    const int scl = 0x7F7F7F7F;
    unsigned co[2][2], no[2][2];
    S.aoff(cur, R, C, co);
    const char* cB = cur.B;
    G8_STAGE(G8_SB(0, 0), cB, voffB); G8_STAGE(G8_SA(0, 0), Abase, co[0]); G8_STAGE(G8_SB(0, 1), cB + hstep, voffB); G8_STAGE(G8_SA(0, 1), Abase, co[1]);
    if (wr == 1) G8_BAR;
    G8_WAIT_V(4); G8_BAR;
    G8_STAGE(G8_SB(1, 0), cB + kstep, voffB); G8_STAGE(G8_SA(1, 0), Abase + kstep, co[0]); G8_STAGE(G8_SB(1, 1), cB + hstep + kstep, voffB);
    G8_WAIT_V(6); G8_BAR;
    for (;;) {
        const bool has_next = S.next(ui + 1, nxt);
        unsigned adelta = 0u;
        if constexpr (Sched::AFFINE) { adelta = has_next ? (unsigned)((nxt.row0 - cur.row0) * rowB) : 0u; }
        else { if (has_next) { int tz = tid; asm volatile("" : "+v"(tz)); int R2[2], C2[2]; stage_rc(tz * 16, R2[0], C2[0]); stage_rc(tz * 16 + 8192, R2[1], C2[1]); S.aoff(nxt, R2, C2, no); } else { no[0][0] = co[0][0]; no[0][1] = co[0][1]; no[1][0] = co[1][0]; no[1][1] = co[1][1]; } }
        const char* nB = has_next ? nxt.B : cB;
#pragma nounroll
        for (int t = 0; t < nt; t += 2) {
            const bool last = (t == nt - 2);
            const char* a1 = Abase + (size_t)(t + 1) * kstep;
            const char* a2 = last ? Abase : Abase + (size_t)(t + 2) * kstep; const char* b2 = last ? nB : cB + (size_t)(t + 2) * kstep;
            const char* a3 = a2 + kstep; const char* b3 = b2 + kstep;
            unsigned o2[2][2];
            if constexpr (Sched::AFFINE) { const unsigned dd = last ? adelta : 0u; o2[0][0] = co[0][0] + dd; o2[0][1] = co[0][1] + dd; o2[1][0] = co[1][0] + dd; o2[1][1] = co[1][1] + dd; }
            else { o2[0][0] = last ? no[0][0] : co[0][0]; o2[0][1] = last ? no[0][1] : co[0][1]; o2[1][0] = last ? no[1][0] : co[1][0]; o2[1][1] = last ? no[1][1] : co[1][1]; }
            G8_LDB(B0, 0, 0); G8_SCHED; G8_LDA(At, 0, 0); G8_STAGE(G8_SA(1, 1), a1, co[1]);
            G8_WAIT_L(8); G8_BAR; G8_WAIT_L(0); G8_MMA(0, 0, At, B0); G8_BAR; G8_SCHED;
            G8_LDB(B1, 0, 1); G8_STAGE(G8_SB(0, 0), b2, voffB);
            G8_BAR; G8_WAIT_L(0); G8_MMA(0, 1, At, B1); G8_BAR;
            G8_LDA(At, 0, 1); G8_STAGE(G8_SA(0, 0), a2, o2[0]);
            G8_BAR; G8_WAIT_L(0); G8_MMA(1, 0, At, B0); G8_BAR; G8_SCHED;
            G8_STAGE(G8_SB(0, 1), b2 + hstep, voffB);
            G8_WAIT_V(6); G8_BAR; G8_MMA(1, 1, At, B1); G8_BAR;
            G8_LDB(B0, 1, 0); G8_SCHED; G8_LDA(At, 1, 0); G8_STAGE(G8_SA(0, 1), a2, o2[1]);
            G8_WAIT_L(8); G8_BAR; G8_WAIT_L(0); G8_MMA(0, 0, At, B0); G8_BAR; G8_SCHED;
            G8_LDB(B1, 1, 1); G8_STAGE(G8_SB(1, 0), b3, voffB);
            G8_BAR; G8_WAIT_L(0); G8_MMA(0, 1, At, B1); G8_BAR;
            G8_LDA(At, 1, 1); G8_STAGE(G8_SA(1, 0), a3, o2[0]);
            G8_BAR; G8_WAIT_L(0); G8_MMA(1, 0, At, B0); G8_BAR; G8_SCHED;
            G8_STAGE(G8_SB(1, 1), b3 + hstep, voffB);
            G8_WAIT_V(6); G8_BAR; G8_MMA(1, 1, At, B1); G8_BAR;
        }
        if constexpr (FP8) { __builtin_amdgcn_sched_barrier(0); asm volatile("s_nop 15\n\ts_nop 15" ::: "memory"); __builtin_amdgcn_sched_barrier(0); }
        { int fr2 = fr, fq2 = fq; asm volatile("" : "+v"(fr2), "+v"(fq2)); E(acc, cur, wr, wc, fr2, fq2); }
        if (!has_next) break;
#pragma unroll
        for (int a = 0; a < 2; ++a)
#pragma unroll
            for (int b = 0; b < 2; ++b)
#pragma unroll
                for (int m = 0; m < 4; ++m)
#pragma unroll
                    for (int n = 0; n < 2; ++n) acc[a][b][m][n] = (f32x4){0.f, 0.f, 0.f, 0.f};
        cur = nxt; cB = nB; ++ui;
        if constexpr (Sched::AFFINE) { co[0][0] += adelta; co[0][1] += adelta; co[1][0] += adelta; co[1][1] += adelta; }
        else { co[0][0] = no[0][0]; co[0][1] = no[0][1]; co[1][0] = no[1][0]; co[1][1] = no[1][1]; }
    }
    G8_WAIT_V(0);
    if (wr == 0) G8_BAR;
    G8_BAR;
#undef G8_SA
#undef G8_SB
#undef G8_STAGE
#undef G8_LD2
#undef G8_LDA
#undef G8_LDB
#undef G8_MMA
#undef G8_WAIT_V
#undef G8_WAIT_L
#undef G8_BAR
#undef G8_SCHED
}
__device__ __forceinline__ int xcd_major_block() { const int b = blockIdx.x, G = vG(); return ((G & 7) == 0) ? ((b & 7) * (G >> 3) + (b >> 3)) : b; }
}

__device__ __forceinline__ void phase_prologue0(const Params& p, char* lds) {
    const int tid = threadIdx.x, G = vG();
    {
        float* act = (float*)lds;
        float* part = (float*)(lds + 20480);
        float* MF = (float*)(p.ws + OFF_MF);
        for (int e = tid; e < 5 * 1024; e += 512) {
            const int v = e >> 10, kk = e & 1023;
            const float cv = (v < 4) ? p.c[v * D + kk] : p.c_ctx[kk];
            act[e] = cv / (1.0f + __expf(-cv));
        }
        __syncthreads();
        for (int it = blockIdx.x; it < 192; it += G) {
            const int i = it / 96, n0 = (it % 96) * 64, cg = tid & 15, kq = tid >> 4;
            const float* wp = p.mod_w + ((size_t)i * D + kq * 32) * 6144 + n0 + cg * 4;
            f32x4 a0 = {0.f, 0.f, 0.f, 0.f}, a1 = a0, a2 = a0, a3 = a0, a4 = a0;
#pragma unroll 8
            for (int kk = 0; kk < 32; ++kk) {
                const f32x4 wv = *(const f32x4*)(wp + (size_t)kk * 6144);
                const int k = kq * 32 + kk;
                a0 += act[k] * wv; a1 += act[1024 + k] * wv; a2 += act[2048 + k] * wv; a3 += act[3072 + k] * wv; a4 += act[4096 + k] * wv;
            }
            __syncthreads();
            *(f32x4*)(part + (kq * 5 + 0) * 64 + cg * 4) = a0; *(f32x4*)(part + (kq * 5 + 1) * 64 + cg * 4) = a1; *(f32x4*)(part + (kq * 5 + 2) * 64 + cg * 4) = a2;
            *(f32x4*)(part + (kq * 5 + 3) * 64 + cg * 4) = a3; *(f32x4*)(part + (kq * 5 + 4) * 64 + cg * 4) = a4;
            __syncthreads();
            if (tid < 320) {
                const int v = tid >> 6, c = tid & 63;
                float sum = p.mod_b[i * 6144 + n0 + c];
#pragma unroll 8
                for (int q = 0; q < 32; ++q) sum += part[(q * 5 + v) * 64 + c];
                MF[(size_t)(i * 5 + v) * 6144 + n0 + c] = sum;
            }
        }
    }
    {
        float* rope = (float*)(p.ws + OFF_ROPE);
        for (int e = blockIdx.x * 512 + tid; e < 1024; e += G * 512) {
            const int pos = e >> 4, i = e & 15;
            const float inv = powf(10000.0f, -(float)i / 16.0f);
            const float ang = (float)pos * inv;
            rope[e] = cosf(ang); rope[1024 + e] = sinf(ang);
        }
        float2* ABAR = (float2*)(p.ws + OFF_ABAR); float2* A64 = (float2*)(p.ws + OFF_A64);
        bf16_t* CM = (bf16_t*)(p.ws + OFF_CMAT);
        for (int e = blockIdx.x * 512 + tid; e < 4096; e += G * 512) {
            const int dg = e >> 6;
            const float lre = p.s5_lam_re[e], lim = p.s5_lam_im[e];
            const float dt = expf(p.s5_log_dt[dg]);
            const float mag = expf(lre * dt);
            float sn, cs; sincosf(lim * dt, &sn, &cs);
            const float ar = mag * cs, ai = mag * sn;
            ABAR[e] = make_float2(ar, ai);
            float pr = ar, pi = ai;
#pragma unroll
            for (int q = 0; q < 6; ++q) { const float nr = pr * pr - pi * pi, ni = 2.0f * pr * pi; pr = nr; pi = ni; }
            A64[e] = make_float2(pr, pi);
            const float nr = ar - 1.0f, ni = ai, den = lre * lre + lim * lim;
            const float cr = (nr * lre + ni * lim) / den, ci = (ni * lre - nr * lim) / den;
            const int pidx = e & 63;
            bf16_t* bt = (bf16_t*)(p.ws + OFF_BBAR) + ((size_t)dg * 128 + 2 * pidx) * 16;
#pragma unroll
            for (int h = 0; h < 16; ++h) {
                const float br = p.s5_b_re[(size_t)e * 16 + h], bi = p.s5_b_im[(size_t)e * 16 + h];
                const unsigned pk = pack2(cr * br - ci * bi, cr * bi + ci * br);
                bt[h] = (bf16_t)(pk & 0xffffu); bt[16 + h] = (bf16_t)(pk >> 16);
            }
        }
        for (int e = blockIdx.x * 512 + tid; e < 64 * 16 * 128; e += G * 512) {
            const int k = e & 127, dgh = e >> 7, pp = k >> 1;
            const float v = (k & 1) ? -p.s5_c_im[(size_t)dgh * 64 + pp] : p.s5_c_re[(size_t)dgh * 64 + pp];
            CM[e] = (bf16_t)(pack2(v, 0.f) & 0xffffu);
        }
    }
}

template <bool FP8>
__device__ __forceinline__ void conv_matrices(const float* src, int nmat, int K, int N, int Npad, bf16_t* dst, bool perm, int& base, char* lds) {
    const int tid = threadIdx.x, G = vG();
    const int tk = K >> 6, tn = Npad >> 8, per = tk * tn, total = nmat * per;
    float* T = (float*)lds;
    int start = (int)(((long)blockIdx.x - (long)(base % G) + G) % G);
    f32x4 rv[8];
    auto issue = [&](int ti) {
        const int mat = ti / per, r = ti % per, kt = r / tn, nt = r % tn;
        const float* S = src + (size_t)mat * K * N + (size_t)(kt * 64) * N + nt * 256 + (tid & 63) * 4;
        const bool ok = nt * 256 + (tid & 63) * 4 < N;
#pragma unroll
        for (int i = 0; i < 8; ++i) {
            rv[i] = (f32x4){0.f, 0.f, 0.f, 0.f};
            if (ok) rv[i] = __builtin_nontemporal_load((const f32x4*)(S + (size_t)((tid >> 6) + 8 * i) * N));
        }
    };
    if (start < total) issue(start);
    for (int ti = start; ti < total; ti += G) {
        const int mat = ti / per, r = ti % per, kt = r / tn, nt = r % tn;
        bf16_t* Dm = dst + (size_t)mat * Npad * K;
        const int k0 = kt * 64, n0 = nt * 256;
        __syncthreads();
#pragma unroll
        for (int i = 0; i < 8; ++i) *(f32x4*)(T + ((tid >> 6) + 8 * i) * 260 + (tid & 63) * 4) = rv[i];
        __syncthreads();
        if (ti + G < total) issue(ti + G);
        const int n = tid >> 1, kh = tid & 1;
        int drow = n0 + n;
        if (perm) { const int up = drow >> 10, jj = drow & 1023; drow = ((jj >> 4) << 5) + (up << 4) + (jj & 15); }
        if constexpr (FP8) {
            unsigned pk[8];
#pragma unroll
            for (int j = 0; j < 8; ++j) pk[j] = pack4_fp8(64.f * T[(kh * 32 + 4 * j) * 260 + n], 64.f * T[(kh * 32 + 4 * j + 1) * 260 + n], 64.f * T[(kh * 32 + 4 * j + 2) * 260 + n], 64.f * T[(kh * 32 + 4 * j + 3) * 260 + n]);
            uint4* dp = (uint4*)((char*)dst + (size_t)mat * Npad * K + (size_t)drow * K + k0 + kh * 32);
            dp[0] = make_uint4(pk[0], pk[1], pk[2], pk[3]); dp[1] = make_uint4(pk[4], pk[5], pk[6], pk[7]);
        } else {
            unsigned pk[16];
#pragma unroll
            for (int j = 0; j < 16; ++j) pk[j] = pack2(T[(kh * 32 + 2 * j) * 260 + n], T[(kh * 32 + 2 * j + 1) * 260 + n]);
            uint4* dp = (uint4*)(Dm + (size_t)drow * K + k0 + kh * 32);
            dp[0] = make_uint4(pk[0], pk[1], pk[2], pk[3]); dp[1] = make_uint4(pk[4], pk[5], pk[6], pk[7]);
            dp[2] = make_uint4(pk[8], pk[9], pk[10], pk[11]); dp[3] = make_uint4(pk[12], pk[13], pk[14], pk[15]);
        }
    }
    base += total;
}
__device__ __forceinline__ void phase_prologue1(const Params& p, char* lds) {
    const int tid = threadIdx.x, G = vG();
    int base = 0;
    conv_matrices<false>(p.rec_w_in, 1, 1024, 2080, 2304, (bf16_t*)(p.ws + OFF_WRI), false, base, lds);
    conv_matrices<false>(p.rec_w_out, 1, 1024, 1024, 1024, (bf16_t*)(p.ws + OFF_WRO), false, base, lds);
    conv_matrices<false>(p.s5_glu_w, 1, 512, 512, 512, (bf16_t*)(p.ws + OFF_WGLU), false, base, lds);
    conv_matrices<false>(p.mla_w_down, 1, 1024, 704, DNW, (bf16_t*)(p.ws + OFF_WDN), false, base, lds);
    conv_matrices<false>(p.mla_w_uq, 1, 384, 1536, 1536, (bf16_t*)(p.ws + OFF_WUQ), false, base, lds);
    conv_matrices<false>(p.mla_w_ukv, 1, 256, 2048, 2048, (bf16_t*)(p.ws + OFF_WUKV), false, base, lds);
    conv_matrices<false>(p.mla_w_o, 1, 1024, 1024, 1024, (bf16_t*)(p.ws + OFF_WO), false, base, lds);
}

constexpr int CV_TILES_IN = 32 * 16 * 8, CV_TILES_OUT = 32 * 16 * 4, CV_TILES_SET = CV_TILES_IN + CV_TILES_OUT;
constexpr size_t OFF_ZERO64 = OFF_CNT + 2048;
constexpr size_t OFF_TICKET = OFF_CNT + 1024;
constexpr int N_COMPUTE = 208;
struct CvTile { const float* S; char* dst; int N, k0, drow, f8; };
__device__ __forceinline__ CvTile cv_decode(const Params& p, int tg) {
    const int tid = threadIdx.x, set = tg / CV_TILES_SET, t = tg % CV_TILES_SET;
    const bool is_in = t < CV_TILES_IN; const int tt = is_in ? t : t - CV_TILES_IN;
    const int N = is_in ? 2048 : 1024, tn = N >> 8, per = 16 * tn;
    const int mat = set * NE + tt / per, r = tt % per, kt = r / tn, nt = r % tn, k0 = kt * 64, n0 = nt * 256;
    CvTile c; c.N = N; c.k0 = k0;
    c.S = (is_in ? p.exp_w_in : p.exp_w_out) + (size_t)mat * 1024 * N + (size_t)k0 * N + n0 + (tid & 63) * 4;
    int drow = n0 + (tid >> 1);
    if (is_in) { const int up = drow >> 10, jj = drow & 1023; drow = ((jj >> 4) << 5) + (up << 4) + (jj & 15); }
    c.drow = drow; c.f8 = is_in ? (FP8_G1 != 0) : (FP8_G2 != 0);
    c.dst = p.ws + (is_in ? OFF_EWI : OFF_EWO) + (size_t)mat * N * 1024 * (c.f8 ? 1 : 2);
    return c;
}
__device__ __forceinline__ void cv_load(const CvTile& c, f32x4 (&rv)[8]) {
#pragma unroll
    for (int i = 0; i < 8; ++i) rv[i] = __builtin_nontemporal_load((const f32x4*)(c.S + (size_t)((threadIdx.x >> 6) + 8 * i) * c.N));
}
__device__ __forceinline__ void cv_to_lds(const f32x4 (&rv)[8], float* T) {
#pragma unroll
    for (int i = 0; i < 8; ++i) *(f32x4*)(T + ((threadIdx.x >> 6) + 8 * i) * 260 + (threadIdx.x & 63) * 4) = rv[i];
}
__device__ __forceinline__ void cv_store(const CvTile& c, const float* T) {
    const int n = threadIdx.x >> 1, kh = threadIdx.x & 1;
    if (c.f8) {
        unsigned pk[8];
#pragma unroll
        for (int j = 0; j < 8; ++j) pk[j] = pack4_fp8(64.f * T[(kh * 32 + 4 * j) * 260 + n], 64.f * T[(kh * 32 + 4 * j + 1) * 260 + n], 64.f * T[(kh * 32 + 4 * j + 2) * 260 + n], 64.f * T[(kh * 32 + 4 * j + 3) * 260 + n]);
        uint4* dp = (uint4*)(c.dst + (size_t)c.drow * 1024 + c.k0 + kh * 32);
        dp[0] = make_uint4(pk[0], pk[1], pk[2], pk[3]); dp[1] = make_uint4(pk[4], pk[5], pk[6], pk[7]);
    } else {
        unsigned pk[16];
#pragma unroll
        for (int j = 0; j < 16; ++j) pk[j] = pack2(T[(kh * 32 + 2 * j) * 260 + n], T[(kh * 32 + 2 * j + 1) * 260 + n]);
        uint4* dp = (uint4*)(c.dst + ((size_t)c.drow * 1024 + c.k0 + kh * 32) * 2);
        dp[0] = make_uint4(pk[0], pk[1], pk[2], pk[3]); dp[1] = make_uint4(pk[4], pk[5], pk[6], pk[7]);
        dp[2] = make_uint4(pk[8], pk[9], pk[10], pk[11]); dp[3] = make_uint4(pk[12], pk[13], pk[14], pk[15]);
    }
}
__device__ __forceinline__ void convert_static(const Params& p, int base, int c, int stride, int count, int hi, char* lds) {
    float* T = (float*)lds;
    __syncthreads();
    int t = base + c;
    if (count <= 0 || t >= hi) return;
    f32x4 rv[8];
    CvTile cur = cv_decode(p, t);
    cv_load(cur, rv);
    for (int i = 0; i < count; ++i) {
        const int tn = t + stride;
        const bool more = (i + 1 < count) && (tn < hi);
        cv_to_lds(rv, T);
        __syncthreads();
        CvTile nxt = cur;
        if (more) { nxt = cv_decode(p, tn); cv_load(nxt, rv); }
        cv_store(cur, T);
        if (!more) break;
        cur = nxt; t = tn;
        __syncthreads();
    }
}
constexpr int CV3_NC = 204, CV3_Q = 26, CV7_NC = 136, CV7_Q = 4, CV8_NC = 136, CV8_Q = 18, CV13_NC = 204, CV13_Q = 8, CV15_NC = 192, CV15_Q = 14;
constexpr int CV_B3 = 0, CV_B7 = CV_B3 + (256 - CV3_NC) * CV3_Q, CV_B8 = CV_B7 + (256 - CV7_NC) * CV7_Q, CV_B9 = CV_B8 + (256 - CV8_NC) * CV8_Q;
constexpr int CV_B13 = CV_TILES_SET, CV_B15 = CV_B13 + (256 - CV13_NC) * CV13_Q, CV_B17 = CV_B15 + (256 - CV15_NC) * CV15_Q;
static_assert(CV_B9 <= CV_TILES_SET && CV_B17 <= 2 * CV_TILES_SET, "conversion quotas exceed the tile sets");

__device__ __forceinline__ void load_row(const float* rp, int lane, float4 (&v)[4]) {
#pragma unroll
    for (int j = 0; j < 4; ++j) v[j] = *(const float4*)(rp + 4 * lane + 256 * j);
}
__device__ __forceinline__ float row_rstd(const float4 (&v)[4]) {
    float ss = 0.f;
#pragma unroll
    for (int j = 0; j < 4; ++j) ss += v[j].x * v[j].x + v[j].y * v[j].y + v[j].z * v[j].z + v[j].w * v[j].w;
    ss = wave_sum(ss);
    return rsqrtf(ss * (1.0f / 1024.0f) + EPS);
}
__device__ __forceinline__ void modulate_store(const float4 (&v)[4], float rstd, const float* g, const float* shift, const float* scale,
                                               bf16_t* dst, int lane, float4 (&o)[4]) {
#pragma unroll
    for (int j = 0; j < 4; ++j) {
        const int col = 4 * lane + 256 * j;
        const float4 gg = *(const float4*)(g + col), sh = *(const float4*)(shift + col), sc = *(const float4*)(scale + col);
        o[j].x = v[j].x * rstd * gg.x * (1.0f + sc.x) + sh.x; o[j].y = v[j].y * rstd * gg.y * (1.0f + sc.y) + sh.y;
        o[j].z = v[j].z * rstd * gg.z * (1.0f + sc.z) + sh.z; o[j].w = v[j].w * rstd * gg.w * (1.0f + sc.w) + sh.w;
        *(uint2*)(dst + col) = make_uint2(pack2(o[j].x, o[j].y), pack2(o[j].z, o[j].w));
    }
}
__device__ __forceinline__ const float* input_row(const Params& p, int r) { const int b = r / SB, s = r % SB; return (s < CTXL) ? p.ctx + ((size_t)b * CTXL + s) * D : p.x + ((size_t)b * SEQ + (s - CTXL)) * D; }
__device__ __forceinline__ int row_modv(int r) { const int b = r / SB, s = r % SB; return (s < CTXL) ? 4 : b; }

__device__ __forceinline__ void phase_prenorm(const Params& p, int L) {
    const int lane = threadIdx.x & 63, gw = blockIdx.x * 8 + (threadIdx.x >> 6), GW = vG() * 8;
    const float* xs = (const float*)(p.ws + OFF_XS); bf16_t* HB = (bf16_t*)(p.ws + OFF_HB);
    const float* MF = (const float*)(p.ws + OFF_MF);
    for (int r = gw; r < NT; r += GW) {
        float4 v[4], o[4]; load_row(L == 0 ? input_row(p, r) : xs + (size_t)r * D, lane, v);
        const float rstd = row_rstd(v);
        const float* mv = MF + (size_t)(L * 5 + row_modv(r)) * 6144;
        modulate_store(v, rstd, p.norm_mix_pre + L * D, mv, mv + 1024, HB + (size_t)r * D, lane, o);
    }
}

struct EpiBf16 {
    bf16_t* O; int ld; int row0, col0;
    __device__ __forceinline__ void operator()(const f32x4 (&acc)[4][4], int wm, int wn, int lane) const {
#pragma unroll
        for (int m = 0; m < 4; ++m) {
            bf16_t* rp = O + (size_t)(row0 + wm * 64 + m * 16 + (lane & 15)) * ld + col0 + wn * 64 + 4 * (lane >> 4);
#pragma unroll
            for (int n = 0; n < 4; ++n) *(uint2*)(rp + n * 16) = make_uint2(pack2(acc[m][n][0], acc[m][n][1]), pack2(acc[m][n][2], acc[m][n][3]));
        }
    }
};
struct EpiF32 {
    float* O; int ld; int row0, col0;
    __device__ __forceinline__ void operator()(const f32x4 (&acc)[4][4], int wm, int wn, int lane) const {
#pragma unroll
        for (int m = 0; m < 4; ++m) {
            float* rp = O + (size_t)(row0 + wm * 64 + m * 16 + (lane & 15)) * ld + col0 + wn * 64 + 4 * (lane >> 4);
#pragma unroll
            for (int n = 0; n < 4; ++n) *(f32x4*)(rp + n * 16) = acc[m][n];
        }
    }
};
struct EpiGlu {
    bf16_t* MIX; const bf16_t* Y; const float* bias; int row0, col0;
    __device__ __forceinline__ void operator()(const f32x4 (&acc)[4][4], int wm, int wn, int lane) const {
#pragma unroll
        for (int m = 0; m < 4; ++m) {
            const int row = row0 + wm * 64 + m * 16 + (lane & 15);
#pragma unroll
            for (int n = 0; n < 4; ++n) {
                const int col = col0 + wn * 64 + n * 16 + 4 * (lane >> 4);
                const uint2 yv = *(const uint2*)(Y + (size_t)row * 512 + col);
                const f32x4 bb = *(const f32x4*)(bias + col);
                const float y0 = lo_bf(yv.x), y1 = hi_bf(yv.x), y2 = lo_bf(yv.y), y3 = hi_bf(yv.y);
                const float o0 = y0 * sigmoidf_(acc[m][n][0] + bb[0]), o1 = y1 * sigmoidf_(acc[m][n][1] + bb[1]);
                const float o2 = y2 * sigmoidf_(acc[m][n][2] + bb[2]), o3 = y3 * sigmoidf_(acc[m][n][3] + bb[3]);
                *(uint2*)(MIX + (size_t)row * D + 512 + col) = make_uint2(pack2(o0, o1), pack2(o2, o3));
            }
        }
    }
};
struct EpiMoe1 {
    bf16_t* ACT; const float* bin; int prow0, tn;
    __device__ __forceinline__ void operator()(const f32x4 (&acc)[4][4], int wm, int wn, int lane) const {
#pragma unroll
        for (int m = 0; m < 4; ++m) {
            const int row = prow0 + wm * 64 + m * 16 + (lane & 15);
#pragma unroll
            for (int h = 0; h < 2; ++h) {
                const int j0 = 64 * tn + 32 * wn + 16 * h + 4 * (lane >> 4);
                const f32x4 bg = *(const f32x4*)(bin + j0), bu = *(const f32x4*)(bin + 1024 + j0);
                float o[4];
#pragma unroll
                for (int q = 0; q < 4; ++q) {
                    float gt = acc[m][2 * h][q] + bg[q], up = acc[m][2 * h + 1][q] + bu[q];
                    gt = fminf(gt, 7.0f); up = fminf(fmaxf(up, -7.0f), 7.0f);
                    o[q] = (up + 1.0f) * gt * sigmoidf_(1.702f * gt);
                }
                *(uint2*)(ACT + (size_t)row * D + j0) = make_uint2(pack2(o[0], o[1]), pack2(o[2], o[3]));
            }
        }
    }
};
struct EpiBf16Bias {
    bf16_t* O; const float* bias; int row0, col0;
    __device__ __forceinline__ void operator()(const f32x4 (&acc)[4][4], int wm, int wn, int lane) const {
#pragma unroll
        for (int m = 0; m < 4; ++m) {
            bf16_t* rp = O + (size_t)(row0 + wm * 64 + m * 16 + (lane & 15)) * D;
#pragma unroll
            for (int n = 0; n < 4; ++n) {
                const int col = col0 + wn * 64 + n * 16 + 4 * (lane >> 4);
                const f32x4 bb = *(const f32x4*)(bias + col);
                *(uint2*)(rp + col) = make_uint2(pack2(acc[m][n][0] + bb[0], acc[m][n][1] + bb[1]), pack2(acc[m][n][2] + bb[2], acc[m][n][3] + bb[3]));
            }
        }
    }
};

__device__ __forceinline__ void phase_gemm_recin(const Params& p, char* lds) {
    const bf16_t* A = (const bf16_t*)(p.ws + OFF_HB); const bf16_t* Bt = (const bf16_t*)(p.ws + OFF_WRI); bf16_t* O = (bf16_t*)(p.ws + OFF_PB);
    const int nN = PW / 128, nunits = (NT / 256) * nN;
    for (int u = blockIdx.x; u < nunits; u += vG()) {
        const int mt = u / nN, tn = u % nN;
        EpiBf16 epi{O, PW, mt * 256, tn * 128};
        gemm_dense<true>(A, D, mt * 256, Bt, D, tn * 128, D, lds, epi);
    }
}
__device__ __forceinline__ void phase_gemm_glu(const Params& p, char* lds) {
    const bf16_t* A = (const bf16_t*)(p.ws + OFF_Y); const bf16_t* Bt = (const bf16_t*)(p.ws + OFF_WGLU);
    const int nunits = (NT / 256) * 4;
    for (int u = blockIdx.x; u < nunits; u += vG()) {
        const int mt = u >> 2, tn = u & 3;
        EpiGlu epi{(bf16_t*)(p.ws + OFF_MIX), A, p.s5_glu_b, mt * 256, tn * 128};
        gemm_dense<true>(A, 512, mt * 256, Bt, 512, tn * 128, 512, lds, epi);
    }
}
__device__ __forceinline__ void phase_gemm_out(const Params& p, size_t offA, size_t offW, bool xonly, char* lds) {
    const bf16_t* A = (const bf16_t*)(p.ws + offA); const bf16_t* Bt = (const bf16_t*)(p.ws + offW); float* O = (float*)(p.ws + OFF_YX);
    const int nmt = xonly ? 64 : 68, nunits = nmt * 8;
    for (int u = blockIdx.x; u < nunits; u += vG()) {
        const int mi = u >> 3, tn = u & 7;
        const int row0 = xonly ? ((mi >> 4) * SB + ((mi & 15) + 1) * 256) : mi * 256;
        EpiF32 epi{O, D, row0, tn * 128};
        gemm_dense<true>(A, D, row0, Bt, D, tn * 128, D, lds, epi);
    }
}

__device__ __forceinline__ void phase_postmix(const Params& p, int L, bool xonly, char* lds) {
    const int tid = fresh_tid(), lane = tid & 63, gw = blockIdx.x * 8 + (tid >> 6), GW = vG() * 8;
    float* rwT = (float*)lds;
    const float* rw = p.router_w + (size_t)L * D * NE;
    for (int e = tid; e < D * NE; e += 512) rwT[(e & 31) * 1024 + (e >> 5)] = rw[e];
    __syncthreads();
    float* __restrict__ xs = (float*)(p.ws + OFF_XS); bf16_t* __restrict__ HB = (bf16_t*)(p.ws + OFF_HB);
    const float* __restrict__ MF = (const float*)(p.ws + OFF_MF);
    int* CNT = (int*)(p.ws + OFF_CNT) + L * NE; int* __restrict__ LIST = (int*)(p.ws + OFF_LIST);
    int* SE = (int*)(p.ws + OFF_SE); int* SP = (int*)(p.ws + OFF_SP); float* GT = (float*)(p.ws + OFF_GT);
    const float* gpost = p.norm_mix_post + L * D; const float* gpre = p.norm_ffn_pre + L * D;
    const float rbias = p.router_b[L * NE + ((lane >> 1) & 31)];
    const int nrows = xonly ? NB * SEQ : NT;
#pragma unroll 1
    for (int ri = gw; ri < nrows; ri += GW) {
        const int r = xonly ? ((ri >> 12) * SB + CTXL + (ri & 4095)) : ri;
        const float* mv = MF + (size_t)(L * 5 + row_modv(r)) * 6144;
        float4 y[4], xv[4], f[4];
        {
            const bf16_t* yp = (const bf16_t*)(p.ws + OFF_YX) + (size_t)r * D;
#pragma unroll
            for (int j = 0; j < 4; ++j) { const uint2 t = *(const uint2*)(yp + 4 * lane + 256 * j); y[j] = make_float4(lo_bf(t.x), hi_bf(t.x), lo_bf(t.y), hi_bf(t.y)); }
        }
        load_row(L == 0 ? input_row(p, r) : xs + (size_t)r * D, lane, xv);
        const float rs1 = row_rstd(y);
#pragma unroll
        for (int j = 0; j < 4; ++j) {
            const int col = 4 * lane + 256 * j;
            const float4 gg = *(const float4*)(gpost + col), g2 = *(const float4*)(mv + 2048 + col);
            xv[j].x += g2.x * (y[j].x * rs1 * gg.x); xv[j].y += g2.y * (y[j].y * rs1 * gg.y);
            xv[j].z += g2.z * (y[j].z * rs1 * gg.z); xv[j].w += g2.w * (y[j].w * rs1 * gg.w);
            *(float4*)(xs + (size_t)r * D + col) = xv[j];
        }
        const float rs2 = row_rstd(xv);
        modulate_store(xv, rs2, gpre, mv + 3 * 1024, mv + 4 * 1024, HB + (size_t)r * D, lane, f);
        if (FP8_G1) {
#pragma unroll
            for (int j = 0; j < 4; ++j) *(unsigned*)(p.ws + OFF_HB8 + (size_t)r * D + 4 * lane + 256 * j) = pack4_fp8(f[j].x, f[j].y, f[j].z, f[j].w);
        }
        float pl[32];
#pragma unroll
        for (int e = 0; e < NE; ++e) {
            float s = 0.f;
#pragma unroll
            for (int j = 0; j < 4; ++j) {
                const float4 wv = *(const float4*)(rwT + e * 1024 + 4 * lane + 256 * j);
                s += f[j].x * wv.x + f[j].y * wv.y + f[j].z * wv.z + f[j].w * wv.w;
            }
            pl[e] = s;
            asm volatile("" ::: "memory");
        }
#pragma unroll
        for (int i = 0; i < 16; ++i) { const bool up = (lane & 32) != 0; const float snd = up ? pl[i] : pl[i + 16], kp = up ? pl[i + 16] : pl[i]; pl[i] = kp + __shfl_xor(snd, 32); }
#pragma unroll
        for (int i = 0; i < 8; ++i) { const bool up = (lane & 16) != 0; const float snd = up ? pl[i] : pl[i + 8], kp = up ? pl[i + 8] : pl[i]; pl[i] = kp + __shfl_xor(snd, 16); }
#pragma unroll
        for (int i = 0; i < 4; ++i) { const bool up = (lane & 8) != 0; const float snd = up ? pl[i] : pl[i + 4], kp = up ? pl[i + 4] : pl[i]; pl[i] = kp + __shfl_xor(snd, 8); }
#pragma unroll
        for (int i = 0; i < 2; ++i) { const bool up = (lane & 4) != 0; const float snd = up ? pl[i] : pl[i + 2], kp = up ? pl[i + 2] : pl[i]; pl[i] = kp + __shfl_xor(snd, 4); }
        { const bool up = (lane & 2) != 0; const float snd = up ? pl[0] : pl[1], kp = up ? pl[1] : pl[0]; pl[0] = kp + __shfl_xor(snd, 2); }
        const int myexp = (lane >> 1) & 31;
        float mylogit = pl[0] + __shfl_xor(pl[0], 1) + rbias;
        float tv[4]; int tix[4];
#pragma unroll
        for (int k = 0; k < 4; ++k) {
            float v = mylogit; int idx = myexp;
#pragma unroll
            for (int o = 32; o >= 2; o >>= 1) {
                const float ov = __shfl_xor(v, o); const int oi = __shfl_xor(idx, o);
                if (ov > v || (ov == v && oi < idx)) { v = ov; idx = oi; }
            }
            tv[k] = v; tix[k] = idx;
            if (myexp == idx) mylogit = -3.0e38f;
        }
        const float e1 = __expf(tv[1] - tv[0]), e2 = __expf(tv[2] - tv[0]), e3 = __expf(tv[3] - tv[0]);
        const float inv = 1.0f / (1.0f + e1 + e2 + e3);
        if (lane < 4) {
            const int ex = lane == 0 ? tix[0] : lane == 1 ? tix[1] : lane == 2 ? tix[2] : tix[3];
            const float gtv = (lane == 0 ? 1.0f : lane == 1 ? e1 : lane == 2 ? e2 : e3) * inv;
            const int pos = atomicAdd(&CNT[ex], 1);
            LIST[(size_t)ex * NT + pos] = r;
            SE[r * 4 + lane] = ex; SP[r * 4 + lane] = pos; GT[r * 4 + lane] = gtv;
        }
    }
}

__device__ __forceinline__ void moe_prefix(const Params& p, int L, int* tp) {
    if (threadIdx.x == 0) {
        unsigned* CNT = (unsigned*)(p.ws + OFF_CNT) + L * NE;
        int s = 0; tp[0] = 0;
        for (int e = 0; e < NE; ++e) { const int c = (int)xb_ld(&CNT[e]); tp[33 + e] = c; s += (c + 255) >> 8; tp[e + 1] = s; }
    }
    __syncthreads();
}
__device__ __forceinline__ void phase_moe1(const Params& p, int L, char* lds) {
    int* tp = (int*)(lds + 2 * G_STAGE);
    moe_prefix(p, L, tp);
    const int tid = threadIdx.x, srow = tid >> 3, sch = (tid & 7) * 8;
    const bf16_t* HB = (const bf16_t*)(p.ws + OFF_HB); const int* LIST = (const int*)(p.ws + OFF_LIST);
    const int nunits = tp[32] * 16;
    for (int u = blockIdx.x; u < nunits; u += vG()) {
        const int mtg = u >> 4, tn = u & 15;
        int e = 0; while (tp[e + 1] <= mtg) ++e;
        const int mt = mtg - tp[e], cnt = tp[33 + e];
        const int* le = LIST + (size_t)e * NT;
        const bf16_t* ap[4];
#pragma unroll
        for (int j = 0; j < 4; ++j) { const int pos = mt * 256 + srow + 64 * j; const int tok = le[pos < cnt ? pos : 0]; ap[j] = HB + (size_t)tok * D + sch; }
        const bf16_t* b = (const bf16_t*)(p.ws + OFF_EWI) + ((size_t)(L * NE + e) * 2048 + tn * 128 + srow) * D + sch;
        EpiMoe1 epi{(bf16_t*)(p.ws + OFF_ACT), p.exp_b_in + (size_t)(L * NE + e) * 2048, mtg * 256, tn};
        gemm_tile<true>(ap[0], ap[1], ap[2], ap[3], b, b + (size_t)64 * D, D, lds, epi);
    }
}
__device__ __forceinline__ void phase_moe2(const Params& p, int L, char* lds) {
    int* tp = (int*)(lds + 2 * G_STAGE);
    moe_prefix(p, L, tp);
    const int nunits = tp[32] * 8;
    for (int u = blockIdx.x; u < nunits; u += vG()) {
        const int mtg = u >> 3, tn = u & 7;
        int e = 0; while (tp[e + 1] <= mtg) ++e;
        EpiBf16Bias epi{(bf16_t*)(p.ws + OFF_YR), p.exp_b_out + (size_t)(L * NE + e) * D, mtg * 256, tn * 128};
        gemm_dense<true>((const bf16_t*)(p.ws + OFF_ACT), D, mtg * 256, (const bf16_t*)(p.ws + OFF_EWO) + (size_t)(L * NE + e) * D * D, D, tn * 128, D, lds, epi);
    }
}
constexpr int G8_TAB = g8::STAGE_BYTES, G8_TP = g8::STAGE_BYTES + 16384;
constexpr int G8_NSLOT = 16;
template <bool GATHER>
struct SchedMoe8 {
    static constexpr bool AFFINE = !GATHER;
    const int* tp; const unsigned* tab; const int* list; const char* Bbase; size_t bexp; int ntn_sh, rowB, x, j, bpx; int tx1, tx2, tx3, tx4;
    __device__ __forceinline__ void init(const int* tp_, const unsigned* tab_, const int* list_, const char* Bbase_, size_t bexp_, int ntn_sh_, int rowB_) {
        tp = tp_; tab = tab_; list = list_; Bbase = Bbase_; bexp = bexp_; ntn_sh = ntn_sh_; rowB = rowB_;
        const int cblk = g8::xcd_major_block(); bpx = vG() >> 3; x = cblk / bpx; j = cblk % bpx;
        tx1 = tp[x + 1] - tp[x]; tx2 = tx1 + tp[x + 9] - tp[x + 8]; tx3 = tx2 + tp[x + 17] - tp[x + 16]; tx4 = tx3 + tp[x + 25] - tp[x + 24];
    }
    __device__ __forceinline__ bool next(int i, g8::Unit& u) const {
        const int l = i * bpx + j, tl = l >> ntn_sh, tn = l & ((1 << ntn_sh) - 1);
        if (tl >= tx4) return false;
        const int k = (tl >= tx1) + (tl >= tx2) + (tl >= tx3), e = x + 8 * k;
        const int mt = tl - (k == 0 ? 0 : k == 1 ? tx1 : k == 2 ? tx2 : tx3);
        u.B = Bbase + (size_t)e * bexp + (size_t)tn * 256 * rowB; u.row0 = (tp[e] + mt) * 256; u.tn = tn; u.e = e; u.slot = i; return true;
    }
    __device__ __forceinline__ void aoff(const g8::Unit& u, const int (&R)[2], const int (&C)[2], unsigned (&o)[2][2]) const {
#pragma unroll
        for (int h = 0; h < 2; ++h)
#pragma unroll
            for (int i = 0; i < 2; ++i) {
                if (GATHER) {
                    unsigned ro;
                    if (u.slot < G8_NSLOT) ro = tab[u.slot * 256 + h * 128 + R[i]];
                    else { const int pos = u.row0 - tp[u.e] * 256 + h * 128 + R[i]; ro = (unsigned)list[(size_t)u.e * NT + (pos < tp[33 + u.e] ? pos : 0)] * (unsigned)rowB; }
                    o[h][i] = ro + (unsigned)C[i] * 2u;
                } else o[h][i] = (unsigned)((u.row0 + h * 128 + R[i]) * rowB + C[i] * 2);
            }
    }
};
struct SchedDense8 {
    static constexpr bool AFFINE = true;
    const char* Bbase; int nunits, ntn, rowB, G, cblk;
    __device__ __forceinline__ bool next(int i, g8::Unit& u) const {
        const int L = i * G + cblk; if (L >= nunits) return false;
        const int mt = L / ntn, tn = L % ntn;
        u.B = Bbase + (size_t)tn * 256 * rowB; u.row0 = mt * 256; u.tn = tn; u.e = 0; u.slot = i; return true;
    }
    __device__ __forceinline__ void aoff(const g8::Unit& u, const int (&R)[2], const int (&C)[2], unsigned (&o)[2][2]) const {
#pragma unroll
        for (int h = 0; h < 2; ++h)
#pragma unroll
            for (int i = 0; i < 2; ++i) o[h][i] = (unsigned)((u.row0 + h * 128 + R[i]) * rowB + C[i] * 2);
    }
};
template <bool OUT8>
struct EpiMoe1_8 {
    bf16_t* ACT; const float* bin_all; float sc;
    __device__ __forceinline__ void operator()(const f32x4 (&acc)[2][2][4][2], const g8::Unit& u, int wr, int wc, int fr, int fq) const {
        const float* bin = bin_all + (size_t)u.e * 2048;
#pragma unroll
        for (int bj = 0; bj < 2; ++bj) {
            const int j0 = 128 * u.tn + 64 * bj + 16 * wc + 4 * fq;
            const f32x4 bg = *(const f32x4*)(bin + j0), bu1 = *(const f32x4*)(bin + 1024 + j0) + 1.0f;
#pragma unroll
            for (int ai = 0; ai < 2; ++ai)
#pragma unroll
                for (int m = 0; m < 4; ++m) {
                    const int row = u.row0 + 128 * ai + 64 * wr + 16 * m + fr;
                    const f32x4 gv = acc[ai][bj][m][0] * sc + bg, uv = acc[ai][bj][m][1] * sc + bu1;
                    f32x4 gm, um, ex, rc;
#pragma unroll
                    for (int q = 0; q < 4; ++q) { gm[q] = fminf(gv[q], 7.0f); um[q] = __builtin_amdgcn_fmed3f(uv[q], -6.0f, 8.0f); }
                    const f32x4 ea = gm * (-1.702f * 1.4426950408889634f);
#pragma unroll
                    for (int q = 0; q < 4; ++q) ex[q] = __builtin_amdgcn_exp2f(ea[q]);
                    const f32x4 den = ex + 1.0f;
#pragma unroll
                    for (int q = 0; q < 4; ++q) rc[q] = __builtin_amdgcn_rcpf(den[q]);
                    const f32x4 ov = um * (gm * rc);
                    const float o[4] = {ov[0], ov[1], ov[2], ov[3]};
                    if constexpr (OUT8) *(unsigned*)((char*)ACT + (size_t)row * D + j0) = pack4_fp8(o[0], o[1], o[2], o[3]);
                    else *(uint2*)(ACT + (size_t)row * D + j0) = make_uint2(pack2(o[0], o[1]), pack2(o[2], o[3]));
                }
        }
    }
};
struct EpiBias8 {
    bf16_t* O; const float* bias_all; float sc;
    __device__ __forceinline__ void operator()(const f32x4 (&acc)[2][2][4][2], const g8::Unit& u, int wr, int wc, int fr, int fq) const {
        const float* bias = bias_all + (size_t)u.e * D;
#pragma unroll
        for (int bj = 0; bj < 2; ++bj)
#pragma unroll
            for (int n = 0; n < 2; ++n) {
                const int col = 256 * u.tn + 128 * bj + 32 * wc + 16 * n + 4 * fq;
                const f32x4 bb = *(const f32x4*)(bias + col);
#pragma unroll
                for (int ai = 0; ai < 2; ++ai)
#pragma unroll
                    for (int m = 0; m < 4; ++m) {
                        const int row = u.row0 + 128 * ai + 64 * wr + 16 * m + fr;
                        const f32x4 v = acc[ai][bj][m][n] * sc + bb;
                        *(uint2*)(O + (size_t)row * D + col) = make_uint2(pack2(v[0], v[1]), pack2(v[2], v[3]));
                    }
            }
    }
};
struct EpiBf16_8 {
    bf16_t* O; int ld, ncols;
    __device__ __forceinline__ void operator()(const f32x4 (&acc)[2][2][4][2], const g8::Unit& u, int wr, int wc, int fr, int fq) const {
#pragma unroll
        for (int bj = 0; bj < 2; ++bj)
#pragma unroll
            for (int n = 0; n < 2; ++n) {
                const int col = 256 * u.tn + 128 * bj + 32 * wc + 16 * n + 4 * fq;
                if (col < ncols) {
#pragma unroll
                    for (int ai = 0; ai < 2; ++ai)
#pragma unroll
                        for (int m = 0; m < 4; ++m) {
                            const int row = u.row0 + 128 * ai + 64 * wr + 16 * m + fr;
                            *(uint2*)(O + (size_t)row * ld + col) = make_uint2(pack2(acc[ai][bj][m][n][0], acc[ai][bj][m][n][1]), pack2(acc[ai][bj][m][n][2], acc[ai][bj][m][n][3]));
                        }
                }
            }
    }
};
__device__ __forceinline__ void phase_gemm_recin8(const Params& p, char* lds) {
    SchedDense8 S{p.ws + OFF_WRI, 68 * 9, 9, 2 * D, vG(), g8::xcd_major_block()};
    EpiBf16_8 E{(bf16_t*)(p.ws + OFF_PB), PW, PW};
    g8::gemm8<false>((LAS unsigned char*)lds, p.ws + OFF_HB, 2 * D, S, E);
}
__device__ __forceinline__ void phase_moe1_8(const Params& p, int L, char* lds) {
    int* tp = (int*)(lds + G8_TP); unsigned* tab = (unsigned*)(lds + G8_TAB);
    moe_prefix(p, L, tp);
    const int tid = threadIdx.x;
    const int* LIST = (const int*)(p.ws + OFF_LIST);
    constexpr int EB = FP8_G1 ? 1 : 2;
    SchedMoe8<true> S; S.init(tp, tab, LIST, p.ws + OFF_EWI + (size_t)L * NE * 2048 * D * EB, (size_t)2048 * D * EB, 3, D * EB);
    for (int slot = 0; slot < G8_NSLOT; ++slot) {
        g8::Unit u; if (!S.next(slot, u)) break;
        const int cnt = tp[33 + u.e];
        if (tid < 256) { const int pos = u.row0 - tp[u.e] * 256 + tid; tab[slot * 256 + tid] = (unsigned)LIST[(size_t)u.e * NT + (pos < cnt ? pos : 0)] * (unsigned)(D * EB); }
    }
    __syncthreads();
    EpiMoe1_8<FP8_G2 != 0> E{(bf16_t*)(p.ws + OFF_ACT), p.exp_b_in + (size_t)L * NE * 2048, FP8_G1 ? (1.0f / 64.0f) : 1.0f};
    g8::gemm8<FP8_G1 != 0>((LAS unsigned char*)lds, p.ws + (FP8_G1 ? OFF_HB8 : OFF_HB), D * EB, S, E);
}
__device__ __forceinline__ void phase_moe2_8(const Params& p, int L, char* lds) {
    int* tp = (int*)(lds + G8_TP);
    moe_prefix(p, L, tp);
    constexpr int EB = FP8_G2 ? 1 : 2;
    SchedMoe8<false> S; S.init(tp, nullptr, nullptr, p.ws + OFF_EWO + (size_t)L * NE * D * D * EB, (size_t)D * D * EB, 2, D * EB);
    EpiBias8 E{(bf16_t*)(p.ws + OFF_YR), p.exp_b_out + (size_t)L * NE * D, FP8_G2 ? (1.0f / 64.0f) : 1.0f};
    g8::gemm8<FP8_G2 != 0>((LAS unsigned char*)lds, p.ws + OFF_ACT, D * EB, S, E);
}
struct EpiF32_8 {
    float* O; int ld;
    __device__ __forceinline__ void operator()(const f32x4 (&acc)[2][2][4][2], const g8::Unit& u, int wr, int wc, int fr, int fq) const {
#pragma unroll
        for (int ai = 0; ai < 2; ++ai)
#pragma unroll
            for (int m = 0; m < 4; ++m) {
                float* rp = O + (size_t)(u.row0 + 128 * ai + 64 * wr + 16 * m + fr) * ld + 256 * u.tn + 32 * wc + 4 * fq;
#pragma unroll
                for (int bj = 0; bj < 2; ++bj)
#pragma unroll
                    for (int n = 0; n < 2; ++n) *(f32x4*)(rp + 128 * bj + 16 * n) = acc[ai][bj][m][n];
            }
    }
};
struct SchedX8 {
    static constexpr bool AFFINE = true;
    const char* Bbase; int nunits, ntn, rowB, G, cblk;
    __device__ __forceinline__ bool next(int i, g8::Unit& u) const {
        const int L = i * G + cblk; if (L >= nunits) return false;
        const int mi = L / ntn, tn = L % ntn;
        u.B = Bbase + (size_t)tn * 256 * rowB; u.row0 = (mi >> 4) * SB + ((mi & 15) + 1) * 256; u.tn = tn; u.e = 0; u.slot = i; return true;
    }
    __device__ __forceinline__ void aoff(const g8::Unit& u, const int (&R)[2], const int (&C)[2], unsigned (&o)[2][2]) const {
#pragma unroll
        for (int h = 0; h < 2; ++h)
#pragma unroll
            for (int i = 0; i < 2; ++i) o[h][i] = (unsigned)((u.row0 + h * 128 + R[i]) * rowB + C[i] * 2);
    }
};
struct EpiQ8 {
    bf16_t* QF; const float* rope;
    __device__ __forceinline__ void operator()(const f32x4 (&acc)[2][2][4][2], const g8::Unit& u, int wr, int wc, int fr, int fq) const {
        const float qs = 0.07216878364870322f * 1.4426950408889634f;
        const int sx0 = (u.row0 % SB) - CTXL + 64 * wr + fr;
        const int c0 = 256 * u.tn + 32 * wc;
        const int ta = (c0 >> 4) % 12, tb = ((c0 + 128) >> 4) % 12;
#pragma unroll
        for (int ai = 0; ai < 2; ++ai)
#pragma unroll
            for (int m = 0; m < 4; ++m) {
                const int sx = sx0 + 128 * ai + 16 * m;
                bf16_t* rp = QF + (size_t)(u.row0 + 128 * ai + 64 * wr + 16 * m + fr) * 1536 + c0 + 4 * fq;
#pragma unroll
                for (int bj = 0; bj < 2; ++bj) {
                    const int t12 = bj ? tb : ta;
                    f32x4 o0 = acc[ai][bj][m][0], o1 = acc[ai][bj][m][1];
                    if (t12 >= 8) {
                        const float* rr = rope + ((t12 == 8) ? (sx >> 6) : (sx & 63)) * 16 + 4 * fq;
                        const f32x4 cs = *(const f32x4*)rr, sn = *(const f32x4*)(rr + 1024);
                        const f32x4 t0 = o0 * cs - o1 * sn, t1 = o1 * cs + o0 * sn; o0 = t0; o1 = t1;
                    }
                    if (FP8_QK) {
                        char* r8 = (char*)QF + (size_t)(u.row0 + 128 * ai + 64 * wr + 16 * m + fr) * 1536 + c0 + 4 * fq + 128 * bj;
                        const float q16 = qs * 16.0f;
                        *(unsigned*)(r8) = pack4_fp8(o0[0] * q16, o0[1] * q16, o0[2] * q16, o0[3] * q16);
                        *(unsigned*)(r8 + 16) = pack4_fp8(o1[0] * q16, o1[1] * q16, o1[2] * q16, o1[3] * q16);
                    } else {
                        *(uint2*)(rp + 128 * bj) = make_uint2(pack2(o0[0] * qs, o0[1] * qs), pack2(o0[2] * qs, o0[3] * qs));
                        *(uint2*)(rp + 128 * bj + 16) = make_uint2(pack2(o1[0] * qs, o1[1] * qs), pack2(o1[2] * qs, o1[3] * qs));
                    }
                }
            }
    }
};
struct EpiGlu8 {
    bf16_t* MIX; const bf16_t* Y; const float* bias;
    __device__ __forceinline__ void operator()(const f32x4 (&acc)[2][2][4][2], const g8::Unit& u, int wr, int wc, int fr, int fq) const {
#pragma unroll
        for (int bj = 0; bj < 2; ++bj)
#pragma unroll
            for (int n = 0; n < 2; ++n) {
                const int col = 256 * u.tn + 128 * bj + 32 * wc + 16 * n + 4 * fq;
                const f32x4 bb = *(const f32x4*)(bias + col);
#pragma unroll
                for (int ai = 0; ai < 2; ++ai)
#pragma unroll
                    for (int m = 0; m < 4; ++m) {
                        const int row = u.row0 + 128 * ai + 64 * wr + 16 * m + fr;
                        const uint2 yv = *(const uint2*)(Y + (size_t)row * 512 + col);
                        const f32x4 a = acc[ai][bj][m][n] + bb;
                        const float o0 = lo_bf(yv.x) * sigmoidf_(a[0]), o1 = hi_bf(yv.x) * sigmoidf_(a[1]), o2 = lo_bf(yv.y) * sigmoidf_(a[2]), o3 = hi_bf(yv.y) * sigmoidf_(a[3]);
                        *(uint2*)(MIX + (size_t)row * D + 512 + col) = make_uint2(pack2(o0, o1), pack2(o2, o3));
                    }
            }
    }
};
__device__ __forceinline__ void phase_gemm_glu8(const Params& p, char* lds) {
    SchedDense8 S{p.ws + OFF_WGLU, 68 * 2, 2, 1024, vG(), g8::xcd_major_block()};
    EpiGlu8 E{(bf16_t*)(p.ws + OFF_MIX), (const bf16_t*)(p.ws + OFF_Y), p.s5_glu_b};
    g8::gemm8<false>((LAS unsigned char*)lds, p.ws + OFF_Y, 1024, S, E);
}
__device__ __forceinline__ void phase_gemm_recout8(const Params& p, char* lds) {
    SchedDense8 S{p.ws + OFF_WRO, 68 * 4, 4, 2 * D, vG(), g8::xcd_major_block()};
    EpiBf16_8 E{(bf16_t*)(p.ws + OFF_YX), D, D};
    g8::gemm8<false>((LAS unsigned char*)lds, p.ws + OFF_MIX, 2 * D, S, E);
}
__device__ __forceinline__ void phase_gemm_down8(const Params& p, char* lds) {
    SchedDense8 S{p.ws + OFF_WDN, 68 * 3, 3, 2 * D, vG(), g8::xcd_major_block()};
    EpiBf16_8 E{(bf16_t*)(p.ws + OFF_DN), DNW, DNW};
    g8::gemm8<false>((LAS unsigned char*)lds, p.ws + OFF_HB, 2 * D, S, E);
}
__device__ __forceinline__ void phase_gemm_wo8(const Params& p, char* lds) {
    SchedX8 S{p.ws + OFF_WO, 64 * 4, 4, 2 * D, vG(), g8::xcd_major_block()};
    EpiBf16_8 E{(bf16_t*)(p.ws + OFF_YX), D, D};
    g8::gemm8<false>((LAS unsigned char*)lds, p.ws + OFF_OB, 2 * D, S, E);
}
__device__ __forceinline__ void phase_gemm_q8(const Params& p, char* lds) {
    SchedX8 S{p.ws + OFF_WUQ, 64 * 6, 6, 768, vG(), g8::xcd_major_block()};
    EpiQ8 E{(bf16_t*)(p.ws + OFF_QF), (const float*)(p.ws + OFF_ROPE)};
    g8::gemm8<false>((LAS unsigned char*)lds, p.ws + OFF_CQ, 768, S, E);
}
__device__ __forceinline__ void phase_combine(const Params& p, int L, bool last, char* lds) {
    int* tp = (int*)lds;
    moe_prefix(p, L, tp);
    const int tid = fresh_tid(), lane = tid & 63, gw = blockIdx.x * 8 + (tid >> 6), GW = vG() * 8;
    float* xs = (float*)(p.ws + OFF_XS); const bf16_t* YR = (const bf16_t*)(p.ws + OFF_YR); bf16_t* HB = (bf16_t*)(p.ws + OFF_HB);
    const float* MF = (const float*)(p.ws + OFF_MF);
    const int* SE = (const int*)(p.ws + OFF_SE); const int* SP = (const int*)(p.ws + OFF_SP); const float* GT = (const float*)(p.ws + OFF_GT);
    const float* gpost = p.norm_ffn_post + L * D;
    const int nrows = last ? NB * SEQ : NT;
    auto rowof = [&](int ri) { return last ? ((ri >> 12) * SB + CTXL + (ri & 4095)) : ri; };
    int ne[4], npos[4]; float ng[4];
    uint2 nyv[4][4]; f32x4 nxv[4]; float dg[4];
    auto fetch_idx = [&](int ri) {
        const int r = rowof(ri);
#pragma unroll
        for (int k = 0; k < 4; ++k) { ne[k] = SE[r * 4 + k]; npos[k] = SP[r * 4 + k]; ng[k] = GT[r * 4 + k]; }
    };
    auto fetch_data = [&](int ri) {
        const int r = rowof(ri);
#pragma unroll
        for (int k = 0; k < 4; ++k) {
            const bf16_t* yr = YR + (size_t)(tp[ne[k]] * 256 + npos[k]) * D;
#pragma unroll
            for (int j = 0; j < 4; ++j) nyv[k][j] = *(const uint2*)(yr + 4 * lane + 256 * j);
            dg[k] = ng[k];
        }
#pragma unroll
        for (int j = 0; j < 4; ++j) nxv[j] = *(const f32x4*)(xs + (size_t)r * D + 4 * lane + 256 * j);
    };
    if (gw < nrows) { fetch_idx(gw); fetch_data(gw); }
    if (gw + GW < nrows) fetch_idx(gw + GW);
    for (int ri = gw; ri < nrows; ri += GW) {
        const int r = rowof(ri);
        const float* mv = MF + (size_t)(L * 5 + row_modv(r)) * 6144;
        float4 f[4], xv[4];
#pragma unroll
        for (int j = 0; j < 4; ++j) {
            f[j] = make_float4(0.f, 0.f, 0.f, 0.f);
#pragma unroll
            for (int k = 0; k < 4; ++k) { f[j].x += dg[k] * lo_bf(nyv[k][j].x); f[j].y += dg[k] * hi_bf(nyv[k][j].x); f[j].z += dg[k] * lo_bf(nyv[k][j].y); f[j].w += dg[k] * hi_bf(nyv[k][j].y); }
            xv[j] = make_float4(nxv[j][0], nxv[j][1], nxv[j][2], nxv[j][3]);
        }
        if (ri + GW < nrows) fetch_data(ri + GW);
        if (ri + 2 * GW < nrows) fetch_idx(ri + 2 * GW);
        __builtin_amdgcn_sched_barrier(0);
        const float rs = row_rstd(f);
#pragma unroll
        for (int j = 0; j < 4; ++j) {
            const int col = 4 * lane + 256 * j;
            const float4 gg = *(const float4*)(gpost + col), g5 = *(const float4*)(mv + 5 * 1024 + col);
            xv[j].x += g5.x * (f[j].x * rs * gg.x); xv[j].y += g5.y * (f[j].y * rs * gg.y);
            xv[j].z += g5.z * (f[j].z * rs * gg.z); xv[j].w += g5.w * (f[j].w * rs * gg.w);
            if (last) *(float4*)(p.out + (size_t)ri * D + col) = xv[j];
            else *(float4*)(xs + (size_t)r * D + col) = xv[j];
        }
        if (!last) {
            const float rs2 = row_rstd(xv);
            const float* mv1 = MF + (size_t)((L + 1) * 5 + row_modv(r)) * 6144;
            float4 o[4];
            modulate_store(xv, rs2, p.norm_mix_pre + (L + 1) * D, mv1, mv1 + 1024, HB + (size_t)r * D, lane, o);
        }
    }
}

__device__ __forceinline__ void gla_cum(const Params& p, uint2 v, int h, char* lds) {
    const int tid = threadIdx.x;
    float* Gm = (float*)lds; float* RF = (float*)(lds + 32768);
    {
        const int row = tid >> 3, c4 = (tid & 7) * 4;
        *(float4*)(RF + row * 32 + c4) = make_float4(lo_bf(v.x), hi_bf(v.x), lo_bf(v.y), hi_bf(v.y));
    }
    __syncthreads();
    const int d = tid & 63, dir = (tid >> 6) & 1, tg = tid >> 7;
    {
        float wv[16];
#pragma unroll
        for (int r = 0; r < 16; ++r) wv[r] = p.gla_gate_w[(dir * 16 + r) * 256 + h * 64 + d];
        const float bias = p.gla_gate_b[dir * 256 + h * 64 + d];
        for (int tt = 0; tt < 16; ++tt) {
            const int tok = tg * 16 + tt;
            float x = bias;
#pragma unroll
            for (int r = 0; r < 16; ++r) x += RF[tok * 32 + dir * 16 + r] * wv[r];
            const float ls = fminf(x, 0.f) - 0.6931471805599453f * __builtin_amdgcn_logf(1.0f + __builtin_amdgcn_exp2f(-1.4426950408889634f * fabsf(x)));
            Gm[(dir * 64 + tok) * 64 + d] = ls * (1.0f / 16.0f);
        }
    }
    __syncthreads();
    {
        float* gp = Gm + (dir * 64 + (dir ? 63 - tg * 16 : tg * 16)) * 64 + d;
        const int st = dir ? -64 : 64;
        float v[16];
#pragma unroll
        for (int i = 0; i < 16; ++i) v[i] = gp[i * st];
#pragma unroll
        for (int i = 1; i < 16; ++i) v[i] += v[i - 1];
        RF[(dir * 4 + tg) * 64 + d] = v[15];
        __syncthreads();
        float off = 0.f;
        for (int q = 0; q < tg; ++q) off += RF[(dir * 4 + q) * 64 + d];
#pragma unroll
        for (int i = 0; i < 16; ++i) gp[i * st] = v[i] + off;
    }
    __syncthreads();
}
__device__ __forceinline__ void gla_load_v(const Params& p, int r0, int h, uint2 (&vr)[4]) {
    const int tid = threadIdx.x;
    const bf16_t* Pb = (const bf16_t*)(p.ws + OFF_PB) + (size_t)(r0 + (tid >> 5)) * PW + COL_V + h * 128 + (tid & 31) * 4;
#pragma unroll
    for (int i = 0; i < 4; ++i) vr[i] = *(const uint2*)(Pb + (size_t)(16 * i) * PW);
}
__device__ __forceinline__ void gla_stage_vt(const uint2 (&vr)[4], char* VT) {
    const int tid = threadIdx.x, dv0 = (tid & 31) * 4;
#pragma unroll
    for (int i = 0; i < 4; ++i) {
        const int j = (tid >> 5) + 16 * i, cj = j >> 3, bo = (j & 7) * 2;
        *(bf16_t*)(VT + swz(dv0 + 0, cj, 128) + bo) = (bf16_t)(vr[i].x & 0xffffu); *(bf16_t*)(VT + swz(dv0 + 1, cj, 128) + bo) = (bf16_t)(vr[i].x >> 16);
        *(bf16_t*)(VT + swz(dv0 + 2, cj, 128) + bo) = (bf16_t)(vr[i].y & 0xffffu); *(bf16_t*)(VT + swz(dv0 + 3, cj, 128) + bo) = (bf16_t)(vr[i].y >> 16);
    }
}
__device__ __forceinline__ int dir_chunk(int dir, int c) { return dir ? (c < 4 ? 3 - c : 71 - c) : c; }

__device__ __forceinline__ void gla_local_item(const Params& p, int item, int b, int c, int h, char* lds) {
    const int tid = threadIdx.x, lane = tid & 63, w = tid >> 6, r0 = b * SB + c * 64;
    const bf16_t* Pb = (const bf16_t*)(p.ws + OFF_PB);
    const uint2 rfv = *(const uint2*)(Pb + (size_t)(r0 + (tid >> 3)) * PW + COL_RF + (tid & 7) * 4);
    const uint4 kraw = *(const uint4*)(Pb + (size_t)(r0 + (tid >> 3)) * PW + COL_K + h * 64 + (tid & 7) * 8);
    uint2 vr[4]; gla_load_v(p, r0, h, vr);
    __syncthreads();
    gla_cum(p, rfv, h, lds);
    const float* Gm = (const float*)lds;
    char* KE = lds + 40960; char* VT = lds + 57344;
    {
        float4* cg = (float4*)(p.ws + OFF_CUM) + (size_t)item * 2048;
#pragma unroll
        for (int i = 0; i < 4; ++i) cg[tid + 512 * i] = *(const float4*)(Gm + (tid + 512 * i) * 4);
    }
    {
        const int j = tid >> 3, dgp = tid & 7, cj = j >> 3, bo = (j & 7) * 2;
        const unsigned ka[4] = {kraw.x, kraw.y, kraw.z, kraw.w};
#pragma unroll
        for (int dir = 0; dir < 2; ++dir) {
#pragma unroll
            for (int e = 0; e < 4; ++e) {
                const int d0 = dgp * 8 + 2 * e;
                const float cl0 = dir ? Gm[64 * 64 + d0] : Gm[63 * 64 + d0], cl1 = dir ? Gm[64 * 64 + d0 + 1] : Gm[63 * 64 + d0 + 1];
                const unsigned pk = pack2(lo_bf(ka[e]) * __expf(cl0 - Gm[(dir * 64 + j) * 64 + d0]), hi_bf(ka[e]) * __expf(cl1 - Gm[(dir * 64 + j) * 64 + d0 + 1]));
                *(bf16_t*)(KE + dir * 8192 + swz(d0, cj, 128) + bo) = (bf16_t)(pk & 0xffffu);
                *(bf16_t*)(KE + dir * 8192 + swz(d0 + 1, cj, 128) + bo) = (bf16_t)(pk >> 16);
            }
        }
    }
    gla_stage_vt(vr, VT);
    __syncthreads();
    {
        const int dir = w >> 2, nq = w & 3;
        f32x4 acc[4][2];
#pragma unroll
        for (int m = 0; m < 4; ++m) { acc[m][0] = (f32x4){0.f, 0.f, 0.f, 0.f}; acc[m][1] = (f32x4){0.f, 0.f, 0.f, 0.f}; }
#pragma unroll
        for (int ks = 0; ks < 2; ++ks) {
            bf16x8 bfr[2];
#pragma unroll
            for (int n = 0; n < 2; ++n) bfr[n] = ldfrag(VT, 128, nq * 32 + n * 16, ks * 32, lane);
#pragma unroll
            for (int m = 0; m < 4; ++m) {
                const bf16x8 af = ldfrag(KE + dir * 8192, 128, m * 16, ks * 32, lane);
#pragma unroll
                for (int n = 0; n < 2; ++n) acc[m][n] = mfma16(bfr[n], af, acc[m][n]);
            }
        }
        const int nd = dir_chunk(dir, c);
        float* KVb = (float*)(p.ws + OFF_KV) + ((size_t)(((b * 2 + dir) * 4 + h) * NCH + nd)) * 8192;
#pragma unroll
        for (int m = 0; m < 4; ++m)
#pragma unroll
            for (int n = 0; n < 2; ++n) *(f32x4*)(KVb + (m * 16 + (lane & 15)) * 128 + nq * 32 + n * 16 + 4 * (lane >> 4)) = acc[m][n];
    }
    if (tid < 128) {
        const int dir = tid >> 6, d = tid & 63, nd = dir_chunk(dir, c);
        const float cl = dir ? Gm[(64 + 0) * 64 + d] : Gm[63 * 64 + d];
        ((float*)(p.ws + OFF_DL))[((size_t)(((b * 2 + dir) * 4 + h) * NCH + nd)) * 64 + d] = __expf(cl);
    }
}

__device__ __forceinline__ void phase_gla_scan(const Params& p) {
    const int tid = threadIdx.x;
    for (int it = blockIdx.x; it < 512; it += vG()) {
        const int combo = it >> 4, el = (it & 15) * 512 + tid, d = el >> 7;
        float* base = (float*)(p.ws + OFF_KV) + (size_t)combo * NCH * 8192 + el;
        const float* dl = (const float*)(p.ws + OFF_DL) + (size_t)combo * NCH * 64 + d;
        float s = 0.f;
#pragma unroll 4
        for (int n = 0; n < NCH; ++n) {
            const float kv = base[(size_t)n * 8192], dec = dl[n * 64];
            base[(size_t)n * 8192] = s;
            s = dec * s + kv;
        }
    }
    for (int it = blockIdx.x; it < 32; it += vG()) {
        const int idx = it * 512 + tid, pp = idx & 63, g = (idx >> 6) & 31, dir = (idx >> 11) & 1, b = idx >> 12;
        float2* he = (float2*)(p.ws + OFF_HE) + ((size_t)((b * 2 + dir) * 32 + g) * NCH) * 64 + pp;
        const float2 a64 = ((const float2*)(p.ws + OFF_A64))[(dir * 32 + g) * 64 + pp];
        float hr = 0.f, hi = 0.f;
#pragma unroll 4
        for (int n = 0; n < NCH; ++n) {
            const float2 e = he[(size_t)n * 64];
            he[(size_t)n * 64] = make_float2(hr, hi);
            const float nr = a64.x * hr - a64.y * hi + e.x, ni = a64.x * hi + a64.y * hr + e.y;
            hr = nr; hi = ni;
        }
    }
}

__device__ __forceinline__ void gla_out_item(const Params& p, int item, int b, int c, int h, char* lds) {
    const int tid = threadIdx.x, lane = tid & 63, w = tid >> 6, r0 = b * SB + c * 64;
    float* Gw = (float*)lds; const float* Gm = (const float*)lds;
    char* QD = lds + 40960; char* KI = lds + 49152; char* AT = lds + 57344; char* VT = lds + 65536; char* ST = lds + 81920;
    const bf16_t* Pb = (const bf16_t*)(p.ws + OFF_PB);
    const f32x4* cg = (const f32x4*)(p.ws + OFF_CUM) + (size_t)item * 2048;
    const f32x4 cum0 = cg[tid], cum1 = cg[tid + 512], cum2 = cg[tid + 1024], cum3 = cg[tid + 1536];
    const uint4 qraw = *(const uint4*)(Pb + (size_t)(r0 + (tid >> 3)) * PW + COL_Q + h * 64 + (tid & 7) * 8);
    const uint4 kraw = *(const uint4*)(Pb + (size_t)(r0 + (tid >> 3)) * PW + COL_K + h * 64 + (tid & 7) * 8);
    uint2 vr[4]; gla_load_v(p, r0, h, vr);
    const uint4 g0 = *(const uint4*)(Pb + (size_t)(r0 + (tid >> 3)) * PW + COL_G + h * 128 + (tid & 7) * 16);
    const uint4 g1 = *(const uint4*)(Pb + (size_t)(r0 + (tid >> 3)) * PW + COL_G + h * 128 + (tid & 7) * 16 + 8);
    float sv[2][16];
#pragma unroll
    for (int dir = 0; dir < 2; ++dir) {
        const int dv = tid & 127, dq = tid >> 7, nd = dir_chunk(dir, c);
        const float* S = (const float*)(p.ws + OFF_KV) + ((size_t)(((b * 2 + dir) * 4 + h) * NCH + nd)) * 8192 + (dq * 16) * 128 + dv;
#pragma unroll
        for (int e = 0; e < 16; ++e) sv[dir][e] = S[e * 128];
    }
    __syncthreads();
    *(f32x4*)(Gw + tid * 4) = cum0; *(f32x4*)(Gw + (tid + 512) * 4) = cum1; *(f32x4*)(Gw + (tid + 1024) * 4) = cum2; *(f32x4*)(Gw + (tid + 1536) * 4) = cum3;
    gla_stage_vt(vr, VT);
    __syncthreads();
    f32x4 acco[4];
#pragma unroll
    for (int n = 0; n < 4; ++n) acco[n] = (f32x4){0.f, 0.f, 0.f, 0.f};
    const int mi = w & 3, nd0 = (w >> 2) * 4;
    for (int dir = 0; dir < 2; ++dir) {
        {
            const int i = tid >> 3, dg = tid & 7;
            const unsigned qa[4] = {qraw.x, qraw.y, qraw.z, qraw.w}, ka[4] = {kraw.x, kraw.y, kraw.z, kraw.w};
            unsigned qo[4], ko[4];
#pragma unroll
            for (int e = 0; e < 4; ++e) {
                const float c0 = Gm[(dir * 64 + i) * 64 + dg * 8 + 2 * e], c1 = Gm[(dir * 64 + i) * 64 + dg * 8 + 2 * e + 1];
                qo[e] = pack2(lo_bf(qa[e]) * 0.125f * __expf(c0), hi_bf(qa[e]) * 0.125f * __expf(c1));
                ko[e] = pack2(lo_bf(ka[e]) * __expf(-c0), hi_bf(ka[e]) * __expf(-c1));
            }
            *(uint4*)(QD + swz(i, dg, 128)) = make_uint4(qo[0], qo[1], qo[2], qo[3]);
            *(uint4*)(KI + swz(i, dg, 128)) = make_uint4(ko[0], ko[1], ko[2], ko[3]);
        }
        {
            const int dv = tid & 127, dq = tid >> 7;
            unsigned pk[8];
#pragma unroll
            for (int e = 0; e < 8; ++e) pk[e] = dir ? pack2(sv[1][2 * e], sv[1][2 * e + 1]) : pack2(sv[0][2 * e], sv[0][2 * e + 1]);
            *(uint4*)(ST + swz(dv, dq * 2, 128)) = make_uint4(pk[0], pk[1], pk[2], pk[3]);
            *(uint4*)(ST + swz(dv, dq * 2 + 1, 128)) = make_uint4(pk[4], pk[5], pk[6], pk[7]);
        }
        __syncthreads();
        {
            const int mi2 = w >> 1, nj0 = (w & 1) * 2;
#pragma unroll
            for (int t = 0; t < 2; ++t) {
                const int nj = nj0 + t;
                f32x4 a = (f32x4){0.f, 0.f, 0.f, 0.f};
#pragma unroll
                for (int ks = 0; ks < 2; ++ks) a = mfma16(ldfrag(KI, 128, nj * 16, ks * 32, lane), ldfrag(QD, 128, mi2 * 16, ks * 32, lane), a);
                const int i = mi2 * 16 + (lane & 15), j0 = nj * 16 + 4 * (lane >> 4);
                float v[4];
#pragma unroll
                for (int q = 0; q < 4; ++q) { const int j = j0 + q; const bool keep = dir ? (j >= i) : (j <= i); v[q] = keep ? a[q] : 0.f; }
                *(uint2*)(AT + swz(i, j0 >> 3, 128) + (j0 & 7) * 2) = make_uint2(pack2(v[0], v[1]), pack2(v[2], v[3]));
            }
        }
        __syncthreads();
#pragma unroll
        for (int ks = 0; ks < 2; ++ks) {
            const bf16x8 xq = ldfrag(QD, 128, mi * 16, ks * 32, lane), xa = ldfrag(AT, 128, mi * 16, ks * 32, lane);
#pragma unroll
            for (int n = 0; n < 4; ++n) {
                acco[n] = mfma16(ldfrag(ST, 128, (nd0 + n) * 16, ks * 32, lane), xq, acco[n]);
                acco[n] = mfma16(ldfrag(VT, 128, (nd0 + n) * 16, ks * 32, lane), xa, acco[n]);
            }
        }
        __syncthreads();
    }
    float* OUT = (float*)lds;
    {
        const int i = mi * 16 + (lane & 15);
#pragma unroll
        for (int n = 0; n < 4; ++n) *(f32x4*)(OUT + i * 132 + (nd0 + n) * 16 + 4 * (lane >> 4)) = acco[n];
    }
    __syncthreads();
    {
        const int i = tid >> 3, seg = tid & 7;
        float o[16]; float ss = 0.f;
#pragma unroll
        for (int e = 0; e < 4; ++e) { const float4 v = *(const float4*)(OUT + i * 132 + seg * 16 + 4 * e); o[4 * e] = v.x; o[4 * e + 1] = v.y; o[4 * e + 2] = v.z; o[4 * e + 3] = v.w; }
#pragma unroll
        for (int e = 0; e < 16; ++e) ss += o[e] * o[e];
        ss += __shfl_xor(ss, 1); ss += __shfl_xor(ss, 2); ss += __shfl_xor(ss, 4);
        const float rstd = rsqrtf(ss * (1.0f / 128.0f) + EPS);
        const unsigned ga[8] = {g0.x, g0.y, g0.z, g0.w, g1.x, g1.y, g1.z, g1.w};
        unsigned pk[8];
#pragma unroll
        for (int e = 0; e < 8; ++e) {
            const float ga0 = lo_bf(ga[e]), ga1 = hi_bf(ga[e]);
            const float n0 = p.gla_norm[seg * 16 + 2 * e], n1 = p.gla_norm[seg * 16 + 2 * e + 1];
            pk[e] = pack2(o[2 * e] * rstd * n0 * (ga0 * sigmoidf_(ga0)), o[2 * e + 1] * rstd * n1 * (ga1 * sigmoidf_(ga1)));
        }
        bf16_t* mp = (bf16_t*)(p.ws + OFF_MIX) + (size_t)(r0 + i) * D + h * 128 + seg * 16;
        *(uint4*)mp = make_uint4(pk[0], pk[1], pk[2], pk[3]); *(uint4*)(mp + 8) = make_uint4(pk[4], pk[5], pk[6], pk[7]);
    }
}

template <bool FULL>
__device__ __forceinline__ void s5_item(const Params& p, int b, int c, int go, char* lds) {
    const int tid = threadIdx.x, lane = tid & 63, w = tid >> 6, g = go * 8 + w, r0 = b * SB + c * 64;
    char* HS = lds + w * 8192;
    const bf16_t* Pb = (const bf16_t*)(p.ws + OFF_PB);
    const int fr = lane & 15, fq = lane >> 4;
    bf16x8 uf[4];
#pragma unroll
    for (int m = 0; m < 4; ++m) {
        uf[m] = (bf16x8){0, 0, 0, 0, 0, 0, 0, 0};
        if (fq < 2) uf[m] = *(const bf16x8*)(Pb + (size_t)(r0 + m * 16 + fr) * PW + COL_U + g * 16 + fq * 8);
    }
    f32x4 accy[4];
#pragma unroll
    for (int m = 0; m < 4; ++m) accy[m] = (f32x4){0.f, 0.f, 0.f, 0.f};
    __syncthreads();
    for (int dir = 0; dir < 2; ++dir) {
        const int dg = dir * 32 + g, idx = dg * 64 + lane;
        const float2 a = ((const float2*)(p.ws + OFF_ABAR))[idx];
        bf16x8 bfr[8];
#pragma unroll
        for (int j = 0; j < 8; ++j) {
            bfr[j] = (bf16x8){0, 0, 0, 0, 0, 0, 0, 0};
            if (fq < 2) bfr[j] = *(const bf16x8*)((const bf16_t*)(p.ws + OFF_BBAR) + ((size_t)dg * 128 + j * 16 + fr) * 16 + fq * 8);
        }
        const int nd = dir_chunk(dir, c);
        float2* HEp = (float2*)(p.ws + OFF_HE) + ((size_t)((b * 2 + dir) * 32 + g) * NCH) * 64 + lane;
        float hr = 0.f, hi = 0.f;
        bf16x8 cfrag[4];
        if (FULL) {
            const float2 h0 = HEp[(size_t)nd * 64]; hr = h0.x; hi = h0.y;
            const bf16_t* CM = (const bf16_t*)(p.ws + OFF_CMAT) + ((size_t)(dg * 16 + fr)) * 128 + fq * 8;
#pragma unroll
            for (int ks = 0; ks < 4; ++ks) cfrag[ks] = *(const bf16x8*)(CM + ks * 32);
        }
        for (int half = 0; half < 2; ++half) {
            const int mt0 = (dir ? 1 - half : half) * 2;
#pragma unroll
            for (int mt = 0; mt < 2; ++mt) {
                const bf16x8 ua = (mt0 == 0) ? uf[mt] : uf[2 + mt];
#pragma unroll
                for (int j = 0; j < 8; ++j) {
                    const f32x4 d = mfma16(bfr[j], ua, (f32x4){0.f, 0.f, 0.f, 0.f});
                    const int row = mt * 16 + fr;
                    *(uint2*)(HS + row * 256 + ((((2 * j) | (fq >> 1)) ^ (row & 15)) << 4) + (fq & 1) * 8) = make_uint2(pack2(d[0], d[1]), pack2(d[2], d[3]));
                }
            }
            __syncthreads();
            {
                const int ch = lane >> 2, sub = (lane & 3) * 4;
#pragma unroll 8
                for (int tt = 0; tt < 32; ++tt) {
                    const int tl = dir ? 31 - tt : tt;
                    unsigned* ptr = (unsigned*)(HS + tl * 256 + ((ch ^ (tl & 15)) << 4) + sub);
                    const unsigned bu = *ptr;
                    const float nhr = a.x * hr - a.y * hi + lo_bf(bu), nhi = a.x * hi + a.y * hr + hi_bf(bu);
                    hr = nhr; hi = nhi;
                    if (FULL) *ptr = pack2(hr, hi);
                }
            }
            if (FULL) {
                __syncthreads();
#pragma unroll
                for (int mt = 0; mt < 2; ++mt)
#pragma unroll
                    for (int ks = 0; ks < 4; ++ks) {
                        const int row = mt * 16 + fr;
                        const bf16x8 hf = *(const bf16x8*)(HS + row * 256 + (((ks * 4 + fq) ^ (row & 15)) << 4));
                        if (mt0 == 0) accy[mt] = mfma16(cfrag[ks], hf, accy[mt]); else accy[2 + mt] = mfma16(cfrag[ks], hf, accy[2 + mt]);
                    }
            }
            __syncthreads();
        }
        if (!FULL) HEp[(size_t)nd * 64] = make_float2(hr, hi);
    }
    if (FULL) {
        bf16_t* Yb = (bf16_t*)(p.ws + OFF_Y);
        const int h0 = 4 * fq;
        const f32x4 dd = *(const f32x4*)(p.s5_d + g * 16 + h0);
#pragma unroll
        for (int mt = 0; mt < 4; ++mt) {
            const int tok = mt * 16 + fr;
            const uint2 uv = *(const uint2*)(Pb + (size_t)(r0 + tok) * PW + COL_U + g * 16 + h0);
            const float ua[4] = {lo_bf(uv.x), hi_bf(uv.x), lo_bf(uv.y), hi_bf(uv.y)};
            float o[4];
#pragma unroll
            for (int q = 0; q < 4; ++q) {
                const float y = accy[mt][q] + dd[q] * ua[q];
                const float z2 = 2.0f * 0.7978845608028654f * (y + 0.044715f * y * y * y);
                o[q] = y * sigmoidf_(z2);
            }
            *(uint2*)(Yb + (size_t)(r0 + tok) * 512 + g * 16 + h0) = make_uint2(pack2(o[0], o[1]), pack2(o[2], o[3]));
        }
    }
}
__device__ __forceinline__ void phase_rec_local(const Params& p, char* lds) {
    for (int it = blockIdx.x; it < 2176; it += vG()) {
        if (it < 1088) { const int b = it / 272, r = it % 272; gla_local_item(p, it, b, r >> 2, r & 3, lds); }
        else { const int j = it - 1088, b = j / 272, r = j % 272; s5_item<false>(p, b, r >> 2, r & 3, lds); }
    }
}
__device__ __forceinline__ void phase_rec_out(const Params& p, char* lds) {
    for (int it = blockIdx.x; it < 2176; it += vG()) {
        if (it < 1088) { const int b = it / 272, r = it % 272; gla_out_item(p, it, b, r >> 2, r & 3, lds); }
        else { const int j = it - 1088, b = j / 272, r = j % 272; s5_item<true>(p, b, r >> 2, r & 3, lds); }
    }
}

__device__ __forceinline__ void phase_gemm_down(const Params& p, char* lds) {
    const bf16_t* A = (const bf16_t*)(p.ws + OFF_HB); const bf16_t* Bt = (const bf16_t*)(p.ws + OFF_WDN); float* O = (float*)(p.ws + OFF_DN);
    const int nunits = (NT / 256) * 6;
    for (int u = blockIdx.x; u < nunits; u += vG()) {
        const int mt = u / 6, tn = u % 6;
        EpiF32 epi{O, DNW, mt * 256, tn * 128};
        gemm_dense<true>(A, D, mt * 256, Bt, D, tn * 128, D, lds, epi);
    }
}
__device__ __forceinline__ void phase_mla_norm(const Params& p) {
    const int lane = threadIdx.x & 63, gw = blockIdx.x * 8 + (threadIdx.x >> 6), GW = vG() * 8;
    const float* rope = (const float*)(p.ws + OFF_ROPE);
    bf16_t* CQ = (bf16_t*)(p.ws + OFF_CQ); bf16_t* CKV = (bf16_t*)(p.ws + OFF_CKV); bf16_t* KR = (bf16_t*)(p.ws + OFF_KR);
    for (int r = gw; r < NT; r += GW) {
        const bf16_t* rp = (const bf16_t*)(p.ws + OFF_DN) + (size_t)r * DNW;
        float2 q[3]; float ss = 0.f;
#pragma unroll
        for (int j = 0; j < 3; ++j) { const unsigned t = *(const unsigned*)(rp + 2 * lane + 128 * j); q[j] = make_float2(lo_bf(t), hi_bf(t)); ss += q[j].x * q[j].x + q[j].y * q[j].y; }
        ss = wave_sum(ss);
        const float rq = rsqrtf(ss * (1.0f / 384.0f) + EPS);
#pragma unroll
        for (int j = 0; j < 3; ++j) {
            const int col = 2 * lane + 128 * j;
            *(unsigned*)(CQ + (size_t)r * 384 + col) = pack2(q[j].x * rq * p.mla_q_norm[col], q[j].y * rq * p.mla_q_norm[col + 1]);
        }
        const uint2 kt = *(const uint2*)(rp + 384 + 4 * lane);
        const float4 kv = make_float4(lo_bf(kt.x), hi_bf(kt.x), lo_bf(kt.y), hi_bf(kt.y));
        float s2 = wave_sum(kv.x * kv.x + kv.y * kv.y + kv.z * kv.z + kv.w * kv.w);
        const float rk = rsqrtf(s2 * (1.0f / 256.0f) + EPS);
        const float4 gk = *(const float4*)(p.mla_kv_norm + 4 * lane);
        *(uint2*)(CKV + (size_t)r * 256 + 4 * lane) = make_uint2(pack2(kv.x * rk * gk.x, kv.y * rk * gk.y), pack2(kv.z * rk * gk.z, kv.w * rk * gk.w));
        const float v = bf2f(rp[640 + lane]);
        const float pv = __shfl_xor(v, 16);
        const int s = r % SB;
        float o = v;
        if (s >= CTXL) {
            const int sx = s - CTXL, half = lane >> 5, idx = lane & 31, fi = idx & 15;
            const int pos = half ? (sx & 63) : (sx >> 6);
            const float cs = rope[pos * 16 + fi], sn = rope[1024 + pos * 16 + fi];
            o = (idx < 16) ? (v * cs - pv * sn) : (v * cs + pv * sn);
        }
        if (FP8_QK) ((unsigned char*)KR)[(size_t)r * 64 + lane] = (unsigned char)(pack4_fp8(o, 0.f, 0.f, 0.f) & 0xffu);
        else KR[(size_t)r * 64 + lane] = (bf16_t)(pack2(o, 0.f) & 0xffffu);
    }
}
struct EpiQ {
    bf16_t* QF; const float* rope; int row0, col0;
    __device__ __forceinline__ void operator()(const f32x4 (&acc)[4][4], int wm, int wn, int lane) const {
        const float qs = 0.07216878364870322f * 1.4426950408889634f;
        const int base = (col0 + wn * 64) >> 4;
        const bool isrope = (base % 12) == 8;
#pragma unroll
        for (int m = 0; m < 4; ++m) {
            const int row = row0 + wm * 64 + m * 16 + (lane & 15);
            f32x4 o0 = acc[m][0], o1 = acc[m][1], o2 = acc[m][2], o3 = acc[m][3];
            if (isrope) {
                const int sx = (row % SB) - CTXL, gr = sx >> 6, gc = sx & 63;
                const f32x4 cr = *(const f32x4*)(rope + gr * 16 + 4 * (lane >> 4)), sr = *(const f32x4*)(rope + 1024 + gr * 16 + 4 * (lane >> 4));
                const f32x4 cc = *(const f32x4*)(rope + gc * 16 + 4 * (lane >> 4)), sc = *(const f32x4*)(rope + 1024 + gc * 16 + 4 * (lane >> 4));
                const f32x4 t0 = o0 * cr - o1 * sr, t1 = o1 * cr + o0 * sr, t2 = o2 * cc - o3 * sc, t3 = o3 * cc + o2 * sc;
                o0 = t0; o1 = t1; o2 = t2; o3 = t3;
            }
            bf16_t* rp = QF + (size_t)row * 1536 + col0 + wn * 64 + 4 * (lane >> 4);
            *(uint2*)(rp) = make_uint2(pack2(o0[0] * qs, o0[1] * qs), pack2(o0[2] * qs, o0[3] * qs));
            *(uint2*)(rp + 16) = make_uint2(pack2(o1[0] * qs, o1[1] * qs), pack2(o1[2] * qs, o1[3] * qs));
            *(uint2*)(rp + 32) = make_uint2(pack2(o2[0] * qs, o2[1] * qs), pack2(o2[2] * qs, o2[3] * qs));
            *(uint2*)(rp + 48) = make_uint2(pack2(o3[0] * qs, o3[1] * qs), pack2(o3[2] * qs, o3[3] * qs));
        }
    }
};
struct EpiKV {
    bf16_t* KN; bf16_t* VT; int row0, tn;
    __device__ __forceinline__ void operator()(const f32x4 (&acc)[4][4], int wm, int wn, int lane) const {
        const int head = tn >> 1; const bool isv = tn & 1;
        const int b = row0 / SB, s0 = row0 % SB;
#pragma unroll
        for (int m = 0; m < 4; ++m) {
            const int rl = wm * 64 + m * 16 + 4 * (lane >> 4);
#pragma unroll
            for (int n = 0; n < 4; ++n) {
                const int cw = wn * 64 + n * 16 + (lane & 15);
                if (isv) {
                    *(uint2*)(VT + ((size_t)((b * 8 + head) * 128 + cw)) * SB + s0 + rl) = make_uint2(pack2(acc[m][n][0], acc[m][n][1]), pack2(acc[m][n][2], acc[m][n][3]));
                } else {
                    const unsigned p01 = pack2(acc[m][n][0], acc[m][n][1]), p23 = pack2(acc[m][n][2], acc[m][n][3]);
                    bf16_t* kp = KN + (size_t)(row0 + rl) * D + head * 128 + cw;
                    kp[0] = (bf16_t)(p01 & 0xffffu); kp[D] = (bf16_t)(p01 >> 16); kp[2 * D] = (bf16_t)(p23 & 0xffffu); kp[3 * D] = (bf16_t)(p23 >> 16);
                }
            }
        }
    }
};
struct EpiKV8 {
    bf16_t* KN; bf16_t* VT;
    __device__ __forceinline__ void operator()(const f32x4 (&acc)[2][2][4][2], const g8::Unit& u, int wr, int wc, int fr, int fq) const {
        const int head = u.tn, b = u.row0 / SB, s0 = u.row0 % SB;
#pragma unroll
        for (int ai = 0; ai < 2; ++ai)
#pragma unroll
            for (int m = 0; m < 4; ++m) {
                const int rl = 128 * ai + 64 * wr + 16 * m + fr;
                bf16_t* kp = KN + (size_t)(u.row0 + rl) * D + head * 128 + 32 * wc + 4 * fq;
                if (FP8_QK) {
                    char* k8 = (char*)KN + (size_t)(u.row0 + rl) * D + head * 128 + 32 * wc + 4 * fq;
                    *(unsigned*)(k8) = pack4_fp8(acc[ai][0][m][0][0], acc[ai][0][m][0][1], acc[ai][0][m][0][2], acc[ai][0][m][0][3]);
                    *(unsigned*)(k8 + 16) = pack4_fp8(acc[ai][0][m][1][0], acc[ai][0][m][1][1], acc[ai][0][m][1][2], acc[ai][0][m][1][3]);
                } else {
                    *(uint2*)(kp) = make_uint2(pack2(acc[ai][0][m][0][0], acc[ai][0][m][0][1]), pack2(acc[ai][0][m][0][2], acc[ai][0][m][0][3]));
                    *(uint2*)(kp + 16) = make_uint2(pack2(acc[ai][0][m][1][0], acc[ai][0][m][1][1]), pack2(acc[ai][0][m][1][2], acc[ai][0][m][1][3]));
                }
#pragma unroll
                for (int n = 0; n < 2; ++n) {
                    const unsigned p01 = pack2(acc[ai][1][m][n][0], acc[ai][1][m][n][1]), p23 = pack2(acc[ai][1][m][n][2], acc[ai][1][m][n][3]);
                    bf16_t* vp = VT + ((size_t)((b * 8 + head) * 128 + 32 * wc + 16 * n + 4 * fq)) * SB + s0 + rl;
                    vp[0] = (bf16_t)(p01 & 0xffffu); vp[SB] = (bf16_t)(p01 >> 16); vp[2 * SB] = (bf16_t)(p23 & 0xffffu); vp[3 * SB] = (bf16_t)(p23 >> 16);
                }
            }
    }
};
__device__ __forceinline__ void phase_gemm_kv8(const Params& p, char* lds) {
    SchedDense8 S{p.ws + OFF_WUKV, 68 * 8, 8, 512, vG(), g8::xcd_major_block()};
    EpiKV8 E{(bf16_t*)(p.ws + OFF_KN), (bf16_t*)(p.ws + OFF_VT)};
    g8::gemm8<false>((LAS unsigned char*)lds, p.ws + OFF_CKV, 512, S, E);
}
__device__ __forceinline__ void phase_gemm_kv(const Params& p, char* lds) {
    const int nkv = 68 * 16;
    for (int v = blockIdx.x; v < nkv; v += vG()) {
        const int mt = v >> 4, tn = v & 15;
        EpiKV epi{(bf16_t*)(p.ws + OFF_KN), (bf16_t*)(p.ws + OFF_VT), mt * 256, tn};
        gemm_dense<false>((const bf16_t*)(p.ws + OFF_CKV), 256, mt * 256, (const bf16_t*)(p.ws + OFF_WUKV), 256, tn * 128, 256, lds, epi);
    }
}
__device__ __forceinline__ void phase_gemm_qkv(const Params& p, char* lds) {
    const int nq = 64 * 12, nkv = 68 * 16;
    for (int u = blockIdx.x; u < nq + nkv; u += vG()) {
        if (u < nq) {
            const int mi = u / 12, tn = u % 12, row0 = (mi >> 4) * SB + ((mi & 15) + 1) * 256;
            EpiQ epi{(bf16_t*)(p.ws + OFF_QF), (const float*)(p.ws + OFF_ROPE), row0, tn * 128};
            gemm_dense<true>((const bf16_t*)(p.ws + OFF_CQ), 384, row0, (const bf16_t*)(p.ws + OFF_WUQ), 384, tn * 128, 384, lds, epi);
        } else {
            const int v = u - nq, mt = v >> 4, tn = v & 15;
            EpiKV epi{(bf16_t*)(p.ws + OFF_KN), (bf16_t*)(p.ws + OFF_VT), mt * 256, tn};
            gemm_dense<false>((const bf16_t*)(p.ws + OFF_CKV), 256, mt * 256, (const bf16_t*)(p.ws + OFF_WUKV), 256, tn * 128, 256, lds, epi);
        }
    }
}
__device__ __forceinline__ void phase_attention(const Params& p, char* lds) {
    const int tid = threadIdx.x, lane = tid & 63, w = tid >> 6;
    const bf16_t* QF = (const bf16_t*)(p.ws + OFF_QF); const bf16_t* KN = (const bf16_t*)(p.ws + OFF_KN);
    const bf16_t* KR = (const bf16_t*)(p.ws + OFF_KR); const bf16_t* VTg = (const bf16_t*)(p.ws + OFF_VT);
    bf16_t* OB = (bf16_t*)(p.ws + OFF_OB);
    char* Ps = lds + 122880 + w * 4096;
    const FragBase fbk = fragbase(lane, 384), fbv = fragbase(lane, 128);
    for (int it = blockIdx.x; it < NB * 8 * 16; it += vG()) {
        const int b = it >> 7, h = (it >> 4) & 7, qt = it & 15;
        const int qrow0 = b * SB + CTXL + qt * 256 + w * 32;
        bf16x8 qf[2][6];
#pragma unroll
        for (int m = 0; m < 2; ++m)
#pragma unroll
            for (int ks = 0; ks < 6; ++ks) qf[m][ks] = *(const bf16x8*)(QF + (size_t)(qrow0 + m * 16 + (lane & 15)) * 1536 + h * 192 + ks * 32 + (lane >> 4) * 8);
        f32x4 acco[2][8];
#pragma unroll
        for (int m = 0; m < 2; ++m)
#pragma unroll
            for (int n = 0; n < 8; ++n) acco[m][n] = (f32x4){0.f, 0.f, 0.f, 0.f};
        float mrun[2] = {0.f, 0.f}; bool first = true;
        f32x4 lacc[2] = {(f32x4){0.f, 0.f, 0.f, 0.f}, (f32x4){0.f, 0.f, 0.f, 0.f}};
        unsigned koff[3], kstep[3], voff[2];
#pragma unroll
        for (int i = 0; i < 3; ++i) {
            const int L = (w + 8 * i) * 64 + lane, r = L / 24, q = L % 24;
            const int c = (q & ~7) | ((q & 7) ^ ((r >> 1) & 7));
            koff[i] = (c < 16) ? (unsigned)(OFF_KN + ((size_t)(b * SB + r) * D + h * 128 + c * 8) * 2) : (unsigned)(OFF_KR + ((size_t)(b * SB + r) * 64 + (c - 16) * 8) * 2);
            kstep[i] = (c < 16) ? 64u * D * 2u : 64u * 64u * 2u;
        }
#pragma unroll
        for (int i = 0; i < 2; ++i) {
            const int L = (w + 8 * i) * 64 + lane, r = L >> 3, q = L & 7, c = q ^ ((r >> 1) & 7);
            voff[i] = (unsigned)(OFF_VT + ((size_t)((b * 8 + h) * 128 + r) * SB + c * 8) * 2);
        }
        auto dma = [&](int kt, int st) {
            char* Ks = lds + st * 24576; char* Vs = lds + 73728 + st * 16384;
#pragma unroll
            for (int i = 0; i < 3; ++i)
                __builtin_amdgcn_global_load_lds((const unsigned*)(p.ws + (size_t)(koff[i] + (unsigned)kt * kstep[i])), (LAS unsigned*)(Ks + (w + 8 * i) * 1024 + lane * 16), 16, 0, 0);
#pragma unroll
            for (int i = 0; i < 2; ++i)
                __builtin_amdgcn_global_load_lds((const unsigned*)(p.ws + (size_t)(voff[i] + (unsigned)kt * 128u)), (LAS unsigned*)(Vs + (w + 8 * i) * 1024 + lane * 16), 16, 0, 0);
        };
        f32x4 s[2][4];
        auto do_S = [&](int st) {
            const char* Ks = lds + st * 24576;
#pragma unroll
            for (int m = 0; m < 2; ++m)
#pragma unroll
                for (int n = 0; n < 4; ++n) s[m][n] = (f32x4){-mrun[m], -mrun[m], -mrun[m], -mrun[m]};
            bf16x8 kf[4];
#pragma unroll
            for (int i = 0; i < 3; ++i) kf[i] = ldfrag2(Ks, fbk, 384, (i & 3) * 16, i >> 2);
#pragma unroll
            for (int i = 0; i < 24; ++i) {
                if (i + 3 < 24) kf[(i + 3) & 3] = ldfrag2(Ks, fbk, 384, ((i + 3) & 3) * 16, (i + 3) >> 2);
                __builtin_amdgcn_sched_barrier(0);
                s[0][i & 3] = mfma16(kf[i & 3], qf[0][i >> 2], s[0][i & 3]); s[1][i & 3] = mfma16(kf[i & 3], qf[1][i >> 2], s[1][i & 3]);
            }
        };
        auto do_SM_PV = [&](int st) {
            const char* Vs = lds + 73728 + st * 16384;
#pragma unroll
            for (int m = 0; m < 2; ++m) {
                float mx = s[m][0][0];
#pragma unroll
                for (int n = 0; n < 4; ++n)
#pragma unroll
                    for (int q = 0; q < 4; ++q) mx = fmaxf(mx, s[m][n][q]);
                if (__any(first || mx > 64.0f)) {
                    mx = fmaxf(mx, __shfl_xor(mx, 16)); mx = fmaxf(mx, __shfl_xor(mx, 32));
                    const float delta = first ? mx : fmaxf(mx, 0.f), alpha = first ? 1.0f : __builtin_amdgcn_exp2f(-delta);
                    lacc[m] *= alpha;
#pragma unroll
                    for (int n = 0; n < 8; ++n) acco[m][n] *= alpha;
#pragma unroll
                    for (int n = 0; n < 4; ++n) s[m][n] -= delta;
                    mrun[m] += delta;
                }
#pragma unroll
                for (int n = 0; n < 4; ++n) {
                    float pv[4];
#pragma unroll
                    for (int q = 0; q < 4; ++q) pv[q] = __builtin_amdgcn_exp2f(s[m][n][q]);
                    *(uint2*)(Ps + m * 2048 + (lane & 15) * 128 + ((((n * 2) | (lane >> 5)) ^ (((lane & 15) >> 1) & 7)) << 4) + ((lane >> 4) & 1) * 8) = make_uint2(pack2(pv[0], pv[1]), pack2(pv[2], pv[3]));
                }
            }
            first = false;
            __builtin_amdgcn_wave_barrier();
            {
                bf16x8 pf[2][2], vf[4];
#pragma unroll
                for (int ks = 0; ks < 2; ++ks) { pf[ks][0] = ldfrag2(Ps, fbv, 128, 0, ks); pf[ks][1] = ldfrag2(Ps, fbv, 128, 16, ks); }
                {
                    const bf16x8 ones = (bf16x8){16256, 16256, 16256, 16256, 16256, 16256, 16256, 16256};
#pragma unroll
                    for (int ks = 0; ks < 2; ++ks) { lacc[0] = mfma16(ones, pf[ks][0], lacc[0]); lacc[1] = mfma16(ones, pf[ks][1], lacc[1]); }
                }
#pragma unroll
                for (int i = 0; i < 3; ++i) vf[i] = ldfrag2(Vs, fbv, 128, (i & 7) * 16, i >> 3);
#pragma unroll
                for (int i = 0; i < 16; ++i) {
                    if (i + 3 < 16) vf[(i + 3) & 3] = ldfrag2(Vs, fbv, 128, ((i + 3) & 7) * 16, (i + 3) >> 3);
                    __builtin_amdgcn_sched_barrier(0);
                    acco[0][i & 7] = mfma16(vf[i & 3], pf[i >> 3][0], acco[0][i & 7]); acco[1][i & 7] = mfma16(vf[i & 3], pf[i >> 3][1], acco[1][i & 7]);
                }
            }
        };
        __syncthreads();
        dma(0, 0); dma(1, 1);
        asm volatile("s_waitcnt vmcnt(0)" ::: "memory");
        __syncthreads();
        const int nkt = SB / 64;
        const bool grpA = w < 4;
        int st = 0, stp = 2;
        for (int kt = 0; kt < nkt; ++kt) {
            const bool more2 = (kt + 2) < nkt;
            if (grpA) do_S(st); else if (kt > 0) do_SM_PV(stp);
            asm volatile("s_waitcnt lgkmcnt(0)" ::: "memory");
            __builtin_amdgcn_s_barrier();
            asm volatile("" ::: "memory");
            if (more2) dma(kt + 2, stp);
            if (grpA) do_SM_PV(st); else do_S(st);
            if (more2) asm volatile("s_waitcnt vmcnt(5)" ::: "memory"); else asm volatile("s_waitcnt vmcnt(0)" ::: "memory");
            asm volatile("s_waitcnt lgkmcnt(0)" ::: "memory");
            __builtin_amdgcn_s_barrier();
            asm volatile("" ::: "memory");
            stp = st; st = (st == 2) ? 0 : st + 1;
        }
        if (!grpA) do_SM_PV(stp);
#pragma unroll
        for (int m = 0; m < 2; ++m) {
            const float il = 1.0f / lacc[m][0];
            bf16_t* op = OB + (size_t)(qrow0 + m * 16 + (lane & 15)) * D + h * 128 + 4 * (lane >> 4);
#pragma unroll
            for (int n = 0; n < 8; ++n) *(uint2*)(op + n * 16) = make_uint2(pack2(acco[m][n][0] * il, acco[m][n][1] * il), pack2(acco[m][n][2] * il, acco[m][n][3] * il));
        }
    }
}

__device__ __forceinline__ void phase_attention8(const Params& p, char* lds) {
    const int tid = threadIdx.x, lane = tid & 63, w = tid >> 6;
    const bf16_t* QF = (const bf16_t*)(p.ws + OFF_QF); const bf16_t* KN = (const bf16_t*)(p.ws + OFF_KN);
    const bf16_t* KR = (const bf16_t*)(p.ws + OFF_KR); const bf16_t* VTg = (const bf16_t*)(p.ws + OFF_VT);
    bf16_t* OB = (bf16_t*)(p.ws + OFF_OB);
    char* Ps = lds + 98304 + w * 4096;
    const FragBase fbv = fragbase(lane, 128);
    const int fr = lane & 15, fq = lane >> 4;
    for (int it = blockIdx.x; it < NB * 8 * 16; it += vG()) {
        const int b = it >> 7, h = (it >> 4) & 7, qt = it & 15;
        const int qrow0 = b * SB + CTXL + qt * 256 + w * 32;
        g8::i32x8 q8[2][2];
#pragma unroll
        for (int m = 0; m < 2; ++m) {
            const char* qp = p.ws + OFF_QF + (size_t)(qrow0 + m * 16 + fr) * 1536 + h * 192 + 32 * fq;
            q8[m][0] = __builtin_shufflevector(*(const g8::i32x4_t*)qp, *(const g8::i32x4_t*)(qp + 16), 0, 1, 2, 3, 4, 5, 6, 7);
            q8[m][1] = (g8::i32x8){0, 0, 0, 0, 0, 0, 0, 0};
            if (fq < 2) q8[m][1] = __builtin_shufflevector(*(const g8::i32x4_t*)(qp + 128), *(const g8::i32x4_t*)(qp + 144), 0, 1, 2, 3, 4, 5, 6, 7);
        }
        f32x4 acco[2][8];
#pragma unroll
        for (int m = 0; m < 2; ++m)
#pragma unroll
            for (int n = 0; n < 8; ++n) acco[m][n] = (f32x4){0.f, 0.f, 0.f, 0.f};
        float mrun[2] = {0.f, 0.f}; bool first = true;
        f32x4 lacc[2] = {(f32x4){0.f, 0.f, 0.f, 0.f}, (f32x4){0.f, 0.f, 0.f, 0.f}};
        unsigned koff[2], kstep[2], voff[2];
#pragma unroll
        for (int i = 0; i < 2; ++i) {
            const int L = (w + 8 * i) * 64 + lane, r = L >> 4, q = L & 15, c = q ^ (r & 15);
            if (c < 8) { koff[i] = (unsigned)(OFF_KN + (size_t)(b * SB + r) * D + h * 128 + c * 16); kstep[i] = 64u * D; }
            else if (c < 12) { koff[i] = (unsigned)(OFF_KR + (size_t)(b * SB + r) * 64 + (c - 8) * 16); kstep[i] = 64u * 64u; }
            else { koff[i] = (unsigned)(OFF_ZERO64 + (c - 12) * 16); kstep[i] = 0u; }
        }
#pragma unroll
        for (int i = 0; i < 2; ++i) {
            const int L = (w + 8 * i) * 64 + lane, r = L >> 3, q = L & 7, c = q ^ ((r >> 1) & 7);
            voff[i] = (unsigned)(OFF_VT + ((size_t)((b * 8 + h) * 128 + r) * SB + c * 8) * 2);
        }
        auto dma = [&](int kt, int st) {
            char* Ks = lds + st * 16384; char* Vs = lds + 49152 + st * 16384;
#pragma unroll
            for (int i = 0; i < 2; ++i)
                __builtin_amdgcn_global_load_lds((const unsigned*)(p.ws + (size_t)(koff[i] + (unsigned)kt * kstep[i])), (LAS unsigned*)(Ks + (w + 8 * i) * 1024 + lane * 16), 16, 0, 0);
#pragma unroll
            for (int i = 0; i < 2; ++i)
                __builtin_amdgcn_global_load_lds((const unsigned*)(p.ws + (size_t)(voff[i] + (unsigned)kt * 128u)), (LAS unsigned*)(Vs + (w + 8 * i) * 1024 + lane * 16), 16, 0, 0);
        };
        f32x4 s[2][4];
        auto do_S = [&](int st) {
            const char* Ks = lds + st * 16384;
#pragma unroll
            for (int m = 0; m < 2; ++m)
#pragma unroll
                for (int n = 0; n < 4; ++n) s[m][n] = (f32x4){-mrun[m], -mrun[m], -mrun[m], -mrun[m]};
            const int ksc = 0x7F7F7F7F, qsc = 0x7B7B7B7B;
            auto ldk = [&](int i) {
                const int c0 = 8 * (i >> 2) + 2 * fq;
                const char* rp = Ks + ((i & 3) * 16 + fr) * 256;
                return __builtin_shufflevector(*(const g8::i32x4_t*)(rp + ((c0 ^ fr) << 4)), *(const g8::i32x4_t*)(rp + (((c0 + 1) ^ fr) << 4)), 0, 1, 2, 3, 4, 5, 6, 7);
            };
            g8::i32x8 kf[3];
            kf[0] = ldk(0); kf[1] = ldk(1);
#pragma unroll
            for (int i = 0; i < 8; ++i) {
                if (i + 2 < 8) kf[(i + 2) % 3] = ldk(i + 2);
                __builtin_amdgcn_sched_barrier(0);
                asm volatile("s_nop 1\n\tv_mfma_scale_f32_16x16x128_f8f6f4 %0, %1, %2, %0, %3, %4 op_sel_hi:[0,0,0]" : "+v"(s[0][i & 3]) : "v"(kf[i % 3]), "v"(q8[0][i >> 2]), "v"(ksc), "v"(qsc));
                asm volatile("s_nop 1\n\tv_mfma_scale_f32_16x16x128_f8f6f4 %0, %1, %2, %0, %3, %4 op_sel_hi:[0,0,0]" : "+v"(s[1][i & 3]) : "v"(kf[i % 3]), "v"(q8[1][i >> 2]), "v"(ksc), "v"(qsc));
            }
            __builtin_amdgcn_sched_barrier(0); asm volatile("s_nop 15\n\ts_nop 15" ::: "memory"); __builtin_amdgcn_sched_barrier(0);
        };
        auto do_SM_PV = [&](int st) {
            const char* Vs = lds + 49152 + st * 16384;
#pragma unroll
            for (int m = 0; m < 2; ++m) {
                float mx = s[m][0][0];
#pragma unroll
                for (int n = 0; n < 4; ++n)
#pragma unroll
                    for (int q = 0; q < 4; ++q) mx = fmaxf(mx, s[m][n][q]);
                if (__any(first || mx > 64.0f)) {
                    mx = fmaxf(mx, __shfl_xor(mx, 16)); mx = fmaxf(mx, __shfl_xor(mx, 32));
                    const float delta = first ? mx : fmaxf(mx, 0.f), alpha = first ? 1.0f : __builtin_amdgcn_exp2f(-delta);
                    lacc[m] *= alpha;
#pragma unroll
                    for (int n = 0; n < 8; ++n) acco[m][n] *= alpha;
#pragma unroll
                    for (int n = 0; n < 4; ++n) s[m][n] -= delta;
                    mrun[m] += delta;
                }
#pragma unroll
                for (int n = 0; n < 4; ++n) {
                    float pv[4];
#pragma unroll
                    for (int q = 0; q < 4; ++q) pv[q] = __builtin_amdgcn_exp2f(s[m][n][q]);
                    *(uint2*)(Ps + m * 2048 + (lane & 15) * 128 + ((((n * 2) | (lane >> 5)) ^ (((lane & 15) >> 1) & 7)) << 4) + ((lane >> 4) & 1) * 8) = make_uint2(pack2(pv[0], pv[1]), pack2(pv[2], pv[3]));
                }
            }
            first = false;
            __builtin_amdgcn_wave_barrier();
            {
                bf16x8 pf[2][2], vf[4];
#pragma unroll
                for (int ks = 0; ks < 2; ++ks) { pf[ks][0] = ldfrag2(Ps, fbv, 128, 0, ks); pf[ks][1] = ldfrag2(Ps, fbv, 128, 16, ks); }
                {
                    const bf16x8 ones = (bf16x8){16256, 16256, 16256, 16256, 16256, 16256, 16256, 16256};
#pragma unroll
                    for (int ks = 0; ks < 2; ++ks) { lacc[0] = mfma16(ones, pf[ks][0], lacc[0]); lacc[1] = mfma16(ones, pf[ks][1], lacc[1]); }
                }
#pragma unroll
                for (int i = 0; i < 3; ++i) vf[i] = ldfrag2(Vs, fbv, 128, (i & 7) * 16, i >> 3);
#pragma unroll
                for (int i = 0; i < 16; ++i) {
                    if (i + 3 < 16) vf[(i + 3) & 3] = ldfrag2(Vs, fbv, 128, ((i + 3) & 7) * 16, (i + 3) >> 3);
                    __builtin_amdgcn_sched_barrier(0);
                    acco[0][i & 7] = mfma16(vf[i & 3], pf[i >> 3][0], acco[0][i & 7]); acco[1][i & 7] = mfma16(vf[i & 3], pf[i >> 3][1], acco[1][i & 7]);
                }
            }
        };
        __syncthreads();
        dma(0, 0); dma(1, 1);
        asm volatile("s_waitcnt vmcnt(0)" ::: "memory");
        __syncthreads();
        const int nkt = SB / 64;
        const bool grpA = w < 4;
        int st = 0, stp = 2;
        for (int kt = 0; kt < nkt; ++kt) {
            const bool more2 = (kt + 2) < nkt;
            if (grpA) do_S(st); else if (kt > 0) do_SM_PV(stp);
            asm volatile("s_waitcnt lgkmcnt(0)" ::: "memory");
            __builtin_amdgcn_s_barrier();
            asm volatile("" ::: "memory");
            if (more2) dma(kt + 2, stp);
            if (grpA) do_SM_PV(st); else do_S(st);
            if (more2) asm volatile("s_waitcnt vmcnt(5)" ::: "memory"); else asm volatile("s_waitcnt vmcnt(0)" ::: "memory");
            asm volatile("s_waitcnt lgkmcnt(0)" ::: "memory");
            __builtin_amdgcn_s_barrier();
            asm volatile("" ::: "memory");
            stp = st; st = (st == 2) ? 0 : st + 1;
        }
        if (!grpA) do_SM_PV(stp);
#pragma unroll
        for (int m = 0; m < 2; ++m) {
            const float il = 1.0f / lacc[m][0];
            bf16_t* op = OB + (size_t)(qrow0 + m * 16 + (lane & 15)) * D + h * 128 + 4 * (lane >> 4);
#pragma unroll
            for (int n = 0; n < 8; ++n) *(uint2*)(op + n * 16) = make_uint2(pack2(acco[m][n][0] * il, acco[m][n][1] * il), pack2(acco[m][n][2] * il, acco[m][n][3] * il));
        }
    }
}

constexpr int LDS_BYTES = 16 + 155648 + 512;
#ifndef ONLY_PHASE
#define ONLY_PHASE -1
#endif
#define RUN_PHASE(i, call) do { if ((ONLY_PHASE < 0 || ONLY_PHASE == (i)) && p.phase_lo <= (i) && (i) < p.phase_hi) { call; } if (p.phase_lo <= (i) && (i) + 1 < p.phase_hi) xcd_barrier(bar); } while (0)

__global__ void __launch_bounds__(512, 2) hybrid_forward(Params p) {
    extern __shared__ __attribute__((aligned(16))) char smem[];
    if (threadIdx.x == 0) *(uint4*)smem = make_uint4(0u, 0u, gridDim.x, 0u);
    __syncthreads();
    char* lds = smem + 16;
    XcdBarrier bar; bar.bar = (unsigned*)(p.ws + OFF_BAR); bar.x = 0; bar.st = (volatile LAS unsigned*)smem;
    if (p.phase_hi - p.phase_lo > 1) bar = xcd_barrier_post((unsigned*)(p.ws + OFF_BAR), (volatile LAS unsigned*)smem);
    RUN_PHASE(0, { phase_prologue0(p, lds); phase_prologue1(p, lds); });
    RUN_PHASE(1, phase_prenorm(p, 0));
    const bool split = (gridDim.x == 256);
#define RUN_SPLIT(i, nc, q, base, hi, call) do { if (split && p.phase_lo <= (i) && (i) < p.phase_hi) set_vG(nc); \
        RUN_PHASE(i, { if (!split || (int)blockIdx.x < (nc)) { call; } else convert_static(p, base, (int)blockIdx.x - (nc), 256 - (nc), q, hi, lds); }); \
        if (split && p.phase_lo <= (i) && (i) < p.phase_hi) set_vG((int)gridDim.x); } while (0)
    RUN_SPLIT(3, CV3_NC, CV3_Q, CV_B3, CV_TILES_SET, phase_gemm_recin8(p, lds));
    RUN_PHASE(4, phase_rec_local(p, lds));
    RUN_PHASE(5, phase_gla_scan(p));
    RUN_PHASE(6, phase_rec_out(p, lds));
    RUN_SPLIT(7, CV7_NC, CV7_Q, CV_B7, CV_TILES_SET, phase_gemm_glu8(p, lds));
    RUN_SPLIT(8, CV8_NC, CV8_Q, CV_B8, CV_TILES_SET, phase_gemm_recout8(p, lds));
    RUN_PHASE(9, { phase_postmix(p, 0, false, lds); convert_static(p, split ? CV_B9 : 0, (int)blockIdx.x, (int)gridDim.x, 1 << 20, CV_TILES_SET, lds); });
    RUN_PHASE(10, phase_moe1_8(p, 0, lds));
    RUN_PHASE(11, phase_moe2_8(p, 0, lds));
    RUN_PHASE(12, phase_combine(p, 0, false, lds));
    RUN_SPLIT(13, CV13_NC, CV13_Q, CV_B13, 2 * CV_TILES_SET, phase_gemm_down8(p, lds));
    RUN_PHASE(14, phase_mla_norm(p));
    RUN_SPLIT(15, CV15_NC, CV15_Q, CV_B15, 2 * CV_TILES_SET, { phase_gemm_kv8(p, lds); __syncthreads(); phase_gemm_q8(p, lds); });
    RUN_PHASE(16, { if (FP8_QK) phase_attention8(p, lds); else phase_attention(p, lds); });
    RUN_PHASE(17, { phase_gemm_wo8(p, lds); convert_static(p, split ? CV_B17 : CV_TILES_SET, (int)blockIdx.x, (int)gridDim.x, 1 << 20, 2 * CV_TILES_SET, lds); });
    RUN_PHASE(18, phase_postmix(p, 1, true, lds));
    RUN_PHASE(19, phase_moe1_8(p, 1, lds));
    RUN_PHASE(20, phase_moe2_8(p, 1, lds));
    RUN_PHASE(21, phase_combine(p, 1, true, lds));
#if DBG_STOP >= 0
    if (p.phase_lo == 22) {
        float* o = p.out;
        for (size_t e = (size_t)blockIdx.x * 512 + threadIdx.x; e < (size_t)NB * SEQ * 1024; e += (size_t)gridDim.x * 512) {
            const int ri = (int)(e >> 10), c = (int)(e & 1023), r = (ri >> 12) * SB + CTXL + (ri & 4095);
            float v;
            if (DBG_SRC == 0) v = ((const float*)(p.ws + OFF_XS))[(size_t)r * 1024 + c];
            else if (DBG_SRC == 1) v = bf2f(((const bf16_t*)(p.ws + OFF_PB))[(size_t)r * PW + DBG_COL + c]);
            else if (DBG_SRC == 2) v = bf2f(((const bf16_t*)(p.ws + OFF_MIX))[(size_t)r * 1024 + (DBG_COL + c) % 1024]);
            else if (DBG_SRC == 3) v = bf2f(((const bf16_t*)(p.ws + OFF_YX))[(size_t)r * 1024 + c]);
            else if (DBG_SRC == 4) v = bf2f(((const bf16_t*)(p.ws + OFF_Y))[(size_t)r * 512 + (c & 511)]);
            else if (DBG_SRC == 5) v = bf2f(((const bf16_t*)(p.ws + OFF_HB))[(size_t)r * 1024 + c]);
            else if (DBG_SRC == 6) v = bf2f(((const bf16_t*)(p.ws + OFF_WRI))[(size_t)(ri % 2304) * 1024 + c]);
            else v = ((const float*)(p.ws + OFF_MF))[(size_t)(e % 61440)];
            if (!(fabsf(v) < 1.0e30f)) v = 1.0e4f;
            o[e] = v;
        }
    }
#endif
}

extern "C" void kernel_launch(void* const* d_in, const int* in_sizes, int n_in, void* d_out, int out_size, void* d_ws, size_t ws_size, hipStream_t stream) {
    static int grid = 0;
    if (!grid) {
        int dev = 0, cus = 0, per_cu = 0;
        hipGetDevice(&dev);
        hipDeviceGetAttribute(&cus, hipDeviceAttributeMultiprocessorCount, dev);
        hipFuncSetAttribute((const void*)hybrid_forward, hipFuncAttributeMaxDynamicSharedMemorySize, LDS_BYTES);
        hipOccupancyMaxActiveBlocksPerMultiprocessor(&per_cu, hybrid_forward, 512, LDS_BYTES);
        if (per_cu < 1) { fprintf(stderr, "occupancy query returned %d\n", per_cu); per_cu = 1; }
        grid = cus * 1;
    }
    if (ws_size < WS_TOTAL) { fprintf(stderr, "workspace too small: %zu < %zu\n", ws_size, (size_t)WS_TOTAL); return; }
    hipMemsetAsync(d_ws, 0, ZERO_BYTES, stream);
    Params p{};
    const float** f = (const float**)&p;
    for (int i = 0; i < 37; ++i) f[i] = (const float*)d_in[i];
    p.out = (float*)d_out; p.ws = (char*)d_ws;
#if DBG_STOP >= 0
    for (int i = 0; i <= DBG_STOP; ++i) { p.phase_lo = i; p.phase_hi = i + 1; hipLaunchKernelGGL(hybrid_forward, dim3(grid), dim3(512), LDS_BYTES, stream, p); }
    p.phase_lo = 22; p.phase_hi = 23; hipLaunchKernelGGL(hybrid_forward, dim3(grid), dim3(512), LDS_BYTES, stream, p);
#elif MK_MULTI
    for (int i = 0; i < NPHASE; ++i) { p.phase_lo = i; p.phase_hi = i + 1; hipLaunchKernelGGL(hybrid_forward, dim3(grid), dim3(512), LDS_BYTES, stream, p); }
#else
    p.phase_lo = 0; p.phase_hi = NPHASE;
    hipLaunchKernelGGL(hybrid_forward, dim3(grid), dim3(512), LDS_BYTES, stream, p);
#endif
}
```

```cpp
#include <hip/hip_runtime.h>
#include <stdint.h>
#include <stdio.h>

#ifndef DBG_STOP
#define DBG_STOP -1
#endif
#ifndef DBG_SRC
#define DBG_SRC 0
#endif
#ifndef DBG_COL
#define DBG_COL 0
#endif
#ifndef FP8_G1
#define FP8_G1 1
#endif
#ifndef FP8_G2
#define FP8_G2 1
#endif
#ifndef FP8_QK
#define FP8_QK 1
#endif
#ifndef MK_MULTI
#define MK_MULTI 0
#endif

typedef unsigned short bf16_t;
typedef short bf16x8 __attribute__((ext_vector_type(8)));
typedef float f32x4 __attribute__((ext_vector_type(4)));

constexpr int D = 1024, NB = 4, SEQ = 4096, CTXL = 256;
constexpr int SB = SEQ + CTXL;
constexpr int NT = NB * SB;
constexpr int NCH = SB / 64;
constexpr int PW = 2176;
constexpr int COL_Q = 0, COL_K = 256, COL_V = 512, COL_G = 1024, COL_RF = 1536, COL_U = 1568;
constexpr int NE = 32, TOPK = 4;
constexpr int MAXPR = 78080;
constexpr int DNW = 768;
constexpr float EPS = 1e-6f;
constexpr int NPHASE = 22;

constexpr size_t al256(size_t x) { return (x + 255) & ~(size_t)255; }
constexpr size_t OFF_BAR = 0;
constexpr size_t OFF_CNT = 16384;
constexpr size_t ZERO_BYTES = 20480;
constexpr size_t OFF_MP = ZERO_BYTES;
constexpr size_t OFF_MF = OFF_MP + al256((size_t)8 * 2 * 5 * 6144 * 4);
constexpr size_t OFF_ROPE = OFF_MF + al256((size_t)2 * 5 * 6144 * 4);
constexpr size_t OFF_ABAR = OFF_ROPE + al256(2 * 1024 * 4);
constexpr size_t OFF_A64 = OFF_ABAR + al256(4096 * 8);
constexpr size_t OFF_BBAR = OFF_A64 + al256(4096 * 8);
constexpr size_t OFF_CMAT = OFF_BBAR + al256((size_t)4096 * 16 * 8);
constexpr size_t OFF_WRI = OFF_CMAT + al256((size_t)64 * 16 * 128 * 2);
constexpr size_t OFF_WRO = OFF_WRI + al256((size_t)2304 * 1024 * 2);
constexpr size_t OFF_WGLU = OFF_WRO + al256((size_t)1024 * 1024 * 2);
constexpr size_t OFF_WDN = OFF_WGLU + al256((size_t)512 * 512 * 2);
constexpr size_t OFF_WUQ = OFF_WDN + al256((size_t)DNW * 1024 * 2);
constexpr size_t OFF_WUKV = OFF_WUQ + al256((size_t)1536 * 384 * 2);
constexpr size_t OFF_WO = OFF_WUKV + al256((size_t)2048 * 256 * 2);
constexpr size_t OFF_EWI = OFF_WO + al256((size_t)1024 * 1024 * 2);
constexpr size_t OFF_EWO = OFF_EWI + al256((size_t)64 * 2048 * 1024 * 2);
constexpr size_t OFF_XS = OFF_EWO + al256((size_t)64 * 1024 * 1024 * 2);
constexpr size_t OFF_HB = OFF_XS + al256((size_t)NT * 1024 * 4);
constexpr size_t OFF_PB = OFF_HB + al256((size_t)NT * 1024 * 2);
constexpr size_t OFF_KV = OFF_PB + al256((size_t)NT * PW * 2);
constexpr size_t OFF_DL = OFF_KV + al256((size_t)32 * NCH * 64 * 128 * 4);
constexpr size_t OFF_HE = OFF_DL + al256((size_t)32 * NCH * 64 * 4);
constexpr size_t OFF_Y = OFF_HE + al256((size_t)4 * 2 * 32 * NCH * 64 * 8);
constexpr size_t OFF_MIX = OFF_Y + al256((size_t)NT * 512 * 2);
constexpr size_t OFF_YX = OFF_MIX + al256((size_t)NT * 1024 * 2);
constexpr size_t OFF_LIST = OFF_YX + al256((size_t)NT * 1024 * 4);
constexpr size_t OFF_SE = OFF_LIST + al256((size_t)NE * NT * 4);
constexpr size_t OFF_SP = OFF_SE + al256((size_t)NT * 4 * 4);
constexpr size_t OFF_GT = OFF_SP + al256((size_t)NT * 4 * 4);
constexpr size_t OFF_ACT = OFF_GT + al256((size_t)NT * 4 * 4);
constexpr size_t OFF_YR = OFF_ACT + al256((size_t)MAXPR * 1024 * 2);
constexpr size_t OFF_DN = OFF_YR + al256((size_t)MAXPR * 1024 * 2);
constexpr size_t OFF_CQ = OFF_DN + al256((size_t)NT * DNW * 4);
constexpr size_t OFF_CKV = OFF_CQ + al256((size_t)NT * 384 * 2);
constexpr size_t OFF_KR = OFF_CKV + al256((size_t)NT * 256 * 2);
constexpr size_t OFF_QF = OFF_KR + al256((size_t)NT * 64 * 2);
constexpr size_t OFF_KN = OFF_QF + al256((size_t)NT * 1536 * 2);
constexpr size_t OFF_VT = OFF_KN + al256((size_t)NT * 1024 * 2);
constexpr size_t OFF_OB = OFF_VT + al256((size_t)NT * 1024 * 2);
constexpr size_t OFF_HB8 = OFF_OB + al256((size_t)NT * 1024 * 2);
constexpr size_t OFF_CUM = OFF_HB8 + al256((size_t)NT * 1024);
constexpr size_t WS_TOTAL = OFF_CUM + al256((size_t)1088 * 8192 * 4);
static_assert(WS_TOTAL < (1ull << 31), "32-bit workspace offsets");

struct Params {
    const float *x, *c, *ctx, *c_ctx, *mod_w, *mod_b, *norm_mix_pre, *norm_mix_post, *norm_ffn_pre, *norm_ffn_post;
    const float *router_w, *router_b, *exp_w_in, *exp_b_in, *exp_w_out, *exp_b_out, *rec_w_in, *rec_w_out;
    const float *gla_gate_w, *gla_gate_b, *gla_norm, *s5_lam_re, *s5_lam_im, *s5_log_dt, *s5_b_re, *s5_b_im;
    const float *s5_c_re, *s5_c_im, *s5_d, *s5_glu_w, *s5_glu_b, *mla_w_down, *mla_q_norm, *mla_kv_norm;
    const float *mla_w_uq, *mla_w_ukv, *mla_w_o;
    float* out;
    char* ws;
    int phase_lo, phase_hi;
};

#define XB_TMO      128
#define XB_XCNT(j)  (256  + 64 * (j))
#define XB_XSUB(j)  (1280 + 64 * (j))
#define XB_XGEN(j)  (2304 + 64 * (j))
#define XB_TOP      3328
#define XB_TOPGEN   3392
#define XCD_BAR_WORDS 3456
#define XB_SPIN_CAP (1u << 22)
#define LAS __attribute__((address_space(3)))

__device__ __forceinline__ unsigned xb_ld(unsigned* p)              { return __hip_atomic_load(p, __ATOMIC_RELAXED, __HIP_MEMORY_SCOPE_AGENT); }
__device__ __forceinline__ unsigned xb_add(unsigned* p, unsigned v) { return __hip_atomic_fetch_add(p, v, __ATOMIC_RELAXED, __HIP_MEMORY_SCOPE_AGENT); }
__device__ __forceinline__ unsigned xb_xcc_id() { return (unsigned)__builtin_amdgcn_s_getreg((3 << 11) | 20) & 0xFu; }
#define XB_SPIN(cond, bar) do { unsigned _sp = 0; while (cond) { __builtin_amdgcn_s_sleep(1); \
    if ((++_sp & 255u) == 0u) { if (xb_ld(&(bar)[XB_TMO])) break; if (_sp > XB_SPIN_CAP) { atomicAdd(&(bar)[XB_TMO], 1u); break; } } } } while (0)

struct XcdBarrier { unsigned* bar; unsigned x; volatile LAS unsigned* st; };

__device__ __forceinline__ XcdBarrier xcd_barrier_post(unsigned* bar, volatile LAS unsigned* st) {
    XcdBarrier b; b.bar = bar; b.x = xb_xcc_id(); b.st = st;
    if (threadIdx.x == 0) (void)xb_add(&bar[XB_XCNT(b.x)], 1u);
    return b;
}
__device__ __forceinline__ void xcd_barrier_complete(unsigned* bar, unsigned x, unsigned& nloc, unsigned& nx) {
    const unsigned G = gridDim.x * gridDim.y * gridDim.z;
    unsigned sum, cnt, mine, sp = 0u;
    for (;;) {
        sum = 0u; cnt = 0u; mine = 0u;
#pragma unroll
        for (unsigned j = 0; j < 16; ++j) { const unsigned c = xb_ld(&bar[XB_XCNT(j)]); sum += c; cnt += (c > 0u) ? 1u : 0u; mine = (j == x) ? c : mine; }
        if (sum == G) break;
        __builtin_amdgcn_s_sleep(1);
        if ((++sp & 255u) == 0u) { if (xb_ld(&bar[XB_TMO])) break; if (sp > XB_SPIN_CAP) { atomicAdd(&bar[XB_TMO], 1u); break; } }
    }
    nloc = mine > 0u ? mine : 1u; nx = cnt > 0u ? cnt : 1u;
}
__device__ __forceinline__ void xcd_barrier(const XcdBarrier& b) {
    asm volatile("s_waitcnt vmcnt(0)" ::: "memory");
    __syncthreads();
    if (threadIdx.x == 0) {
        unsigned* bar = b.bar;
        __builtin_amdgcn_s_waitcnt(0);
        unsigned nloc = b.st[0], nx = b.st[1];
        if (nloc == 0u) { xcd_barrier_complete(bar, b.x, nloc, nx); b.st[0] = nloc; b.st[1] = nx; }
        const unsigned old = xb_add(&bar[XB_XSUB(b.x)], 1u);
        const unsigned gen = old / nloc;
        if (old + 1u == (gen + 1u) * nloc) {
            __builtin_amdgcn_fence(__ATOMIC_RELEASE, "agent");
            asm volatile("s_waitcnt vmcnt(0)" ::: "memory");
            const unsigned og = xb_add(&bar[XB_TOP], 1u);
            const unsigned tg = og / nx;
            if (og + 1u == (tg + 1u) * nx) xb_add(&bar[XB_TOPGEN], 1u);
            else XB_SPIN(xb_ld(&bar[XB_TOPGEN]) == tg, bar);
            __builtin_amdgcn_fence(__ATOMIC_ACQUIRE, "agent");
            xb_add(&bar[XB_XGEN(b.x)], 1u);
            asm volatile("s_waitcnt vmcnt(0)" ::: "memory");
        } else {
            XB_SPIN(xb_ld(&bar[XB_XGEN(b.x)]) == gen, bar);
            __builtin_amdgcn_fence(__ATOMIC_ACQUIRE, "agent");
            asm volatile("s_waitcnt vmcnt(0)" ::: "memory");
        }
    }
    __syncthreads();
}

__device__ __forceinline__ int vG() { extern __shared__ __attribute__((aligned(16))) char smem_hdr[]; return __builtin_amdgcn_readfirstlane(*(volatile int*)(smem_hdr + 8)); }
__device__ __forceinline__ void set_vG(int v) { extern __shared__ __attribute__((aligned(16))) char smem_hdr[]; __syncthreads(); if (threadIdx.x == 0) *(volatile int*)(smem_hdr + 8) = v; __syncthreads(); }

__device__ __forceinline__ int fresh_tid() { int t = threadIdx.x; asm volatile("" : "+v"(t)); return t; }
__device__ __forceinline__ float bf2f(bf16_t h) { return __uint_as_float(((unsigned)h) << 16); }
typedef float f32x2_t __attribute__((ext_vector_type(2)));
typedef __bf16 bf16x2_t __attribute__((ext_vector_type(2)));
__device__ __forceinline__ unsigned pack2(float lo, float hi) { const f32x2_t v = {lo, hi}; const bf16x2_t b = __builtin_convertvector(v, bf16x2_t); return __builtin_bit_cast(unsigned, b); }
__device__ __forceinline__ unsigned pack4_fp8(float a, float b, float c, float d) {
    int r = __builtin_amdgcn_cvt_pk_fp8_f32(a, b, 0, false); r = __builtin_amdgcn_cvt_pk_fp8_f32(c, d, r, true); return (unsigned)r;
}
__device__ __forceinline__ float lo_bf(unsigned u) { return __uint_as_float(u << 16); }
__device__ __forceinline__ float hi_bf(unsigned u) { return __uint_as_float(u & 0xffff0000u); }
__device__ __forceinline__ float wave_sum(float v) {
#pragma unroll
    for (int o = 32; o >= 1; o >>= 1) v += __shfl_xor(v, o);
    return v;
}
__device__ __forceinline__ float sigmoidf_(float x) { return __builtin_amdgcn_rcpf(1.0f + __builtin_amdgcn_exp2f(-1.4426950408889634f * x)); }
__device__ __forceinline__ int swz(int r, int c, int RS) { return r * RS + ((c ^ ((r >> 1) & 7)) << 4); }
__device__ __forceinline__ int swz256(int r, int c) { return r * 256 + ((c ^ (r & 15)) << 4); }
__device__ __forceinline__ f32x4 mfma16(bf16x8 a, bf16x8 b, f32x4 c) { return __builtin_amdgcn_mfma_f32_16x16x32_bf16(a, b, c, 0, 0, 0); }
__device__ __forceinline__ bf16x8 ldfrag(const char* tile, int RS, int row0, int k0, int lane) {
    return *(const bf16x8*)(tile + swz(row0 + (lane & 15), (k0 >> 3) + (lane >> 4), RS));
}

struct FragBase { int b0, b1; };
__device__ __forceinline__ FragBase fragbase(int lane, int RS) {
    const int r = lane & 15, t = (lane >> 4) ^ ((r >> 1) & 7);
    FragBase f; f.b0 = r * RS + (t << 4); f.b1 = r * RS + ((t ^ 4) << 4); return f;
}
__device__ __forceinline__ bf16x8 ldfrag2(const char* tile, const FragBase& fb, int RS, int row0, int ks) {
    return *(const bf16x8*)(tile + ((ks & 1) ? fb.b1 : fb.b0) + row0 * RS + (ks >> 1) * 128);
}

constexpr int G_ABYTES = 256 * 128, G_BBYTES = 128 * 128, G_STAGE = G_ABYTES + G_BBYTES;
template <bool TRANS, class Epi>
__device__ __forceinline__ void gemm_tile(const bf16_t* a0, const bf16_t* a1, const bf16_t* a2, const bf16_t* a3,
                                          const bf16_t* b0, const bf16_t* b1, int K, char* lds, const Epi& epi) {
    const int tid = threadIdx.x, lane = tid & 63, w = tid >> 6, wm = w >> 1, wn = w & 1;
    const int srow = tid >> 3, sch = tid & 7, soff = swz(srow, sch, 128);
    const FragBase fb = fragbase(lane, 128);
    f32x4 acc[4][4];
#pragma unroll
    for (int m = 0; m < 4; ++m)
#pragma unroll
        for (int n = 0; n < 4; ++n) acc[m][n] = (f32x4){0.f, 0.f, 0.f, 0.f};
    uint4 ra0 = *(const uint4*)a0, ra1 = *(const uint4*)a1, ra2 = *(const uint4*)a2, ra3 = *(const uint4*)a3;
    uint4 rb0 = *(const uint4*)b0, rb1 = *(const uint4*)b1;
    {
        char* As = lds; char* Bs = lds + G_ABYTES;
        *(uint4*)(As + soff) = ra0; *(uint4*)(As + soff + 8192) = ra1; *(uint4*)(As + soff + 16384) = ra2; *(uint4*)(As + soff + 24576) = ra3;
        *(uint4*)(Bs + soff) = rb0; *(uint4*)(Bs + soff + 8192) = rb1;
    }
    __syncthreads();
    const int nk = K >> 6;
    for (int kt = 0; kt < nk; ++kt) {
        const bool more = (kt + 1) < nk;
        if (more) {
            const int ko = (kt + 1) * 64;
            ra0 = *(const uint4*)(a0 + ko); ra1 = *(const uint4*)(a1 + ko); ra2 = *(const uint4*)(a2 + ko); ra3 = *(const uint4*)(a3 + ko);
            rb0 = *(const uint4*)(b0 + ko); rb1 = *(const uint4*)(b1 + ko);
        }
        const char* As = lds + (kt & 1) * G_STAGE; const char* Bs = As + G_ABYTES;
#pragma unroll
        for (int ks = 0; ks < 2; ++ks) {
            bf16x8 af[4], bfr[4];
#pragma unroll
            for (int m = 0; m < 4; ++m) af[m] = ldfrag2(As + wm * 8192, fb, 128, m * 16, ks);
#pragma unroll
            for (int n = 0; n < 4; ++n) bfr[n] = ldfrag2(Bs + wn * 8192, fb, 128, n * 16, ks);
#pragma unroll
            for (int m = 0; m < 4; ++m)
#pragma unroll
                for (int n = 0; n < 4; ++n) acc[m][n] = TRANS ? mfma16(bfr[n], af[m], acc[m][n]) : mfma16(af[m], bfr[n], acc[m][n]);
        }
        if (more) {
            char* As2 = lds + ((kt + 1) & 1) * G_STAGE; char* Bs2 = As2 + G_ABYTES;
            *(uint4*)(As2 + soff) = ra0; *(uint4*)(As2 + soff + 8192) = ra1; *(uint4*)(As2 + soff + 16384) = ra2; *(uint4*)(As2 + soff + 24576) = ra3;
            *(uint4*)(Bs2 + soff) = rb0; *(uint4*)(Bs2 + soff + 8192) = rb1;
        }
        __syncthreads();
    }
    epi(acc, wm, wn, lane);
}
template <bool TRANS, class Epi>
__device__ __forceinline__ void gemm_dense(const bf16_t* A, int lda, int row0, const bf16_t* Bt, int ldb, int col0, int K, char* lds, const Epi& epi) {
    const int tid = threadIdx.x, srow = tid >> 3, sch = (tid & 7) * 8;
    const bf16_t* a = A + (size_t)(row0 + srow) * lda + sch;
    const bf16_t* b = Bt + (size_t)(col0 + srow) * ldb + sch;
    gemm_tile<TRANS>(a, a + (size_t)64 * lda, a + (size_t)128 * lda, a + (size_t)192 * lda, b, b + (size_t)64 * ldb, K, lds, epi);
}

namespace g8 {
constexpr int BK = 64, HALF = 128, HTB = HALF * BK * 2, STAGE_BYTES = 8 * HTB;
__device__ __forceinline__ void stage_rc(int b, int& R, int& C) { R = b >> 7; const int q = (b >> 4) & 7; C = (q ^ ((R >> 1) & 7)) * 8; }
struct Unit { const char* B; int row0, tn, e, slot; };

typedef int i32x8 __attribute__((ext_vector_type(8)));
typedef int i32x4_t __attribute__((ext_vector_type(4)));
__device__ __forceinline__ bf16x8 lo8(i32x8 v) { return __builtin_bit_cast(bf16x8, __builtin_shufflevector(v, v, 0, 1, 2, 3)); }
__device__ __forceinline__ bf16x8 hi8(i32x8 v) { return __builtin_bit_cast(bf16x8, __builtin_shufflevector(v, v, 4, 5, 6, 7)); }
template <bool FP8, class Epi, class Sched>
__device__ __forceinline__ void gemm8(LAS unsigned char* lds, const char* Abase, int rowB, const Sched& S, const Epi& E) {
    const int tid = threadIdx.x, wid = __builtin_amdgcn_readfirstlane(tid >> 6), lane = tid & 63, wr = wid >> 2, wc = wid & 3, fr = lane & 15, fq = lane >> 4;
    const int nt = rowB / 128;
    int R[2], C[2]; unsigned voffB[2];
#pragma unroll
    for (int i = 0; i < 2; ++i) { stage_rc(tid * 16 + i * 8192, R[i], C[i]); voffB[i] = (unsigned)(R[i] * rowB + C[i] * 2); }
    const size_t kstep = (size_t)(BK * 2);
    const size_t hstep = (size_t)HALF * rowB;
    const unsigned ldsw = (unsigned)wid * 1024u;
    const int fsw = fq ^ ((fr >> 1) & 7);
    const int aoff = (wr * 64 + fr) * 128 + (fsw << 4), aoff1 = (wr * 64 + fr) * 128 + ((fsw ^ 4) << 4);
    const int boff = (wc * 32 + fr) * 128 + (fsw << 4), boff1 = (wc * 32 + fr) * 128 + ((fsw ^ 4) << 4);
#define G8_SA(b, h) (((b) * 2 + (h)) * HTB)
#define G8_SB(b, h) ((4 + (b) * 2 + (h)) * HTB)
#define G8_STAGE(bufoff, gbase, voff) do { _Pragma("unroll") for (int _i = 0; _i < 2; ++_i) \
        __builtin_amdgcn_global_load_lds((const unsigned*)((const char*)(gbase) + (voff)[_i]), (LAS unsigned*)(lds + (bufoff) + ldsw + _i * 8192), 16, 0, 0); } while (0)
#define G8_LD2(a0, a1) __builtin_shufflevector(*(const LAS i32x4_t*)(a0), *(const LAS i32x4_t*)(a1), 0, 1, 2, 3, 4, 5, 6, 7)
#define G8_LDA(dst, b, h) do { _Pragma("unroll") for (int m = 0; m < 4; ++m) dst[m] = G8_LD2(lds + G8_SA(b, h) + aoff + m * 2048, lds + G8_SA(b, h) + aoff1 + m * 2048); } while (0)
#define G8_LDB(dst, b, h) do { _Pragma("unroll") for (int n = 0; n < 2; ++n) dst[n] = G8_LD2(lds + G8_SB(b, h) + boff + n * 2048, lds + G8_SB(b, h) + boff1 + n * 2048); } while (0)
#define G8_MMA(ai, bj, At, Bt) do { __builtin_amdgcn_s_setprio(1); _Pragma("unroll") for (int m = 0; m < 4; ++m) _Pragma("unroll") for (int n = 0; n < 2; ++n) { \
        if constexpr (FP8) asm volatile("s_nop 1\n\tv_mfma_scale_f32_16x16x128_f8f6f4 %0, %1, %2, %0, %3, %3 op_sel_hi:[0,0,0]" : "+v"(acc[ai][bj][m][n]) : "v"(Bt[n]), "v"(At[m]), "v"(scl)); \
        else { acc[ai][bj][m][n] = __builtin_amdgcn_mfma_f32_16x16x32_bf16(lo8(Bt[n]), lo8(At[m]), acc[ai][bj][m][n], 0, 0, 0); \
               acc[ai][bj][m][n] = __builtin_amdgcn_mfma_f32_16x16x32_bf16(hi8(Bt[n]), hi8(At[m]), acc[ai][bj][m][n], 0, 0, 0); } } \
        __builtin_amdgcn_s_setprio(0); } while (0)
#define G8_WAIT_V(n) asm volatile("s_waitcnt vmcnt(" #n ")" ::: "memory")
#define G8_WAIT_L(n) asm volatile("s_waitcnt lgkmcnt(" #n ")" ::: "memory")
#define G8_BAR __builtin_amdgcn_s_barrier()
#define G8_SCHED __builtin_amdgcn_sched_barrier(0)
    Unit cur, nxt; int ui = 0;
    if (!S.next(0, cur)) return;
    f32x4 acc[2][2][4][2];
#pragma unroll
    for (int a = 0; a < 2; ++a)
#pragma unroll
        for (int b = 0; b < 2; ++b)
#pragma unroll
            for (int m = 0; m < 4; ++m)
#pragma unroll
                for (int n = 0; n < 2; ++n) acc[a][b][m][n] = (f32x4){0.f, 0.f, 0.f, 0.f};
    i32x8 At[4], B0[2], B1[2];
    const int scl = 0x7F7F7F7F;
    unsigned co[2][2], no[2][2];
    S.aoff(cur, R, C, co);
    const char* cB = cur.B;
    G8_STAGE(G8_SB(0, 0), cB, voffB); G8_STAGE(G8_SA(0, 0), Abase, co[0]); G8_STAGE(G8_SB(0, 1), cB + hstep, voffB); G8_STAGE(G8_SA(0, 1), Abase, co[1]);
    if (wr == 1) G8_BAR;
    G8_WAIT_V(4); G8_BAR;
    G8_STAGE(G8_SB(1, 0), cB + kstep, voffB); G8_STAGE(G8_SA(1, 0), Abase + kstep, co[0]); G8_STAGE(G8_SB(1, 1), cB + hstep + kstep, voffB);
    G8_WAIT_V(6); G8_BAR;
    for (;;) {
        const bool has_next = S.next(ui + 1, nxt);
        unsigned adelta = 0u;
        if constexpr (Sched::AFFINE) { adelta = has_next ? (unsigned)((nxt.row0 - cur.row0) * rowB) : 0u; }
        else { if (has_next) { int tz = tid; asm volatile("" : "+v"(tz)); int R2[2], C2[2]; stage_rc(tz * 16, R2[0], C2[0]); stage_rc(tz * 16 + 8192, R2[1], C2[1]); S.aoff(nxt, R2, C2, no); } else { no[0][0] = co[0][0]; no[0][1] = co[0][1]; no[1][0] = co[1][0]; no[1][1] = co[1][1]; } }
        const char* nB = has_next ? nxt.B : cB;
#pragma nounroll
        for (int t = 0; t < nt; t += 2) {
            const bool last = (t == nt - 2);
            const char* a1 = Abase + (size_t)(t + 1) * kstep;
            const char* a2 = last ? Abase : Abase + (size_t)(t + 2) * kstep; const char* b2 = last ? nB : cB + (size_t)(t + 2) * kstep;
            const char* a3 = a2 + kstep; const char* b3 = b2 + kstep;
            unsigned o2[2][2];
            if constexpr (Sched::AFFINE) { const unsigned dd = last ? adelta : 0u; o2[0][0] = co[0][0] + dd; o2[0][1] = co[0][1] + dd; o2[1][0] = co[1][0] + dd; o2[1][1] = co[1][1] + dd; }
            else { o2[0][0] = last ? no[0][0] : co[0][0]; o2[0][1] = last ? no[0][1] : co[0][1]; o2[1][0] = last ? no[1][0] : co[1][0]; o2[1][1] = last ? no[1][1] : co[1][1]; }
            G8_LDB(B0, 0, 0); G8_SCHED; G8_LDA(At, 0, 0); G8_STAGE(G8_SA(1, 1), a1, co[1]);
            G8_WAIT_L(8); G8_BAR; G8_WAIT_L(0); G8_MMA(0, 0, At, B0); G8_BAR; G8_SCHED;
            G8_LDB(B1, 0, 1); G8_STAGE(G8_SB(0, 0), b2, voffB);
            G8_BAR; G8_WAIT_L(0); G8_MMA(0, 1, At, B1); G8_BAR;
            G8_LDA(At, 0, 1); G8_STAGE(G8_SA(0, 0), a2, o2[0]);
            G8_BAR; G8_WAIT_L(0); G8_MMA(1, 0, At, B0); G8_BAR; G8_SCHED;
            G8_STAGE(G8_SB(0, 1), b2 + hstep, voffB);
            G8_WAIT_V(6); G8_BAR; G8_MMA(1, 1, At, B1); G8_BAR;
            G8_LDB(B0, 1, 0); G8_SCHED; G8_LDA(At, 1, 0); G8_STAGE(G8_SA(0, 1), a2, o2[1]);
            G8_WAIT_L(8); G8_BAR; G8_WAIT_L(0); G8_MMA(0, 0, At, B0); G8_BAR; G8_SCHED;
            G8_LDB(B1, 1, 1); G8_STAGE(G8_SB(1, 0), b3, voffB);
            G8_BAR; G8_WAIT_L(0); G8_MMA(0, 1, At, B1); G8_BAR;
            G8_LDA(At, 1, 1); G8_STAGE(G8_SA(1, 0), a3, o2[0]);
            G8_BAR; G8_WAIT_L(0); G8_MMA(1, 0, At, B0); G8_BAR; G8_SCHED;
            G8_STAGE(G8_SB(1, 1), b3 + hstep, voffB);
            G8_WAIT_V(6); G8_BAR; G8_MMA(1, 1, At, B1); G8_BAR;
        }
        if constexpr (FP8) { __builtin_amdgcn_sched_barrier(0); asm volatile("s_nop 15\n\ts_nop 15" ::: "memory"); __builtin_amdgcn_sched_barrier(0); }
        { int fr2 = fr, fq2 = fq; asm volatile("" : "+v"(fr2), "+v"(fq2)); E(acc, cur, wr, wc, fr2, fq2); }
        if (!has_next) break;
#pragma unroll
        for (int a = 0; a < 2; ++a)
#pragma unroll
            for (int b = 0; b < 2; ++b)
#pragma unroll
                for (int m = 0; m < 4; ++m)
#pragma unroll
                    for (int n = 0; n < 2; ++n) acc[a][b][m][n] = (f32x4){0.f, 0.f, 0.f, 0.f};
        cur = nxt; cB = nB; ++ui;
        if constexpr (Sched::AFFINE) { co[0][0] += adelta; co[0][1] += adelta; co[1][0] += adelta; co[1][1] += adelta; }
        else { co[0][0] = no[0][0]; co[0][1] = no[0][1]; co[1][0] = no[1][0]; co[1][1] = no[1][1]; }
    }
    G8_WAIT_V(0);
    if (wr == 0) G8_BAR;
    G8_BAR;
#undef G8_SA
#undef G8_SB
#undef G8_STAGE
#undef G8_LD2
#undef G8_LDA
#undef G8_LDB
#undef G8_MMA
#undef G8_WAIT_V
#undef G8_WAIT_L
#undef G8_BAR
#undef G8_SCHED
}
__device__ __forceinline__ int xcd_major_block() { const int b = blockIdx.x, G = vG(); return ((G & 7) == 0) ? ((b & 7) * (G >> 3) + (b >> 3)) : b; }
}

__device__ __forceinline__ void phase_prologue0(const Params& p, char* lds) {
    const int tid = threadIdx.x, G = vG();
    {
        float* act = (float*)lds;
        float* part = (float*)(lds + 20480);
        float* MF = (float*)(p.ws + OFF_MF);
        for (int e = tid; e < 5 * 1024; e += 512) {
            const int v = e >> 10, kk = e & 1023;
            const float cv = (v < 4) ? p.c[v * D + kk] : p.c_ctx[kk];
            act[e] = cv / (1.0f + __expf(-cv));
        }
        __syncthreads();
        for (int it = blockIdx.x; it < 192; it += G) {
            const int i = it / 96, n0 = (it % 96) * 64, cg = tid & 15, kq = tid >> 4;
            const float* wp = p.mod_w + ((size_t)i * D + kq * 32) * 6144 + n0 + cg * 4;
            f32x4 a0 = {0.f, 0.f, 0.f, 0.f}, a1 = a0, a2 = a0, a3 = a0, a4 = a0;
#pragma unroll 8
            for (int kk = 0; kk < 32; ++kk) {
                const f32x4 wv = *(const f32x4*)(wp + (size_t)kk * 6144);
                const int k = kq * 32 + kk;
                a0 += act[k] * wv; a1 += act[1024 + k] * wv; a2 += act[2048 + k] * wv; a3 += act[3072 + k] * wv; a4 += act[4096 + k] * wv;
            }
            __syncthreads();
            *(f32x4*)(part + (kq * 5 + 0) * 64 + cg * 4) = a0; *(f32x4*)(part + (kq * 5 + 1) * 64 + cg * 4) = a1; *(f32x4*)(part + (kq * 5 + 2) * 64 + cg * 4) = a2;
            *(f32x4*)(part + (kq * 5 + 3) * 64 + cg * 4) = a3; *(f32x4*)(part + (kq * 5 + 4) * 64 + cg * 4) = a4;
            __syncthreads();
            if (tid < 320) {
                const int v = tid >> 6, c = tid & 63;
                float sum = p.mod_b[i * 6144 + n0 + c];
#pragma unroll 8
                for (int q = 0; q < 32; ++q) sum += part[(q * 5 + v) * 64 + c];
                MF[(size_t)(i * 5 + v) * 6144 + n0 + c] = sum;
            }
        }
    }
    {
        float* rope = (float*)(p.ws + OFF_ROPE);
        for (int e = blockIdx.x * 512 + tid; e < 1024; e += G * 512) {
            const int pos = e >> 4, i = e & 15;
            const float inv = powf(10000.0f, -(float)i / 16.0f);
            const float ang = (float)pos * inv;
            rope[e] = cosf(ang); rope[1024 + e] = sinf(ang);
        }
        float2* ABAR = (float2*)(p.ws + OFF_ABAR); float2* A64 = (float2*)(p.ws + OFF_A64);
        bf16_t* CM = (bf16_t*)(p.ws + OFF_CMAT);
        for (int e = blockIdx.x * 512 + tid; e < 4096; e += G * 512) {
            const int dg = e >> 6;
            const float lre = p.s5_lam_re[e], lim = p.s5_lam_im[e];
            const float dt = expf(p.s5_log_dt[dg]);
            const float mag = expf(lre * dt);
            float sn, cs; sincosf(lim * dt, &sn, &cs);
            const float ar = mag * cs, ai = mag * sn;
            ABAR[e] = make_float2(ar, ai);
            float pr = ar, pi = ai;
#pragma unroll
            for (int q = 0; q < 6; ++q) { const float nr = pr * pr - pi * pi, ni = 2.0f * pr * pi; pr = nr; pi = ni; }
            A64[e] = make_float2(pr, pi);
            const float nr = ar - 1.0f, ni = ai, den = lre * lre + lim * lim;
            const float cr = (nr * lre + ni * lim) / den, ci = (ni * lre - nr * lim) / den;
            const int pidx = e & 63;
            bf16_t* bt = (bf16_t*)(p.ws + OFF_BBAR) + ((size_t)dg * 128 + 2 * pidx) * 16;
#pragma unroll
            for (int h = 0; h < 16; ++h) {
                const float br = p.s5_b_re[(size_t)e * 16 + h], bi = p.s5_b_im[(size_t)e * 16 + h];
                const unsigned pk = pack2(cr * br - ci * bi, cr * bi + ci * br);
                bt[h] = (bf16_t)(pk & 0xffffu); bt[16 + h] = (bf16_t)(pk >> 16);
            }
        }
        for (int e = blockIdx.x * 512 + tid; e < 64 * 16 * 128; e += G * 512) {
            const int k = e & 127, dgh = e >> 7, pp = k >> 1;
            const float v = (k & 1) ? -p.s5_c_im[(size_t)dgh * 64 + pp] : p.s5_c_re[(size_t)dgh * 64 + pp];
            CM[e] = (bf16_t)(pack2(v, 0.f) & 0xffffu);
        }
    }
}

template <bool FP8>
__device__ __forceinline__ void conv_matrices(const float* src, int nmat, int K, int N, int Npad, bf16_t* dst, bool perm, int& base, char* lds) {
    const int tid = threadIdx.x, G = vG();
    const int tk = K >> 6, tn = Npad >> 8, per = tk * tn, total = nmat * per;
    float* T = (float*)lds;
    int start = (int)(((long)blockIdx.x - (long)(base % G) + G) % G);
    f32x4 rv[8];
    auto issue = [&](int ti) {
        const int mat = ti / per, r = ti % per, kt = r / tn, nt = r % tn;
        const float* S = src + (size_t)mat * K * N + (size_t)(kt * 64) * N + nt * 256 + (tid & 63) * 4;
        const bool ok = nt * 256 + (tid & 63) * 4 < N;
#pragma unroll
        for (int i = 0; i < 8; ++i) {
            rv[i] = (f32x4){0.f, 0.f, 0.f, 0.f};
            if (ok) rv[i] = __builtin_nontemporal_load((const f32x4*)(S + (size_t)((tid >> 6) + 8 * i) * N));
        }
    };
    if (start < total) issue(start);
    for (int ti = start; ti < total; ti += G) {
        const int mat = ti / per, r = ti % per, kt = r / tn, nt = r % tn;
        bf16_t* Dm = dst + (size_t)mat * Npad * K;
        const int k0 = kt * 64, n0 = nt * 256;
        __syncthreads();
#pragma unroll
        for (int i = 0; i < 8; ++i) *(f32x4*)(T + ((tid >> 6) + 8 * i) * 260 + (tid & 63) * 4) = rv[i];
        __syncthreads();
        if (ti + G < total) issue(ti + G);
        const int n = tid >> 1, kh = tid & 1;
        int drow = n0 + n;
        if (perm) { const int up = drow >> 10, jj = drow & 1023; drow = ((jj >> 4) << 5) + (up << 4) + (jj & 15); }
        if constexpr (FP8) {
            unsigned pk[8];
#pragma unroll
            for (int j = 0; j < 8; ++j) pk[j] = pack4_fp8(64.f * T[(kh * 32 + 4 * j) * 260 + n], 64.f * T[(kh * 32 + 4 * j + 1) * 260 + n], 64.f * T[(kh * 32 + 4 * j + 2) * 260 + n], 64.f * T[(kh * 32 + 4 * j + 3) * 260 + n]);
            uint4* dp = (uint4*)((char*)dst + (size_t)mat * Npad * K + (size_t)drow * K + k0 + kh * 32);
            dp[0] = make_uint4(pk[0], pk[1], pk[2], pk[3]); dp[1] = make_uint4(pk[4], pk[5], pk[6], pk[7]);
        } else {
            unsigned pk[16];
#pragma unroll
            for (int j = 0; j < 16; ++j) pk[j] = pack2(T[(kh * 32 + 2 * j) * 260 + n], T[(kh * 32 + 2 * j + 1) * 260 + n]);
            uint4* dp = (uint4*)(Dm + (size_t)drow * K + k0 + kh * 32);
            dp[0] = make_uint4(pk[0], pk[1], pk[2], pk[3]); dp[1] = make_uint4(pk[4], pk[5], pk[6], pk[7]);
            dp[2] = make_uint4(pk[8], pk[9], pk[10], pk[11]); dp[3] = make_uint4(pk[12], pk[13], pk[14], pk[15]);
        }
    }
    base += total;
}
__device__ __forceinline__ void phase_prologue1(const Params& p, char* lds) {
    const int tid = threadIdx.x, G = vG();
    int base = 0;
    conv_matrices<false>(p.rec_w_in, 1, 1024, 2080, 2304, (bf16_t*)(p.ws + OFF_WRI), false, base, lds);
    conv_matrices<false>(p.rec_w_out, 1, 1024, 1024, 1024, (bf16_t*)(p.ws + OFF_WRO), false, base, lds);
    conv_matrices<false>(p.s5_glu_w, 1, 512, 512, 512, (bf16_t*)(p.ws + OFF_WGLU), false, base, lds);
    conv_matrices<false>(p.mla_w_down, 1, 1024, 704, DNW, (bf16_t*)(p.ws + OFF_WDN), false, base, lds);
    conv_matrices<false>(p.mla_w_uq, 1, 384, 1536, 1536, (bf16_t*)(p.ws + OFF_WUQ), false, base, lds);
    conv_matrices<false>(p.mla_w_ukv, 1, 256, 2048, 2048, (bf16_t*)(p.ws + OFF_WUKV), false, base, lds);
    conv_matrices<false>(p.mla_w_o, 1, 1024, 1024, 1024, (bf16_t*)(p.ws + OFF_WO), false, base, lds);
}

constexpr int CV_TILES_IN = 32 * 16 * 8, CV_TILES_OUT = 32 * 16 * 4, CV_TILES_SET = CV_TILES_IN + CV_TILES_OUT;
constexpr size_t OFF_ZERO64 = OFF_CNT + 2048;
constexpr size_t OFF_TICKET = OFF_CNT + 1024;
constexpr int N_COMPUTE = 208;
struct CvTile { const float* S; char* dst; int N, k0, drow, f8; };
__device__ __forceinline__ CvTile cv_decode(const Params& p, int tg) {
    const int tid = threadIdx.x, set = tg / CV_TILES_SET, t = tg % CV_TILES_SET;
    const bool is_in = t < CV_TILES_IN; const int tt = is_in ? t : t - CV_TILES_IN;
    const int N = is_in ? 2048 : 1024, tn = N >> 8, per = 16 * tn;
    const int mat = set * NE + tt / per, r = tt % per, kt = r / tn, nt = r % tn, k0 = kt * 64, n0 = nt * 256;
    CvTile c; c.N = N; c.k0 = k0;
    c.S = (is_in ? p.exp_w_in : p.exp_w_out) + (size_t)mat * 1024 * N + (size_t)k0 * N + n0 + (tid & 63) * 4;
    int drow = n0 + (tid >> 1);
    if (is_in) { const int up = drow >> 10, jj = drow & 1023; drow = ((jj >> 4) << 5) + (up << 4) + (jj & 15); }
    c.drow = drow; c.f8 = is_in ? (FP8_G1 != 0) : (FP8_G2 != 0);
    c.dst = p.ws + (is_in ? OFF_EWI : OFF_EWO) + (size_t)mat * N * 1024 * (c.f8 ? 1 : 2);
    return c;
}
__device__ __forceinline__ void cv_load(const CvTile& c, f32x4 (&rv)[8]) {
#pragma unroll
    for (int i = 0; i < 8; ++i) rv[i] = __builtin_nontemporal_load((const f32x4*)(c.S + (size_t)((threadIdx.x >> 6) + 8 * i) * c.N));
}
__device__ __forceinline__ void cv_to_lds(const f32x4 (&rv)[8], float* T) {
#pragma unroll
    for (int i = 0; i < 8; ++i) *(f32x4*)(T + ((threadIdx.x >> 6) + 8 * i) * 260 + (threadIdx.x & 63) * 4) = rv[i];
}
__device__ __forceinline__ void cv_store(const CvTile& c, const float* T) {
    const int n = threadIdx.x >> 1, kh = threadIdx.x & 1;
    if (c.f8) {
        unsigned pk[8];
#pragma unroll
        for (int j = 0; j < 8; ++j) pk[j] = pack4_fp8(64.f * T[(kh * 32 + 4 * j) * 260 + n], 64.f * T[(kh * 32 + 4 * j + 1) * 260 + n], 64.f * T[(kh * 32 + 4 * j + 2) * 260 + n], 64.f * T[(kh * 32 + 4 * j + 3) * 260 + n]);
        uint4* dp = (uint4*)(c.dst + (size_t)c.drow * 1024 + c.k0 + kh * 32);
        dp[0] = make_uint4(pk[0], pk[1], pk[2], pk[3]); dp[1] = make_uint4(pk[4], pk[5], pk[6], pk[7]);
    } else {
        unsigned pk[16];
#pragma unroll
        for (int j = 0; j < 16; ++j) pk[j] = pack2(T[(kh * 32 + 2 * j) * 260 + n], T[(kh * 32 + 2 * j + 1) * 260 + n]);
        uint4* dp = (uint4*)(c.dst + ((size_t)c.drow * 1024 + c.k0 + kh * 32) * 2);
        dp[0] = make_uint4(pk[0], pk[1], pk[2], pk[3]); dp[1] = make_uint4(pk[4], pk[5], pk[6], pk[7]);
        dp[2] = make_uint4(pk[8], pk[9], pk[10], pk[11]); dp[3] = make_uint4(pk[12], pk[13], pk[14], pk[15]);
    }
}
__device__ __forceinline__ void convert_static(const Params& p, int base, int c, int stride, int count, int hi, char* lds) {
    float* T = (float*)lds;
    __syncthreads();
    int t = base + c;
    if (count <= 0 || t >= hi) return;
    f32x4 rv[8];
    CvTile cur = cv_decode(p, t);
    cv_load(cur, rv);
    for (int i = 0; i < count; ++i) {
        const int tn = t + stride;
        const bool more = (i + 1 < count) && (tn < hi);
        cv_to_lds(rv, T);
        __syncthreads();
        CvTile nxt = cur;
        if (more) { nxt = cv_decode(p, tn); cv_load(nxt, rv); }
        cv_store(cur, T);
        if (!more) break;
        cur = nxt; t = tn;
        __syncthreads();
    }
}
constexpr int CV3_NC = 204, CV3_Q = 26, CV7_NC = 136, CV7_Q = 4, CV8_NC = 136, CV8_Q = 18, CV13_NC = 204, CV13_Q = 8, CV15_NC = 192, CV15_Q = 14;
constexpr int CV_B3 = 0, CV_B7 = CV_B3 + (256 - CV3_NC) * CV3_Q, CV_B8 = CV_B7 + (256 - CV7_NC) * CV7_Q, CV_B9 = CV_B8 + (256 - CV8_NC) * CV8_Q;
constexpr int CV_B13 = CV_TILES_SET, CV_B15 = CV_B13 + (256 - CV13_NC) * CV13_Q, CV_B17 = CV_B15 + (256 - CV15_NC) * CV15_Q;
static_assert(CV_B9 <= CV_TILES_SET && CV_B17 <= 2 * CV_TILES_SET, "conversion quotas exceed the tile sets");

__device__ __forceinline__ void load_row(const float* rp, int lane, float4 (&v)[4]) {
#pragma unroll
    for (int j = 0; j < 4; ++j) v[j] = *(const float4*)(rp + 4 * lane + 256 * j);
}
__device__ __forceinline__ float row_rstd(const float4 (&v)[4]) {
    float ss = 0.f;
#pragma unroll
    for (int j = 0; j < 4; ++j) ss += v[j].x * v[j].x + v[j].y * v[j].y + v[j].z * v[j].z + v[j].w * v[j].w;
    ss = wave_sum(ss);
    return rsqrtf(ss * (1.0f / 1024.0f) + EPS);
}
__device__ __forceinline__ void modulate_store(const float4 (&v)[4], float rstd, const float* g, const float* shift, const float* scale,
                                               bf16_t* dst, int lane, float4 (&o)[4]) {
#pragma unroll
    for (int j = 0; j < 4; ++j) {
        const int col = 4 * lane + 256 * j;
        const float4 gg = *(const float4*)(g + col), sh = *(const float4*)(shift + col), sc = *(const float4*)(scale + col);
        o[j].x = v[j].x * rstd * gg.x * (1.0f + sc.x) + sh.x; o[j].y = v[j].y * rstd * gg.y * (1.0f + sc.y) + sh.y;
        o[j].z = v[j].z * rstd * gg.z * (1.0f + sc.z) + sh.z; o[j].w = v[j].w * rstd * gg.w * (1.0f + sc.w) + sh.w;
        *(uint2*)(dst + col) = make_uint2(pack2(o[j].x, o[j].y), pack2(o[j].z, o[j].w));
    }
}
__device__ __forceinline__ const float* input_row(const Params& p, int r) { const int b = r / SB, s = r % SB; return (s < CTXL) ? p.ctx + ((size_t)b * CTXL + s) * D : p.x + ((size_t)b * SEQ + (s - CTXL)) * D; }
__device__ __forceinline__ int row_modv(int r) { const int b = r / SB, s = r % SB; return (s < CTXL) ? 4 : b; }

__device__ __forceinline__ void phase_prenorm(const Params& p, int L) {
    const int lane = threadIdx.x & 63, gw = blockIdx.x * 8 + (threadIdx.x >> 6), GW = vG() * 8;
    const float* xs = (const float*)(p.ws + OFF_XS); bf16_t* HB = (bf16_t*)(p.ws + OFF_HB);
    const float* MF = (const float*)(p.ws + OFF_MF);
    for (int r = gw; r < NT; r += GW) {
        float4 v[4], o[4]; load_row(L == 0 ? input_row(p, r) : xs + (size_t)r * D, lane, v);
        const float rstd = row_rstd(v);
        const float* mv = MF + (size_t)(L * 5 + row_modv(r)) * 6144;
        modulate_store(v, rstd, p.norm_mix_pre + L * D, mv, mv + 1024, HB + (size_t)r * D, lane, o);
    }
}

struct EpiBf16 {
    bf16_t* O; int ld; int row0, col0;
    __device__ __forceinline__ void operator()(const f32x4 (&acc)[4][4], int wm, int wn, int lane) const {
#pragma unroll
        for (int m = 0; m < 4; ++m) {
            bf16_t* rp = O + (size_t)(row0 + wm * 64 + m * 16 + (lane & 15)) * ld + col0 + wn * 64 + 4 * (lane >> 4);
#pragma unroll
            for (int n = 0; n < 4; ++n) *(uint2*)(rp + n * 16) = make_uint2(pack2(acc[m][n][0], acc[m][n][1]), pack2(acc[m][n][2], acc[m][n][3]));
        }
    }
};
struct EpiF32 {
    float* O; int ld; int row0, col0;
    __device__ __forceinline__ void operator()(const f32x4 (&acc)[4][4], int wm, int wn, int lane) const {
#pragma unroll
        for (int m = 0; m < 4; ++m) {
            float* rp = O + (size_t)(row0 + wm * 64 + m * 16 + (lane & 15)) * ld + col0 + wn * 64 + 4 * (lane >> 4);
#pragma unroll
            for (int n = 0; n < 4; ++n) *(f32x4*)(rp + n * 16) = acc[m][n];
        }
    }
};
struct EpiGlu {
    bf16_t* MIX; const bf16_t* Y; const float* bias; int row0, col0;
    __device__ __forceinline__ void operator()(const f32x4 (&acc)[4][4], int wm, int wn, int lane) const {
#pragma unroll
        for (int m = 0; m < 4; ++m) {
            const int row = row0 + wm * 64 + m * 16 + (lane & 15);
#pragma unroll
            for (int n = 0; n < 4; ++n) {
                const int col = col0 + wn * 64 + n * 16 + 4 * (lane >> 4);
                const uint2 yv = *(const uint2*)(Y + (size_t)row * 512 + col);
                const f32x4 bb = *(const f32x4*)(bias + col);
                const float y0 = lo_bf(yv.x), y1 = hi_bf(yv.x), y2 = lo_bf(yv.y), y3 = hi_bf(yv.y);
                const float o0 = y0 * sigmoidf_(acc[m][n][0] + bb[0]), o1 = y1 * sigmoidf_(acc[m][n][1] + bb[1]);
                const float o2 = y2 * sigmoidf_(acc[m][n][2] + bb[2]), o3 = y3 * sigmoidf_(acc[m][n][3] + bb[3]);
                *(uint2*)(MIX + (size_t)row * D + 512 + col) = make_uint2(pack2(o0, o1), pack2(o2, o3));
            }
        }
    }
};
struct EpiMoe1 {
    bf16_t* ACT; const float* bin; int prow0, tn;
    __device__ __forceinline__ void operator()(const f32x4 (&acc)[4][4], int wm, int wn, int lane) const {
#pragma unroll
        for (int m = 0; m < 4; ++m) {
            const int row = prow0 + wm * 64 + m * 16 + (lane & 15);
#pragma unroll
            for (int h = 0; h < 2; ++h) {
                const int j0 = 64 * tn + 32 * wn + 16 * h + 4 * (lane >> 4);
                const f32x4 bg = *(const f32x4*)(bin + j0), bu = *(const f32x4*)(bin + 1024 + j0);
                float o[4];
#pragma unroll
                for (int q = 0; q < 4; ++q) {
                    float gt = acc[m][2 * h][q] + bg[q], up = acc[m][2 * h + 1][q] + bu[q];
                    gt = fminf(gt, 7.0f); up = fminf(fmaxf(up, -7.0f), 7.0f);
                    o[q] = (up + 1.0f) * gt * sigmoidf_(1.702f * gt);
                }
                *(uint2*)(ACT + (size_t)row * D + j0) = make_uint2(pack2(o[0], o[1]), pack2(o[2], o[3]));
            }
        }
    }
};
struct EpiBf16Bias {
    bf16_t* O; const float* bias; int row0, col0;
    __device__ __forceinline__ void operator()(const f32x4 (&acc)[4][4], int wm, int wn, int lane) const {
#pragma unroll
        for (int m = 0; m < 4; ++m) {
            bf16_t* rp = O + (size_t)(row0 + wm * 64 + m * 16 + (lane & 15)) * D;
#pragma unroll
            for (int n = 0; n < 4; ++n) {
                const int col = col0 + wn * 64 + n * 16 + 4 * (lane >> 4);
                const f32x4 bb = *(const f32x4*)(bias + col);
                *(uint2*)(rp + col) = make_uint2(pack2(acc[m][n][0] + bb[0], acc[m][n][1] + bb[1]), pack2(acc[m][n][2] + bb[2], acc[m][n][3] + bb[3]));
            }
        }
    }
};

__device__ __forceinline__ void phase_gemm_recin(const Params& p, char* lds) {
    const bf16_t* A = (const bf16_t*)(p.ws + OFF_HB); const bf16_t* Bt = (const bf16_t*)(p.ws + OFF_WRI); bf16_t* O = (bf16_t*)(p.ws + OFF_PB);
    const int nN = PW / 128, nunits = (NT / 256) * nN;
    for (int u = blockIdx.x; u < nunits; u += vG()) {
        const int mt = u / nN, tn = u % nN;
        EpiBf16 epi{O, PW, mt * 256, tn * 128};
        gemm_dense<true>(A, D, mt * 256, Bt, D, tn * 128, D, lds, epi);
    }
}
__device__ __forceinline__ void phase_gemm_glu(const Params& p, char* lds) {
    const bf16_t* A = (const bf16_t*)(p.ws + OFF_Y); const bf16_t* Bt = (const bf16_t*)(p.ws + OFF_WGLU);
    const int nunits = (NT / 256) * 4;
    for (int u = blockIdx.x; u < nunits; u += vG()) {
        const int mt = u >> 2, tn = u & 3;
        EpiGlu epi{(bf16_t*)(p.ws + OFF_MIX), A, p.s5_glu_b, mt * 256, tn * 128};
        gemm_dense<true>(A, 512, mt * 256, Bt, 512, tn * 128, 512, lds, epi);
    }
}
__device__ __forceinline__ void phase_gemm_out(const Params& p, size_t offA, size_t offW, bool xonly, char* lds) {
    const bf16_t* A = (const bf16_t*)(p.ws + offA); const bf16_t* Bt = (const bf16_t*)(p.ws + offW); float* O = (float*)(p.ws + OFF_YX);
    const int nmt = xonly ? 64 : 68, nunits = nmt * 8;
    for (int u = blockIdx.x; u < nunits; u += vG()) {
        const int mi = u >> 3, tn = u & 7;
        const int row0 = xonly ? ((mi >> 4) * SB + ((mi & 15) + 1) * 256) : mi * 256;
        EpiF32 epi{O, D, row0, tn * 128};
        gemm_dense<true>(A, D, row0, Bt, D, tn * 128, D, lds, epi);
    }
}

__device__ __forceinline__ void phase_postmix(const Params& p, int L, bool xonly, char* lds) {
    const int tid = fresh_tid(), lane = tid & 63, gw = blockIdx.x * 8 + (tid >> 6), GW = vG() * 8;
    float* rwT = (float*)lds;
    const float* rw = p.router_w + (size_t)L * D * NE;
    for (int e = tid; e < D * NE; e += 512) rwT[(e & 31) * 1024 + (e >> 5)] = rw[e];
    __syncthreads();
    float* __restrict__ xs = (float*)(p.ws + OFF_XS); bf16_t* __restrict__ HB = (bf16_t*)(p.ws + OFF_HB);
    const float* __restrict__ MF = (const float*)(p.ws + OFF_MF);
    int* CNT = (int*)(p.ws + OFF_CNT) + L * NE; int* __restrict__ LIST = (int*)(p.ws + OFF_LIST);
    int* SE = (int*)(p.ws + OFF_SE); int* SP = (int*)(p.ws + OFF_SP); float* GT = (float*)(p.ws + OFF_GT);
    const float* gpost = p.norm_mix_post + L * D; const float* gpre = p.norm_ffn_pre + L * D;
    const float rbias = p.router_b[L * NE + ((lane >> 1) & 31)];
    const int nrows = xonly ? NB * SEQ : NT;
#pragma unroll 1
    for (int ri = gw; ri < nrows; ri += GW) {
        const int r = xonly ? ((ri >> 12) * SB + CTXL + (ri & 4095)) : ri;
        const float* mv = MF + (size_t)(L * 5 + row_modv(r)) * 6144;
        float4 y[4], xv[4], f[4];
        {
            const bf16_t* yp = (const bf16_t*)(p.ws + OFF_YX) + (size_t)r * D;
#pragma unroll
            for (int j = 0; j < 4; ++j) { const uint2 t = *(const uint2*)(yp + 4 * lane + 256 * j); y[j] = make_float4(lo_bf(t.x), hi_bf(t.x), lo_bf(t.y), hi_bf(t.y)); }
        }
        load_row(L == 0 ? input_row(p, r) : xs + (size_t)r * D, lane, xv);
        const float rs1 = row_rstd(y);
#pragma unroll
        for (int j = 0; j < 4; ++j) {
            const int col = 4 * lane + 256 * j;
            const float4 gg = *(const float4*)(gpost + col), g2 = *(const float4*)(mv + 2048 + col);
            xv[j].x += g2.x * (y[j].x * rs1 * gg.x); xv[j].y += g2.y * (y[j].y * rs1 * gg.y);
            xv[j].z += g2.z * (y[j].z * rs1 * gg.z); xv[j].w += g2.w * (y[j].w * rs1 * gg.w);
            *(float4*)(xs + (size_t)r * D + col) = xv[j];
        }
        const float rs2 = row_rstd(xv);
        modulate_store(xv, rs2, gpre, mv + 3 * 1024, mv + 4 * 1024, HB + (size_t)r * D, lane, f);
        if (FP8_G1) {
#pragma unroll
            for (int j = 0; j < 4; ++j) *(unsigned*)(p.ws + OFF_HB8 + (size_t)r * D + 4 * lane + 256 * j) = pack4_fp8(f[j].x, f[j].y, f[j].z, f[j].w);
        }
        float pl[32];
#pragma unroll
        for (int e = 0; e < NE; ++e) {
            float s = 0.f;
#pragma unroll
            for (int j = 0; j < 4; ++j) {
                const float4 wv = *(const float4*)(rwT + e * 1024 + 4 * lane + 256 * j);
                s += f[j].x * wv.x + f[j].y * wv.y + f[j].z * wv.z + f[j].w * wv.w;
            }
            pl[e] = s;
            asm volatile("" ::: "memory");
        }
#pragma unroll
        for (int i = 0; i < 16; ++i) { const bool up = (lane & 32) != 0; const float snd = up ? pl[i] : pl[i + 16], kp = up ? pl[i + 16] : pl[i]; pl[i] = kp + __shfl_xor(snd, 32); }
#pragma unroll
        for (int i = 0; i < 8; ++i) { const bool up = (lane & 16) != 0; const float snd = up ? pl[i] : pl[i + 8], kp = up ? pl[i + 8] : pl[i]; pl[i] = kp + __shfl_xor(snd, 16); }
#pragma unroll
        for (int i = 0; i < 4; ++i) { const bool up = (lane & 8) != 0; const float snd = up ? pl[i] : pl[i + 4], kp = up ? pl[i + 4] : pl[i]; pl[i] = kp + __shfl_xor(snd, 8); }
#pragma unroll
        for (int i = 0; i < 2; ++i) { const bool up = (lane & 4) != 0; const float snd = up ? pl[i] : pl[i + 2], kp = up ? pl[i + 2] : pl[i]; pl[i] = kp + __shfl_xor(snd, 4); }
        { const bool up = (lane & 2) != 0; const float snd = up ? pl[0] : pl[1], kp = up ? pl[1] : pl[0]; pl[0] = kp + __shfl_xor(snd, 2); }
        const int myexp = (lane >> 1) & 31;
        float mylogit = pl[0] + __shfl_xor(pl[0], 1) + rbias;
        float tv[4]; int tix[4];
#pragma unroll
        for (int k = 0; k < 4; ++k) {
            float v = mylogit; int idx = myexp;
#pragma unroll
            for (int o = 32; o >= 2; o >>= 1) {
                const float ov = __shfl_xor(v, o); const int oi = __shfl_xor(idx, o);
                if (ov > v || (ov == v && oi < idx)) { v = ov; idx = oi; }
            }
            tv[k] = v; tix[k] = idx;
            if (myexp == idx) mylogit = -3.0e38f;
        }
        const float e1 = __expf(tv[1] - tv[0]), e2 = __expf(tv[2] - tv[0]), e3 = __expf(tv[3] - tv[0]);
        const float inv = 1.0f / (1.0f + e1 + e2 + e3);
        if (lane < 4) {
            const int ex = lane == 0 ? tix[0] : lane == 1 ? tix[1] : lane == 2 ? tix[2] : tix[3];
            const float gtv = (lane == 0 ? 1.0f : lane == 1 ? e1 : lane == 2 ? e2 : e3) * inv;
            const int pos = atomicAdd(&CNT[ex], 1);
            LIST[(size_t)ex * NT + pos] = r;
            SE[r * 4 + lane] = ex; SP[r * 4 + lane] = pos; GT[r * 4 + lane] = gtv;
        }
    }
}

__device__ __forceinline__ void moe_prefix(const Params& p, int L, int* tp) {
    if (threadIdx.x == 0) {
        unsigned* CNT = (unsigned*)(p.ws + OFF_CNT) + L * NE;
        int s = 0; tp[0] = 0;
        for (int e = 0; e < NE; ++e) { const int c = (int)xb_ld(&CNT[e]); tp[33 + e] = c; s += (c + 255) >> 8; tp[e + 1] = s; }
    }
    __syncthreads();
}
__device__ __forceinline__ void phase_moe1(const Params& p, int L, char* lds) {
    int* tp = (int*)(lds + 2 * G_STAGE);
    moe_prefix(p, L, tp);
    const int tid = threadIdx.x, srow = tid >> 3, sch = (tid & 7) * 8;
    const bf16_t* HB = (const bf16_t*)(p.ws + OFF_HB); const int* LIST = (const int*)(p.ws + OFF_LIST);
    const int nunits = tp[32] * 16;
    for (int u = blockIdx.x; u < nunits; u += vG()) {
        const int mtg = u >> 4, tn = u & 15;
        int e = 0; while (tp[e + 1] <= mtg) ++e;
        const int mt = mtg - tp[e], cnt = tp[33 + e];
        const int* le = LIST + (size_t)e * NT;
        const bf16_t* ap[4];
#pragma unroll
        for (int j = 0; j < 4; ++j) { const int pos = mt * 256 + srow + 64 * j; const int tok = le[pos < cnt ? pos : 0]; ap[j] = HB + (size_t)tok * D + sch; }
        const bf16_t* b = (const bf16_t*)(p.ws + OFF_EWI) + ((size_t)(L * NE + e) * 2048 + tn * 128 + srow) * D + sch;
        EpiMoe1 epi{(bf16_t*)(p.ws + OFF_ACT), p.exp_b_in + (size_t)(L * NE + e) * 2048, mtg * 256, tn};
        gemm_tile<true>(ap[0], ap[1], ap[2], ap[3], b, b + (size_t)64 * D, D, lds, epi);
    }
}
__device__ __forceinline__ void phase_moe2(const Params& p, int L, char* lds) {
    int* tp = (int*)(lds + 2 * G_STAGE);
    moe_prefix(p, L, tp);
    const int nunits = tp[32] * 8;
    for (int u = blockIdx.x; u < nunits; u += vG()) {
        const int mtg = u >> 3, tn = u & 7;
        int e = 0; while (tp[e + 1] <= mtg) ++e;
        EpiBf16Bias epi{(bf16_t*)(p.ws + OFF_YR), p.exp_b_out + (size_t)(L * NE + e) * D, mtg * 256, tn * 128};
        gemm_dense<true>((const bf16_t*)(p.ws + OFF_ACT), D, mtg * 256, (const bf16_t*)(p.ws + OFF_EWO) + (size_t)(L * NE + e) * D * D, D, tn * 128, D, lds, epi);
    }
}
constexpr int G8_TAB = g8::STAGE_BYTES, G8_TP = g8::STAGE_BYTES + 16384;
constexpr int G8_NSLOT = 16;
template <bool GATHER>
struct SchedMoe8 {
    static constexpr bool AFFINE = !GATHER;
    const int* tp; const unsigned* tab; const int* list; const char* Bbase; size_t bexp; int ntn_sh, rowB, x, j, bpx; int tx1, tx2, tx3, tx4;
    __device__ __forceinline__ void init(const int* tp_, const unsigned* tab_, const int* list_, const char* Bbase_, size_t bexp_, int ntn_sh_, int rowB_) {
        tp = tp_; tab = tab_; list = list_; Bbase = Bbase_; bexp = bexp_; ntn_sh = ntn_sh_; rowB = rowB_;
        const int cblk = g8::xcd_major_block(); bpx = vG() >> 3; x = cblk / bpx; j = cblk % bpx;
        tx1 = tp[x + 1] - tp[x]; tx2 = tx1 + tp[x + 9] - tp[x + 8]; tx3 = tx2 + tp[x + 17] - tp[x + 16]; tx4 = tx3 + tp[x + 25] - tp[x + 24];
    }
    __device__ __forceinline__ bool next(int i, g8::Unit& u) const {
        const int l = i * bpx + j, tl = l >> ntn_sh, tn = l & ((1 << ntn_sh) - 1);
        if (tl >= tx4) return false;
        const int k = (tl >= tx1) + (tl >= tx2) + (tl >= tx3), e = x + 8 * k;
        const int mt = tl - (k == 0 ? 0 : k == 1 ? tx1 : k == 2 ? tx2 : tx3);
        u.B = Bbase + (size_t)e * bexp + (size_t)tn * 256 * rowB; u.row0 = (tp[e] + mt) * 256; u.tn = tn; u.e = e; u.slot = i; return true;
    }
    __device__ __forceinline__ void aoff(const g8::Unit& u, const int (&R)[2], const int (&C)[2], unsigned (&o)[2][2]) const {
#pragma unroll
        for (int h = 0; h < 2; ++h)
#pragma unroll
            for (int i = 0; i < 2; ++i) {
                if (GATHER) {
                    unsigned ro;
                    if (u.slot < G8_NSLOT) ro = tab[u.slot * 256 + h * 128 + R[i]];
                    else { const int pos = u.row0 - tp[u.e] * 256 + h * 128 + R[i]; ro = (unsigned)list[(size_t)u.e * NT + (pos < tp[33 + u.e] ? pos : 0)] * (unsigned)rowB; }
                    o[h][i] = ro + (unsigned)C[i] * 2u;
                } else o[h][i] = (unsigned)((u.row0 + h * 128 + R[i]) * rowB + C[i] * 2);
            }
    }
};
struct SchedDense8 {
    static constexpr bool AFFINE = true;
    const char* Bbase; int nunits, ntn, rowB, G, cblk;
    __device__ __forceinline__ bool next(int i, g8::Unit& u) const {
        const int L = i * G + cblk; if (L >= nunits) return false;
        const int mt = L / ntn, tn = L % ntn;
        u.B = Bbase + (size_t)tn * 256 * rowB; u.row0 = mt * 256; u.tn = tn; u.e = 0; u.slot = i; return true;
    }
    __device__ __forceinline__ void aoff(const g8::Unit& u, const int (&R)[2], const int (&C)[2], unsigned (&o)[2][2]) const {
#pragma unroll
        for (int h = 0; h < 2; ++h)
#pragma unroll
            for (int i = 0; i < 2; ++i) o[h][i] = (unsigned)((u.row0 + h * 128 + R[i]) * rowB + C[i] * 2);
    }
};
template <bool OUT8>
struct EpiMoe1_8 {
    bf16_t* ACT; const float* bin_all; float sc;
    __device__ __forceinline__ void operator()(const f32x4 (&acc)[2][2][4][2], const g8::Unit& u, int wr, int wc, int fr, int fq) const {
        const float* bin = bin_all + (size_t)u.e * 2048;
#pragma unroll
        for (int bj = 0; bj < 2; ++bj) {
            const int j0 = 128 * u.tn + 64 * bj + 16 * wc + 4 * fq;
            const f32x4 bg = *(const f32x4*)(bin + j0), bu1 = *(const f32x4*)(bin + 1024 + j0) + 1.0f;
#pragma unroll
            for (int ai = 0; ai < 2; ++ai)
#pragma unroll
                for (int m = 0; m < 4; ++m) {
                    const int row = u.row0 + 128 * ai + 64 * wr + 16 * m + fr;
                    const f32x4 gv = acc[ai][bj][m][0] * sc + bg, uv = acc[ai][bj][m][1] * sc + bu1;
                    f32x4 gm, um, ex, rc;
#pragma unroll
                    for (int q = 0; q < 4; ++q) { gm[q] = fminf(gv[q], 7.0f); um[q] = __builtin_amdgcn_fmed3f(uv[q], -6.0f, 8.0f); }
                    const f32x4 ea = gm * (-1.702f * 1.4426950408889634f);
#pragma unroll
                    for (int q = 0; q < 4; ++q) ex[q] = __builtin_amdgcn_exp2f(ea[q]);
                    const f32x4 den = ex + 1.0f;
#pragma unroll
                    for (int q = 0; q < 4; ++q) rc[q] = __builtin_amdgcn_rcpf(den[q]);
                    const f32x4 ov = um * (gm * rc);
                    const float o[4] = {ov[0], ov[1], ov[2], ov[3]};
                    if constexpr (OUT8) *(unsigned*)((char*)ACT + (size_t)row * D + j0) = pack4_fp8(o[0], o[1], o[2], o[3]);
                    else *(uint2*)(ACT + (size_t)row * D + j0) = make_uint2(pack2(o[0], o[1]), pack2(o[2], o[3]));
                }
        }
    }
};
struct EpiBias8 {
    bf16_t* O; const float* bias_all; float sc;
    __device__ __forceinline__ void operator()(const f32x4 (&acc)[2][2][4][2], const g8::Unit& u, int wr, int wc, int fr, int fq) const {
        const float* bias = bias_all + (size_t)u.e * D;
#pragma unroll
        for (int bj = 0; bj < 2; ++bj)
#pragma unroll
            for (int n = 0; n < 2; ++n) {
                const int col = 256 * u.tn + 128 * bj + 32 * wc + 16 * n + 4 * fq;
                const f32x4 bb = *(const f32x4*)(bias + col);
#pragma unroll
                for (int ai = 0; ai < 2; ++ai)
#pragma unroll
                    for (int m = 0; m < 4; ++m) {
                        const int row = u.row0 + 128 * ai + 64 * wr + 16 * m + fr;
                        const f32x4 v = acc[ai][bj][m][n] * sc + bb;
                        *(uint2*)(O + (size_t)row * D + col) = make_uint2(pack2(v[0], v[1]), pack2(v[2], v[3]));
                    }
            }
    }
};
struct EpiBf16_8 {
    bf16_t* O; int ld, ncols;
    __device__ __forceinline__ void operator()(const f32x4 (&acc)[2][2][4][2], const g8::Unit& u, int wr, int wc, int fr, int fq) const {
#pragma unroll
        for (int bj = 0; bj < 2; ++bj)
#pragma unroll
            for (int n = 0; n < 2; ++n) {
                const int col = 256 * u.tn + 128 * bj + 32 * wc + 16 * n + 4 * fq;
                if (col < ncols) {
#pragma unroll
                    for (int ai = 0; ai < 2; ++ai)
#pragma unroll
                        for (int m = 0; m < 4; ++m) {
                            const int row = u.row0 + 128 * ai + 64 * wr + 16 * m + fr;
                            *(uint2*)(O + (size_t)row * ld + col) = make_uint2(pack2(acc[ai][bj][m][n][0], acc[ai][bj][m][n][1]), pack2(acc[ai][bj][m][n][2], acc[ai][bj][m][n][3]));
                        }
                }
            }
    }
};
__device__ __forceinline__ void phase_gemm_recin8(const Params& p, char* lds) {
    SchedDense8 S{p.ws + OFF_WRI, 68 * 9, 9, 2 * D, vG(), g8::xcd_major_block()};
    EpiBf16_8 E{(bf16_t*)(p.ws + OFF_PB), PW, PW};
    g8::gemm8<false>((LAS unsigned char*)lds, p.ws + OFF_HB, 2 * D, S, E);
}
__device__ __forceinline__ void phase_moe1_8(const Params& p, int L, char* lds) {
    int* tp = (int*)(lds + G8_TP); unsigned* tab = (unsigned*)(lds + G8_TAB);
    moe_prefix(p, L, tp);
    const int tid = threadIdx.x;
    const int* LIST = (const int*)(p.ws + OFF_LIST);
    constexpr int EB = FP8_G1 ? 1 : 2;
    SchedMoe8<true> S; S.init(tp, tab, LIST, p.ws + OFF_EWI + (size_t)L * NE * 2048 * D * EB, (size_t)2048 * D * EB, 3, D * EB);
    for (int slot = 0; slot < G8_NSLOT; ++slot) {
        g8::Unit u; if (!S.next(slot, u)) break;
        const int cnt = tp[33 + u.e];
        if (tid < 256) { const int pos = u.row0 - tp[u.e] * 256 + tid; tab[slot * 256 + tid] = (unsigned)LIST[(size_t)u.e * NT + (pos < cnt ? pos : 0)] * (unsigned)(D * EB); }
    }
    __syncthreads();
    EpiMoe1_8<FP8_G2 != 0> E{(bf16_t*)(p.ws + OFF_ACT), p.exp_b_in + (size_t)L * NE * 2048, FP8_G1 ? (1.0f / 64.0f) : 1.0f};
    g8::gemm8<FP8_G1 != 0>((LAS unsigned char*)lds, p.ws + (FP8_G1 ? OFF_HB8 : OFF_HB), D * EB, S, E);
}
__device__ __forceinline__ void phase_moe2_8(const Params& p, int L, char* lds) {
    int* tp = (int*)(lds + G8_TP);
    moe_prefix(p, L, tp);
    constexpr int EB = FP8_G2 ? 1 : 2;
    SchedMoe8<false> S; S.init(tp, nullptr, nullptr, p.ws + OFF_EWO + (size_t)L * NE * D * D * EB, (size_t)D * D * EB, 2, D * EB);
    EpiBias8 E{(bf16_t*)(p.ws + OFF_YR), p.exp_b_out + (size_t)L * NE * D, FP8_G2 ? (1.0f / 64.0f) : 1.0f};
    g8::gemm8<FP8_G2 != 0>((LAS unsigned char*)lds, p.ws + OFF_ACT, D * EB, S, E);
}
struct EpiF32_8 {
    float* O; int ld;
    __device__ __forceinline__ void operator()(const f32x4 (&acc)[2][2][4][2], const g8::Unit& u, int wr, int wc, int fr, int fq) const {
#pragma unroll
        for (int ai = 0; ai < 2; ++ai)
#pragma unroll
            for (int m = 0; m < 4; ++m) {
                float* rp = O + (size_t)(u.row0 + 128 * ai + 64 * wr + 16 * m + fr) * ld + 256 * u.tn + 32 * wc + 4 * fq;
#pragma unroll
                for (int bj = 0; bj < 2; ++bj)
#pragma unroll
                    for (int n = 0; n < 2; ++n) *(f32x4*)(rp + 128 * bj + 16 * n) = acc[ai][bj][m][n];
            }
    }
};
struct SchedX8 {
    static constexpr bool AFFINE = true;
    const char* Bbase; int nunits, ntn, rowB, G, cblk;
    __device__ __forceinline__ bool next(int i, g8::Unit& u) const {
        const int L = i * G + cblk; if (L >= nunits) return false;
        const int mi = L / ntn, tn = L % ntn;
        u.B = Bbase + (size_t)tn * 256 * rowB; u.row0 = (mi >> 4) * SB + ((mi & 15) + 1) * 256; u.tn = tn; u.e = 0; u.slot = i; return true;
    }
    __device__ __forceinline__ void aoff(const g8::Unit& u, const int (&R)[2], const int (&C)[2], unsigned (&o)[2][2]) const {
#pragma unroll
        for (int h = 0; h < 2; ++h)
#pragma unroll
            for (int i = 0; i < 2; ++i) o[h][i] = (unsigned)((u.row0 + h * 128 + R[i]) * rowB + C[i] * 2);
    }
};
struct EpiQ8 {
    bf16_t* QF; const float* rope;
    __device__ __forceinline__ void operator()(const f32x4 (&acc)[2][2][4][2], const g8::Unit& u, int wr, int wc, int fr, int fq) const {
        const float qs = 0.07216878364870322f * 1.4426950408889634f;
        const int sx0 = (u.row0 % SB) - CTXL + 64 * wr + fr;
        const int c0 = 256 * u.tn + 32 * wc;
        const int ta = (c0 >> 4) % 12, tb = ((c0 + 128) >> 4) % 12;
#pragma unroll
        for (int ai = 0; ai < 2; ++ai)
#pragma unroll
            for (int m = 0; m < 4; ++m) {
                const int sx = sx0 + 128 * ai + 16 * m;
                bf16_t* rp = QF + (size_t)(u.row0 + 128 * ai + 64 * wr + 16 * m + fr) * 1536 + c0 + 4 * fq;
#pragma unroll
                for (int bj = 0; bj < 2; ++bj) {
                    const int t12 = bj ? tb : ta;
                    f32x4 o0 = acc[ai][bj][m][0], o1 = acc[ai][bj][m][1];
                    if (t12 >= 8) {
                        const float* rr = rope + ((t12 == 8) ? (sx >> 6) : (sx & 63)) * 16 + 4 * fq;
                        const f32x4 cs = *(const f32x4*)rr, sn = *(const f32x4*)(rr + 1024);
                        const f32x4 t0 = o0 * cs - o1 * sn, t1 = o1 * cs + o0 * sn; o0 = t0; o1 = t1;
                    }
                    if (FP8_QK) {
                        char* r8 = (char*)QF + (size_t)(u.row0 + 128 * ai + 64 * wr + 16 * m + fr) * 1536 + c0 + 4 * fq + 128 * bj;
                        const float q16 = qs * 16.0f;
                        *(unsigned*)(r8) = pack4_fp8(o0[0] * q16, o0[1] * q16, o0[2] * q16, o0[3] * q16);
                        *(unsigned*)(r8 + 16) = pack4_fp8(o1[0] * q16, o1[1] * q16, o1[2] * q16, o1[3] * q16);
                    } else {
                        *(uint2*)(rp + 128 * bj) = make_uint2(pack2(o0[0] * qs, o0[1] * qs), pack2(o0[2] * qs, o0[3] * qs));
                        *(uint2*)(rp + 128 * bj + 16) = make_uint2(pack2(o1[0] * qs, o1[1] * qs), pack2(o1[2] * qs, o1[3] * qs));
                    }
                }
            }
    }
};
struct EpiGlu8 {
    bf16_t* MIX; const bf16_t* Y; const float* bias;
    __device__ __forceinline__ void operator()(const f32x4 (&acc)[2][2][4][2], const g8::Unit& u, int wr, int wc, int fr, int fq) const {
#pragma unroll
        for (int bj = 0; bj < 2; ++bj)
#pragma unroll
            for (int n = 0; n < 2; ++n) {
                const int col = 256 * u.tn + 128 * bj + 32 * wc + 16 * n + 4 * fq;
                const f32x4 bb = *(const f32x4*)(bias + col);
#pragma unroll
                for (int ai = 0; ai < 2; ++ai)
#pragma unroll
                    for (int m = 0; m < 4; ++m) {
                        const int row = u.row0 + 128 * ai + 64 * wr + 16 * m + fr;
                        const uint2 yv = *(const uint2*)(Y + (size_t)row * 512 + col);
                        const f32x4 a = acc[ai][bj][m][n] + bb;
                        const float o0 = lo_bf(yv.x) * sigmoidf_(a[0]), o1 = hi_bf(yv.x) * sigmoidf_(a[1]), o2 = lo_bf(yv.y) * sigmoidf_(a[2]), o3 = hi_bf(yv.y) * sigmoidf_(a[3]);
                        *(uint2*)(MIX + (size_t)row * D + 512 + col) = make_uint2(pack2(o0, o1), pack2(o2, o3));
                    }
            }
    }
};
__device__ __forceinline__ void phase_gemm_glu8(const Params& p, char* lds) {
    SchedDense8 S{p.ws + OFF_WGLU, 68 * 2, 2, 1024, vG(), g8::xcd_major_block()};
    EpiGlu8 E{(bf16_t*)(p.ws + OFF_MIX), (const bf16_t*)(p.ws + OFF_Y), p.s5_glu_b};
    g8::gemm8<false>((LAS unsigned char*)lds, p.ws + OFF_Y, 1024, S, E);
}
__device__ __forceinline__ void phase_gemm_recout8(const Params& p, char* lds) {
    SchedDense8 S{p.ws + OFF_WRO, 68 * 4, 4, 2 * D, vG(), g8::xcd_major_block()};
    EpiBf16_8 E{(bf16_t*)(p.ws + OFF_YX), D, D};
    g8::gemm8<false>((LAS unsigned char*)lds, p.ws + OFF_MIX, 2 * D, S, E);
}
__device__ __forceinline__ void phase_gemm_down8(const Params& p, char* lds) {
    SchedDense8 S{p.ws + OFF_WDN, 68 * 3, 3, 2 * D, vG(), g8::xcd_major_block()};
    EpiBf16_8 E{(bf16_t*)(p.ws + OFF_DN), DNW, DNW};
    g8::gemm8<false>((LAS unsigned char*)lds, p.ws + OFF_HB, 2 * D, S, E);
}
__device__ __forceinline__ void phase_gemm_wo8(const Params& p, char* lds) {
    SchedX8 S{p.ws + OFF_WO, 64 * 4, 4, 2 * D, vG(), g8::xcd_major_block()};
    EpiBf16_8 E{(bf16_t*)(p.ws + OFF_YX), D, D};
    g8::gemm8<false>((LAS unsigned char*)lds, p.ws + OFF_OB, 2 * D, S, E);
}
__device__ __forceinline__ void phase_gemm_q8(const Params& p, char* lds) {
    SchedX8 S{p.ws + OFF_WUQ, 64 * 6, 6, 768, vG(), g8::xcd_major_block()};
    EpiQ8 E{(bf16_t*)(p.ws + OFF_QF), (const float*)(p.ws + OFF_ROPE)};
    g8::gemm8<false>((LAS unsigned char*)lds, p.ws + OFF_CQ, 768, S, E);
}
__device__ __forceinline__ void phase_combine(const Params& p, int L, bool last, char* lds) {
    int* tp = (int*)lds;
    moe_prefix(p, L, tp);
    const int tid = fresh_tid(), lane = tid & 63, gw = blockIdx.x * 8 + (tid >> 6), GW = vG() * 8;
    float* xs = (float*)(p.ws + OFF_XS); const bf16_t* YR = (const bf16_t*)(p.ws + OFF_YR); bf16_t* HB = (bf16_t*)(p.ws + OFF_HB);
    const float* MF = (const float*)(p.ws + OFF_MF);
    const int* SE = (const int*)(p.ws + OFF_SE); const int* SP = (const int*)(p.ws + OFF_SP); const float* GT = (const float*)(p.ws + OFF_GT);
    const float* gpost = p.norm_ffn_post + L * D;
    const int nrows = last ? NB * SEQ : NT;
    auto rowof = [&](int ri) { return last ? ((ri >> 12) * SB + CTXL + (ri & 4095)) : ri; };
    int ne[4], npos[4]; float ng[4];
    uint2 nyv[4][4]; f32x4 nxv[4]; float dg[4];
    auto fetch_idx = [&](int ri) {
        const int r = rowof(ri);
#pragma unroll
        for (int k = 0; k < 4; ++k) { ne[k] = SE[r * 4 + k]; npos[k] = SP[r * 4 + k]; ng[k] = GT[r * 4 + k]; }
    };
    auto fetch_data = [&](int ri) {
        const int r = rowof(ri);
#pragma unroll
        for (int k = 0; k < 4; ++k) {
            const bf16_t* yr = YR + (size_t)(tp[ne[k]] * 256 + npos[k]) * D;
#pragma unroll
            for (int j = 0; j < 4; ++j) nyv[k][j] = *(const uint2*)(yr + 4 * lane + 256 * j);
            dg[k] = ng[k];
        }
#pragma unroll
        for (int j = 0; j < 4; ++j) nxv[j] = *(const f32x4*)(xs + (size_t)r * D + 4 * lane + 256 * j);
    };
    if (gw < nrows) { fetch_idx(gw); fetch_data(gw); }
    if (gw + GW < nrows) fetch_idx(gw + GW);
    for (int ri = gw; ri < nrows; ri += GW) {
        const int r = rowof(ri);
        const float* mv = MF + (size_t)(L * 5 + row_modv(r)) * 6144;
        float4 f[4], xv[4];
#pragma unroll
        for (int j = 0; j < 4; ++j) {
            f[j] = make_float4(0.f, 0.f, 0.f, 0.f);
#pragma unroll
            for (int k = 0; k < 4; ++k) { f[j].x += dg[k] * lo_bf(nyv[k][j].x); f[j].y += dg[k] * hi_bf(nyv[k][j].x); f[j].z += dg[k] * lo_bf(nyv[k][j].y); f[j].w += dg[k] * hi_bf(nyv[k][j].y); }
            xv[j] = make_float4(nxv[j][0], nxv[j][1], nxv[j][2], nxv[j][3]);
        }
        if (ri + GW < nrows) fetch_data(ri + GW);
        if (ri + 2 * GW < nrows) fetch_idx(ri + 2 * GW);
        __builtin_amdgcn_sched_barrier(0);
        const float rs = row_rstd(f);
#pragma unroll
        for (int j = 0; j < 4; ++j) {
            const int col = 4 * lane + 256 * j;
            const float4 gg = *(const float4*)(gpost + col), g5 = *(const float4*)(mv + 5 * 1024 + col);
            xv[j].x += g5.x * (f[j].x * rs * gg.x); xv[j].y += g5.y * (f[j].y * rs * gg.y);
            xv[j].z += g5.z * (f[j].z * rs * gg.z); xv[j].w += g5.w * (f[j].w * rs * gg.w);
            if (last) *(float4*)(p.out + (size_t)ri * D + col) = xv[j];
            else *(float4*)(xs + (size_t)r * D + col) = xv[j];
        }
        if (!last) {
            const float rs2 = row_rstd(xv);
            const float* mv1 = MF + (size_t)((L + 1) * 5 + row_modv(r)) * 6144;
            float4 o[4];
            modulate_store(xv, rs2, p.norm_mix_pre + (L + 1) * D, mv1, mv1 + 1024, HB + (size_t)r * D, lane, o);
        }
    }
}

__device__ __forceinline__ void gla_cum(const Params& p, uint2 v, int h, char* lds) {
    const int tid = threadIdx.x;
    float* Gm = (float*)lds; float* RF = (float*)(lds + 32768);
    {
        const int row = tid >> 3, c4 = (tid & 7) * 4;
        *(float4*)(RF + row * 32 + c4) = make_float4(lo_bf(v.x), hi_bf(v.x), lo_bf(v.y), hi_bf(v.y));
    }
    __syncthreads();
    const int d = tid & 63, dir = (tid >> 6) & 1, tg = tid >> 7;
    {
        float wv[16];
#pragma unroll
        for (int r = 0; r < 16; ++r) wv[r] = p.gla_gate_w[(dir * 16 + r) * 256 + h * 64 + d];
        const float bias = p.gla_gate_b[dir * 256 + h * 64 + d];
        for (int tt = 0; tt < 16; ++tt) {
            const int tok = tg * 16 + tt;
            float x = bias;
#pragma unroll
            for (int r = 0; r < 16; ++r) x += RF[tok * 32 + dir * 16 + r] * wv[r];
            const float ls = fminf(x, 0.f) - 0.6931471805599453f * __builtin_amdgcn_logf(1.0f + __builtin_amdgcn_exp2f(-1.4426950408889634f * fabsf(x)));
            Gm[(dir * 64 + tok) * 64 + d] = ls * (1.0f / 16.0f);
        }
    }
    __syncthreads();
    {
        float* gp = Gm + (dir * 64 + (dir ? 63 - tg * 16 : tg * 16)) * 64 + d;
        const int st = dir ? -64 : 64;
        float v[16];
#pragma unroll
        for (int i = 0; i < 16; ++i) v[i] = gp[i * st];
#pragma unroll
        for (int i = 1; i < 16; ++i) v[i] += v[i - 1];
        RF[(dir * 4 + tg) * 64 + d] = v[15];
        __syncthreads();
        float off = 0.f;
        for (int q = 0; q < tg; ++q) off += RF[(dir * 4 + q) * 64 + d];
#pragma unroll
        for (int i = 0; i < 16; ++i) gp[i * st] = v[i] + off;
    }
    __syncthreads();
}
__device__ __forceinline__ void gla_load_v(const Params& p, int r0, int h, uint2 (&vr)[4]) {
    const int tid = threadIdx.x;
    const bf16_t* Pb = (const bf16_t*)(p.ws + OFF_PB) + (size_t)(r0 + (tid >> 5)) * PW + COL_V + h * 128 + (tid & 31) * 4;
#pragma unroll
    for (int i = 0; i < 4; ++i) vr[i] = *(const uint2*)(Pb + (size_t)(16 * i) * PW);
}
__device__ __forceinline__ void gla_stage_vt(const uint2 (&vr)[4], char* VT) {
    const int tid = threadIdx.x, dv0 = (tid & 31) * 4;
#pragma unroll
    for (int i = 0; i < 4; ++i) {
        const int j = (tid >> 5) + 16 * i, cj = j >> 3, bo = (j & 7) * 2;
        *(bf16_t*)(VT + swz(dv0 + 0, cj, 128) + bo) = (bf16_t)(vr[i].x & 0xffffu); *(bf16_t*)(VT + swz(dv0 + 1, cj, 128) + bo) = (bf16_t)(vr[i].x >> 16);
        *(bf16_t*)(VT + swz(dv0 + 2, cj, 128) + bo) = (bf16_t)(vr[i].y & 0xffffu); *(bf16_t*)(VT + swz(dv0 + 3, cj, 128) + bo) = (bf16_t)(vr[i].y >> 16);
    }
}
__device__ __forceinline__ int dir_chunk(int dir, int c) { return dir ? (c < 4 ? 3 - c : 71 - c) : c; }

__device__ __forceinline__ void gla_local_item(const Params& p, int item, int b, int c, int h, char* lds) {
    const int tid = threadIdx.x, lane = tid & 63, w = tid >> 6, r0 = b * SB + c * 64;
    const bf16_t* Pb = (const bf16_t*)(p.ws + OFF_PB);
    const uint2 rfv = *(const uint2*)(Pb + (size_t)(r0 + (tid >> 3)) * PW + COL_RF + (tid & 7) * 4);
    const uint4 kraw = *(const uint4*)(Pb + (size_t)(r0 + (tid >> 3)) * PW + COL_K + h * 64 + (tid & 7) * 8);
    uint2 vr[4]; gla_load_v(p, r0, h, vr);
    __syncthreads();
    gla_cum(p, rfv, h, lds);
    const float* Gm = (const float*)lds;
    char* KE = lds + 40960; char* VT = lds + 57344;
    {
        float4* cg = (float4*)(p.ws + OFF_CUM) + (size_t)item * 2048;
#pragma unroll
        for (int i = 0; i < 4; ++i) cg[tid + 512 * i] = *(const float4*)(Gm + (tid + 512 * i) * 4);
    }
    {
        const int j = tid >> 3, dgp = tid & 7, cj = j >> 3, bo = (j & 7) * 2;
        const unsigned ka[4] = {kraw.x, kraw.y, kraw.z, kraw.w};
#pragma unroll
        for (int dir = 0; dir < 2; ++dir) {
#pragma unroll
            for (int e = 0; e < 4; ++e) {
                const int d0 = dgp * 8 + 2 * e;
                const float cl0 = dir ? Gm[64 * 64 + d0] : Gm[63 * 64 + d0], cl1 = dir ? Gm[64 * 64 + d0 + 1] : Gm[63 * 64 + d0 + 1];
                const unsigned pk = pack2(lo_bf(ka[e]) * __expf(cl0 - Gm[(dir * 64 + j) * 64 + d0]), hi_bf(ka[e]) * __expf(cl1 - Gm[(dir * 64 + j) * 64 + d0 + 1]));
                *(bf16_t*)(KE + dir * 8192 + swz(d0, cj, 128) + bo) = (bf16_t)(pk & 0xffffu);
                *(bf16_t*)(KE + dir * 8192 + swz(d0 + 1, cj, 128) + bo) = (bf16_t)(pk >> 16);
            }
        }
    }
    gla_stage_vt(vr, VT);
    __syncthreads();
    {
        const int dir = w >> 2, nq = w & 3;
        f32x4 acc[4][2];
#pragma unroll
        for (int m = 0; m < 4; ++m) { acc[m][0] = (f32x4){0.f, 0.f, 0.f, 0.f}; acc[m][1] = (f32x4){0.f, 0.f, 0.f, 0.f}; }
#pragma unroll
        for (int ks = 0; ks < 2; ++ks) {
            bf16x8 bfr[2];
#pragma unroll
            for (int n = 0; n < 2; ++n) bfr[n] = ldfrag(VT, 128, nq * 32 + n * 16, ks * 32, lane);
#pragma unroll
            for (int m = 0; m < 4; ++m) {
                const bf16x8 af = ldfrag(KE + dir * 8192, 128, m * 16, ks * 32, lane);
#pragma unroll
                for (int n = 0; n < 2; ++n) acc[m][n] = mfma16(bfr[n], af, acc[m][n]);
            }
        }
        const int nd = dir_chunk(dir, c);
        float* KVb = (float*)(p.ws + OFF_KV) + ((size_t)(((b * 2 + dir) * 4 + h) * NCH + nd)) * 8192;
#pragma unroll
        for (int m = 0; m < 4; ++m)
#pragma unroll
            for (int n = 0; n < 2; ++n) *(f32x4*)(KVb + (m * 16 + (lane & 15)) * 128 + nq * 32 + n * 16 + 4 * (lane >> 4)) = acc[m][n];
    }
    if (tid < 128) {
        const int dir = tid >> 6, d = tid & 63, nd = dir_chunk(dir, c);
        const float cl = dir ? Gm[(64 + 0) * 64 + d] : Gm[63 * 64 + d];
        ((float*)(p.ws + OFF_DL))[((size_t)(((b * 2 + dir) * 4 + h) * NCH + nd)) * 64 + d] = __expf(cl);
    }
}

__device__ __forceinline__ void phase_gla_scan(const Params& p) {
    const int tid = threadIdx.x;
    for (int it = blockIdx.x; it < 512; it += vG()) {
        const int combo = it >> 4, el = (it & 15) * 512 + tid, d = el >> 7;
        float* base = (float*)(p.ws + OFF_KV) + (size_t)combo * NCH * 8192 + el;
        const float* dl = (const float*)(p.ws + OFF_DL) + (size_t)combo * NCH * 64 + d;
        float s = 0.f;
        for (int n0 = 0; n0 < NCH; n0 += 17) {
            float kv[17], dec[17];
#pragma unroll
            for (int i = 0; i < 17; ++i) { kv[i] = base[(size_t)(n0 + i) * 8192]; dec[i] = dl[(n0 + i) * 64]; }
#pragma unroll
            for (int i = 0; i < 17; ++i) { base[(size_t)(n0 + i) * 8192] = s; s = dec[i] * s + kv[i]; }
        }
    }
    for (int it = blockIdx.x; it < 32; it += vG()) {
        const int idx = it * 512 + tid, pp = idx & 63, g = (idx >> 6) & 31, dir = (idx >> 11) & 1, b = idx >> 12;
        float2* he = (float2*)(p.ws + OFF_HE) + ((size_t)((b * 2 + dir) * 32 + g) * NCH) * 64 + pp;
        const float2 a64 = ((const float2*)(p.ws + OFF_A64))[(dir * 32 + g) * 64 + pp];
        float hr = 0.f, hi = 0.f;
        for (int n0 = 0; n0 < NCH; n0 += 17) {
            float2 e[17];
#pragma unroll
            for (int i = 0; i < 17; ++i) e[i] = he[(size_t)(n0 + i) * 64];
#pragma unroll
            for (int i = 0; i < 17; ++i) {
                he[(size_t)(n0 + i) * 64] = make_float2(hr, hi);
                const float nr = a64.x * hr - a64.y * hi + e[i].x, ni = a64.x * hi + a64.y * hr + e[i].y;
                hr = nr; hi = ni;
            }
        }
    }
}

__device__ __forceinline__ void gla_out_item(const Params& p, int item, int b, int c, int h, char* lds) {
    const int tid = threadIdx.x, lane = tid & 63, w = tid >> 6, r0 = b * SB + c * 64;
    float* Gw = (float*)lds; const float* Gm = (const float*)lds;
    char* QD = lds + 40960; char* KI = lds + 49152; char* AT = lds + 57344; char* VT = lds + 65536; char* ST = lds + 81920;
    const bf16_t* Pb = (const bf16_t*)(p.ws + OFF_PB);
    const f32x4* cg = (const f32x4*)(p.ws + OFF_CUM) + (size_t)item * 2048;
    const f32x4 cum0 = cg[tid], cum1 = cg[tid + 512], cum2 = cg[tid + 1024], cum3 = cg[tid + 1536];
    const uint4 qraw = *(const uint4*)(Pb + (size_t)(r0 + (tid >> 3)) * PW + COL_Q + h * 64 + (tid & 7) * 8);
    const uint4 kraw = *(const uint4*)(Pb + (size_t)(r0 + (tid >> 3)) * PW + COL_K + h * 64 + (tid & 7) * 8);
    uint2 vr[4]; gla_load_v(p, r0, h, vr);
    const uint4 g0 = *(const uint4*)(Pb + (size_t)(r0 + (tid >> 3)) * PW + COL_G + h * 128 + (tid & 7) * 16);
    const uint4 g1 = *(const uint4*)(Pb + (size_t)(r0 + (tid >> 3)) * PW + COL_G + h * 128 + (tid & 7) * 16 + 8);
    float sv[2][16];
#pragma unroll
    for (int dir = 0; dir < 2; ++dir) {
        const int dv = tid & 127, dq = tid >> 7, nd = dir_chunk(dir, c);
        const float* S = (const float*)(p.ws + OFF_KV) + ((size_t)(((b * 2 + dir) * 4 + h) * NCH + nd)) * 8192 + (dq * 16) * 128 + dv;
#pragma unroll
        for (int e = 0; e < 16; ++e) sv[dir][e] = S[e * 128];
    }
    __syncthreads();
    *(f32x4*)(Gw + tid * 4) = cum0; *(f32x4*)(Gw + (tid + 512) * 4) = cum1; *(f32x4*)(Gw + (tid + 1024) * 4) = cum2; *(f32x4*)(Gw + (tid + 1536) * 4) = cum3;
    gla_stage_vt(vr, VT);
    __syncthreads();
    f32x4 acco[4];
#pragma unroll
    for (int n = 0; n < 4; ++n) acco[n] = (f32x4){0.f, 0.f, 0.f, 0.f};
    const int mi = w & 3, nd0 = (w >> 2) * 4;
    for (int dir = 0; dir < 2; ++dir) {
        {
            const int i = tid >> 3, dg = tid & 7;
            const unsigned qa[4] = {qraw.x, qraw.y, qraw.z, qraw.w}, ka[4] = {kraw.x, kraw.y, kraw.z, kraw.w};
            unsigned qo[4], ko[4];
#pragma unroll
            for (int e = 0; e < 4; ++e) {
                const float c0 = Gm[(dir * 64 + i) * 64 + dg * 8 + 2 * e], c1 = Gm[(dir * 64 + i) * 64 + dg * 8 + 2 * e + 1];
                qo[e] = pack2(lo_bf(qa[e]) * 0.125f * __expf(c0), hi_bf(qa[e]) * 0.125f * __expf(c1));
                ko[e] = pack2(lo_bf(ka[e]) * __expf(-c0), hi_bf(ka[e]) * __expf(-c1));
            }
            *(uint4*)(QD + swz(i, dg, 128)) = make_uint4(qo[0], qo[1], qo[2], qo[3]);
            *(uint4*)(KI + swz(i, dg, 128)) = make_uint4(ko[0], ko[1], ko[2], ko[3]);
        }
        {
            const int dv = tid & 127, dq = tid >> 7;
            unsigned pk[8];
#pragma unroll
            for (int e = 0; e < 8; ++e) pk[e] = dir ? pack2(sv[1][2 * e], sv[1][2 * e + 1]) : pack2(sv[0][2 * e], sv[0][2 * e + 1]);
            *(uint4*)(ST + swz(dv, dq * 2, 128)) = make_uint4(pk[0], pk[1], pk[2], pk[3]);
            *(uint4*)(ST + swz(dv, dq * 2 + 1, 128)) = make_uint4(pk[4], pk[5], pk[6], pk[7]);
        }
        __syncthreads();
        {
            const int mi2 = w >> 1, nj0 = (w & 1) * 2;
#pragma unroll
            for (int t = 0; t < 2; ++t) {
                const int nj = nj0 + t;
                f32x4 a = (f32x4){0.f, 0.f, 0.f, 0.f};
#pragma unroll
                for (int ks = 0; ks < 2; ++ks) a = mfma16(ldfrag(KI, 128, nj * 16, ks * 32, lane), ldfrag(QD, 128, mi2 * 16, ks * 32, lane), a);
                const int i = mi2 * 16 + (lane & 15), j0 = nj * 16 + 4 * (lane >> 4);
                float v[4];
#pragma unroll
                for (int q = 0; q < 4; ++q) { const int j = j0 + q; const bool keep = dir ? (j >= i) : (j <= i); v[q] = keep ? a[q] : 0.f; }
                *(uint2*)(AT + swz(i, j0 >> 3, 128) + (j0 & 7) * 2) = make_uint2(pack2(v[0], v[1]), pack2(v[2], v[3]));
            }
        }
        __syncthreads();
#pragma unroll
        for (int ks = 0; ks < 2; ++ks) {
            const bf16x8 xq = ldfrag(QD, 128, mi * 16, ks * 32, lane), xa = ldfrag(AT, 128, mi * 16, ks * 32, lane);
#pragma unroll
            for (int n = 0; n < 4; ++n) {
                acco[n] = mfma16(ldfrag(ST, 128, (nd0 + n) * 16, ks * 32, lane), xq, acco[n]);
                acco[n] = mfma16(ldfrag(VT, 128, (nd0 + n) * 16, ks * 32, lane), xa, acco[n]);
            }
        }
        __syncthreads();
    }
    float* OUT = (float*)lds;
    {
        const int i = mi * 16 + (lane & 15);
#pragma unroll
        for (int n = 0; n < 4; ++n) *(f32x4*)(OUT + i * 132 + (nd0 + n) * 16 + 4 * (lane >> 4)) = acco[n];
    }
    __syncthreads();
    {
        const int i = tid >> 3, seg = tid & 7;
        float o[16]; float ss = 0.f;
#pragma unroll
        for (int e = 0; e < 4; ++e) { const float4 v = *(const float4*)(OUT + i * 132 + seg * 16 + 4 * e); o[4 * e] = v.x; o[4 * e + 1] = v.y; o[4 * e + 2] = v.z; o[4 * e + 3] = v.w; }
#pragma unroll
        for (int e = 0; e < 16; ++e) ss += o[e] * o[e];
        ss += __shfl_xor(ss, 1); ss += __shfl_xor(ss, 2); ss += __shfl_xor(ss, 4);
        const float rstd = rsqrtf(ss * (1.0f / 128.0f) + EPS);
        const unsigned ga[8] = {g0.x, g0.y, g0.z, g0.w, g1.x, g1.y, g1.z, g1.w};
        unsigned pk[8];
#pragma unroll
        for (int e = 0; e < 8; ++e) {
            const float ga0 = lo_bf(ga[e]), ga1 = hi_bf(ga[e]);
            const float n0 = p.gla_norm[seg * 16 + 2 * e], n1 = p.gla_norm[seg * 16 + 2 * e + 1];
            pk[e] = pack2(o[2 * e] * rstd * n0 * (ga0 * sigmoidf_(ga0)), o[2 * e + 1] * rstd * n1 * (ga1 * sigmoidf_(ga1)));
        }
        bf16_t* mp = (bf16_t*)(p.ws + OFF_MIX) + (size_t)(r0 + i) * D + h * 128 + seg * 16;
        *(uint4*)mp = make_uint4(pk[0], pk[1], pk[2], pk[3]); *(uint4*)(mp + 8) = make_uint4(pk[4], pk[5], pk[6], pk[7]);
    }
}

template <bool FULL>
__device__ __forceinline__ void s5_item(const Params& p, int b, int c, int go, char* lds) {
    const int tid = threadIdx.x, lane = tid & 63, w = tid >> 6, g = go * 8 + w, r0 = b * SB + c * 64;
    char* HS = lds + w * 8192;
    const bf16_t* Pb = (const bf16_t*)(p.ws + OFF_PB);
    const int fr = lane & 15, fq = lane >> 4;
    bf16x8 uf[4];
#pragma unroll
    for (int m = 0; m < 4; ++m) {
        uf[m] = (bf16x8){0, 0, 0, 0, 0, 0, 0, 0};
        if (fq < 2) uf[m] = *(const bf16x8*)(Pb + (size_t)(r0 + m * 16 + fr) * PW + COL_U + g * 16 + fq * 8);
    }
    f32x4 accy[4];
#pragma unroll
    for (int m = 0; m < 4; ++m) accy[m] = (f32x4){0.f, 0.f, 0.f, 0.f};
    __syncthreads();
    for (int dir = 0; dir < 2; ++dir) {
        const int dg = dir * 32 + g, idx = dg * 64 + lane;
        const float2 a = ((const float2*)(p.ws + OFF_ABAR))[idx];
        bf16x8 bfr[8];
#pragma unroll
        for (int j = 0; j < 8; ++j) {
            bfr[j] = (bf16x8){0, 0, 0, 0, 0, 0, 0, 0};
            if (fq < 2) bfr[j] = *(const bf16x8*)((const bf16_t*)(p.ws + OFF_BBAR) + ((size_t)dg * 128 + j * 16 + fr) * 16 + fq * 8);
        }
        const int nd = dir_chunk(dir, c);
        float2* HEp = (float2*)(p.ws + OFF_HE) + ((size_t)((b * 2 + dir) * 32 + g) * NCH) * 64 + lane;
        float hr = 0.f, hi = 0.f;
        bf16x8 cfrag[4];
        if (FULL) {
            const float2 h0 = HEp[(size_t)nd * 64]; hr = h0.x; hi = h0.y;
            const bf16_t* CM = (const bf16_t*)(p.ws + OFF_CMAT) + ((size_t)(dg * 16 + fr)) * 128 + fq * 8;
#pragma unroll
            for (int ks = 0; ks < 4; ++ks) cfrag[ks] = *(const bf16x8*)(CM + ks * 32);
        }
        for (int half = 0; half < 2; ++half) {
            const int mt0 = (dir ? 1 - half : half) * 2;
#pragma unroll
            for (int mt = 0; mt < 2; ++mt) {
                const bf16x8 ua = (mt0 == 0) ? uf[mt] : uf[2 + mt];
#pragma unroll
                for (int j = 0; j < 8; ++j) {
                    const f32x4 d = mfma16(bfr[j], ua, (f32x4){0.f, 0.f, 0.f, 0.f});
                    const int row = mt * 16 + fr;
                    *(uint2*)(HS + row * 256 + ((((2 * j) | (fq >> 1)) ^ (row & 15)) << 4) + (fq & 1) * 8) = make_uint2(pack2(d[0], d[1]), pack2(d[2], d[3]));
                }
            }
            __syncthreads();
            {
                const int ch = lane >> 2, sub = (lane & 3) * 4;
#pragma unroll 8
                for (int tt = 0; tt < 32; ++tt) {
                    const int tl = dir ? 31 - tt : tt;
                    unsigned* ptr = (unsigned*)(HS + tl * 256 + ((ch ^ (tl & 15)) << 4) + sub);
                    const unsigned bu = *ptr;
                    const float nhr = a.x * hr - a.y * hi + lo_bf(bu), nhi = a.x * hi + a.y * hr + hi_bf(bu);
                    hr = nhr; hi = nhi;
                    if (FULL) *ptr = pack2(hr, hi);
                }
            }
            if (FULL) {
                __syncthreads();
#pragma unroll
                for (int mt = 0; mt < 2; ++mt)
#pragma unroll
                    for (int ks = 0; ks < 4; ++ks) {
                        const int row = mt * 16 + fr;
                        const bf16x8 hf = *(const bf16x8*)(HS + row * 256 + (((ks * 4 + fq) ^ (row & 15)) << 4));
                        if (mt0 == 0) accy[mt] = mfma16(cfrag[ks], hf, accy[mt]); else accy[2 + mt] = mfma16(cfrag[ks], hf, accy[2 + mt]);
                    }
            }
            __syncthreads();
        }
        if (!FULL) HEp[(size_t)nd * 64] = make_float2(hr, hi);
    }
    if (FULL) {
        bf16_t* Yb = (bf16_t*)(p.ws + OFF_Y);
        const int h0 = 4 * fq;
        const f32x4 dd = *(const f32x4*)(p.s5_d + g * 16 + h0);
#pragma unroll
        for (int mt = 0; mt < 4; ++mt) {
            const int tok = mt * 16 + fr;
            const uint2 uv = *(const uint2*)(Pb + (size_t)(r0 + tok) * PW + COL_U + g * 16 + h0);
            const float ua[4] = {lo_bf(uv.x), hi_bf(uv.x), lo_bf(uv.y), hi_bf(uv.y)};
            float o[4];
#pragma unroll
            for (int q = 0; q < 4; ++q) {
                const float y = accy[mt][q] + dd[q] * ua[q];
                const float z2 = 2.0f * 0.7978845608028654f * (y + 0.044715f * y * y * y);
                o[q] = y * sigmoidf_(z2);
            }
            *(uint2*)(Yb + (size_t)(r0 + tok) * 512 + g * 16 + h0) = make_uint2(pack2(o[0], o[1]), pack2(o[2], o[3]));
        }
    }
}
__device__ __forceinline__ void phase_rec_local(const Params& p, char* lds) {
    for (int it = blockIdx.x; it < 2176; it += vG()) {
        if (it < 1088) { const int b = it / 272, r = it % 272; gla_local_item(p, it, b, r >> 2, r & 3, lds); }
        else { const int j = it - 1088, b = j / 272, r = j % 272; s5_item<false>(p, b, r >> 2, r & 3, lds); }
    }
}
__device__ __forceinline__ void phase_rec_out(const Params& p, char* lds) {
    for (int it = blockIdx.x; it < 2176; it += vG()) {
        if (it < 1088) { const int b = it / 272, r = it % 272; gla_out_item(p, it, b, r >> 2, r & 3, lds); }
        else { const int j = it - 1088, b = j / 272, r = j % 272; s5_item<true>(p, b, r >> 2, r & 3, lds); }
    }
}

__device__ __forceinline__ void phase_gemm_down(const Params& p, char* lds) {
    const bf16_t* A = (const bf16_t*)(p.ws + OFF_HB); const bf16_t* Bt = (const bf16_t*)(p.ws + OFF_WDN); float* O = (float*)(p.ws + OFF_DN);
    const int nunits = (NT / 256) * 6;
    for (int u = blockIdx.x; u < nunits; u += vG()) {
        const int mt = u / 6, tn = u % 6;
        EpiF32 epi{O, DNW, mt * 256, tn * 128};
        gemm_dense<true>(A, D, mt * 256, Bt, D, tn * 128, D, lds, epi);
    }
}
__device__ __forceinline__ void phase_mla_norm(const Params& p) {
    const int lane = threadIdx.x & 63, gw = blockIdx.x * 8 + (threadIdx.x >> 6), GW = vG() * 8;
    const float* rope = (const float*)(p.ws + OFF_ROPE);
    bf16_t* CQ = (bf16_t*)(p.ws + OFF_CQ); bf16_t* CKV = (bf16_t*)(p.ws + OFF_CKV); bf16_t* KR = (bf16_t*)(p.ws + OFF_KR);
    for (int r = gw; r < NT; r += GW) {
        const bf16_t* rp = (const bf16_t*)(p.ws + OFF_DN) + (size_t)r * DNW;
        float2 q[3]; float ss = 0.f;
#pragma unroll
        for (int j = 0; j < 3; ++j) { const unsigned t = *(const unsigned*)(rp + 2 * lane + 128 * j); q[j] = make_float2(lo_bf(t), hi_bf(t)); ss += q[j].x * q[j].x + q[j].y * q[j].y; }
        ss = wave_sum(ss);
        const float rq = rsqrtf(ss * (1.0f / 384.0f) + EPS);
#pragma unroll
        for (int j = 0; j < 3; ++j) {
            const int col = 2 * lane + 128 * j;
            *(unsigned*)(CQ + (size_t)r * 384 + col) = pack2(q[j].x * rq * p.mla_q_norm[col], q[j].y * rq * p.mla_q_norm[col + 1]);
        }
        const uint2 kt = *(const uint2*)(rp + 384 + 4 * lane);
        const float4 kv = make_float4(lo_bf(kt.x), hi_bf(kt.x), lo_bf(kt.y), hi_bf(kt.y));
        float s2 = wave_sum(kv.x * kv.x + kv.y * kv.y + kv.z * kv.z + kv.w * kv.w);
        const float rk = rsqrtf(s2 * (1.0f / 256.0f) + EPS);
        const float4 gk = *(const float4*)(p.mla_kv_norm + 4 * lane);
        *(uint2*)(CKV + (size_t)r * 256 + 4 * lane) = make_uint2(pack2(kv.x * rk * gk.x, kv.y * rk * gk.y), pack2(kv.z * rk * gk.z, kv.w * rk * gk.w));
        const float v = bf2f(rp[640 + lane]);
        const float pv = __shfl_xor(v, 16);
        const int s = r % SB;
        float o = v;
        if (s >= CTXL) {
            const int sx = s - CTXL, half = lane >> 5, idx = lane & 31, fi = idx & 15;
            const int pos = half ? (sx & 63) : (sx >> 6);
            const float cs = rope[pos * 16 + fi], sn = rope[1024 + pos * 16 + fi];
            o = (idx < 16) ? (v * cs - pv * sn) : (v * cs + pv * sn);
        }
        if (FP8_QK) ((unsigned char*)KR)[(size_t)r * 64 + lane] = (unsigned char)(pack4_fp8(o, 0.f, 0.f, 0.f) & 0xffu);
        else KR[(size_t)r * 64 + lane] = (bf16_t)(pack2(o, 0.f) & 0xffffu);
    }
}
struct EpiQ {
    bf16_t* QF; const float* rope; int row0, col0;
    __device__ __forceinline__ void operator()(const f32x4 (&acc)[4][4], int wm, int wn, int lane) const {
        const float qs = 0.07216878364870322f * 1.4426950408889634f;
        const int base = (col0 + wn * 64) >> 4;
        const bool isrope = (base % 12) == 8;
#pragma unroll
        for (int m = 0; m < 4; ++m) {
            const int row = row0 + wm * 64 + m * 16 + (lane & 15);
            f32x4 o0 = acc[m][0], o1 = acc[m][1], o2 = acc[m][2], o3 = acc[m][3];
            if (isrope) {
                const int sx = (row % SB) - CTXL, gr = sx >> 6, gc = sx & 63;
                const f32x4 cr = *(const f32x4*)(rope + gr * 16 + 4 * (lane >> 4)), sr = *(const f32x4*)(rope + 1024 + gr * 16 + 4 * (lane >> 4));
                const f32x4 cc = *(const f32x4*)(rope + gc * 16 + 4 * (lane >> 4)), sc = *(const f32x4*)(rope + 1024 + gc * 16 + 4 * (lane >> 4));
                const f32x4 t0 = o0 * cr - o1 * sr, t1 = o1 * cr + o0 * sr, t2 = o2 * cc - o3 * sc, t3 = o3 * cc + o2 * sc;
                o0 = t0; o1 = t1; o2 = t2; o3 = t3;
            }
            bf16_t* rp = QF + (size_t)row * 1536 + col0 + wn * 64 + 4 * (lane >> 4);
            *(uint2*)(rp) = make_uint2(pack2(o0[0] * qs, o0[1] * qs), pack2(o0[2] * qs, o0[3] * qs));
            *(uint2*)(rp + 16) = make_uint2(pack2(o1[0] * qs, o1[1] * qs), pack2(o1[2] * qs, o1[3] * qs));
            *(uint2*)(rp + 32) = make_uint2(pack2(o2[0] * qs, o2[1] * qs), pack2(o2[2] * qs, o2[3] * qs));
            *(uint2*)(rp + 48) = make_uint2(pack2(o3[0] * qs, o3[1] * qs), pack2(o3[2] * qs, o3[3] * qs));
        }
    }
};
struct EpiKV {
    bf16_t* KN; bf16_t* VT; int row0, tn;
    __device__ __forceinline__ void operator()(const f32x4 (&acc)[4][4], int wm, int wn, int lane) const {
        const int head = tn >> 1; const bool isv = tn & 1;
        const int b = row0 / SB, s0 = row0 % SB;
#pragma unroll
        for (int m = 0; m < 4; ++m) {
            const int rl = wm * 64 + m * 16 + 4 * (lane >> 4);
#pragma unroll
            for (int n = 0; n < 4; ++n) {
                const int cw = wn * 64 + n * 16 + (lane & 15);
                if (isv) {
                    *(uint2*)(VT + ((size_t)((b * 8 + head) * 128 + cw)) * SB + s0 + rl) = make_uint2(pack2(acc[m][n][0], acc[m][n][1]), pack2(acc[m][n][2], acc[m][n][3]));
                } else {
                    const unsigned p01 = pack2(acc[m][n][0], acc[m][n][1]), p23 = pack2(acc[m][n][2], acc[m][n][3]);
                    bf16_t* kp = KN + (size_t)(row0 + rl) * D + head * 128 + cw;
                    kp[0] = (bf16_t)(p01 & 0xffffu); kp[D] = (bf16_t)(p01 >> 16); kp[2 * D] = (bf16_t)(p23 & 0xffffu); kp[3 * D] = (bf16_t)(p23 >> 16);
                }
            }
        }
    }
};
struct EpiKV8 {
    bf16_t* KN; bf16_t* VT;
    __device__ __forceinline__ void operator()(const f32x4 (&acc)[2][2][4][2], const g8::Unit& u, int wr, int wc, int fr, int fq) const {
        const int head = u.tn, b = u.row0 / SB, s0 = u.row0 % SB;
#pragma unroll
        for (int ai = 0; ai < 2; ++ai)
#pragma unroll
            for (int m = 0; m < 4; ++m) {
                const int rl = 128 * ai + 64 * wr + 16 * m + fr;
                bf16_t* kp = KN + (size_t)(u.row0 + rl) * D + head * 128 + 32 * wc + 4 * fq;
                if (FP8_QK) {
                    char* k8 = (char*)KN + (size_t)(u.row0 + rl) * D + head * 128 + 32 * wc + 4 * fq;
                    *(unsigned*)(k8) = pack4_fp8(acc[ai][0][m][0][0], acc[ai][0][m][0][1], acc[ai][0][m][0][2], acc[ai][0][m][0][3]);
                    *(unsigned*)(k8 + 16) = pack4_fp8(acc[ai][0][m][1][0], acc[ai][0][m][1][1], acc[ai][0][m][1][2], acc[ai][0][m][1][3]);
                } else {
                    *(uint2*)(kp) = make_uint2(pack2(acc[ai][0][m][0][0], acc[ai][0][m][0][1]), pack2(acc[ai][0][m][0][2], acc[ai][0][m][0][3]));
                    *(uint2*)(kp + 16) = make_uint2(pack2(acc[ai][0][m][1][0], acc[ai][0][m][1][1]), pack2(acc[ai][0][m][1][2], acc[ai][0][m][1][3]));
                }
#pragma unroll
                for (int n = 0; n < 2; ++n) {
                    const unsigned p01 = pack2(acc[ai][1][m][n][0], acc[ai][1][m][n][1]), p23 = pack2(acc[ai][1][m][n][2], acc[ai][1][m][n][3]);
                    bf16_t* vp = VT + ((size_t)((b * 8 + head) * 128 + 32 * wc + 16 * n + 4 * fq)) * SB + s0 + rl;
                    vp[0] = (bf16_t)(p01 & 0xffffu); vp[SB] = (bf16_t)(p01 >> 16); vp[2 * SB] = (bf16_t)(p23 & 0xffffu); vp[3 * SB] = (bf16_t)(p23 >> 16);
                }
            }
    }
};
__device__ __forceinline__ void phase_gemm_kv8(const Params& p, char* lds) {
    SchedDense8 S{p.ws + OFF_WUKV, 68 * 8, 8, 512, vG(), g8::xcd_major_block()};
    EpiKV8 E{(bf16_t*)(p.ws + OFF_KN), (bf16_t*)(p.ws + OFF_VT)};
    g8::gemm8<false>((LAS unsigned char*)lds, p.ws + OFF_CKV, 512, S, E);
}
__device__ __forceinline__ void phase_gemm_kv(const Params& p, char* lds) {
    const int nkv = 68 * 16;
    for (int v = blockIdx.x; v < nkv; v += vG()) {
        const int mt = v >> 4, tn = v & 15;
        EpiKV epi{(bf16_t*)(p.ws + OFF_KN), (bf16_t*)(p.ws + OFF_VT), mt * 256, tn};
        gemm_dense<false>((const bf16_t*)(p.ws + OFF_CKV), 256, mt * 256, (const bf16_t*)(p.ws + OFF_WUKV), 256, tn * 128, 256, lds, epi);
    }
}
__device__ __forceinline__ void phase_gemm_qkv(const Params& p, char* lds) {
    const int nq = 64 * 12, nkv = 68 * 16;
    for (int u = blockIdx.x; u < nq + nkv; u += vG()) {
        if (u < nq) {
            const int mi = u / 12, tn = u % 12, row0 = (mi >> 4) * SB + ((mi & 15) + 1) * 256;
            EpiQ epi{(bf16_t*)(p.ws + OFF_QF), (const float*)(p.ws + OFF_ROPE), row0, tn * 128};
            gemm_dense<true>((const bf16_t*)(p.ws + OFF_CQ), 384, row0, (const bf16_t*)(p.ws + OFF_WUQ), 384, tn * 128, 384, lds, epi);
        } else {
            const int v = u - nq, mt = v >> 4, tn = v & 15;
            EpiKV epi{(bf16_t*)(p.ws + OFF_KN), (bf16_t*)(p.ws + OFF_VT), mt * 256, tn};
            gemm_dense<false>((const bf16_t*)(p.ws + OFF_CKV), 256, mt * 256, (const bf16_t*)(p.ws + OFF_WUKV), 256, tn * 128, 256, lds, epi);
        }
    }
}
__device__ __forceinline__ void phase_attention(const Params& p, char* lds) {
    const int tid = threadIdx.x, lane = tid & 63, w = tid >> 6;
    const bf16_t* QF = (const bf16_t*)(p.ws + OFF_QF); const bf16_t* KN = (const bf16_t*)(p.ws + OFF_KN);
    const bf16_t* KR = (const bf16_t*)(p.ws + OFF_KR); const bf16_t* VTg = (const bf16_t*)(p.ws + OFF_VT);
    bf16_t* OB = (bf16_t*)(p.ws + OFF_OB);
    char* Ps = lds + 122880 + w * 4096;
    const FragBase fbk = fragbase(lane, 384), fbv = fragbase(lane, 128);
    for (int it = blockIdx.x; it < NB * 8 * 16; it += vG()) {
        const int b = it >> 7, h = (it >> 4) & 7, qt = it & 15;
        const int qrow0 = b * SB + CTXL + qt * 256 + w * 32;
        bf16x8 qf[2][6];
#pragma unroll
        for (int m = 0; m < 2; ++m)
#pragma unroll
            for (int ks = 0; ks < 6; ++ks) qf[m][ks] = *(const bf16x8*)(QF + (size_t)(qrow0 + m * 16 + (lane & 15)) * 1536 + h * 192 + ks * 32 + (lane >> 4) * 8);
        f32x4 acco[2][8];
#pragma unroll
        for (int m = 0; m < 2; ++m)
#pragma unroll
            for (int n = 0; n < 8; ++n) acco[m][n] = (f32x4){0.f, 0.f, 0.f, 0.f};
        float mrun[2] = {0.f, 0.f}; bool first = true;
        f32x4 lacc[2] = {(f32x4){0.f, 0.f, 0.f, 0.f}, (f32x4){0.f, 0.f, 0.f, 0.f}};
        unsigned koff[3], kstep[3], voff[2];
#pragma unroll
        for (int i = 0; i < 3; ++i) {
            const int L = (w + 8 * i) * 64 + lane, r = L / 24, q = L % 24;
            const int c = (q & ~7) | ((q & 7) ^ ((r >> 1) & 7));
            koff[i] = (c < 16) ? (unsigned)(OFF_KN + ((size_t)(b * SB + r) * D + h * 128 + c * 8) * 2) : (unsigned)(OFF_KR + ((size_t)(b * SB + r) * 64 + (c - 16) * 8) * 2);
            kstep[i] = (c < 16) ? 64u * D * 2u : 64u * 64u * 2u;
        }
#pragma unroll
        for (int i = 0; i < 2; ++i) {
            const int L = (w + 8 * i) * 64 + lane, r = L >> 3, q = L & 7, c = q ^ ((r >> 1) & 7);
            voff[i] = (unsigned)(OFF_VT + ((size_t)((b * 8 + h) * 128 + r) * SB + c * 8) * 2);
        }
        auto dma = [&](int kt, int st) {
            char* Ks = lds + st * 24576; char* Vs = lds + 73728 + st * 16384;
#pragma unroll
            for (int i = 0; i < 3; ++i)
                __builtin_amdgcn_global_load_lds((const unsigned*)(p.ws + (size_t)(koff[i] + (unsigned)kt * kstep[i])), (LAS unsigned*)(Ks + (w + 8 * i) * 1024 + lane * 16), 16, 0, 0);
#pragma unroll
            for (int i = 0; i < 2; ++i)
                __builtin_amdgcn_global_load_lds((const unsigned*)(p.ws + (size_t)(voff[i] + (unsigned)kt * 128u)), (LAS unsigned*)(Vs + (w + 8 * i) * 1024 + lane * 16), 16, 0, 0);
        };
        f32x4 s[2][4];
        auto do_S = [&](int st) {
            const char* Ks = lds + st * 24576;
#pragma unroll
            for (int m = 0; m < 2; ++m)
#pragma unroll
                for (int n = 0; n < 4; ++n) s[m][n] = (f32x4){-mrun[m], -mrun[m], -mrun[m], -mrun[m]};
            bf16x8 kf[4];
#pragma unroll
            for (int i = 0; i < 3; ++i) kf[i] = ldfrag2(Ks, fbk, 384, (i & 3) * 16, i >> 2);
#pragma unroll
            for (int i = 0; i < 24; ++i) {
                if (i + 3 < 24) kf[(i + 3) & 3] = ldfrag2(Ks, fbk, 384, ((i + 3) & 3) * 16, (i + 3) >> 2);
                __builtin_amdgcn_sched_barrier(0);
                s[0][i & 3] = mfma16(kf[i & 3], qf[0][i >> 2], s[0][i & 3]); s[1][i & 3] = mfma16(kf[i & 3], qf[1][i >> 2], s[1][i & 3]);
            }
        };
        auto do_SM_PV = [&](int st) {
            const char* Vs = lds + 73728 + st * 16384;
#pragma unroll
            for (int m = 0; m < 2; ++m) {
                float mx = s[m][0][0];
#pragma unroll
                for (int n = 0; n < 4; ++n)
#pragma unroll
                    for (int q = 0; q < 4; ++q) mx = fmaxf(mx, s[m][n][q]);
                if (__any(first || mx > 64.0f)) {
                    mx = fmaxf(mx, __shfl_xor(mx, 16)); mx = fmaxf(mx, __shfl_xor(mx, 32));
                    const float delta = first ? mx : fmaxf(mx, 0.f), alpha = first ? 1.0f : __builtin_amdgcn_exp2f(-delta);
                    lacc[m] *= alpha;
#pragma unroll
                    for (int n = 0; n < 8; ++n) acco[m][n] *= alpha;
#pragma unroll
                    for (int n = 0; n < 4; ++n) s[m][n] -= delta;
                    mrun[m] += delta;
                }
#pragma unroll
                for (int n = 0; n < 4; ++n) {
                    float pv[4];
#pragma unroll
                    for (int q = 0; q < 4; ++q) pv[q] = __builtin_amdgcn_exp2f(s[m][n][q]);
                    *(uint2*)(Ps + m * 2048 + (lane & 15) * 128 + ((((n * 2) | (lane >> 5)) ^ (((lane & 15) >> 1) & 7)) << 4) + ((lane >> 4) & 1) * 8) = make_uint2(pack2(pv[0], pv[1]), pack2(pv[2], pv[3]));
                }
            }
            first = false;
            __builtin_amdgcn_wave_barrier();
            {
                bf16x8 pf[2][2], vf[4];
#pragma unroll
                for (int ks = 0; ks < 2; ++ks) { pf[ks][0] = ldfrag2(Ps, fbv, 128, 0, ks); pf[ks][1] = ldfrag2(Ps, fbv, 128, 16, ks); }
                {
                    const bf16x8 ones = (bf16x8){16256, 16256, 16256, 16256, 16256, 16256, 16256, 16256};
#pragma unroll
                    for (int ks = 0; ks < 2; ++ks) { lacc[0] = mfma16(ones, pf[ks][0], lacc[0]); lacc[1] = mfma16(ones, pf[ks][1], lacc[1]); }
                }
#pragma unroll
                for (int i = 0; i < 3; ++i) vf[i] = ldfrag2(Vs, fbv, 128, (i & 7) * 16, i >> 3);
#pragma unroll
                for (int i = 0; i < 16; ++i) {
                    if (i + 3 < 16) vf[(i + 3) & 3] = ldfrag2(Vs, fbv, 128, ((i + 3) & 7) * 16, (i + 3) >> 3);
                    __builtin_amdgcn_sched_barrier(0);
                    acco[0][i & 7] = mfma16(vf[i & 3], pf[i >> 3][0], acco[0][i & 7]); acco[1][i & 7] = mfma16(vf[i & 3], pf[i >> 3][1], acco[1][i & 7]);
                }
            }
        };
        __syncthreads();
        dma(0, 0); dma(1, 1);
        asm volatile("s_waitcnt vmcnt(0)" ::: "memory");
        __syncthreads();
        const int nkt = SB / 64;
        const bool grpA = w < 4;
        int st = 0, stp = 2;
        for (int kt = 0; kt < nkt; ++kt) {
            const bool more2 = (kt + 2) < nkt;
            if (grpA) do_S(st); else if (kt > 0) do_SM_PV(stp);
            asm volatile("s_waitcnt lgkmcnt(0)" ::: "memory");
            __builtin_amdgcn_s_barrier();
            asm volatile("" ::: "memory");
            if (more2) dma(kt + 2, stp);
            if (grpA) do_SM_PV(st); else do_S(st);
            if (more2) asm volatile("s_waitcnt vmcnt(5)" ::: "memory"); else asm volatile("s_waitcnt vmcnt(0)" ::: "memory");
            asm volatile("s_waitcnt lgkmcnt(0)" ::: "memory");
            __builtin_amdgcn_s_barrier();
            asm volatile("" ::: "memory");
            stp = st; st = (st == 2) ? 0 : st + 1;
        }
        if (!grpA) do_SM_PV(stp);
#pragma unroll
        for (int m = 0; m < 2; ++m) {
            const float il = 1.0f / lacc[m][0];
            bf16_t* op = OB + (size_t)(qrow0 + m * 16 + (lane & 15)) * D + h * 128 + 4 * (lane >> 4);
#pragma unroll
            for (int n = 0; n < 8; ++n) *(uint2*)(op + n * 16) = make_uint2(pack2(acco[m][n][0] * il, acco[m][n][1] * il), pack2(acco[m][n][2] * il, acco[m][n][3] * il));
        }
    }
}

__device__ __forceinline__ void phase_attention8(const Params& p, char* lds) {
    const int tid = threadIdx.x, lane = tid & 63, w = tid >> 6;
    const bf16_t* QF = (const bf16_t*)(p.ws + OFF_QF); const bf16_t* KN = (const bf16_t*)(p.ws + OFF_KN);
    const bf16_t* KR = (const bf16_t*)(p.ws + OFF_KR); const bf16_t* VTg = (const bf16_t*)(p.ws + OFF_VT);
    bf16_t* OB = (bf16_t*)(p.ws + OFF_OB);
    char* Ps = lds + 98304 + w * 4096;
    const FragBase fbv = fragbase(lane, 128);
    const int fr = lane & 15, fq = lane >> 4;
    for (int it = blockIdx.x; it < NB * 8 * 16; it += vG()) {
        const int b = it >> 7, h = (it >> 4) & 7, qt = it & 15;
        const int qrow0 = b * SB + CTXL + qt * 256 + w * 32;
        g8::i32x8 q8[2][2];
#pragma unroll
        for (int m = 0; m < 2; ++m) {
            const char* qp = p.ws + OFF_QF + (size_t)(qrow0 + m * 16 + fr) * 1536 + h * 192 + 32 * fq;
            q8[m][0] = __builtin_shufflevector(*(const g8::i32x4_t*)qp, *(const g8::i32x4_t*)(qp + 16), 0, 1, 2, 3, 4, 5, 6, 7);
            q8[m][1] = (g8::i32x8){0, 0, 0, 0, 0, 0, 0, 0};
            if (fq < 2) q8[m][1] = __builtin_shufflevector(*(const g8::i32x4_t*)(qp + 128), *(const g8::i32x4_t*)(qp + 144), 0, 1, 2, 3, 4, 5, 6, 7);
        }
        f32x4 acco[2][8];
#pragma unroll
        for (int m = 0; m < 2; ++m)
#pragma unroll
            for (int n = 0; n < 8; ++n) acco[m][n] = (f32x4){0.f, 0.f, 0.f, 0.f};
        float mrun[2] = {0.f, 0.f}; bool first = true;
        f32x4 lacc[2] = {(f32x4){0.f, 0.f, 0.f, 0.f}, (f32x4){0.f, 0.f, 0.f, 0.f}};
        unsigned koff[2], kstep[2], voff[2];
#pragma unroll
        for (int i = 0; i < 2; ++i) {
            const int L = (w + 8 * i) * 64 + lane, r = L >> 4, q = L & 15, c = q ^ (r & 15);
            if (c < 8) { koff[i] = (unsigned)(OFF_KN + (size_t)(b * SB + r) * D + h * 128 + c * 16); kstep[i] = 64u * D; }
            else if (c < 12) { koff[i] = (unsigned)(OFF_KR + (size_t)(b * SB + r) * 64 + (c - 8) * 16); kstep[i] = 64u * 64u; }
            else { koff[i] = (unsigned)(OFF_ZERO64 + (c - 12) * 16); kstep[i] = 0u; }
        }
#pragma unroll
        for (int i = 0; i < 2; ++i) {
            const int L = (w + 8 * i) * 64 + lane, r = L >> 3, q = L & 7, c = q ^ ((r >> 1) & 7);
            voff[i] = (unsigned)(OFF_VT + ((size_t)((b * 8 + h) * 128 + r) * SB + c * 8) * 2);
        }
        auto dma = [&](int kt, int st) {
            char* Ks = lds + st * 16384; char* Vs = lds + 49152 + st * 16384;
#pragma unroll
            for (int i = 0; i < 2; ++i)
                __builtin_amdgcn_global_load_lds((const unsigned*)(p.ws + (size_t)(koff[i] + (unsigned)kt * kstep[i])), (LAS unsigned*)(Ks + (w + 8 * i) * 1024 + lane * 16), 16, 0, 0);
#pragma unroll
            for (int i = 0; i < 2; ++i)
                __builtin_amdgcn_global_load_lds((const unsigned*)(p.ws + (size_t)(voff[i] + (unsigned)kt * 128u)), (LAS unsigned*)(Vs + (w + 8 * i) * 1024 + lane * 16), 16, 0, 0);
        };
        f32x4 s[2][4];
        auto do_S = [&](int st) {
            const char* Ks = lds + st * 16384;
#pragma unroll
            for (int m = 0; m < 2; ++m)
#pragma unroll
                for (int n = 0; n < 4; ++n) s[m][n] = (f32x4){-mrun[m], -mrun[m], -mrun[m], -mrun[m]};
            const int ksc = 0x7F7F7F7F, qsc = 0x7B7B7B7B;
            auto ldk = [&](int i) {
                const int c0 = 8 * (i >> 2) + 2 * fq;
                const char* rp = Ks + ((i & 3) * 16 + fr) * 256;
                return __builtin_shufflevector(*(const g8::i32x4_t*)(rp + ((c0 ^ fr) << 4)), *(const g8::i32x4_t*)(rp + (((c0 + 1) ^ fr) << 4)), 0, 1, 2, 3, 4, 5, 6, 7);
            };
            g8::i32x8 kf[3];
            kf[0] = ldk(0); kf[1] = ldk(1);
#pragma unroll
            for (int i = 0; i < 8; ++i) {
                if (i + 2 < 8) kf[(i + 2) % 3] = ldk(i + 2);
                __builtin_amdgcn_sched_barrier(0);
                asm volatile("s_nop 1\n\tv_mfma_scale_f32_16x16x128_f8f6f4 %0, %1, %2, %0, %3, %4 op_sel_hi:[0,0,0]" : "+v"(s[0][i & 3]) : "v"(kf[i % 3]), "v"(q8[0][i >> 2]), "v"(ksc), "v"(qsc));
                asm volatile("s_nop 1\n\tv_mfma_scale_f32_16x16x128_f8f6f4 %0, %1, %2, %0, %3, %4 op_sel_hi:[0,0,0]" : "+v"(s[1][i & 3]) : "v"(kf[i % 3]), "v"(q8[1][i >> 2]), "v"(ksc), "v"(qsc));
            }
            __builtin_amdgcn_sched_barrier(0); asm volatile("s_nop 15\n\ts_nop 15" ::: "memory"); __builtin_amdgcn_sched_barrier(0);
        };
        auto do_SM_PV = [&](int st) {
            const char* Vs = lds + 49152 + st * 16384;
#pragma unroll
            for (int m = 0; m < 2; ++m) {
                float mx = s[m][0][0];
#pragma unroll
                for (int n = 0; n < 4; ++n)
#pragma unroll
                    for (int q = 0; q < 4; ++q) mx = fmaxf(mx, s[m][n][q]);
                if (__any(first || mx > 64.0f)) {
                    mx = fmaxf(mx, __shfl_xor(mx, 16)); mx = fmaxf(mx, __shfl_xor(mx, 32));
                    const float delta = first ? mx : fmaxf(mx, 0.f), alpha = first ? 1.0f : __builtin_amdgcn_exp2f(-delta);
                    lacc[m] *= alpha;
#pragma unroll
                    for (int n = 0; n < 8; ++n) acco[m][n] *= alpha;
#pragma unroll
                    for (int n = 0; n < 4; ++n) s[m][n] -= delta;
                    mrun[m] += delta;
                }
#pragma unroll
                for (int n = 0; n < 4; ++n) {
                    float pv[4];
#pragma unroll
                    for (int q = 0; q < 4; ++q) pv[q] = __builtin_amdgcn_exp2f(s[m][n][q]);
                    *(uint2*)(Ps + m * 2048 + (lane & 15) * 128 + ((((n * 2) | (lane >> 5)) ^ (((lane & 15) >> 1) & 7)) << 4) + ((lane >> 4) & 1) * 8) = make_uint2(pack2(pv[0], pv[1]), pack2(pv[2], pv[3]));
                }
            }
            first = false;
            __builtin_amdgcn_wave_barrier();
            {
                bf16x8 pf[2][2], vf[4];
#pragma unroll
                for (int ks = 0; ks < 2; ++ks) { pf[ks][0] = ldfrag2(Ps, fbv, 128, 0, ks); pf[ks][1] = ldfrag2(Ps, fbv, 128, 16, ks); }
                {
                    const bf16x8 ones = (bf16x8){16256, 16256, 16256, 16256, 16256, 16256, 16256, 16256};
#pragma unroll
                    for (int ks = 0; ks < 2; ++ks) { lacc[0] = mfma16(ones, pf[ks][0], lacc[0]); lacc[1] = mfma16(ones, pf[ks][1], lacc[1]); }
                }
#pragma unroll
                for (int i = 0; i < 3; ++i) vf[i] = ldfrag2(Vs, fbv, 128, (i & 7) * 16, i >> 3);
#pragma unroll
                for (int i = 0; i < 16; ++i) {
                    if (i + 3 < 16) vf[(i + 3) & 3] = ldfrag2(Vs, fbv, 128, ((i + 3) & 7) * 16, (i + 3) >> 3);
                    __builtin_amdgcn_sched_barrier(0);
                    acco[0][i & 7] = mfma16(vf[i & 3], pf[i >> 3][0], acco[0][i & 7]); acco[1][i & 7] = mfma16(vf[i & 3], pf[i >> 3][1], acco[1][i & 7]);
                }
            }
        };
        __syncthreads();
        dma(0, 0); dma(1, 1);
        asm volatile("s_waitcnt vmcnt(0)" ::: "memory");
        __syncthreads();
        const int nkt = SB / 64;
        const bool grpA = w < 4;
        int st = 0, stp = 2;
        for (int kt = 0; kt < nkt; ++kt) {
            const bool more2 = (kt + 2) < nkt;
            if (grpA) do_S(st); else if (kt > 0) do_SM_PV(stp);
            asm volatile("s_waitcnt lgkmcnt(0)" ::: "memory");
            __builtin_amdgcn_s_barrier();
            asm volatile("" ::: "memory");
            if (more2) dma(kt + 2, stp);
            if (grpA) do_SM_PV(st); else do_S(st);
            if (more2) asm volatile("s_waitcnt vmcnt(5)" ::: "memory"); else asm volatile("s_waitcnt vmcnt(0)" ::: "memory");
            asm volatile("s_waitcnt lgkmcnt(0)" ::: "memory");
            __builtin_amdgcn_s_barrier();
            asm volatile("" ::: "memory");
            stp = st; st = (st == 2) ? 0 : st + 1;
        }
        if (!grpA) do_SM_PV(stp);
#pragma unroll
        for (int m = 0; m < 2; ++m) {
            const float il = 1.0f / lacc[m][0];
            bf16_t* op = OB + (size_t)(qrow0 + m * 16 + (lane & 15)) * D + h * 128 + 4 * (lane >> 4);
#pragma unroll
            for (int n = 0; n < 8; ++n) *(uint2*)(op + n * 16) = make_uint2(pack2(acco[m][n][0] * il, acco[m][n][1] * il), pack2(acco[m][n][2] * il, acco[m][n][3] * il));
        }
    }
}

constexpr int LDS_BYTES = 16 + 155648 + 512;
#ifndef ONLY_PHASE
#define ONLY_PHASE -1
#endif
#define RUN_PHASE(i, call) do { if ((ONLY_PHASE < 0 || ONLY_PHASE == (i)) && p.phase_lo <= (i) && (i) < p.phase_hi) { call; } if (p.phase_lo <= (i) && (i) + 1 < p.phase_hi) xcd_barrier(bar); } while (0)

__global__ void __launch_bounds__(512, 2) hybrid_forward(Params p) {
    extern __shared__ __attribute__((aligned(16))) char smem[];
    if (threadIdx.x == 0) *(uint4*)smem = make_uint4(0u, 0u, gridDim.x, 0u);
    __syncthreads();
    char* lds = smem + 16;
    XcdBarrier bar; bar.bar = (unsigned*)(p.ws + OFF_BAR); bar.x = 0; bar.st = (volatile LAS unsigned*)smem;
    if (p.phase_hi - p.phase_lo > 1) bar = xcd_barrier_post((unsigned*)(p.ws + OFF_BAR), (volatile LAS unsigned*)smem);
    RUN_PHASE(0, { phase_prologue0(p, lds); phase_prologue1(p, lds); });
    RUN_PHASE(1, phase_prenorm(p, 0));
    const bool split = (gridDim.x == 256);
#define RUN_SPLIT(i, nc, q, base, hi, call) do { if (split && p.phase_lo <= (i) && (i) < p.phase_hi) set_vG(nc); \
        RUN_PHASE(i, { if (!split || (int)blockIdx.x < (nc)) { call; } else convert_static(p, base, (int)blockIdx.x - (nc), 256 - (nc), q, hi, lds); }); \
        if (split && p.phase_lo <= (i) && (i) < p.phase_hi) set_vG((int)gridDim.x); } while (0)
    RUN_SPLIT(3, CV3_NC, CV3_Q, CV_B3, CV_TILES_SET, phase_gemm_recin8(p, lds));
    RUN_PHASE(4, phase_rec_local(p, lds));
    RUN_PHASE(5, phase_gla_scan(p));
    RUN_PHASE(6, phase_rec_out(p, lds));
    RUN_SPLIT(7, CV7_NC, CV7_Q, CV_B7, CV_TILES_SET, phase_gemm_glu8(p, lds));
    RUN_SPLIT(8, CV8_NC, CV8_Q, CV_B8, CV_TILES_SET, phase_gemm_recout8(p, lds));
    RUN_PHASE(9, { phase_postmix(p, 0, false, lds); convert_static(p, split ? CV_B9 : 0, (int)blockIdx.x, (int)gridDim.x, 1 << 20, CV_TILES_SET, lds); });
    RUN_PHASE(10, phase_moe1_8(p, 0, lds));
    RUN_PHASE(11, phase_moe2_8(p, 0, lds));
    RUN_PHASE(12, phase_combine(p, 0, false, lds));
    RUN_SPLIT(13, CV13_NC, CV13_Q, CV_B13, 2 * CV_TILES_SET, phase_gemm_down8(p, lds));
    RUN_PHASE(14, phase_mla_norm(p));
    RUN_SPLIT(15, CV15_NC, CV15_Q, CV_B15, 2 * CV_TILES_SET, { phase_gemm_kv8(p, lds); __syncthreads(); phase_gemm_q8(p, lds); });
    RUN_PHASE(16, { if (FP8_QK) phase_attention8(p, lds); else phase_attention(p, lds); });
    RUN_PHASE(17, { phase_gemm_wo8(p, lds); convert_static(p, split ? CV_B17 : CV_TILES_SET, (int)blockIdx.x, (int)gridDim.x, 1 << 20, 2 * CV_TILES_SET, lds); });
    RUN_PHASE(18, phase_postmix(p, 1, true, lds));
    RUN_PHASE(19, phase_moe1_8(p, 1, lds));
    RUN_PHASE(20, phase_moe2_8(p, 1, lds));
    RUN_PHASE(21, phase_combine(p, 1, true, lds));
#if DBG_STOP >= 0
    if (p.phase_lo == 22) {
        float* o = p.out;
        for (size_t e = (size_t)blockIdx.x * 512 + threadIdx.x; e < (size_t)NB * SEQ * 1024; e += (size_t)gridDim.x * 512) {
            const int ri = (int)(e >> 10), c = (int)(e & 1023), r = (ri >> 12) * SB + CTXL + (ri & 4095);
            float v;
            if (DBG_SRC == 0) v = ((const float*)(p.ws + OFF_XS))[(size_t)r * 1024 + c];
            else if (DBG_SRC == 1) v = bf2f(((const bf16_t*)(p.ws + OFF_PB))[(size_t)r * PW + DBG_COL + c]);
            else if (DBG_SRC == 2) v = bf2f(((const bf16_t*)(p.ws + OFF_MIX))[(size_t)r * 1024 + (DBG_COL + c) % 1024]);
            else if (DBG_SRC == 3) v = bf2f(((const bf16_t*)(p.ws + OFF_YX))[(size_t)r * 1024 + c]);
            else if (DBG_SRC == 4) v = bf2f(((const bf16_t*)(p.ws + OFF_Y))[(size_t)r * 512 + (c & 511)]);
            else if (DBG_SRC == 5) v = bf2f(((const bf16_t*)(p.ws + OFF_HB))[(size_t)r * 1024 + c]);
            else if (DBG_SRC == 6) v = bf2f(((const bf16_t*)(p.ws + OFF_WRI))[(size_t)(ri % 2304) * 1024 + c]);
            else v = ((const float*)(p.ws + OFF_MF))[(size_t)(e % 61440)];
            if (!(fabsf(v) < 1.0e30f)) v = 1.0e4f;
            o[e] = v;
        }
    }
#endif
}

extern "C" void kernel_launch(void* const* d_in, const int* in_sizes, int n_in, void* d_out, int out_size, void* d_ws, size_t ws_size, hipStream_t stream) {
    static int grid = 0;
    if (!grid) {
        int dev = 0, cus = 0, per_cu = 0;
        hipGetDevice(&dev);
        hipDeviceGetAttribute(&cus, hipDeviceAttributeMultiprocessorCount, dev);
        hipFuncSetAttribute((const void*)hybrid_forward, hipFuncAttributeMaxDynamicSharedMemorySize, LDS_BYTES);
        hipOccupancyMaxActiveBlocksPerMultiprocessor(&per_cu, hybrid_forward, 512, LDS_BYTES);
        if (per_cu < 1) { fprintf(stderr, "occupancy query returned %d\n", per_cu); per_cu = 1; }
        grid = cus * 1;
    }
    if (ws_size < WS_TOTAL) { fprintf(stderr, "workspace too small: %zu < %zu\n", ws_size, (size_t)WS_TOTAL); return; }
    hipMemsetAsync(d_ws, 0, ZERO_BYTES, stream);
    Params p{};
    const float** f = (const float**)&p;
    for (int i = 0; i < 37; ++i) f[i] = (const float*)d_in[i];
    p.out = (float*)d_out; p.ws = (char*)d_ws;
#if DBG_STOP >= 0
    for (int i = 0; i <= DBG_STOP; ++i) { p.phase_lo = i; p.phase_hi = i + 1; hipLaunchKernelGGL(hybrid_forward, dim3(grid), dim3(512), LDS_BYTES, stream, p); }
    p.phase_lo = 22; p.phase_hi = 23; hipLaunchKernelGGL(hybrid_forward, dim3(grid), dim3(512), LDS_BYTES, stream, p);
#elif MK_MULTI
    for (int i = 0; i < NPHASE; ++i) { p.phase_lo = i; p.phase_hi = i + 1; hipLaunchKernelGGL(hybrid_forward, dim3(grid), dim3(512), LDS_BYTES, stream, p); }
#else
    p.phase_lo = 0; p.phase_hi = NPHASE;
    hipLaunchKernelGGL(hybrid_forward, dim3(grid), dim3(512), LDS_BYTES, stream, p);
#endif
}
```

```cpp
#include <hip/hip_runtime.h>
#include <stdint.h>
#include <stdio.h>

#ifndef DBG_STOP
#define DBG_STOP -1
#endif
#ifndef DBG_SRC
#define DBG_SRC 0
#endif
#ifndef DBG_COL
#define DBG_COL 0
#endif
#ifndef FP8_G1
#define FP8_G1 1
#endif
#ifndef FP8_G2
#define FP8_G2 1
#endif
#ifndef FP8_QK
#define FP8_QK 1
#endif
#ifndef MK_MULTI
#define MK_MULTI 0
#endif

typedef unsigned short bf16_t;
typedef short bf16x8 __attribute__((ext_vector_type(8)));
typedef float f32x4 __attribute__((ext_vector_type(4)));

constexpr int D = 1024, NB = 4, SEQ = 4096, CTXL = 256;
constexpr int SB = SEQ + CTXL;
constexpr int NT = NB * SB;
constexpr int NCH = SB / 64;
constexpr int PW = 2176;
constexpr int COL_Q = 0, COL_K = 256, COL_V = 512, COL_G = 1024, COL_RF = 1536, COL_U = 1568;
constexpr int NE = 32, TOPK = 4;
constexpr int MAXPR = 78080;
constexpr int DNW = 768;
constexpr float EPS = 1e-6f;
constexpr int NPHASE = 22;

constexpr size_t al256(size_t x) { return (x + 255) & ~(size_t)255; }
constexpr size_t OFF_BAR = 0;
constexpr size_t OFF_CNT = 16384;
constexpr size_t ZERO_BYTES = 20480;
constexpr size_t OFF_MP = ZERO_BYTES;
constexpr size_t OFF_MF = OFF_MP + al256((size_t)8 * 2 * 5 * 6144 * 4);
constexpr size_t OFF_ROPE = OFF_MF + al256((size_t)2 * 5 * 6144 * 4);
constexpr size_t OFF_ABAR = OFF_ROPE + al256(2 * 1024 * 4);
constexpr size_t OFF_A64 = OFF_ABAR + al256(4096 * 8);
constexpr size_t OFF_BBAR = OFF_A64 + al256(4096 * 8);
constexpr size_t OFF_CMAT = OFF_BBAR + al256((size_t)4096 * 16 * 8);
constexpr size_t OFF_WRI = OFF_CMAT + al256((size_t)64 * 16 * 128 * 2);
constexpr size_t OFF_WRO = OFF_WRI + al256((size_t)2304 * 1024 * 2);
constexpr size_t OFF_WGLU = OFF_WRO + al256((size_t)1024 * 1024 * 2);
constexpr size_t OFF_WDN = OFF_WGLU + al256((size_t)512 * 512 * 2);
constexpr size_t OFF_WUQ = OFF_WDN + al256((size_t)DNW * 1024 * 2);
constexpr size_t OFF_WUKV = OFF_WUQ + al256((size_t)1536 * 384 * 2);
constexpr size_t OFF_WO = OFF_WUKV + al256((size_t)2048 * 256 * 2);
constexpr size_t OFF_EWI = OFF_WO + al256((size_t)1024 * 1024 * 2);
constexpr size_t OFF_EWO = OFF_EWI + al256((size_t)64 * 2048 * 1024 * 2);
constexpr size_t OFF_XS = OFF_EWO + al256((size_t)64 * 1024 * 1024 * 2);
constexpr size_t OFF_HB = OFF_XS + al256((size_t)NT * 1024 * 4);
constexpr size_t OFF_PB = OFF_HB + al256((size_t)NT * 1024 * 2);
constexpr size_t OFF_KV = OFF_PB + al256((size_t)NT * PW * 2);
constexpr size_t OFF_DL = OFF_KV + al256((size_t)32 * NCH * 64 * 128 * 4);
constexpr size_t OFF_HE = OFF_DL + al256((size_t)32 * NCH * 64 * 4);
constexpr size_t OFF_Y = OFF_HE + al256((size_t)4 * 2 * 32 * NCH * 64 * 8);
constexpr size_t OFF_MIX = OFF_Y + al256((size_t)NT * 512 * 2);
constexpr size_t OFF_YX = OFF_MIX + al256((size_t)NT * 1024 * 2);
constexpr size_t OFF_LIST = OFF_YX + al256((size_t)NT * 1024 * 4);
constexpr size_t OFF_SE = OFF_LIST + al256((size_t)NE * NT * 4);
constexpr size_t OFF_SP = OFF_SE + al256((size_t)NT * 4 * 4);
constexpr size_t OFF_GT = OFF_SP + al256((size_t)NT * 4 * 4);
constexpr size_t OFF_ACT = OFF_GT + al256((size_t)NT * 4 * 4);
constexpr size_t OFF_YR = OFF_ACT + al256((size_t)MAXPR * 1024 * 2);
constexpr size_t OFF_DN = OFF_YR + al256((size_t)MAXPR * 1024 * 2);
constexpr size_t OFF_CQ = OFF_DN + al256((size_t)NT * DNW * 4);
constexpr size_t OFF_CKV = OFF_CQ + al256((size_t)NT * 384 * 2);
constexpr size_t OFF_KR = OFF_CKV + al256((size_t)NT * 256 * 2);
constexpr size_t OFF_QF = OFF_KR + al256((size_t)NT * 64 * 2);
constexpr size_t OFF_KN = OFF_QF + al256((size_t)NT * 1536 * 2);
constexpr size_t OFF_VT = OFF_KN + al256((size_t)NT * 1024 * 2);
constexpr size_t OFF_OB = OFF_VT + al256((size_t)NT * 1024 * 2);
constexpr size_t OFF_HB8 = OFF_OB + al256((size_t)NT * 1024 * 2);
constexpr size_t OFF_CUM = OFF_HB8 + al256((size_t)NT * 1024);
constexpr size_t WS_TOTAL = OFF_CUM + al256((size_t)1088 * 8192 * 4);
static_assert(WS_TOTAL < (1ull << 31), "32-bit workspace offsets");

struct Params {
    const float *x, *c, *ctx, *c_ctx, *mod_w, *mod_b, *norm_mix_pre, *norm_mix_post, *norm_ffn_pre, *norm_ffn_post;
    const float *router_w, *router_b, *exp_w_in, *exp_b_in, *exp_w_out, *exp_b_out, *rec_w_in, *rec_w_out;
    const float *gla_gate_w, *gla_gate_b, *gla_norm, *s5_lam_re, *s5_lam_im, *s5_log_dt, *s5_b_re, *s5_b_im;
    const float *s5_c_re, *s5_c_im, *s5_d, *s5_glu_w, *s5_glu_b, *mla_w_down, *mla_q_norm, *mla_kv_norm;
    const float *mla_w_uq, *mla_w_ukv, *mla_w_o;
    float* out;
    char* ws;
    int phase_lo, phase_hi;
};

#define XB_TMO      128
#define XB_XCNT(j)  (256  + 64 * (j))
#define XB_XSUB(j)  (1280 + 64 * (j))
#define XB_XGEN(j)  (2304 + 64 * (j))
#define XB_TOP      3328
#define XB_TOPGEN   3392
#define XCD_BAR_WORDS 3456
#define XB_SPIN_CAP (1u << 22)
#define LAS __attribute__((address_space(3)))

__device__ __forceinline__ unsigned xb_ld(unsigned* p)              { return __hip_atomic_load(p, __ATOMIC_RELAXED, __HIP_MEMORY_SCOPE_AGENT); }
__device__ __forceinline__ unsigned xb_add(unsigned* p, unsigned v) { return __hip_atomic_fetch_add(p, v, __ATOMIC_RELAXED, __HIP_MEMORY_SCOPE_AGENT); }
__device__ __forceinline__ unsigned xb_xcc_id() { return (unsigned)__builtin_amdgcn_s_getreg((3 << 11) | 20) & 0xFu; }
#define XB_SPIN(cond, bar) do { unsigned _sp = 0; while (cond) { __builtin_amdgcn_s_sleep(1); \
    if ((++_sp & 255u) == 0u) { if (xb_ld(&(bar)[XB_TMO])) break; if (_sp > XB_SPIN_CAP) { atomicAdd(&(bar)[XB_TMO], 1u); break; } } } } while (0)

struct XcdBarrier { unsigned* bar; unsigned x; volatile LAS unsigned* st; };

__device__ __forceinline__ XcdBarrier xcd_barrier_post(unsigned* bar, volatile LAS unsigned* st) {
    XcdBarrier b; b.bar = bar; b.x = xb_xcc_id(); b.st = st;
    if (threadIdx.x == 0) (void)xb_add(&bar[XB_XCNT(b.x)], 1u);
    return b;
}
__device__ __forceinline__ void xcd_barrier_complete(unsigned* bar, unsigned x, unsigned& nloc, unsigned& nx) {
    const unsigned G = gridDim.x * gridDim.y * gridDim.z;
    unsigned sum, cnt, mine, sp = 0u;
    for (;;) {
        sum = 0u; cnt = 0u; mine = 0u;
#pragma unroll
        for (unsigned j = 0; j < 16; ++j) { const unsigned c = xb_ld(&bar[XB_XCNT(j)]); sum += c; cnt += (c > 0u) ? 1u : 0u; mine = (j == x) ? c : mine; }
        if (sum == G) break;
        __builtin_amdgcn_s_sleep(1);
        if ((++sp & 255u) == 0u) { if (xb_ld(&bar[XB_TMO])) break; if (sp > XB_SPIN_CAP) { atomicAdd(&bar[XB_TMO], 1u); break; } }
    }
    nloc = mine > 0u ? mine : 1u; nx = cnt > 0u ? cnt : 1u;
}
__device__ __forceinline__ void xcd_barrier(const XcdBarrier& b) {
    asm volatile("s_waitcnt vmcnt(0)" ::: "memory");
    __syncthreads();
    if (threadIdx.x == 0) {
        unsigned* bar = b.bar;
        __builtin_amdgcn_s_waitcnt(0);
        unsigned nloc = b.st[0], nx = b.st[1];
        if (nloc == 0u) { xcd_barrier_complete(bar, b.x, nloc, nx); b.st[0] = nloc; b.st[1] = nx; }
        const unsigned old = xb_add(&bar[XB_XSUB(b.x)], 1u);
        const unsigned gen = old / nloc;
        if (old + 1u == (gen + 1u) * nloc) {
            __builtin_amdgcn_fence(__ATOMIC_RELEASE, "agent");
            asm volatile("s_waitcnt vmcnt(0)" ::: "memory");
            const unsigned og = xb_add(&bar[XB_TOP], 1u);
            const unsigned tg = og / nx;
            if (og + 1u == (tg + 1u) * nx) xb_add(&bar[XB_TOPGEN], 1u);
            else XB_SPIN(xb_ld(&bar[XB_TOPGEN]) == tg, bar);
            __builtin_amdgcn_fence(__ATOMIC_ACQUIRE, "agent");
            xb_add(&bar[XB_XGEN(b.x)], 1u);
            asm volatile("s_waitcnt vmcnt(0)" ::: "memory");
        } else {
            XB_SPIN(xb_ld(&bar[XB_XGEN(b.x)]) == gen, bar);
            __builtin_amdgcn_fence(__ATOMIC_ACQUIRE, "agent");
            asm volatile("s_waitcnt vmcnt(0)" ::: "memory");
        }
    }
    __syncthreads();
}

__device__ __forceinline__ int vG() { extern __shared__ __attribute__((aligned(16))) char smem_hdr[]; return __builtin_amdgcn_readfirstlane(*(volatile int*)(smem_hdr + 8)); }
__device__ __forceinline__ void set_vG(int v) { extern __shared__ __attribute__((aligned(16))) char smem_hdr[]; __syncthreads(); if (threadIdx.x == 0) *(volatile int*)(smem_hdr + 8) = v; __syncthreads(); }

__device__ __forceinline__ int fresh_tid() { int t = threadIdx.x; asm volatile("" : "+v"(t)); return t; }
__device__ __forceinline__ float bf2f(bf16_t h) { return __uint_as_float(((unsigned)h) << 16); }
typedef float f32x2_t __attribute__((ext_vector_type(2)));
typedef __bf16 bf16x2_t __attribute__((ext_vector_type(2)));
__device__ __forceinline__ unsigned pack2(float lo, float hi) { const f32x2_t v = {lo, hi}; const bf16x2_t b = __builtin_convertvector(v, bf16x2_t); return __builtin_bit_cast(unsigned, b); }
__device__ __forceinline__ unsigned pack4_fp8(float a, float b, float c, float d) {
    int r = __builtin_amdgcn_cvt_pk_fp8_f32(a, b, 0, false); r = __builtin_amdgcn_cvt_pk_fp8_f32(c, d, r, true); return (unsigned)r;
}
__device__ __forceinline__ float lo_bf(unsigned u) { return __uint_as_float(u << 16); }
__device__ __forceinline__ float hi_bf(unsigned u) { return __uint_as_float(u & 0xffff0000u); }
__device__ __forceinline__ float wave_sum(float v) {
#pragma unroll
    for (int o = 32; o >= 1; o >>= 1) v += __shfl_xor(v, o);
    return v;
}
__device__ __forceinline__ float sigmoidf_(float x) { return __builtin_amdgcn_rcpf(1.0f + __builtin_amdgcn_exp2f(-1.4426950408889634f * x)); }
__device__ __forceinline__ int swz(int r, int c, int RS) { return r * RS + ((c ^ ((r >> 1) & 7)) << 4); }
__device__ __forceinline__ int swz256(int r, int c) { return r * 256 + ((c ^ (r & 15)) << 4); }
__device__ __forceinline__ f32x4 mfma16(bf16x8 a, bf16x8 b, f32x4 c) { return __builtin_amdgcn_mfma_f32_16x16x32_bf16(a, b, c, 0, 0, 0); }
__device__ __forceinline__ bf16x8 ldfrag(const char* tile, int RS, int row0, int k0, int lane) {
    return *(const bf16x8*)(tile + swz(row0 + (lane & 15), (k0 >> 3) + (lane >> 4), RS));
}

struct FragBase { int b0, b1; };
__device__ __forceinline__ FragBase fragbase(int lane, int RS) {
    const int r = lane & 15, t = (lane >> 4) ^ ((r >> 1) & 7);
    FragBase f; f.b0 = r * RS + (t << 4); f.b1 = r * RS + ((t ^ 4) << 4); return f;
}
__device__ __forceinline__ bf16x8 ldfrag2(const char* tile, const FragBase& fb, int RS, int row0, int ks) {
    return *(const bf16x8*)(tile + ((ks & 1) ? fb.b1 : fb.b0) + row0 * RS + (ks >> 1) * 128);
}

constexpr int G_ABYTES = 256 * 128, G_BBYTES = 128 * 128, G_STAGE = G_ABYTES + G_BBYTES;
template <bool TRANS, class Epi>
__device__ __forceinline__ void gemm_tile(const bf16_t* a0, const bf16_t* a1, const bf16_t* a2, const bf16_t* a3,
                                          const bf16_t* b0, const bf16_t* b1, int K, char* lds, const Epi& epi) {
    const int tid = threadIdx.x, lane = tid & 63, w = tid >> 6, wm = w >> 1, wn = w & 1;
    const int srow = tid >> 3, sch = tid & 7, soff = swz(srow, sch, 128);
    const FragBase fb = fragbase(lane, 128);
    f32x4 acc[4][4];
#pragma unroll
    for (int m = 0; m < 4; ++m)
#pragma unroll
        for (int n = 0; n < 4; ++n) acc[m][n] = (f32x4){0.f, 0.f, 0.f, 0.f};
    uint4 ra0 = *(const uint4*)a0, ra1 = *(const uint4*)a1, ra2 = *(const uint4*)a2, ra3 = *(const uint4*)a3;
    uint4 rb0 = *(const uint4*)b0, rb1 = *(const uint4*)b1;
    {
        char* As = lds; char* Bs = lds + G_ABYTES;
        *(uint4*)(As + soff) = ra0; *(uint4*)(As + soff + 8192) = ra1; *(uint4*)(As + soff + 16384) = ra2; *(uint4*)(As + soff + 24576) = ra3;
        *(uint4*)(Bs + soff) = rb0; *(uint4*)(Bs + soff + 8192) = rb1;
    }
    __syncthreads();
    const int nk = K >> 6;
    for (int kt = 0; kt < nk; ++kt) {
        const bool more = (kt + 1) < nk;
        if (more) {
            const int ko = (kt + 1) * 64;
            ra0 = *(const uint4*)(a0 + ko); ra1 = *(const uint4*)(a1 + ko); ra2 = *(const uint4*)(a2 + ko); ra3 = *(const uint4*)(a3 + ko);
            rb0 = *(const uint4*)(b0 + ko); rb1 = *(const uint4*)(b1 + ko);
        }
        const char* As = lds + (kt & 1) * G_STAGE; const char* Bs = As + G_ABYTES;
#pragma unroll
        for (int ks = 0; ks < 2; ++ks) {
            bf16x8 af[4], bfr[4];
#pragma unroll
            for (int m = 0; m < 4; ++m) af[m] = ldfrag2(As + wm * 8192, fb, 128, m * 16, ks);
#pragma unroll
            for (int n = 0; n < 4; ++n) bfr[n] = ldfrag2(Bs + wn * 8192, fb, 128, n * 16, ks);
#pragma unroll
            for (int m = 0; m < 4; ++m)
#pragma unroll
                for (int n = 0; n < 4; ++n) acc[m][n] = TRANS ? mfma16(bfr[n], af[m], acc[m][n]) : mfma16(af[m], bfr[n], acc[m][n]);
        }
        if (more) {
            char* As2 = lds + ((kt + 1) & 1) * G_STAGE; char* Bs2 = As2 + G_ABYTES;
            *(uint4*)(As2 + soff) = ra0; *(uint4*)(As2 + soff + 8192) = ra1; *(uint4*)(As2 + soff + 16384) = ra2; *(uint4*)(As2 + soff + 24576) = ra3;
            *(uint4*)(Bs2 + soff) = rb0; *(uint4*)(Bs2 + soff + 8192) = rb1;
        }
        __syncthreads();
    }
    epi(acc, wm, wn, lane);
}
template <bool TRANS, class Epi>
__device__ __forceinline__ void gemm_dense(const bf16_t* A, int lda, int row0, const bf16_t* Bt, int ldb, int col0, int K, char* lds, const Epi& epi) {
    const int tid = threadIdx.x, srow = tid >> 3, sch = (tid & 7) * 8;
    const bf16_t* a = A + (size_t)(row0 + srow) * lda + sch;
    const bf16_t* b = Bt + (size_t)(col0 + srow) * ldb + sch;
    gemm_tile<TRANS>(a, a + (size_t)64 * lda, a + (size_t)128 * lda, a + (size_t)192 * lda, b, b + (size_t)64 * ldb, K, lds, epi);
}

namespace g8 {
constexpr int BK = 64, HALF = 128, HTB = HALF * BK * 2, STAGE_BYTES = 8 * HTB;
__device__ __forceinline__ void stage_rc(int b, int& R, int& C) { R = b >> 7; const int q = (b >> 4) & 7; C = (q ^ ((R >> 1) & 7)) * 8; }
struct Unit { const char* B; int row0, tn, e, slot; };

typedef int i32x8 __attribute__((ext_vector_type(8)));
typedef int i32x4_t __attribute__((ext_vector_type(4)));
__device__ __forceinline__ bf16x8 lo8(i32x8 v) { return __builtin_bit_cast(bf16x8, __builtin_shufflevector(v, v, 0, 1, 2, 3)); }
__device__ __forceinline__ bf16x8 hi8(i32x8 v) { return __builtin_bit_cast(bf16x8, __builtin_shufflevector(v, v, 4, 5, 6, 7)); }
template <bool FP8, class Epi, class Sched>
__device__ __forceinline__ void gemm8(LAS unsigned char* lds, const char* Abase, int rowB, const Sched& S, const Epi& E) {
    const int tid = threadIdx.x, wid = __builtin_amdgcn_readfirstlane(tid >> 6), lane = tid & 63, wr = wid >> 2, wc = wid & 3, fr = lane & 15, fq = lane >> 4;
    const int nt = rowB / 128;
    int R[2], C[2]; unsigned voffB[2];
#pragma unroll
    for (int i = 0; i < 2; ++i) { stage_rc(tid * 16 + i * 8192, R[i], C[i]); voffB[i] = (unsigned)(R[i] * rowB + C[i] * 2); }
    const size_t kstep = (size_t)(BK * 2);
    const size_t hstep = (size_t)HALF * rowB;
    const unsigned ldsw = (unsigned)wid * 1024u;
    const int fsw = fq ^ ((fr >> 1) & 7);
    const int aoff = (wr * 64 + fr) * 128 + (fsw << 4), aoff1 = (wr * 64 + fr) * 128 + ((fsw ^ 4) << 4);
    const int boff = (wc * 32 + fr) * 128 + (fsw << 4), boff1 = (wc * 32 + fr) * 128 + ((fsw ^ 4) << 4);
#define G8_SA(b, h) (((b) * 2 + (h)) * HTB)
#define G8_SB(b, h) ((4 + (b) * 2 + (h)) * HTB)
#define G8_STAGE(bufoff, gbase, voff) do { _Pragma("unroll") for (int _i = 0; _i < 2; ++_i) \
        __builtin_amdgcn_global_load_lds((const unsigned*)((const char*)(gbase) + (voff)[_i]), (LAS unsigned*)(lds + (bufoff) + ldsw + _i * 8192), 16, 0, 0); } while (0)
#define G8_LD2(a0, a1) __builtin_shufflevector(*(const LAS i32x4_t*)(a0), *(const LAS i32x4_t*)(a1), 0, 1, 2, 3, 4, 5, 6, 7)
#define G8_LDA(dst, b, h) do { _Pragma("unroll") for (int m = 0; m < 4; ++m) dst[m] = G8_LD2(lds + G8_SA(b, h) + aoff + m * 2048, lds + G8_SA(b, h) + aoff1 + m * 2048); } while (0)
#define G8_LDB(dst, b, h) do { _Pragma("unroll") for (int n = 0; n < 2; ++n) dst[n] = G8_LD2(lds + G8_SB(b, h) + boff + n * 2048, lds + G8_SB(b, h) + boff1 + n * 2048); } while (0)
#define G8_MMA(ai, bj, At, Bt) do { __builtin_amdgcn_s_setprio(1); _Pragma("unroll") for (int m = 0; m < 4; ++m) _Pragma("unroll") for (int n = 0; n < 2; ++n) { \
        if constexpr (FP8) asm volatile("s_nop 1\n\tv_mfma_scale_f32_16x16x128_f8f6f4 %0, %1, %2, %0, %3, %3 op_sel_hi:[0,0,0]" : "+v"(acc[ai][bj][m][n]) : "v"(Bt[n]), "v"(At[m]), "v"(scl)); \
        else { acc[ai][bj][m][n] = __builtin_amdgcn_mfma_f32_16x16x32_bf16(lo8(Bt[n]), lo8(At[m]), acc[ai][bj][m][n], 0, 0, 0); \
               acc[ai][bj][m][n] = __builtin_amdgcn_mfma_f32_16x16x32_bf16(hi8(Bt[n]), hi8(At[m]), acc[ai][bj][m][n], 0, 0, 0); } } \
        __builtin_amdgcn_s_setprio(0); } while (0)
#define G8_WAIT_V(n) asm volatile("s_waitcnt vmcnt(" #n ")" ::: "memory")
#define G8_WAIT_L(n) asm volatile("s_waitcnt lgkmcnt(" #n ")" ::: "memory")
#define G8_BAR __builtin_amdgcn_s_barrier()
#define G8_SCHED __builtin_amdgcn_sched_barrier(0)
    Unit cur, nxt; int ui = 0;
    if (!S.next(0, cur)) return;
    f32x4 acc[2][2][4][2];
#pragma unroll
    for (int a = 0; a < 2; ++a)
#pragma unroll
        for (int b = 0; b < 2; ++b)
#pragma unroll
            for (int m = 0; m < 4; ++m)
#pragma unroll
                for (int n = 0; n < 2; ++n) acc[a][b][m][n] = (f32x4){0.f, 0.f, 0.f, 0.f};
    i32x8 At[4], B0[2], B1[2];
    const int scl = 0x7F7F7F7F;
    unsigned co[2][2], no[2][2];
    S.aoff(cur, R, C, co);
    const char* cB = cur.B;
    G8_STAGE(G8_SB(0, 0), cB, voffB); G8_STAGE(G8_SA(0, 0), Abase, co[0]); G8_STAGE(G8_SB(0, 1), cB + hstep, voffB); G8_STAGE(G8_SA(0, 1), Abase, co[1]);
    if (wr == 1) G8_BAR;
    G8_WAIT_V(4); G8_BAR;
    G8_STAGE(G8_SB(1, 0), cB + kstep, voffB); G8_STAGE(G8_SA(1, 0), Abase + kstep, co[0]); G8_STAGE(G8_SB(1, 1), cB + hstep + kstep, voffB);
    G8_WAIT_V(6); G8_BAR;
    for (;;) {
        const bool has_next = S.next(ui + 1, nxt);
        unsigned adelta = 0u;
        if constexpr (Sched::AFFINE) { adelta = has_next ? (unsigned)((nxt.row0 - cur.row0) * rowB) : 0u; }
        else { if (has_next) { int tz = tid; asm volatile("" : "+v"(tz)); int R2[2], C2[2]; stage_rc(tz * 16, R2[0], C2[0]); stage_rc(tz * 16 + 8192, R2[1], C2[1]); S.aoff(nxt, R2, C2, no); } else { no[0][0] = co[0][0]; no[0][1] = co[0][1]; no[1][0] = co[1][0]; no[1][1] = co[1][1]; } }
        const char* nB = has_next ? nxt.B : cB;
#pragma nounroll
        for (int t = 0; t < nt; t += 2) {
            const bool last = (t == nt - 2);
            const char* a1 = Abase + (size_t)(t + 1) * kstep;
            const char* a2 = last ? Abase : Abase + (size_t)(t + 2) * kstep; const char* b2 = last ? nB : cB + (size_t)(t + 2) * kstep;
            const char* a3 = a2 + kstep; const char* b3 = b2 + kstep;
            unsigned o2[2][2];
            if constexpr (Sched::AFFINE) { const unsigned dd = last ? adelta : 0u; o2[0][0] = co[0][0] + dd; o2[0][1] = co[0][1] + dd; o2[1][0] = co[1][0] + dd; o2[1][1] = co[1][1] + dd; }
            else { o2[0][0] = last ? no[0][0] : co[0][0]; o2[0][1] = last ? no[0][1] : co[0][1]; o2[1][0] = last ? no[1][0] : co[1][0]; o2[1][1] = last ? no[1][1] : co[1][1]; }
            G8_LDB(B0, 0, 0); G8_SCHED; G8_LDA(At, 0, 0); G8_STAGE(G8_SA(1, 1), a1, co[1]);
            G8_WAIT_L(8); G8_BAR; G8_WAIT_L(0); G8_MMA(0, 0, At, B0); G8_BAR; G8_SCHED;
            G8_LDB(B1, 0, 1); G8_STAGE(G8_SB(0, 0), b2, voffB);
            G8_BAR; G8_WAIT_L(0); G8_MMA(0, 1, At, B1); G8_BAR;
            G8_LDA(At, 0, 1); G8_STAGE(G8_SA(0, 0), a2, o2[0]);
            G8_BAR; G8_WAIT_L(0); G8_MMA(1, 0, At, B0); G8_BAR; G8_SCHED;
            G8_STAGE(G8_SB(0, 1), b2 + hstep, voffB);
            G8_WAIT_V(6); G8_BAR; G8_MMA(1, 1, At, B1); G8_BAR;
            G8_LDB(B0, 1, 0); G8_SCHED; G8_LDA(At, 1, 0); G8_STAGE(G8_SA(0, 1), a2, o2[1]);
            G8_WAIT_L(8); G8_BAR; G8_WAIT_L(0); G8_MMA(0, 0, At, B0); G8_BAR; G8_SCHED;
            G8_LDB(B1, 1, 1); G8_STAGE(G8_SB(1, 0), b3, voffB);
            G8_BAR; G8_WAIT_L(0); G8_MMA(0, 1, At, B1); G8_BAR;
            G8_LDA(At, 1, 1); G8_STAGE(G8_SA(1, 0), a3, o2[0]);
            G8_BAR; G8_WAIT_L(0); G8_MMA(1, 0, At, B0); G8_BAR; G8_SCHED;
            G8_STAGE(G8_SB(1, 1), b3 + hstep, voffB);
            G8_WAIT_V(6); G8_BAR; G8_MMA(1, 1, At, B1); G8_BAR;
        }
        if constexpr (FP8) { __builtin_amdgcn_sched_barrier(0); asm volatile("s_nop 15\n\ts_nop 15" ::: "memory"); __builtin_amdgcn_sched_barrier(0); }
        { int fr2 = fr, fq2 = fq; asm volatile("" : "+v"(fr2), "+v"(fq2)); E(acc, cur, wr, wc, fr2, fq2); }
        if (!has_next) break;
#pragma unroll
        for (int a = 0; a < 2; ++a)
#pragma unroll
            for (int b = 0; b < 2; ++b)
#pragma unroll
                for (int m = 0; m < 4; ++m)
#pragma unroll
                    for (int n = 0; n < 2; ++n) acc[a][b][m][n] = (f32x4){0.f, 0.f, 0.f, 0.f};
        cur = nxt; cB = nB; ++ui;
        if constexpr (Sched::AFFINE) { co[0][0] += adelta; co[0][1] += adelta; co[1][0] += adelta; co[1][1] += adelta; }
        else { co[0][0] = no[0][0]; co[0][1] = no[0][1]; co[1][0] = no[1][0]; co[1][1] = no[1][1]; }
    }
    G8_WAIT_V(0);
    if (wr == 0) G8_BAR;
    G8_BAR;
#undef G8_SA
#undef G8_SB
#undef G8_STAGE
#undef G8_LD2
#undef G8_LDA
#undef G8_LDB
#undef G8_MMA
#undef G8_WAIT_V
#undef G8_WAIT_L
#undef G8_BAR
#undef G8_SCHED
}
__device__ __forceinline__ int xcd_major_block() { const int b = blockIdx.x, G = vG(); return ((G & 7) == 0) ? ((b & 7) * (G >> 3) + (b >> 3)) : b; }
}

__device__ __forceinline__ void phase_prologue0(const Params& p, char* lds) {
    const int tid = threadIdx.x, G = vG();
    {
        float* act = (float*)lds;
        float* part = (float*)(lds + 20480);
        float* MF = (float*)(p.ws + OFF_MF);
        for (int e = tid; e < 5 * 1024; e += 512) {
            const int v = e >> 10, kk = e & 1023;
            const float cv = (v < 4) ? p.c[v * D + kk] : p.c_ctx[kk];
            act[e] = cv / (1.0f + __expf(-cv));
        }
        __syncthreads();
        for (int it = blockIdx.x; it < 192; it += G) {
            const int i = it / 96, n0 = (it % 96) * 64, cg = tid & 15, kq = tid >> 4;
            const float* wp = p.mod_w + ((size_t)i * D + kq * 32) * 6144 + n0 + cg * 4;
            f32x4 a0 = {0.f, 0.f, 0.f, 0.f}, a1 = a0, a2 = a0, a3 = a0, a4 = a0;
#pragma unroll 8
            for (int kk = 0; kk < 32; ++kk) {
                const f32x4 wv = *(const f32x4*)(wp + (size_t)kk * 6144);
                const int k = kq * 32 + kk;
                a0 += act[k] * wv; a1 += act[1024 + k] * wv; a2 += act[2048 + k] * wv; a3 += act[3072 + k] * wv; a4 += act[4096 + k] * wv;
            }
            __syncthreads();
            *(f32x4*)(part + (kq * 5 + 0) * 64 + cg * 4) = a0; *(f32x4*)(part + (kq * 5 + 1) * 64 + cg * 4) = a1; *(f32x4*)(part + (kq * 5 + 2) * 64 + cg * 4) = a2;
            *(f32x4*)(part + (kq * 5 + 3) * 64 + cg * 4) = a3; *(f32x4*)(part + (kq * 5 + 4) * 64 + cg * 4) = a4;
            __syncthreads();
            if (tid < 320) {
                const int v = tid >> 6, c = tid & 63;
                float sum = p.mod_b[i * 6144 + n0 + c];
#pragma unroll 8
                for (int q = 0; q < 32; ++q) sum += part[(q * 5 + v) * 64 + c];
                MF[(size_t)(i * 5 + v) * 6144 + n0 + c] = sum;
            }
        }
    }
    {
        float* rope = (float*)(p.ws + OFF_ROPE);
        for (int e = blockIdx.x * 512 + tid; e < 1024; e += G * 512) {
            const int pos = e >> 4, i = e & 15;
            const float inv = powf(10000.0f, -(float)i / 16.0f);
            const float ang = (float)pos * inv;
            rope[e] = cosf(ang); rope[1024 + e] = sinf(ang);
        }
        float2* ABAR = (float2*)(p.ws + OFF_ABAR); float2* A64 = (float2*)(p.ws + OFF_A64);
        bf16_t* CM = (bf16_t*)(p.ws + OFF_CMAT);
        for (int e = blockIdx.x * 512 + tid; e < 4096; e += G * 512) {
            const int dg = e >> 6;
            const float lre = p.s5_lam_re[e], lim = p.s5_lam_im[e];
            const float dt = expf(p.s5_log_dt[dg]);
            const float mag = expf(lre * dt);
            float sn, cs; sincosf(lim * dt, &sn, &cs);
            const float ar = mag * cs, ai = mag * sn;
            ABAR[e] = make_float2(ar, ai);
            float pr = ar, pi = ai;
#pragma unroll
            for (int q = 0; q < 6; ++q) { const float nr = pr * pr - pi * pi, ni = 2.0f * pr * pi; pr = nr; pi = ni; }
            A64[e] = make_float2(pr, pi);
            const float nr = ar - 1.0f, ni = ai, den = lre * lre + lim * lim;
            const float cr = (nr * lre + ni * lim) / den, ci = (ni * lre - nr * lim) / den;
            const int pidx = e & 63;
            bf16_t* bt = (bf16_t*)(p.ws + OFF_BBAR) + ((size_t)dg * 128 + 2 * pidx) * 16;
#pragma unroll
            for (int h = 0; h < 16; ++h) {
                const float br = p.s5_b_re[(size_t)e * 16 + h], bi = p.s5_b_im[(size_t)e * 16 + h];
                const unsigned pk = pack2(cr * br - ci * bi, cr * bi + ci * br);
                bt[h] = (bf16_t)(pk & 0xffffu); bt[16 + h] = (bf16_t)(pk >> 16);
            }
        }
        for (int e = blockIdx.x * 512 + tid; e < 64 * 16 * 128; e += G * 512) {
            const int k = e & 127, dgh = e >> 7, pp = k >> 1;
            const float v = (k & 1) ? -p.s5_c_im[(size_t)dgh * 64 + pp] : p.s5_c_re[(size_t)dgh * 64 + pp];
            CM[e] = (bf16_t)(pack2(v, 0.f) & 0xffffu);
        }
    }
}

template <bool FP8>
__device__ __forceinline__ void conv_matrices(const float* src, int nmat, int K, int N, int Npad, bf16_t* dst, bool perm, int& base, char* lds) {
    const int tid = threadIdx.x, G = vG();
    const int tk = K >> 6, tn = Npad >> 8, per = tk * tn, total = nmat * per;
    float* T = (float*)lds;
    int start = (int)(((long)blockIdx.x - (long)(base % G) + G) % G);
    f32x4 rv[8];
    auto issue = [&](int ti) {
        const int mat = ti / per, r = ti % per, kt = r / tn, nt = r % tn;
        const float* S = src + (size_t)mat * K * N + (size_t)(kt * 64) * N + nt * 256 + (tid & 63) * 4;
        const bool ok = nt * 256 + (tid & 63) * 4 < N;
#pragma unroll
        for (int i = 0; i < 8; ++i) {
            rv[i] = (f32x4){0.f, 0.f, 0.f, 0.f};
            if (ok) rv[i] = __builtin_nontemporal_load((const f32x4*)(S + (size_t)((tid >> 6) + 8 * i) * N));
        }
    };
    if (start < total) issue(start);
    for (int ti = start; ti < total; ti += G) {
        const int mat = ti / per, r = ti % per, kt = r / tn, nt = r % tn;
        bf16_t* Dm = dst + (size_t)mat * Npad * K;
        const int k0 = kt * 64, n0 = nt * 256;
        __syncthreads();
#pragma unroll
        for (int i = 0; i < 8; ++i) *(f32x4*)(T + ((tid >> 6) + 8 * i) * 260 + (tid & 63) * 4) = rv[i];
        __syncthreads();
        if (ti + G < total) issue(ti + G);
        const int n = tid >> 1, kh = tid & 1;
        int drow = n0 + n;
        if (perm) { const int up = drow >> 10, jj = drow & 1023; drow = ((jj >> 4) << 5) + (up << 4) + (jj & 15); }
        if constexpr (FP8) {
            unsigned pk[8];
#pragma unroll
            for (int j = 0; j < 8; ++j) pk[j] = pack4_fp8(64.f * T[(kh * 32 + 4 * j) * 260 + n], 64.f * T[(kh * 32 + 4 * j + 1) * 260 + n], 64.f * T[(kh * 32 + 4 * j + 2) * 260 + n], 64.f * T[(kh * 32 + 4 * j + 3) * 260 + n]);
            uint4* dp = (uint4*)((char*)dst + (size_t)mat * Npad * K + (size_t)drow * K + k0 + kh * 32);
            dp[0] = make_uint4(pk[0], pk[1], pk[2], pk[3]); dp[1] = make_uint4(pk[4], pk[5], pk[6], pk[7]);
        } else {
            unsigned pk[16];
#pragma unroll
            for (int j = 0; j < 16; ++j) pk[j] = pack2(T[(kh * 32 + 2 * j) * 260 + n], T[(kh * 32 + 2 * j + 1) * 260 + n]);
            uint4* dp = (uint4*)(Dm + (size_t)drow * K + k0 + kh * 32);
            dp[0] = make_uint4(pk[0], pk[1], pk[2], pk[3]); dp[1] = make_uint4(pk[4], pk[5], pk[6], pk[7]);
            dp[2] = make_uint4(pk[8], pk[9], pk[10], pk[11]); dp[3] = make_uint4(pk[12], pk[13], pk[14], pk[15]);
        }
    }
    base += total;
}
__device__ __forceinline__ void phase_prologue1(const Params& p, char* lds) {
    const int tid = threadIdx.x, G = vG();
    int base = 0;
    conv_matrices<false>(p.rec_w_in, 1, 1024, 2080, 2304, (bf16_t*)(p.ws + OFF_WRI), false, base, lds);
    conv_matrices<false>(p.rec_w_out, 1, 1024, 1024, 1024, (bf16_t*)(p.ws + OFF_WRO), false, base, lds);
    conv_matrices<false>(p.s5_glu_w, 1, 512, 512, 512, (bf16_t*)(p.ws + OFF_WGLU), false, base, lds);
    conv_matrices<false>(p.mla_w_down, 1, 1024, 704, DNW, (bf16_t*)(p.ws + OFF_WDN), false, base, lds);
    conv_matrices<false>(p.mla_w_uq, 1, 384, 1536, 1536, (bf16_t*)(p.ws + OFF_WUQ), false, base, lds);
    conv_matrices<false>(p.mla_w_ukv, 1, 256, 2048, 2048, (bf16_t*)(p.ws + OFF_WUKV), false, base, lds);
    conv_matrices<false>(p.mla_w_o, 1, 1024, 1024, 1024, (bf16_t*)(p.ws + OFF_WO), false, base, lds);
}

constexpr int CV_TILES_IN = 32 * 16 * 8, CV_TILES_OUT = 32 * 16 * 4, CV_TILES_SET = CV_TILES_IN + CV_TILES_OUT;
constexpr size_t OFF_ZERO64 = OFF_CNT + 2048;
constexpr size_t OFF_TICKET = OFF_CNT + 1024;
constexpr int N_COMPUTE = 208;
struct CvTile { const float* S; char* dst; int N, k0, drow, f8; };
__device__ __forceinline__ CvTile cv_decode(const Params& p, int tg) {
    const int tid = threadIdx.x, set = tg / CV_TILES_SET, t = tg % CV_TILES_SET;
    const bool is_in = t < CV_TILES_IN; const int tt = is_in ? t : t - CV_TILES_IN;
    const int N = is_in ? 2048 : 1024, tn = N >> 8, per = 16 * tn;
    const int mat = set * NE + tt / per, r = tt % per, kt = r / tn, nt = r % tn, k0 = kt * 64, n0 = nt * 256;
    CvTile c; c.N = N; c.k0 = k0;
    c.S = (is_in ? p.exp_w_in : p.exp_w_out) + (size_t)mat * 1024 * N + (size_t)k0 * N + n0 + (tid & 63) * 4;
    int drow = n0 + (tid >> 1);
    if (is_in) { const int up = drow >> 10, jj = drow & 1023; drow = ((jj >> 4) << 5) + (up << 4) + (jj & 15); }
    c.drow = drow; c.f8 = is_in ? (FP8_G1 != 0) : (FP8_G2 != 0);
    c.dst = p.ws + (is_in ? OFF_EWI : OFF_EWO) + (size_t)mat * N * 1024 * (c.f8 ? 1 : 2);
    return c;
}
__device__ __forceinline__ void cv_load(const CvTile& c, f32x4 (&rv)[8]) {
#pragma unroll
    for (int i = 0; i < 8; ++i) rv[i] = __builtin_nontemporal_load((const f32x4*)(c.S + (size_t)((threadIdx.x >> 6) + 8 * i) * c.N));
}
__device__ __forceinline__ void cv_to_lds(const f32x4 (&rv)[8], float* T) {
#pragma unroll
    for (int i = 0; i < 8; ++i) *(f32x4*)(T + ((threadIdx.x >> 6) + 8 * i) * 260 + (threadIdx.x & 63) * 4) = rv[i];
}
__device__ __forceinline__ void cv_store(const CvTile& c, const float* T) {
    const int n = threadIdx.x >> 1, kh = threadIdx.x & 1;
    if (c.f8) {
        unsigned pk[8];
#pragma unroll
        for (int j = 0; j < 8; ++j) pk[j] = pack4_fp8(64.f * T[(kh * 32 + 4 * j) * 260 + n], 64.f * T[(kh * 32 + 4 * j + 1) * 260 + n], 64.f * T[(kh * 32 + 4 * j + 2) * 260 + n], 64.f * T[(kh * 32 + 4 * j + 3) * 260 + n]);
        uint4* dp = (uint4*)(c.dst + (size_t)c.drow * 1024 + c.k0 + kh * 32);
        dp[0] = make_uint4(pk[0], pk[1], pk[2], pk[3]); dp[1] = make_uint4(pk[4], pk[5], pk[6], pk[7]);
    } else {
        unsigned pk[16];
#pragma unroll
        for (int j = 0; j < 16; ++j) pk[j] = pack2(T[(kh * 32 + 2 * j) * 260 + n], T[(kh * 32 + 2 * j + 1) * 260 + n]);
        uint4* dp = (uint4*)(c.dst + ((size_t)c.drow * 1024 + c.k0 + kh * 32) * 2);
        dp[0] = make_uint4(pk[0], pk[1], pk[2], pk[3]); dp[1] = make_uint4(pk[4], pk[5], pk[6], pk[7]);
        dp[2] = make_uint4(pk[8], pk[9], pk[10], pk[11]); dp[3] = make_uint4(pk[12], pk[13], pk[14], pk[15]);
    }
}
__device__ __forceinline__ void convert_static(const Params& p, int base, int c, int stride, int count, int hi, char* lds) {
    float* T = (float*)lds;
    __syncthreads();
    int t = base + c;
    if (count <= 0 || t >= hi) return;
    f32x4 rv[8];
    CvTile cur = cv_decode(p, t);
    cv_load(cur, rv);
    for (int i = 0; i < count; ++i) {
        const int tn = t + stride;
        const bool more = (i + 1 < count) && (tn < hi);
        cv_to_lds(rv, T);
        __syncthreads();
        CvTile nxt = cur;
        if (more) { nxt = cv_decode(p, tn); cv_load(nxt, rv); }
        cv_store(cur, T);
        if (!more) break;
        cur = nxt; t = tn;
        __syncthreads();
    }
}
constexpr int CV3_NC = 204, CV3_Q = 26, CV7_NC = 136, CV7_Q = 4, CV8_NC = 136, CV8_Q = 18, CV13_NC = 204, CV13_Q = 8, CV15_NC = 192, CV15_Q = 14;
constexpr int CV_B3 = 0, CV_B7 = CV_B3 + (256 - CV3_NC) * CV3_Q, CV_B8 = CV_B7 + (256 - CV7_NC) * CV7_Q, CV_B9 = CV_B8 + (256 - CV8_NC) * CV8_Q;
constexpr int CV_B13 = CV_TILES_SET, CV_B15 = CV_B13 + (256 - CV13_NC) * CV13_Q, CV_B17 = CV_B15 + (256 - CV15_NC) * CV15_Q;
static_assert(CV_B9 <= CV_TILES_SET && CV_B17 <= 2 * CV_TILES_SET, "conversion quotas exceed the tile sets");

__device__ __forceinline__ void load_row(const float* rp, int lane, float4 (&v)[4]) {
#pragma unroll
    for (int j = 0; j < 4; ++j) v[j] = *(const float4*)(rp + 4 * lane + 256 * j);
}
__device__ __forceinline__ float row_rstd(const float4 (&v)[4]) {
    float ss = 0.f;
#pragma unroll
    for (int j = 0; j < 4; ++j) ss += v[j].x * v[j].x + v[j].y * v[j].y + v[j].z * v[j].z + v[j].w * v[j].w;
    ss = wave_sum(ss);
    return rsqrtf(ss * (1.0f / 1024.0f) + EPS);
}
__device__ __forceinline__ void modulate_store(const float4 (&v)[4], float rstd, const float* g, const float* shift, const float* scale,
                                               bf16_t* dst, int lane, float4 (&o)[4]) {
#pragma unroll
    for (int j = 0; j < 4; ++j) {
        const int col = 4 * lane + 256 * j;
        const float4 gg = *(const float4*)(g + col), sh = *(const float4*)(shift + col), sc = *(const float4*)(scale + col);
        o[j].x = v[j].x * rstd * gg.x * (1.0f + sc.x) + sh.x; o[j].y = v[j].y * rstd * gg.y * (1.0f + sc.y) + sh.y;
        o[j].z = v[j].z * rstd * gg.z * (1.0f + sc.z) + sh.z; o[j].w = v[j].w * rstd * gg.w * (1.0f + sc.w) + sh.w;
        *(uint2*)(dst + col) = make_uint2(pack2(o[j].x, o[j].y), pack2(o[j].z, o[j].w));
    }
}
__device__ __forceinline__ const float* input_row(const Params& p, int r) { const int b = r / SB, s = r % SB; return (s < CTXL) ? p.ctx + ((size_t)b * CTXL + s) * D : p.x + ((size_t)b * SEQ + (s - CTXL)) * D; }
__device__ __forceinline__ int row_modv(int r) { const int b = r / SB, s = r % SB; return (s < CTXL) ? 4 : b; }

__device__ __forceinline__ void phase_prenorm(const Params& p, int L) {
    const int lane = threadIdx.x & 63, gw = blockIdx.x * 8 + (threadIdx.x >> 6), GW = vG() * 8;
    const float* xs = (const float*)(p.ws + OFF_XS); bf16_t* HB = (bf16_t*)(p.ws + OFF_HB);
    const float* MF = (const float*)(p.ws + OFF_MF);
    for (int r = gw; r < NT; r += GW) {
        float4 v[4], o[4]; load_row(L == 0 ? input_row(p, r) : xs + (size_t)r * D, lane, v);
        const float rstd = row_rstd(v);
        const float* mv = MF + (size_t)(L * 5 + row_modv(r)) * 6144;
        modulate_store(v, rstd, p.norm_mix_pre + L * D, mv, mv + 1024, HB + (size_t)r * D, lane, o);
    }
}

struct EpiBf16 {
    bf16_t* O; int ld; int row0, col0;
    __device__ __forceinline__ void operator()(const f32x4 (&acc)[4][4], int wm, int wn, int lane) const {
#pragma unroll
        for (int m = 0; m < 4; ++m) {
            bf16_t* rp = O + (size_t)(row0 + wm * 64 + m * 16 + (lane & 15)) * ld + col0 + wn * 64 + 4 * (lane >> 4);
#pragma unroll
            for (int n = 0; n < 4; ++n) *(uint2*)(rp + n * 16) = make_uint2(pack2(acc[m][n][0], acc[m][n][1]), pack2(acc[m][n][2], acc[m][n][3]));
        }
    }
};
struct EpiF32 {
    float* O; int ld; int row0, col0;
    __device__ __forceinline__ void operator()(const f32x4 (&acc)[4][4], int wm, int wn, int lane) const {
#pragma unroll
        for (int m = 0; m < 4; ++m) {
            float* rp = O + (size_t)(row0 + wm * 64 + m * 16 + (lane & 15)) * ld + col0 + wn * 64 + 4 * (lane >> 4);
#pragma unroll
            for (int n = 0; n < 4; ++n) *(f32x4*)(rp + n * 16) = acc[m][n];
        }
    }
};
struct EpiGlu {
    bf16_t* MIX; const bf16_t* Y; const float* bias; int row0, col0;
    __device__ __forceinline__ void operator()(const f32x4 (&acc)[4][4], int wm, int wn, int lane) const {
#pragma unroll
        for (int m = 0; m < 4; ++m) {
            const int row = row0 + wm * 64 + m * 16 + (lane & 15);
#pragma unroll
            for (int n = 0; n < 4; ++n) {
                const int col = col0 + wn * 64 + n * 16 + 4 * (lane >> 4);
                const uint2 yv = *(const uint2*)(Y + (size_t)row * 512 + col);
                const f32x4 bb = *(const f32x4*)(bias + col);
                const float y0 = lo_bf(yv.x), y1 = hi_bf(yv.x), y2 = lo_bf(yv.y), y3 = hi_bf(yv.y);
                const float o0 = y0 * sigmoidf_(acc[m][n][0] + bb[0]), o1 = y1 * sigmoidf_(acc[m][n][1] + bb[1]);
                const float o2 = y2 * sigmoidf_(acc[m][n][2] + bb[2]), o3 = y3 * sigmoidf_(acc[m][n][3] + bb[3]);
                *(uint2*)(MIX + (size_t)row * D + 512 + col) = make_uint2(pack2(o0, o1), pack2(o2, o3));
            }
        }
    }
};
struct EpiMoe1 {
    bf16_t* ACT; const float* bin; int prow0, tn;
    __device__ __forceinline__ void operator()(const f32x4 (&acc)[4][4], int wm, int wn, int lane) const {
#pragma unroll
        for (int m = 0; m < 4; ++m) {
            const int row = prow0 + wm * 64 + m * 16 + (lane & 15);
#pragma unroll
            for (int h = 0; h < 2; ++h) {
                const int j0 = 64 * tn + 32 * wn + 16 * h + 4 * (lane >> 4);
                const f32x4 bg = *(const f32x4*)(bin + j0), bu = *(const f32x4*)(bin + 1024 + j0);
                float o[4];
#pragma unroll
                for (int q = 0; q < 4; ++q) {
                    float gt = acc[m][2 * h][q] + bg[q], up = acc[m][2 * h + 1][q] + bu[q];
                    gt = fminf(gt, 7.0f); up = fminf(fmaxf(up, -7.0f), 7.0f);
                    o[q] = (up + 1.0f) * gt * sigmoidf_(1.702f * gt);
                }
                *(uint2*)(ACT + (size_t)row * D + j0) = make_uint2(pack2(o[0], o[1]), pack2(o[2], o[3]));
            }
        }
    }
};
struct EpiBf16Bias {
    bf16_t* O; const float* bias; int row0, col0;
    __device__ __forceinline__ void operator()(const f32x4 (&acc)[4][4], int wm, int wn, int lane) const {
#pragma unroll
        for (int m = 0; m < 4; ++m) {
            bf16_t* rp = O + (size_t)(row0 + wm * 64 + m * 16 + (lane & 15)) * D;
#pragma unroll
            for (int n = 0; n < 4; ++n) {
                const int col = col0 + wn * 64 + n * 16 + 4 * (lane >> 4);
                const f32x4 bb = *(const f32x4*)(bias + col);
                *(uint2*)(rp + col) = make_uint2(pack2(acc[m][n][0] + bb[0], acc[m][n][1] + bb[1]), pack2(acc[m][n][2] + bb[2], acc[m][n][3] + bb[3]));
            }
        }
    }
};

__device__ __forceinline__ void phase_gemm_recin(const Params& p, char* lds) {
    const bf16_t* A = (const bf16_t*)(p.ws + OFF_HB); const bf16_t* Bt = (const bf16_t*)(p.ws + OFF_WRI); bf16_t* O = (bf16_t*)(p.ws + OFF_PB);
    const int nN = PW / 128, nunits = (NT / 256) * nN;
    for (int u = blockIdx.x; u < nunits; u += vG()) {
        const int mt = u / nN, tn = u % nN;
        EpiBf16 epi{O, PW, mt * 256, tn * 128};
        gemm_dense<true>(A, D, mt * 256, Bt, D, tn * 128, D, lds, epi);
    }
}
__device__ __forceinline__ void phase_gemm_glu(const Params& p, char* lds) {
    const bf16_t* A = (const bf16_t*)(p.ws + OFF_Y); const bf16_t* Bt = (const bf16_t*)(p.ws + OFF_WGLU);
    const int nunits = (NT / 256) * 4;
    for (int u = blockIdx.x; u < nunits; u += vG()) {
        const int mt = u >> 2, tn = u & 3;
        EpiGlu epi{(bf16_t*)(p.ws + OFF_MIX), A, p.s5_glu_b, mt * 256, tn * 128};
        gemm_dense<true>(A, 512, mt * 256, Bt, 512, tn * 128, 512, lds, epi);
    }
}
__device__ __forceinline__ void phase_gemm_out(const Params& p, size_t offA, size_t offW, bool xonly, char* lds) {
    const bf16_t* A = (const bf16_t*)(p.ws + offA); const bf16_t* Bt = (const bf16_t*)(p.ws + offW); float* O = (float*)(p.ws + OFF_YX);
    const int nmt = xonly ? 64 : 68, nunits = nmt * 8;
    for (int u = blockIdx.x; u < nunits; u += vG()) {
        const int mi = u >> 3, tn = u & 7;
        const int row0 = xonly ? ((mi >> 4) * SB + ((mi & 15) + 1) * 256) : mi * 256;
        EpiF32 epi{O, D, row0, tn * 128};
        gemm_dense<true>(A, D, row0, Bt, D, tn * 128, D, lds, epi);
    }
}

__device__ __forceinline__ void phase_postmix(const Params& p, int L, bool xonly, char* lds) {
    const int tid = fresh_tid(), lane = tid & 63, gw = blockIdx.x * 8 + (tid >> 6), GW = vG() * 8;
    float* rwT = (float*)lds;
    const float* rw = p.router_w + (size_t)L * D * NE;
    for (int e = tid; e < D * NE; e += 512) rwT[(e & 31) * 1024 + (e >> 5)] = rw[e];
    __syncthreads();
    float* __restrict__ xs = (float*)(p.ws + OFF_XS); bf16_t* __restrict__ HB = (bf16_t*)(p.ws + OFF_HB);
    const float* __restrict__ MF = (const float*)(p.ws + OFF_MF);
    int* CNT = (int*)(p.ws + OFF_CNT) + L * NE; int* __restrict__ LIST = (int*)(p.ws + OFF_LIST);
    int* SE = (int*)(p.ws + OFF_SE); int* SP = (int*)(p.ws + OFF_SP); float* GT = (float*)(p.ws + OFF_GT);
    const float* gpost = p.norm_mix_post + L * D; const float* gpre = p.norm_ffn_pre + L * D;
    const float rbias = p.router_b[L * NE + ((lane >> 1) & 31)];
    const int nrows = xonly ? NB * SEQ : NT;
#pragma unroll 1
    for (int ri = gw; ri < nrows; ri += GW) {
        const int r = xonly ? ((ri >> 12) * SB + CTXL + (ri & 4095)) : ri;
        const float* mv = MF + (size_t)(L * 5 + row_modv(r)) * 6144;
        float4 y[4], xv[4], f[4];
        {
            const bf16_t* yp = (const bf16_t*)(p.ws + OFF_YX) + (size_t)r * D;
#pragma unroll
            for (int j = 0; j < 4; ++j) { const uint2 t = *(const uint2*)(yp + 4 * lane + 256 * j); y[j] = make_float4(lo_bf(t.x), hi_bf(t.x), lo_bf(t.y), hi_bf(t.y)); }
        }
        load_row(L == 0 ? input_row(p, r) : xs + (size_t)r * D, lane, xv);
        const float rs1 = row_rstd(y);
#pragma unroll
        for (int j = 0; j < 4; ++j) {
            const int col = 4 * lane + 256 * j;
            const float4 gg = *(const float4*)(gpost + col), g2 = *(const float4*)(mv + 2048 + col);
            xv[j].x += g2.x * (y[j].x * rs1 * gg.x); xv[j].y += g2.y * (y[j].y * rs1 * gg.y);
            xv[j].z += g2.z * (y[j].z * rs1 * gg.z); xv[j].w += g2.w * (y[j].w * rs1 * gg.w);
            *(float4*)(xs + (size_t)r * D + col) = xv[j];
        }
        const float rs2 = row_rstd(xv);
        modulate_store(xv, rs2, gpre, mv + 3 * 1024, mv + 4 * 1024, HB + (size_t)r * D, lane, f);
        if (FP8_G1) {
#pragma unroll
            for (int j = 0; j < 4; ++j) *(unsigned*)(p.ws + OFF_HB8 + (size_t)r * D + 4 * lane + 256 * j) = pack4_fp8(f[j].x, f[j].y, f[j].z, f[j].w);
        }
        float pl[32];
#pragma unroll
        for (int e = 0; e < NE; ++e) {
            float s = 0.f;
#pragma unroll
            for (int j = 0; j < 4; ++j) {
                const float4 wv = *(const float4*)(rwT + e * 1024 + 4 * lane + 256 * j);
                s += f[j].x * wv.x + f[j].y * wv.y + f[j].z * wv.z + f[j].w * wv.w;
            }
            pl[e] = s;
            asm volatile("" ::: "memory");
        }
#pragma unroll
        for (int i = 0; i < 16; ++i) { const bool up = (lane & 32) != 0; const float snd = up ? pl[i] : pl[i + 16], kp = up ? pl[i + 16] : pl[i]; pl[i] = kp + __shfl_xor(snd, 32); }
#pragma unroll
        for (int i = 0; i < 8; ++i) { const bool up = (lane & 16) != 0; const float snd = up ? pl[i] : pl[i + 8], kp = up ? pl[i + 8] : pl[i]; pl[i] = kp + __shfl_xor(snd, 16); }
#pragma unroll
        for (int i = 0; i < 4; ++i) { const bool up = (lane & 8) != 0; const float snd = up ? pl[i] : pl[i + 4], kp = up ? pl[i + 4] : pl[i]; pl[i] = kp + __shfl_xor(snd, 8); }
#pragma unroll
        for (int i = 0; i < 2; ++i) { const bool up = (lane & 4) != 0; const float snd = up ? pl[i] : pl[i + 2], kp = up ? pl[i + 2] : pl[i]; pl[i] = kp + __shfl_xor(snd, 4); }
        { const bool up = (lane & 2) != 0; const float snd = up ? pl[0] : pl[1], kp = up ? pl[1] : pl[0]; pl[0] = kp + __shfl_xor(snd, 2); }
        const int myexp = (lane >> 1) & 31;
        float mylogit = pl[0] + __shfl_xor(pl[0], 1) + rbias;
        float tv[4]; int tix[4];
#pragma unroll
        for (int k = 0; k < 4; ++k) {
            float v = mylogit; int idx = myexp;
#pragma unroll
            for (int o = 32; o >= 2; o >>= 1) {
                const float ov = __shfl_xor(v, o); const int oi = __shfl_xor(idx, o);
                if (ov > v || (ov == v && oi < idx)) { v = ov; idx = oi; }
            }
            tv[k] = v; tix[k] = idx;
            if (myexp == idx) mylogit = -3.0e38f;
        }
        const float e1 = __expf(tv[1] - tv[0]), e2 = __expf(tv[2] - tv[0]), e3 = __expf(tv[3] - tv[0]);
        const float inv = 1.0f / (1.0f + e1 + e2 + e3);
        if (lane < 4) {
            const int ex = lane == 0 ? tix[0] : lane == 1 ? tix[1] : lane == 2 ? tix[2] : tix[3];
            const float gtv = (lane == 0 ? 1.0f : lane == 1 ? e1 : lane == 2 ? e2 : e3) * inv;
            const int pos = atomicAdd(&CNT[ex], 1);
            LIST[(size_t)ex * NT + pos] = r;
            SE[r * 4 + lane] = ex; SP[r * 4 + lane] = pos; GT[r * 4 + lane] = gtv;
        }
    }
}

__device__ __forceinline__ void moe_prefix(const Params& p, int L, int* tp) {
    if (threadIdx.x < 64) {
        const int lane = threadIdx.x;
        unsigned* CNT = (unsigned*)(p.ws + OFF_CNT) + L * NE;
        const int c = (lane < NE) ? (int)xb_ld(&CNT[lane]) : 0;
        int t = (c + 255) >> 8;
#pragma unroll
        for (int o = 1; o < 32; o <<= 1) { const int v = __shfl_up(t, o); if (lane >= o) t += v; }
        if (lane < NE) { tp[33 + lane] = c; tp[lane + 1] = t; }
        if (lane == 0) tp[0] = 0;
    }
    __syncthreads();
}
__device__ __forceinline__ void phase_moe1(const Params& p, int L, char* lds) {
    int* tp = (int*)(lds + 2 * G_STAGE);
    moe_prefix(p, L, tp);
    const int tid = threadIdx.x, srow = tid >> 3, sch = (tid & 7) * 8;
    const bf16_t* HB = (const bf16_t*)(p.ws + OFF_HB); const int* LIST = (const int*)(p.ws + OFF_LIST);
    const int nunits = tp[32] * 16;
    for (int u = blockIdx.x; u < nunits; u += vG()) {
        const int mtg = u >> 4, tn = u & 15;
        int e = 0; while (tp[e + 1] <= mtg) ++e;
        const int mt = mtg - tp[e], cnt = tp[33 + e];
        const int* le = LIST + (size_t)e * NT;
        const bf16_t* ap[4];
#pragma unroll
        for (int j = 0; j < 4; ++j) { const int pos = mt * 256 + srow + 64 * j; const int tok = le[pos < cnt ? pos : 0]; ap[j] = HB + (size_t)tok * D + sch; }
        const bf16_t* b = (const bf16_t*)(p.ws + OFF_EWI) + ((size_t)(L * NE + e) * 2048 + tn * 128 + srow) * D + sch;
        EpiMoe1 epi{(bf16_t*)(p.ws + OFF_ACT), p.exp_b_in + (size_t)(L * NE + e) * 2048, mtg * 256, tn};
        gemm_tile<true>(ap[0], ap[1], ap[2], ap[3], b, b + (size_t)64 * D, D, lds, epi);
    }
}
__device__ __forceinline__ void phase_moe2(const Params& p, int L, char* lds) {
    int* tp = (int*)(lds + 2 * G_STAGE);
    moe_prefix(p, L, tp);
    const int nunits = tp[32] * 8;
    for (int u = blockIdx.x; u < nunits; u += vG()) {
        const int mtg = u >> 3, tn = u & 7;
        int e = 0; while (tp[e + 1] <= mtg) ++e;
        EpiBf16Bias epi{(bf16_t*)(p.ws + OFF_YR), p.exp_b_out + (size_t)(L * NE + e) * D, mtg * 256, tn * 128};
        gemm_dense<true>((const bf16_t*)(p.ws + OFF_ACT), D, mtg * 256, (const bf16_t*)(p.ws + OFF_EWO) + (size_t)(L * NE + e) * D * D, D, tn * 128, D, lds, epi);
    }
}
constexpr int G8_TAB = g8::STAGE_BYTES, G8_TP = g8::STAGE_BYTES + 16384;
constexpr int G8_NSLOT = 16;
template <bool GATHER>
struct SchedMoe8 {
    static constexpr bool AFFINE = !GATHER;
    const int* tp; const unsigned* tab; const int* list; const char* Bbase; size_t bexp; int ntn_sh, rowB, x, j, bpx; int tx1, tx2, tx3, tx4;
    __device__ __forceinline__ void init(const int* tp_, const unsigned* tab_, const int* list_, const char* Bbase_, size_t bexp_, int ntn_sh_, int rowB_) {
        tp = tp_; tab = tab_; list = list_; Bbase = Bbase_; bexp = bexp_; ntn_sh = ntn_sh_; rowB = rowB_;
        const int cblk = g8::xcd_major_block(); bpx = vG() >> 3; x = cblk / bpx; j = cblk % bpx;
        tx1 = tp[x + 1] - tp[x]; tx2 = tx1 + tp[x + 9] - tp[x + 8]; tx3 = tx2 + tp[x + 17] - tp[x + 16]; tx4 = tx3 + tp[x + 25] - tp[x + 24];
    }
    __device__ __forceinline__ bool next(int i, g8::Unit& u) const {
        const int l = i * bpx + j, tl = l >> ntn_sh, tn = l & ((1 << ntn_sh) - 1);
        if (tl >= tx4) return false;
        const int k = (tl >= tx1) + (tl >= tx2) + (tl >= tx3), e = x + 8 * k;
        const int mt = tl - (k == 0 ? 0 : k == 1 ? tx1 : k == 2 ? tx2 : tx3);
        u.B = Bbase + (size_t)e * bexp + (size_t)tn * 256 * rowB; u.row0 = (tp[e] + mt) * 256; u.tn = tn; u.e = e; u.slot = i; return true;
    }
    __device__ __forceinline__ void aoff(const g8::Unit& u, const int (&R)[2], const int (&C)[2], unsigned (&o)[2][2]) const {
#pragma unroll
        for (int h = 0; h < 2; ++h)
#pragma unroll
            for (int i = 0; i < 2; ++i) {
                if (GATHER) {
                    unsigned ro;
                    if (u.slot < G8_NSLOT) ro = tab[u.slot * 256 + h * 128 + R[i]];
                    else { const int pos = u.row0 - tp[u.e] * 256 + h * 128 + R[i]; ro = (unsigned)list[(size_t)u.e * NT + (pos < tp[33 + u.e] ? pos : 0)] * (unsigned)rowB; }
                    o[h][i] = ro + (unsigned)C[i] * 2u;
                } else o[h][i] = (unsigned)((u.row0 + h * 128 + R[i]) * rowB + C[i] * 2);
            }
    }
};
struct SchedDense8 {
    static constexpr bool AFFINE = true;
    const char* Bbase; int nunits, ntn, rowB, G, cblk;
    __device__ __forceinline__ bool next(int i, g8::Unit& u) const {
        const int L = i * G + cblk; if (L >= nunits) return false;
        const int mt = L / ntn, tn = L % ntn;
        u.B = Bbase + (size_t)tn * 256 * rowB; u.row0 = mt * 256; u.tn = tn; u.e = 0; u.slot = i; return true;
    }
    __device__ __forceinline__ void aoff(const g8::Unit& u, const int (&R)[2], const int (&C)[2], unsigned (&o)[2][2]) const {
#pragma unroll
        for (int h = 0; h < 2; ++h)
#pragma unroll
            for (int i = 0; i < 2; ++i) o[h][i] = (unsigned)((u.row0 + h * 128 + R[i]) * rowB + C[i] * 2);
    }
};
template <bool OUT8>
struct EpiMoe1_8 {
    bf16_t* ACT; const float* bin_all; float sc;
    __device__ __forceinline__ void operator()(const f32x4 (&acc)[2][2][4][2], const g8::Unit& u, int wr, int wc, int fr, int fq) const {
        const float* bin = bin_all + (size_t)u.e * 2048;
#pragma unroll
        for (int bj = 0; bj < 2; ++bj) {
            const int j0 = 128 * u.tn + 64 * bj + 16 * wc + 4 * fq;
            const f32x4 bg = *(const f32x4*)(bin + j0), bu1 = *(const f32x4*)(bin + 1024 + j0) + 1.0f;
#pragma unroll
            for (int ai = 0; ai < 2; ++ai)
#pragma unroll
                for (int m = 0; m < 4; ++m) {
                    const int row = u.row0 + 128 * ai + 64 * wr + 16 * m + fr;
                    const f32x4 gv = acc[ai][bj][m][0] * sc + bg, uv = acc[ai][bj][m][1] * sc + bu1;
                    f32x4 gm, um, ex, rc;
#pragma unroll
                    for (int q = 0; q < 4; ++q) { gm[q] = fminf(gv[q], 7.0f); um[q] = __builtin_amdgcn_fmed3f(uv[q], -6.0f, 8.0f); }
                    const f32x4 ea = gm * (-1.702f * 1.4426950408889634f);
#pragma unroll
                    for (int q = 0; q < 4; ++q) ex[q] = __builtin_amdgcn_exp2f(ea[q]);
                    const f32x4 den = ex + 1.0f;
#pragma unroll
                    for (int q = 0; q < 4; ++q) rc[q] = __builtin_amdgcn_rcpf(den[q]);
                    const f32x4 ov = um * (gm * rc);
                    const float o[4] = {ov[0], ov[1], ov[2], ov[3]};
                    if constexpr (OUT8) *(unsigned*)((char*)ACT + (size_t)row * D + j0) = pack4_fp8(o[0], o[1], o[2], o[3]);
                    else *(uint2*)(ACT + (size_t)row * D + j0) = make_uint2(pack2(o[0], o[1]), pack2(o[2], o[3]));
                }
        }
    }
};
struct EpiBias8 {
    bf16_t* O; const float* bias_all; float sc;
    __device__ __forceinline__ void operator()(const f32x4 (&acc)[2][2][4][2], const g8::Unit& u, int wr, int wc, int fr, int fq) const {
        const float* bias = bias_all + (size_t)u.e * D;
#pragma unroll
        for (int bj = 0; bj < 2; ++bj)
#pragma unroll
            for (int n = 0; n < 2; ++n) {
                const int col = 256 * u.tn + 128 * bj + 32 * wc + 16 * n + 4 * fq;
                const f32x4 bb = *(const f32x4*)(bias + col);
#pragma unroll
                for (int ai = 0; ai < 2; ++ai)
#pragma unroll
                    for (int m = 0; m < 4; ++m) {
                        const int row = u.row0 + 128 * ai + 64 * wr + 16 * m + fr;
                        const f32x4 v = acc[ai][bj][m][n] * sc + bb;
                        *(uint2*)(O + (size_t)row * D + col) = make_uint2(pack2(v[0], v[1]), pack2(v[2], v[3]));
                    }
            }
    }
};
struct EpiBf16_8 {
    bf16_t* O; int ld, ncols;
    __device__ __forceinline__ void operator()(const f32x4 (&acc)[2][2][4][2], const g8::Unit& u, int wr, int wc, int fr, int fq) const {
#pragma unroll
        for (int bj = 0; bj < 2; ++bj)
#pragma unroll
            for (int n = 0; n < 2; ++n) {
                const int col = 256 * u.tn + 128 * bj + 32 * wc + 16 * n + 4 * fq;
                if (col < ncols) {
#pragma unroll
                    for (int ai = 0; ai < 2; ++ai)
#pragma unroll
                        for (int m = 0; m < 4; ++m) {
                            const int row = u.row0 + 128 * ai + 64 * wr + 16 * m + fr;
                            *(uint2*)(O + (size_t)row * ld + col) = make_uint2(pack2(acc[ai][bj][m][n][0], acc[ai][bj][m][n][1]), pack2(acc[ai][bj][m][n][2], acc[ai][bj][m][n][3]));
                        }
                }
            }
    }
};
__device__ __forceinline__ void phase_gemm_recin8(const Params& p, char* lds) {
    SchedDense8 S{p.ws + OFF_WRI, 68 * 9, 9, 2 * D, vG(), g8::xcd_major_block()};
    EpiBf16_8 E{(bf16_t*)(p.ws + OFF_PB), PW, PW};
    g8::gemm8<false>((LAS unsigned char*)lds, p.ws + OFF_HB, 2 * D, S, E);
}
__device__ __forceinline__ void phase_moe1_8(const Params& p, int L, char* lds) {
    int* tp = (int*)(lds + G8_TP); unsigned* tab = (unsigned*)(lds + G8_TAB);
    moe_prefix(p, L, tp);
    const int tid = threadIdx.x;
    const int* LIST = (const int*)(p.ws + OFF_LIST);
    constexpr int EB = FP8_G1 ? 1 : 2;
    SchedMoe8<true> S; S.init(tp, tab, LIST, p.ws + OFF_EWI + (size_t)L * NE * 2048 * D * EB, (size_t)2048 * D * EB, 3, D * EB);
    for (int slot = 0; slot < G8_NSLOT; ++slot) {
        g8::Unit u; if (!S.next(slot, u)) break;
        const int cnt = tp[33 + u.e];
        if (tid < 256) { const int pos = u.row0 - tp[u.e] * 256 + tid; tab[slot * 256 + tid] = (unsigned)LIST[(size_t)u.e * NT + (pos < cnt ? pos : 0)] * (unsigned)(D * EB); }
    }
    __syncthreads();
    EpiMoe1_8<FP8_G2 != 0> E{(bf16_t*)(p.ws + OFF_ACT), p.exp_b_in + (size_t)L * NE * 2048, FP8_G1 ? (1.0f / 64.0f) : 1.0f};
    g8::gemm8<FP8_G1 != 0>((LAS unsigned char*)lds, p.ws + (FP8_G1 ? OFF_HB8 : OFF_HB), D * EB, S, E);
}
__device__ __forceinline__ void phase_moe2_8(const Params& p, int L, char* lds) {
    int* tp = (int*)(lds + G8_TP);
    moe_prefix(p, L, tp);
    constexpr int EB = FP8_G2 ? 1 : 2;
    SchedMoe8<false> S; S.init(tp, nullptr, nullptr, p.ws + OFF_EWO + (size_t)L * NE * D * D * EB, (size_t)D * D * EB, 2, D * EB);
    EpiBias8 E{(bf16_t*)(p.ws + OFF_YR), p.exp_b_out + (size_t)L * NE * D, FP8_G2 ? (1.0f / 64.0f) : 1.0f};
    g8::gemm8<FP8_G2 != 0>((LAS unsigned char*)lds, p.ws + OFF_ACT, D * EB, S, E);
}
struct EpiF32_8 {
    float* O; int ld;
    __device__ __forceinline__ void operator()(const f32x4 (&acc)[2][2][4][2], const g8::Unit& u, int wr, int wc, int fr, int fq) const {
#pragma unroll
        for (int ai = 0; ai < 2; ++ai)
#pragma unroll
            for (int m = 0; m < 4; ++m) {
                float* rp = O + (size_t)(u.row0 + 128 * ai + 64 * wr + 16 * m + fr) * ld + 256 * u.tn + 32 * wc + 4 * fq;
#pragma unroll
                for (int bj = 0; bj < 2; ++bj)
#pragma unroll
                    for (int n = 0; n < 2; ++n) *(f32x4*)(rp + 128 * bj + 16 * n) = acc[ai][bj][m][n];
            }
    }
};
struct SchedX8 {
    static constexpr bool AFFINE = true;
    const char* Bbase; int nunits, ntn, rowB, G, cblk;
    __device__ __forceinline__ bool next(int i, g8::Unit& u) const {
        const int L = i * G + cblk; if (L >= nunits) return false;
        const int mi = L / ntn, tn = L % ntn;
        u.B = Bbase + (size_t)tn * 256 * rowB; u.row0 = (mi >> 4) * SB + ((mi & 15) + 1) * 256; u.tn = tn; u.e = 0; u.slot = i; return true;
    }
    __device__ __forceinline__ void aoff(const g8::Unit& u, const int (&R)[2], const int (&C)[2], unsigned (&o)[2][2]) const {
#pragma unroll
        for (int h = 0; h < 2; ++h)
#pragma unroll
            for (int i = 0; i < 2; ++i) o[h][i] = (unsigned)((u.row0 + h * 128 + R[i]) * rowB + C[i] * 2);
    }
};
struct EpiQ8 {
    bf16_t* QF; const float* rope;
    __device__ __forceinline__ void operator()(const f32x4 (&acc)[2][2][4][2], const g8::Unit& u, int wr, int wc, int fr, int fq) const {
        const float qs = 0.07216878364870322f * 1.4426950408889634f;
        const int sx0 = (u.row0 % SB) - CTXL + 64 * wr + fr;
        const int c0 = 256 * u.tn + 32 * wc;
        const int ta = (c0 >> 4) % 12, tb = ((c0 + 128) >> 4) % 12;
#pragma unroll
        for (int ai = 0; ai < 2; ++ai)
#pragma unroll
            for (int m = 0; m < 4; ++m) {
                const int sx = sx0 + 128 * ai + 16 * m;
                bf16_t* rp = QF + (size_t)(u.row0 + 128 * ai + 64 * wr + 16 * m + fr) * 1536 + c0 + 4 * fq;
#pragma unroll
                for (int bj = 0; bj < 2; ++bj) {
                    const int t12 = bj ? tb : ta;
                    f32x4 o0 = acc[ai][bj][m][0], o1 = acc[ai][bj][m][1];
                    if (t12 >= 8) {
                        const float* rr = rope + ((t12 == 8) ? (sx >> 6) : (sx & 63)) * 16 + 4 * fq;
                        const f32x4 cs = *(const f32x4*)rr, sn = *(const f32x4*)(rr + 1024);
                        const f32x4 t0 = o0 * cs - o1 * sn, t1 = o1 * cs + o0 * sn; o0 = t0; o1 = t1;
                    }
                    if (FP8_QK) {
                        char* r8 = (char*)QF + (size_t)(u.row0 + 128 * ai + 64 * wr + 16 * m + fr) * 1536 + c0 + 4 * fq + 128 * bj;
                        const float q16 = qs * 16.0f;
                        *(unsigned*)(r8) = pack4_fp8(o0[0] * q16, o0[1] * q16, o0[2] * q16, o0[3] * q16);
                        *(unsigned*)(r8 + 16) = pack4_fp8(o1[0] * q16, o1[1] * q16, o1[2] * q16, o1[3] * q16);
                    } else {
                        *(uint2*)(rp + 128 * bj) = make_uint2(pack2(o0[0] * qs, o0[1] * qs), pack2(o0[2] * qs, o0[3] * qs));
                        *(uint2*)(rp + 128 * bj + 16) = make_uint2(pack2(o1[0] * qs, o1[1] * qs), pack2(o1[2] * qs, o1[3] * qs));
                    }
                }
            }
    }
};
struct EpiGlu8 {
    bf16_t* MIX; const bf16_t* Y; const float* bias;
    __device__ __forceinline__ void operator()(const f32x4 (&acc)[2][2][4][2], const g8::Unit& u, int wr, int wc, int fr, int fq) const {
#pragma unroll
        for (int bj = 0; bj < 2; ++bj)
#pragma unroll
            for (int n = 0; n < 2; ++n) {
                const int col = 256 * u.tn + 128 * bj + 32 * wc + 16 * n + 4 * fq;
                const f32x4 bb = *(const f32x4*)(bias + col);
#pragma unroll
                for (int ai = 0; ai < 2; ++ai)
#pragma unroll
                    for (int m = 0; m < 4; ++m) {
                        const int row = u.row0 + 128 * ai + 64 * wr + 16 * m + fr;
                        const uint2 yv = *(const uint2*)(Y + (size_t)row * 512 + col);
                        const f32x4 a = acc[ai][bj][m][n] + bb;
                        const float o0 = lo_bf(yv.x) * sigmoidf_(a[0]), o1 = hi_bf(yv.x) * sigmoidf_(a[1]), o2 = lo_bf(yv.y) * sigmoidf_(a[2]), o3 = hi_bf(yv.y) * sigmoidf_(a[3]);
                        *(uint2*)(MIX + (size_t)row * D + 512 + col) = make_uint2(pack2(o0, o1), pack2(o2, o3));
                    }
            }
    }
};
__device__ __forceinline__ void phase_gemm_glu8(const Params& p, char* lds) {
    SchedDense8 S{p.ws + OFF_WGLU, 68 * 2, 2, 1024, vG(), g8::xcd_major_block()};
    EpiGlu8 E{(bf16_t*)(p.ws + OFF_MIX), (const bf16_t*)(p.ws + OFF_Y), p.s5_glu_b};
    g8::gemm8<false>((LAS unsigned char*)lds, p.ws + OFF_Y, 1024, S, E);
}
__device__ __forceinline__ void phase_gemm_recout8(const Params& p, char* lds) {
    SchedDense8 S{p.ws + OFF_WRO, 68 * 4, 4, 2 * D, vG(), g8::xcd_major_block()};
    EpiBf16_8 E{(bf16_t*)(p.ws + OFF_YX), D, D};
    g8::gemm8<false>((LAS unsigned char*)lds, p.ws + OFF_MIX, 2 * D, S, E);
}
__device__ __forceinline__ void phase_gemm_down8(const Params& p, char* lds) {
    SchedDense8 S{p.ws + OFF_WDN, 68 * 3, 3, 2 * D, vG(), g8::xcd_major_block()};
    EpiBf16_8 E{(bf16_t*)(p.ws + OFF_DN), DNW, DNW};
    g8::gemm8<false>((LAS unsigned char*)lds, p.ws + OFF_HB, 2 * D, S, E);
}
__device__ __forceinline__ void phase_gemm_wo8(const Params& p, char* lds) {
    SchedX8 S{p.ws + OFF_WO, 64 * 4, 4, 2 * D, vG(), g8::xcd_major_block()};
    EpiBf16_8 E{(bf16_t*)(p.ws + OFF_YX), D, D};
    g8::gemm8<false>((LAS unsigned char*)lds, p.ws + OFF_OB, 2 * D, S, E);
}
__device__ __forceinline__ void phase_gemm_q8(const Params& p, char* lds) {
    SchedX8 S{p.ws + OFF_WUQ, 64 * 6, 6, 768, vG(), g8::xcd_major_block()};
    EpiQ8 E{(bf16_t*)(p.ws + OFF_QF), (const float*)(p.ws + OFF_ROPE)};
    g8::gemm8<false>((LAS unsigned char*)lds, p.ws + OFF_CQ, 768, S, E);
}
__device__ __forceinline__ void phase_combine(const Params& p, int L, bool last, char* lds) {
    int* tp = (int*)lds;
    moe_prefix(p, L, tp);
    const int tid = fresh_tid(), lane = tid & 63, gw = blockIdx.x * 8 + (tid >> 6), GW = vG() * 8;
    float* xs = (float*)(p.ws + OFF_XS); const bf16_t* YR = (const bf16_t*)(p.ws + OFF_YR); bf16_t* HB = (bf16_t*)(p.ws + OFF_HB);
    const float* MF = (const float*)(p.ws + OFF_MF);
    const int* SE = (const int*)(p.ws + OFF_SE); const int* SP = (const int*)(p.ws + OFF_SP); const float* GT = (const float*)(p.ws + OFF_GT);
    const float* gpost = p.norm_ffn_post + L * D;
    const int nrows = last ? NB * SEQ : NT;
    auto rowof = [&](int ri) { return last ? ((ri >> 12) * SB + CTXL + (ri & 4095)) : ri; };
    int ne[4], npos[4]; float ng[4];
    uint2 nyv[4][4]; f32x4 nxv[4]; float dg[4];
    auto fetch_idx = [&](int ri) {
        const int r = rowof(ri);
#pragma unroll
        for (int k = 0; k < 4; ++k) { ne[k] = SE[r * 4 + k]; npos[k] = SP[r * 4 + k]; ng[k] = GT[r * 4 + k]; }
    };
    auto fetch_data = [&](int ri) {
        const int r = rowof(ri);
#pragma unroll
        for (int k = 0; k < 4; ++k) {
            const bf16_t* yr = YR + (size_t)(tp[ne[k]] * 256 + npos[k]) * D;
#pragma unroll
            for (int j = 0; j < 4; ++j) nyv[k][j] = *(const uint2*)(yr + 4 * lane + 256 * j);
            dg[k] = ng[k];
        }
#pragma unroll
        for (int j = 0; j < 4; ++j) nxv[j] = *(const f32x4*)(xs + (size_t)r * D + 4 * lane + 256 * j);
    };
    if (gw < nrows) { fetch_idx(gw); fetch_data(gw); }
    if (gw + GW < nrows) fetch_idx(gw + GW);
    for (int ri = gw; ri < nrows; ri += GW) {
        const int r = rowof(ri);
        const float* mv = MF + (size_t)(L * 5 + row_modv(r)) * 6144;
        float4 f[4], xv[4];
#pragma unroll
        for (int j = 0; j < 4; ++j) {
            f[j] = make_float4(0.f, 0.f, 0.f, 0.f);
#pragma unroll
            for (int k = 0; k < 4; ++k) { f[j].x += dg[k] * lo_bf(nyv[k][j].x); f[j].y += dg[k] * hi_bf(nyv[k][j].x); f[j].z += dg[k] * lo_bf(nyv[k][j].y); f[j].w += dg[k] * hi_bf(nyv[k][j].y); }
            xv[j] = make_float4(nxv[j][0], nxv[j][1], nxv[j][2], nxv[j][3]);
        }
        if (ri + GW < nrows) fetch_data(ri + GW);
        if (ri + 2 * GW < nrows) fetch_idx(ri + 2 * GW);
        __builtin_amdgcn_sched_barrier(0);
        const float rs = row_rstd(f);
#pragma unroll
        for (int j = 0; j < 4; ++j) {
            const int col = 4 * lane + 256 * j;
            const float4 gg = *(const float4*)(gpost + col), g5 = *(const float4*)(mv + 5 * 1024 + col);
            xv[j].x += g5.x * (f[j].x * rs * gg.x); xv[j].y += g5.y * (f[j].y * rs * gg.y);
            xv[j].z += g5.z * (f[j].z * rs * gg.z); xv[j].w += g5.w * (f[j].w * rs * gg.w);
            if (last) *(float4*)(p.out + (size_t)ri * D + col) = xv[j];
            else *(float4*)(xs + (size_t)r * D + col) = xv[j];
        }
        if (!last) {
            const float rs2 = row_rstd(xv);
            const float* mv1 = MF + (size_t)((L + 1) * 5 + row_modv(r)) * 6144;
            float4 o[4];
            modulate_store(xv, rs2, p.norm_mix_pre + (L + 1) * D, mv1, mv1 + 1024, HB + (size_t)r * D, lane, o);
        }
    }
}

__device__ __forceinline__ void gla_cum(const Params& p, uint2 v, int h, char* lds) {
    const int tid = threadIdx.x;
    float* Gm = (float*)lds; float* RF = (float*)(lds + 32768);
    {
        const int row = tid >> 3, c4 = (tid & 7) * 4;
        *(float4*)(RF + row * 32 + c4) = make_float4(lo_bf(v.x), hi_bf(v.x), lo_bf(v.y), hi_bf(v.y));
    }
    __syncthreads();
    const int d = tid & 63, dir = (tid >> 6) & 1, tg = tid >> 7;
    {
        float wv[16];
#pragma unroll
        for (int r = 0; r < 16; ++r) wv[r] = p.gla_gate_w[(dir * 16 + r) * 256 + h * 64 + d];
        const float bias = p.gla_gate_b[dir * 256 + h * 64 + d];
        for (int tt = 0; tt < 16; ++tt) {
            const int tok = tg * 16 + tt;
            float x = bias;
#pragma unroll
            for (int r = 0; r < 16; ++r) x += RF[tok * 32 + dir * 16 + r] * wv[r];
            const float ls = fminf(x, 0.f) - 0.6931471805599453f * __builtin_amdgcn_logf(1.0f + __builtin_amdgcn_exp2f(-1.4426950408889634f * fabsf(x)));
            Gm[(dir * 64 + tok) * 64 + d] = ls * (1.0f / 16.0f);
        }
    }
    __syncthreads();
    {
        float* gp = Gm + (dir * 64 + (dir ? 63 - tg * 16 : tg * 16)) * 64 + d;
        const int st = dir ? -64 : 64;
        float v[16];
#pragma unroll
        for (int i = 0; i < 16; ++i) v[i] = gp[i * st];
#pragma unroll
        for (int i = 1; i < 16; ++i) v[i] += v[i - 1];
        RF[(dir * 4 + tg) * 64 + d] = v[15];
        __syncthreads();
        float off = 0.f;
        for (int q = 0; q < tg; ++q) off += RF[(dir * 4 + q) * 64 + d];
#pragma unroll
        for (int i = 0; i < 16; ++i) gp[i * st] = v[i] + off;
    }
    __syncthreads();
}
__device__ __forceinline__ void gla_load_v(const Params& p, int r0, int h, uint2 (&vr)[4]) {
    const int tid = threadIdx.x;
    const bf16_t* Pb = (const bf16_t*)(p.ws + OFF_PB) + (size_t)(r0 + (tid >> 5)) * PW + COL_V + h * 128 + (tid & 31) * 4;
#pragma unroll
    for (int i = 0; i < 4; ++i) vr[i] = *(const uint2*)(Pb + (size_t)(16 * i) * PW);
}
__device__ __forceinline__ void gla_stage_vt(const uint2 (&vr)[4], char* VT) {
    const int tid = threadIdx.x, dv0 = (tid & 31) * 4;
#pragma unroll
    for (int i = 0; i < 4; ++i) {
        const int j = (tid >> 5) + 16 * i, cj = j >> 3, bo = (j & 7) * 2;
        *(bf16_t*)(VT + swz(dv0 + 0, cj, 128) + bo) = (bf16_t)(vr[i].x & 0xffffu); *(bf16_t*)(VT + swz(dv0 + 1, cj, 128) + bo) = (bf16_t)(vr[i].x >> 16);
        *(bf16_t*)(VT + swz(dv0 + 2, cj, 128) + bo) = (bf16_t)(vr[i].y & 0xffffu); *(bf16_t*)(VT + swz(dv0 + 3, cj, 128) + bo) = (bf16_t)(vr[i].y >> 16);
    }
}
__device__ __forceinline__ int dir_chunk(int dir, int c) { return dir ? (c < 4 ? 3 - c : 71 - c) : c; }

__device__ __forceinline__ void gla_local_item(const Params& p, int item, int b, int c, int h, char* lds) {
    const int tid = threadIdx.x, lane = tid & 63, w = tid >> 6, r0 = b * SB + c * 64;
    const bf16_t* Pb = (const bf16_t*)(p.ws + OFF_PB);
    const uint2 rfv = *(const uint2*)(Pb + (size_t)(r0 + (tid >> 3)) * PW + COL_RF + (tid & 7) * 4);
    const uint4 kraw = *(const uint4*)(Pb + (size_t)(r0 + (tid >> 3)) * PW + COL_K + h * 64 + (tid & 7) * 8);
    uint2 vr[4]; gla_load_v(p, r0, h, vr);
    __syncthreads();
    gla_cum(p, rfv, h, lds);
    const float* Gm = (const float*)lds;
    char* KE = lds + 40960; char* VT = lds + 57344;
    {
        float4* cg = (float4*)(p.ws + OFF_CUM) + (size_t)item * 2048;
#pragma unroll
        for (int i = 0; i < 4; ++i) cg[tid + 512 * i] = *(const float4*)(Gm + (tid + 512 * i) * 4);
    }
    {
        const int j = tid >> 3, dgp = tid & 7, cj = j >> 3, bo = (j & 7) * 2;
        const unsigned ka[4] = {kraw.x, kraw.y, kraw.z, kraw.w};
#pragma unroll
        for (int dir = 0; dir < 2; ++dir) {
#pragma unroll
            for (int e = 0; e < 4; ++e) {
                const int d0 = dgp * 8 + 2 * e;
                const float cl0 = dir ? Gm[64 * 64 + d0] : Gm[63 * 64 + d0], cl1 = dir ? Gm[64 * 64 + d0 + 1] : Gm[63 * 64 + d0 + 1];
                const unsigned pk = pack2(lo_bf(ka[e]) * __expf(cl0 - Gm[(dir * 64 + j) * 64 + d0]), hi_bf(ka[e]) * __expf(cl1 - Gm[(dir * 64 + j) * 64 + d0 + 1]));
                *(bf16_t*)(KE + dir * 8192 + swz(d0, cj, 128) + bo) = (bf16_t)(pk & 0xffffu);
                *(bf16_t*)(KE + dir * 8192 + swz(d0 + 1, cj, 128) + bo) = (bf16_t)(pk >> 16);
            }
        }
    }
    gla_stage_vt(vr, VT);
    __syncthreads();
    {
        const int dir = w >> 2, nq = w & 3;
        f32x4 acc[4][2];
#pragma unroll
        for (int m = 0; m < 4; ++m) { acc[m][0] = (f32x4){0.f, 0.f, 0.f, 0.f}; acc[m][1] = (f32x4){0.f, 0.f, 0.f, 0.f}; }
#pragma unroll
        for (int ks = 0; ks < 2; ++ks) {
            bf16x8 bfr[2];
#pragma unroll
            for (int n = 0; n < 2; ++n) bfr[n] = ldfrag(VT, 128, nq * 32 + n * 16, ks * 32, lane);
#pragma unroll
            for (int m = 0; m < 4; ++m) {
                const bf16x8 af = ldfrag(KE + dir * 8192, 128, m * 16, ks * 32, lane);
#pragma unroll
                for (int n = 0; n < 2; ++n) acc[m][n] = mfma16(bfr[n], af, acc[m][n]);
            }
        }
        const int nd = dir_chunk(dir, c);
        float* KVb = (float*)(p.ws + OFF_KV) + ((size_t)(((b * 2 + dir) * 4 + h) * NCH + nd)) * 8192;
#pragma unroll
        for (int m = 0; m < 4; ++m)
#pragma unroll
            for (int n = 0; n < 2; ++n) *(f32x4*)(KVb + (m * 16 + (lane & 15)) * 128 + nq * 32 + n * 16 + 4 * (lane >> 4)) = acc[m][n];
    }
    if (tid < 128) {
        const int dir = tid >> 6, d = tid & 63, nd = dir_chunk(dir, c);
        const float cl = dir ? Gm[(64 + 0) * 64 + d] : Gm[63 * 64 + d];
        ((float*)(p.ws + OFF_DL))[((size_t)(((b * 2 + dir) * 4 + h) * NCH + nd)) * 64 + d] = __expf(cl);
    }
}

__device__ __forceinline__ void phase_gla_scan(const Params& p) {
    const int tid = threadIdx.x;
    for (int it = blockIdx.x; it < 512; it += vG()) {
        const int combo = it >> 4, el = (it & 15) * 512 + tid, d = el >> 7;
        float* base = (float*)(p.ws + OFF_KV) + (size_t)combo * NCH * 8192 + el;
        const float* dl = (const float*)(p.ws + OFF_DL) + (size_t)combo * NCH * 64 + d;
        float s = 0.f;
        for (int n0 = 0; n0 < NCH; n0 += 17) {
            float kv[17], dec[17];
#pragma unroll
            for (int i = 0; i < 17; ++i) { kv[i] = base[(size_t)(n0 + i) * 8192]; dec[i] = dl[(n0 + i) * 64]; }
#pragma unroll
            for (int i = 0; i < 17; ++i) { base[(size_t)(n0 + i) * 8192] = s; s = dec[i] * s + kv[i]; }
        }
    }
    for (int it = blockIdx.x; it < 32; it += vG()) {
        const int idx = it * 512 + tid, pp = idx & 63, g = (idx >> 6) & 31, dir = (idx >> 11) & 1, b = idx >> 12;
        float2* he = (float2*)(p.ws + OFF_HE) + ((size_t)((b * 2 + dir) * 32 + g) * NCH) * 64 + pp;
        const float2 a64 = ((const float2*)(p.ws + OFF_A64))[(dir * 32 + g) * 64 + pp];
        float hr = 0.f, hi = 0.f;
        for (int n0 = 0; n0 < NCH; n0 += 17) {
            float2 e[17];
#pragma unroll
            for (int i = 0; i < 17; ++i) e[i] = he[(size_t)(n0 + i) * 64];
#pragma unroll
            for (int i = 0; i < 17; ++i) {
                he[(size_t)(n0 + i) * 64] = make_float2(hr, hi);
                const float nr = a64.x * hr - a64.y * hi + e[i].x, ni = a64.x * hi + a64.y * hr + e[i].y;
                hr = nr; hi = ni;
            }
        }
    }
}

__device__ __forceinline__ void gla_out_item(const Params& p, int item, int b, int c, int h, char* lds) {
    const int tid = threadIdx.x, lane = tid & 63, w = tid >> 6, r0 = b * SB + c * 64;
    float* Gw = (float*)lds; const float* Gm = (const float*)lds;
    char* QD = lds + 40960; char* KI = lds + 49152; char* AT = lds + 57344; char* VT = lds + 65536; char* ST = lds + 81920;
    const bf16_t* Pb = (const bf16_t*)(p.ws + OFF_PB);
    const f32x4* cg = (const f32x4*)(p.ws + OFF_CUM) + (size_t)item * 2048;
    const f32x4 cum0 = cg[tid], cum1 = cg[tid + 512], cum2 = cg[tid + 1024], cum3 = cg[tid + 1536];
    const uint4 qraw = *(const uint4*)(Pb + (size_t)(r0 + (tid >> 3)) * PW + COL_Q + h * 64 + (tid & 7) * 8);
    const uint4 kraw = *(const uint4*)(Pb + (size_t)(r0 + (tid >> 3)) * PW + COL_K + h * 64 + (tid & 7) * 8);
    uint2 vr[4]; gla_load_v(p, r0, h, vr);
    const uint4 g0 = *(const uint4*)(Pb + (size_t)(r0 + (tid >> 3)) * PW + COL_G + h * 128 + (tid & 7) * 16);
    const uint4 g1 = *(const uint4*)(Pb + (size_t)(r0 + (tid >> 3)) * PW + COL_G + h * 128 + (tid & 7) * 16 + 8);
    float sv[2][16];
#pragma unroll
    for (int dir = 0; dir < 2; ++dir) {
        const int dv = tid & 127, dq = tid >> 7, nd = dir_chunk(dir, c);
        const float* S = (const float*)(p.ws + OFF_KV) + ((size_t)(((b * 2 + dir) * 4 + h) * NCH + nd)) * 8192 + (dq * 16) * 128 + dv;
#pragma unroll
        for (int e = 0; e < 16; ++e) sv[dir][e] = S[e * 128];
    }
    __syncthreads();
    *(f32x4*)(Gw + tid * 4) = cum0; *(f32x4*)(Gw + (tid + 512) * 4) = cum1; *(f32x4*)(Gw + (tid + 1024) * 4) = cum2; *(f32x4*)(Gw + (tid + 1536) * 4) = cum3;
    gla_stage_vt(vr, VT);
    __syncthreads();
    f32x4 acco[4];
#pragma unroll
    for (int n = 0; n < 4; ++n) acco[n] = (f32x4){0.f, 0.f, 0.f, 0.f};
    const int mi = w & 3, nd0 = (w >> 2) * 4;
    for (int dir = 0; dir < 2; ++dir) {
        {
            const int i = tid >> 3, dg = tid & 7;
            const unsigned qa[4] = {qraw.x, qraw.y, qraw.z, qraw.w}, ka[4] = {kraw.x, kraw.y, kraw.z, kraw.w};
            unsigned qo[4], ko[4];
#pragma unroll
            for (int e = 0; e < 4; ++e) {
                const float c0 = Gm[(dir * 64 + i) * 64 + dg * 8 + 2 * e], c1 = Gm[(dir * 64 + i) * 64 + dg * 8 + 2 * e + 1];
                qo[e] = pack2(lo_bf(qa[e]) * 0.125f * __expf(c0), hi_bf(qa[e]) * 0.125f * __expf(c1));
                ko[e] = pack2(lo_bf(ka[e]) * __expf(-c0), hi_bf(ka[e]) * __expf(-c1));
            }
            *(uint4*)(QD + swz(i, dg, 128)) = make_uint4(qo[0], qo[1], qo[2], qo[3]);
            *(uint4*)(KI + swz(i, dg, 128)) = make_uint4(ko[0], ko[1], ko[2], ko[3]);
        }
        {
            const int dv = tid & 127, dq = tid >> 7;
            unsigned pk[8];
#pragma unroll
            for (int e = 0; e < 8; ++e) pk[e] = dir ? pack2(sv[1][2 * e], sv[1][2 * e + 1]) : pack2(sv[0][2 * e], sv[0][2 * e + 1]);
            *(uint4*)(ST + swz(dv, dq * 2, 128)) = make_uint4(pk[0], pk[1], pk[2], pk[3]);
            *(uint4*)(ST + swz(dv, dq * 2 + 1, 128)) = make_uint4(pk[4], pk[5], pk[6], pk[7]);
        }
        __syncthreads();
        {
            const int mi2 = w >> 1, nj0 = (w & 1) * 2;
#pragma unroll
            for (int t = 0; t < 2; ++t) {
                const int nj = nj0 + t;
                f32x4 a = (f32x4){0.f, 0.f, 0.f, 0.f};
#pragma unroll
                for (int ks = 0; ks < 2; ++ks) a = mfma16(ldfrag(KI, 128, nj * 16, ks * 32, lane), ldfrag(QD, 128, mi2 * 16, ks * 32, lane), a);
                const int i = mi2 * 16 + (lane & 15), j0 = nj * 16 + 4 * (lane >> 4);
                float v[4];
#pragma unroll
                for (int q = 0; q < 4; ++q) { const int j = j0 + q; const bool keep = dir ? (j >= i) : (j <= i); v[q] = keep ? a[q] : 0.f; }
                *(uint2*)(AT + swz(i, j0 >> 3, 128) + (j0 & 7) * 2) = make_uint2(pack2(v[0], v[1]), pack2(v[2], v[3]));
            }
        }
        __syncthreads();
#pragma unroll
        for (int ks = 0; ks < 2; ++ks) {
            const bf16x8 xq = ldfrag(QD, 128, mi * 16, ks * 32, lane), xa = ldfrag(AT, 128, mi * 16, ks * 32, lane);
#pragma unroll
            for (int n = 0; n < 4; ++n) {
                acco[n] = mfma16(ldfrag(ST, 128, (nd0 + n) * 16, ks * 32, lane), xq, acco[n]);
                acco[n] = mfma16(ldfrag(VT, 128, (nd0 + n) * 16, ks * 32, lane), xa, acco[n]);
            }
        }
        __syncthreads();
    }
    float* OUT = (float*)lds;
    {
        const int i = mi * 16 + (lane & 15);
#pragma unroll
        for (int n = 0; n < 4; ++n) *(f32x4*)(OUT + i * 132 + (nd0 + n) * 16 + 4 * (lane >> 4)) = acco[n];
    }
    __syncthreads();
    {
        const int i = tid >> 3, seg = tid & 7;
        float o[16]; float ss = 0.f;
#pragma unroll
        for (int e = 0; e < 4; ++e) { const float4 v = *(const float4*)(OUT + i * 132 + seg * 16 + 4 * e); o[4 * e] = v.x; o[4 * e + 1] = v.y; o[4 * e + 2] = v.z; o[4 * e + 3] = v.w; }
#pragma unroll
        for (int e = 0; e < 16; ++e) ss += o[e] * o[e];
        ss += __shfl_xor(ss, 1); ss += __shfl_xor(ss, 2); ss += __shfl_xor(ss, 4);
        const float rstd = rsqrtf(ss * (1.0f / 128.0f) + EPS);
        const unsigned ga[8] = {g0.x, g0.y, g0.z, g0.w, g1.x, g1.y, g1.z, g1.w};
        unsigned pk[8];
#pragma unroll
        for (int e = 0; e < 8; ++e) {
            const float ga0 = lo_bf(ga[e]), ga1 = hi_bf(ga[e]);
            const float n0 = p.gla_norm[seg * 16 + 2 * e], n1 = p.gla_norm[seg * 16 + 2 * e + 1];
            pk[e] = pack2(o[2 * e] * rstd * n0 * (ga0 * sigmoidf_(ga0)), o[2 * e + 1] * rstd * n1 * (ga1 * sigmoidf_(ga1)));
        }
        bf16_t* mp = (bf16_t*)(p.ws + OFF_MIX) + (size_t)(r0 + i) * D + h * 128 + seg * 16;
        *(uint4*)mp = make_uint4(pk[0], pk[1], pk[2], pk[3]); *(uint4*)(mp + 8) = make_uint4(pk[4], pk[5], pk[6], pk[7]);
    }
}

template <bool FULL>
__device__ __forceinline__ void s5_item(const Params& p, int b, int c, int go, char* lds) {
    const int tid = threadIdx.x, lane = tid & 63, w = tid >> 6, g = go * 8 + w, r0 = b * SB + c * 64;
    char* HS = lds + w * 8192;
    const bf16_t* Pb = (const bf16_t*)(p.ws + OFF_PB);
    const int fr = lane & 15, fq = lane >> 4;
    bf16x8 uf[4];
#pragma unroll
    for (int m = 0; m < 4; ++m) {
        uf[m] = (bf16x8){0, 0, 0, 0, 0, 0, 0, 0};
        if (fq < 2) uf[m] = *(const bf16x8*)(Pb + (size_t)(r0 + m * 16 + fr) * PW + COL_U + g * 16 + fq * 8);
    }
    f32x4 accy[4];
#pragma unroll
    for (int m = 0; m < 4; ++m) accy[m] = (f32x4){0.f, 0.f, 0.f, 0.f};
    __syncthreads();
    for (int dir = 0; dir < 2; ++dir) {
        const int dg = dir * 32 + g, idx = dg * 64 + lane;
        const float2 a = ((const float2*)(p.ws + OFF_ABAR))[idx];
        bf16x8 bfr[8];
#pragma unroll
        for (int j = 0; j < 8; ++j) {
            bfr[j] = (bf16x8){0, 0, 0, 0, 0, 0, 0, 0};
            if (fq < 2) bfr[j] = *(const bf16x8*)((const bf16_t*)(p.ws + OFF_BBAR) + ((size_t)dg * 128 + j * 16 + fr) * 16 + fq * 8);
        }
        const int nd = dir_chunk(dir, c);
        float2* HEp = (float2*)(p.ws + OFF_HE) + ((size_t)((b * 2 + dir) * 32 + g) * NCH) * 64 + lane;
        float hr = 0.f, hi = 0.f;
        bf16x8 cfrag[4];
        if (FULL) {
            const float2 h0 = HEp[(size_t)nd * 64]; hr = h0.x; hi = h0.y;
            const bf16_t* CM = (const bf16_t*)(p.ws + OFF_CMAT) + ((size_t)(dg * 16 + fr)) * 128 + fq * 8;
#pragma unroll
            for (int ks = 0; ks < 4; ++ks) cfrag[ks] = *(const bf16x8*)(CM + ks * 32);
        }
        for (int half = 0; half < 2; ++half) {
            const int mt0 = (dir ? 1 - half : half) * 2;
#pragma unroll
            for (int mt = 0; mt < 2; ++mt) {
                const bf16x8 ua = (mt0 == 0) ? uf[mt] : uf[2 + mt];
#pragma unroll
                for (int j = 0; j < 8; ++j) {
                    const f32x4 d = mfma16(bfr[j], ua, (f32x4){0.f, 0.f, 0.f, 0.f});
                    const int row = mt * 16 + fr;
                    *(uint2*)(HS + row * 256 + ((((2 * j) | (fq >> 1)) ^ (row & 15)) << 4) + (fq & 1) * 8) = make_uint2(pack2(d[0], d[1]), pack2(d[2], d[3]));
                }
            }
            __syncthreads();
            {
                const int ch = lane >> 2, sub = (lane & 3) * 4;
#pragma unroll 8
                for (int tt = 0; tt < 32; ++tt) {
                    const int tl = dir ? 31 - tt : tt;
                    unsigned* ptr = (unsigned*)(HS + tl * 256 + ((ch ^ (tl & 15)) << 4) + sub);
                    const unsigned bu = *ptr;
                    const float nhr = a.x * hr - a.y * hi + lo_bf(bu), nhi = a.x * hi + a.y * hr + hi_bf(bu);
                    hr = nhr; hi = nhi;
                    if (FULL) *ptr = pack2(hr, hi);
                }
            }
            if (FULL) {
                __syncthreads();
#pragma unroll
                for (int mt = 0; mt < 2; ++mt)
#pragma unroll
                    for (int ks = 0; ks < 4; ++ks) {
                        const int row = mt * 16 + fr;
                        const bf16x8 hf = *(const bf16x8*)(HS + row * 256 + (((ks * 4 + fq) ^ (row & 15)) << 4));
                        if (mt0 == 0) accy[mt] = mfma16(cfrag[ks], hf, accy[mt]); else accy[2 + mt] = mfma16(cfrag[ks], hf, accy[2 + mt]);
                    }
            }
            __syncthreads();
        }
        if (!FULL) HEp[(size_t)nd * 64] = make_float2(hr, hi);
    }
    if (FULL) {
        bf16_t* Yb = (bf16_t*)(p.ws + OFF_Y);
        const int h0 = 4 * fq;
        const f32x4 dd = *(const f32x4*)(p.s5_d + g * 16 + h0);
#pragma unroll
        for (int mt = 0; mt < 4; ++mt) {
            const int tok = mt * 16 + fr;
            const uint2 uv = *(const uint2*)(Pb + (size_t)(r0 + tok) * PW + COL_U + g * 16 + h0);
            const float ua[4] = {lo_bf(uv.x), hi_bf(uv.x), lo_bf(uv.y), hi_bf(uv.y)};
            float o[4];
#pragma unroll
            for (int q = 0; q < 4; ++q) {
                const float y = accy[mt][q] + dd[q] * ua[q];
                const float z2 = 2.0f * 0.7978845608028654f * (y + 0.044715f * y * y * y);
                o[q] = y * sigmoidf_(z2);
            }
            *(uint2*)(Yb + (size_t)(r0 + tok) * 512 + g * 16 + h0) = make_uint2(pack2(o[0], o[1]), pack2(o[2], o[3]));
        }
    }
}
__device__ __forceinline__ void phase_rec_local(const Params& p, char* lds) {
    for (int it = blockIdx.x; it < 2176; it += vG()) {
        if (it < 1088) { const int b = it / 272, r = it % 272; gla_local_item(p, it, b, r >> 2, r & 3, lds); }
        else { const int j = it - 1088, b = j / 272, r = j % 272; s5_item<false>(p, b, r >> 2, r & 3, lds); }
    }
}
__device__ __forceinline__ void phase_rec_out(const Params& p, char* lds) {
    for (int it = blockIdx.x; it < 2176; it += vG()) {
        if (it < 1088) { const int b = it / 272, r = it % 272; gla_out_item(p, it, b, r >> 2, r & 3, lds); }
        else { const int j = it - 1088, b = j / 272, r = j % 272; s5_item<true>(p, b, r >> 2, r & 3, lds); }
    }
}

__device__ __forceinline__ void phase_gemm_down(const Params& p, char* lds) {
    const bf16_t* A = (const bf16_t*)(p.ws + OFF_HB); const bf16_t* Bt = (const bf16_t*)(p.ws + OFF_WDN); float* O = (float*)(p.ws + OFF_DN);
    const int nunits = (NT / 256) * 6;
    for (int u = blockIdx.x; u < nunits; u += vG()) {
        const int mt = u / 6, tn = u % 6;
        EpiF32 epi{O, DNW, mt * 256, tn * 128};
        gemm_dense<true>(A, D, mt * 256, Bt, D, tn * 128, D, lds, epi);
    }
}
__device__ __forceinline__ void phase_mla_norm(const Params& p) {
    const int lane = threadIdx.x & 63, gw = blockIdx.x * 8 + (threadIdx.x >> 6), GW = vG() * 8;
    const float* rope = (const float*)(p.ws + OFF_ROPE);
    bf16_t* CQ = (bf16_t*)(p.ws + OFF_CQ); bf16_t* CKV = (bf16_t*)(p.ws + OFF_CKV); bf16_t* KR = (bf16_t*)(p.ws + OFF_KR);
    for (int r = gw; r < NT; r += GW) {
        const bf16_t* rp = (const bf16_t*)(p.ws + OFF_DN) + (size_t)r * DNW;
        float2 q[3]; float ss = 0.f;
#pragma unroll
        for (int j = 0; j < 3; ++j) { const unsigned t = *(const unsigned*)(rp + 2 * lane + 128 * j); q[j] = make_float2(lo_bf(t), hi_bf(t)); ss += q[j].x * q[j].x + q[j].y * q[j].y; }
        ss = wave_sum(ss);
        const float rq = rsqrtf(ss * (1.0f / 384.0f) + EPS);
#pragma unroll
        for (int j = 0; j < 3; ++j) {
            const int col = 2 * lane + 128 * j;
            *(unsigned*)(CQ + (size_t)r * 384 + col) = pack2(q[j].x * rq * p.mla_q_norm[col], q[j].y * rq * p.mla_q_norm[col + 1]);
        }
        const uint2 kt = *(const uint2*)(rp + 384 + 4 * lane);
        const float4 kv = make_float4(lo_bf(kt.x), hi_bf(kt.x), lo_bf(kt.y), hi_bf(kt.y));
        float s2 = wave_sum(kv.x * kv.x + kv.y * kv.y + kv.z * kv.z + kv.w * kv.w);
        const float rk = rsqrtf(s2 * (1.0f / 256.0f) + EPS);
        const float4 gk = *(const float4*)(p.mla_kv_norm + 4 * lane);
        *(uint2*)(CKV + (size_t)r * 256 + 4 * lane) = make_uint2(pack2(kv.x * rk * gk.x, kv.y * rk * gk.y), pack2(kv.z * rk * gk.z, kv.w * rk * gk.w));
        const float v = bf2f(rp[640 + lane]);
        const float pv = __shfl_xor(v, 16);
        const int s = r % SB;
        float o = v;
        if (s >= CTXL) {
            const int sx = s - CTXL, half = lane >> 5, idx = lane & 31, fi = idx & 15;
            const int pos = half ? (sx & 63) : (sx >> 6);
            const float cs = rope[pos * 16 + fi], sn = rope[1024 + pos * 16 + fi];
            o = (idx < 16) ? (v * cs - pv * sn) : (v * cs + pv * sn);
        }
        if (FP8_QK) ((unsigned char*)KR)[(size_t)r * 64 + lane] = (unsigned char)(pack4_fp8(o, 0.f, 0.f, 0.f) & 0xffu);
        else KR[(size_t)r * 64 + lane] = (bf16_t)(pack2(o, 0.f) & 0xffffu);
    }
}
struct EpiQ {
    bf16_t* QF; const float* rope; int row0, col0;
    __device__ __forceinline__ void operator()(const f32x4 (&acc)[4][4], int wm, int wn, int lane) const {
        const float qs = 0.07216878364870322f * 1.4426950408889634f;
        const int base = (col0 + wn * 64) >> 4;
        const bool isrope = (base % 12) == 8;
#pragma unroll
        for (int m = 0; m < 4; ++m) {
            const int row = row0 + wm * 64 + m * 16 + (lane & 15);
            f32x4 o0 = acc[m][0], o1 = acc[m][1], o2 = acc[m][2], o3 = acc[m][3];
            if (isrope) {
                const int sx = (row % SB) - CTXL, gr = sx >> 6, gc = sx & 63;
                const f32x4 cr = *(const f32x4*)(rope + gr * 16 + 4 * (lane >> 4)), sr = *(const f32x4*)(rope + 1024 + gr * 16 + 4 * (lane >> 4));
                const f32x4 cc = *(const f32x4*)(rope + gc * 16 + 4 * (lane >> 4)), sc = *(const f32x4*)(rope + 1024 + gc * 16 + 4 * (lane >> 4));
                const f32x4 t0 = o0 * cr - o1 * sr, t1 = o1 * cr + o0 * sr, t2 = o2 * cc - o3 * sc, t3 = o3 * cc + o2 * sc;
                o0 = t0; o1 = t1; o2 = t2; o3 = t3;
            }
            bf16_t* rp = QF + (size_t)row * 1536 + col0 + wn * 64 + 4 * (lane >> 4);
            *(uint2*)(rp) = make_uint2(pack2(o0[0] * qs, o0[1] * qs), pack2(o0[2] * qs, o0[3] * qs));
            *(uint2*)(rp + 16) = make_uint2(pack2(o1[0] * qs, o1[1] * qs), pack2(o1[2] * qs, o1[3] * qs));
            *(uint2*)(rp + 32) = make_uint2(pack2(o2[0] * qs, o2[1] * qs), pack2(o2[2] * qs, o2[3] * qs));
            *(uint2*)(rp + 48) = make_uint2(pack2(o3[0] * qs, o3[1] * qs), pack2(o3[2] * qs, o3[3] * qs));
        }
    }
};
struct EpiKV {
    bf16_t* KN; bf16_t* VT; int row0, tn;
    __device__ __forceinline__ void operator()(const f32x4 (&acc)[4][4], int wm, int wn, int lane) const {
        const int head = tn >> 1; const bool isv = tn & 1;
        const int b = row0 / SB, s0 = row0 % SB;
#pragma unroll
        for (int m = 0; m < 4; ++m) {
            const int rl = wm * 64 + m * 16 + 4 * (lane >> 4);
#pragma unroll
            for (int n = 0; n < 4; ++n) {
                const int cw = wn * 64 + n * 16 + (lane & 15);
                if (isv) {
                    *(uint2*)(VT + ((size_t)((b * 8 + head) * 128 + cw)) * SB + s0 + rl) = make_uint2(pack2(acc[m][n][0], acc[m][n][1]), pack2(acc[m][n][2], acc[m][n][3]));
                } else {
                    const unsigned p01 = pack2(acc[m][n][0], acc[m][n][1]), p23 = pack2(acc[m][n][2], acc[m][n][3]);
                    bf16_t* kp = KN + (size_t)(row0 + rl) * D + head * 128 + cw;
                    kp[0] = (bf16_t)(p01 & 0xffffu); kp[D] = (bf16_t)(p01 >> 16); kp[2 * D] = (bf16_t)(p23 & 0xffffu); kp[3 * D] = (bf16_t)(p23 >> 16);
                }
            }
        }
    }
};
struct EpiKV8 {
    bf16_t* KN; bf16_t* VT;
    __device__ __forceinline__ void operator()(const f32x4 (&acc)[2][2][4][2], const g8::Unit& u, int wr, int wc, int fr, int fq) const {
        const int head = u.tn, b = u.row0 / SB, s0 = u.row0 % SB;
#pragma unroll
        for (int ai = 0; ai < 2; ++ai)
#pragma unroll
            for (int m = 0; m < 4; ++m) {
                const int rl = 128 * ai + 64 * wr + 16 * m + fr;
                bf16_t* kp = KN + (size_t)(u.row0 + rl) * D + head * 128 + 32 * wc + 4 * fq;
                if (FP8_QK) {
                    char* k8 = (char*)KN + (size_t)(u.row0 + rl) * D + head * 128 + 32 * wc + 4 * fq;
                    *(unsigned*)(k8) = pack4_fp8(acc[ai][0][m][0][0], acc[ai][0][m][0][1], acc[ai][0][m][0][2], acc[ai][0][m][0][3]);
                    *(unsigned*)(k8 + 16) = pack4_fp8(acc[ai][0][m][1][0], acc[ai][0][m][1][1], acc[ai][0][m][1][2], acc[ai][0][m][1][3]);
                } else {
                    *(uint2*)(kp) = make_uint2(pack2(acc[ai][0][m][0][0], acc[ai][0][m][0][1]), pack2(acc[ai][0][m][0][2], acc[ai][0][m][0][3]));
                    *(uint2*)(kp + 16) = make_uint2(pack2(acc[ai][0][m][1][0], acc[ai][0][m][1][1]), pack2(acc[ai][0][m][1][2], acc[ai][0][m][1][3]));
                }
#pragma unroll
                for (int n = 0; n < 2; ++n) {
                    const unsigned p01 = pack2(acc[ai][1][m][n][0], acc[ai][1][m][n][1]), p23 = pack2(acc[ai][1][m][n][2], acc[ai][1][m][n][3]);
                    bf16_t* vp = VT + ((size_t)((b * 8 + head) * 128 + 32 * wc + 16 * n + 4 * fq)) * SB + s0 + rl;
                    vp[0] = (bf16_t)(p01 & 0xffffu); vp[SB] = (bf16_t)(p01 >> 16); vp[2 * SB] = (bf16_t)(p23 & 0xffffu); vp[3 * SB] = (bf16_t)(p23 >> 16);
                }
            }
    }
};
__device__ __forceinline__ void phase_gemm_kv8(const Params& p, char* lds) {
    SchedDense8 S{p.ws + OFF_WUKV, 68 * 8, 8, 512, vG(), g8::xcd_major_block()};
    EpiKV8 E{(bf16_t*)(p.ws + OFF_KN), (bf16_t*)(p.ws + OFF_VT)};
    g8::gemm8<false>((LAS unsigned char*)lds, p.ws + OFF_CKV, 512, S, E);
}
__device__ __forceinline__ void phase_gemm_kv(const Params& p, char* lds) {
    const int nkv = 68 * 16;
    for (int v = blockIdx.x; v < nkv; v += vG()) {
        const int mt = v >> 4, tn = v & 15;
        EpiKV epi{(bf16_t*)(p.ws + OFF_KN), (bf16_t*)(p.ws + OFF_VT), mt * 256, tn};
        gemm_dense<false>((const bf16_t*)(p.ws + OFF_CKV), 256, mt * 256, (const bf16_t*)(p.ws + OFF_WUKV), 256, tn * 128, 256, lds, epi);
    }
}
__device__ __forceinline__ void phase_gemm_qkv(const Params& p, char* lds) {
    const int nq = 64 * 12, nkv = 68 * 16;
    for (int u = blockIdx.x; u < nq + nkv; u += vG()) {
        if (u < nq) {
            const int mi = u / 12, tn = u % 12, row0 = (mi >> 4) * SB + ((mi & 15) + 1) * 256;
            EpiQ epi{(bf16_t*)(p.ws + OFF_QF), (const float*)(p.ws + OFF_ROPE), row0, tn * 128};
            gemm_dense<true>((const bf16_t*)(p.ws + OFF_CQ), 384, row0, (const bf16_t*)(p.ws + OFF_WUQ), 384, tn * 128, 384, lds, epi);
        } else {
            const int v = u - nq, mt = v >> 4, tn = v & 15;
            EpiKV epi{(bf16_t*)(p.ws + OFF_KN), (bf16_t*)(p.ws + OFF_VT), mt * 256, tn};
            gemm_dense<false>((const bf16_t*)(p.ws + OFF_CKV), 256, mt * 256, (const bf16_t*)(p.ws + OFF_WUKV), 256, tn * 128, 256, lds, epi);
        }
    }
}
__device__ __forceinline__ void phase_attention(const Params& p, char* lds) {
    const int tid = threadIdx.x, lane = tid & 63, w = tid >> 6;
    const bf16_t* QF = (const bf16_t*)(p.ws + OFF_QF); const bf16_t* KN = (const bf16_t*)(p.ws + OFF_KN);
    const bf16_t* KR = (const bf16_t*)(p.ws + OFF_KR); const bf16_t* VTg = (const bf16_t*)(p.ws + OFF_VT);
    bf16_t* OB = (bf16_t*)(p.ws + OFF_OB);
    char* Ps = lds + 122880 + w * 4096;
    const FragBase fbk = fragbase(lane, 384), fbv = fragbase(lane, 128);
    for (int it = blockIdx.x; it < NB * 8 * 16; it += vG()) {
        const int b = it >> 7, h = (it >> 4) & 7, qt = it & 15;
        const int qrow0 = b * SB + CTXL + qt * 256 + w * 32;
        bf16x8 qf[2][6];
#pragma unroll
        for (int m = 0; m < 2; ++m)
#pragma unroll
            for (int ks = 0; ks < 6; ++ks) qf[m][ks] = *(const bf16x8*)(QF + (size_t)(qrow0 + m * 16 + (lane & 15)) * 1536 + h * 192 + ks * 32 + (lane >> 4) * 8);
        f32x4 acco[2][8];
#pragma unroll
        for (int m = 0; m < 2; ++m)
#pragma unroll
            for (int n = 0; n < 8; ++n) acco[m][n] = (f32x4){0.f, 0.f, 0.f, 0.f};
        float mrun[2] = {0.f, 0.f}; bool first = true;
        f32x4 lacc[2] = {(f32x4){0.f, 0.f, 0.f, 0.f}, (f32x4){0.f, 0.f, 0.f, 0.f}};
        unsigned koff[3], kstep[3], voff[2];
#pragma unroll
        for (int i = 0; i < 3; ++i) {
            const int L = (w + 8 * i) * 64 + lane, r = L / 24, q = L % 24;
            const int c = (q & ~7) | ((q & 7) ^ ((r >> 1) & 7));
            koff[i] = (c < 16) ? (unsigned)(OFF_KN + ((size_t)(b * SB + r) * D + h * 128 + c * 8) * 2) : (unsigned)(OFF_KR + ((size_t)(b * SB + r) * 64 + (c - 16) * 8) * 2);
            kstep[i] = (c < 16) ? 64u * D * 2u : 64u * 64u * 2u;
        }
#pragma unroll
        for (int i = 0; i < 2; ++i) {
            const int L = (w + 8 * i) * 64 + lane, r = L >> 3, q = L & 7, c = q ^ ((r >> 1) & 7);
            voff[i] = (unsigned)(OFF_VT + ((size_t)((b * 8 + h) * 128 + r) * SB + c * 8) * 2);
        }
        auto dma = [&](int kt, int st) {
            char* Ks = lds + st * 24576; char* Vs = lds + 73728 + st * 16384;
#pragma unroll
            for (int i = 0; i < 3; ++i)
                __builtin_amdgcn_global_load_lds((const unsigned*)(p.ws + (size_t)(koff[i] + (unsigned)kt * kstep[i])), (LAS unsigned*)(Ks + (w + 8 * i) * 1024 + lane * 16), 16, 0, 0);
#pragma unroll
            for (int i = 0; i < 2; ++i)
                __builtin_amdgcn_global_load_lds((const unsigned*)(p.ws + (size_t)(voff[i] + (unsigned)kt * 128u)), (LAS unsigned*)(Vs + (w + 8 * i) * 1024 + lane * 16), 16, 0, 0);
        };
        f32x4 s[2][4];
        auto do_S = [&](int st) {
            const char* Ks = lds + st * 24576;
#pragma unroll
            for (int m = 0; m < 2; ++m)
#pragma unroll
                for (int n = 0; n < 4; ++n) s[m][n] = (f32x4){-mrun[m], -mrun[m], -mrun[m], -mrun[m]};
            bf16x8 kf[4];
#pragma unroll
            for (int i = 0; i < 3; ++i) kf[i] = ldfrag2(Ks, fbk, 384, (i & 3) * 16, i >> 2);
#pragma unroll
            for (int i = 0; i < 24; ++i) {
                if (i + 3 < 24) kf[(i + 3) & 3] = ldfrag2(Ks, fbk, 384, ((i + 3) & 3) * 16, (i + 3) >> 2);
                __builtin_amdgcn_sched_barrier(0);
                s[0][i & 3] = mfma16(kf[i & 3], qf[0][i >> 2], s[0][i & 3]); s[1][i & 3] = mfma16(kf[i & 3], qf[1][i >> 2], s[1][i & 3]);
            }
        };
        auto do_SM_PV = [&](int st) {
            const char* Vs = lds + 73728 + st * 16384;
#pragma unroll
            for (int m = 0; m < 2; ++m) {
                float mx = s[m][0][0];
#pragma unroll
                for (int n = 0; n < 4; ++n)
#pragma unroll
                    for (int q = 0; q < 4; ++q) mx = fmaxf(mx, s[m][n][q]);
                if (__any(first || mx > 64.0f)) {
                    mx = fmaxf(mx, __shfl_xor(mx, 16)); mx = fmaxf(mx, __shfl_xor(mx, 32));
                    const float delta = first ? mx : fmaxf(mx, 0.f), alpha = first ? 1.0f : __builtin_amdgcn_exp2f(-delta);
                    lacc[m] *= alpha;
#pragma unroll
                    for (int n = 0; n < 8; ++n) acco[m][n] *= alpha;
#pragma unroll
                    for (int n = 0; n < 4; ++n) s[m][n] -= delta;
                    mrun[m] += delta;
                }
#pragma unroll
                for (int n = 0; n < 4; ++n) {
                    float pv[4];
#pragma unroll
                    for (int q = 0; q < 4; ++q) pv[q] = __builtin_amdgcn_exp2f(s[m][n][q]);
                    *(uint2*)(Ps + m * 2048 + (lane & 15) * 128 + ((((n * 2) | (lane >> 5)) ^ (((lane & 15) >> 1) & 7)) << 4) + ((lane >> 4) & 1) * 8) = make_uint2(pack2(pv[0], pv[1]), pack2(pv[2], pv[3]));
                }
            }
            first = false;
            __builtin_amdgcn_wave_barrier();
            {
                bf16x8 pf[2][2], vf[4];
#pragma unroll
                for (int ks = 0; ks < 2; ++ks) { pf[ks][0] = ldfrag2(Ps, fbv, 128, 0, ks); pf[ks][1] = ldfrag2(Ps, fbv, 128, 16, ks); }
                {
                    const bf16x8 ones = (bf16x8){16256, 16256, 16256, 16256, 16256, 16256, 16256, 16256};
#pragma unroll
                    for (int ks = 0; ks < 2; ++ks) { lacc[0] = mfma16(ones, pf[ks][0], lacc[0]); lacc[1] = mfma16(ones, pf[ks][1], lacc[1]); }
                }
#pragma unroll
                for (int i = 0; i < 3; ++i) vf[i] = ldfrag2(Vs, fbv, 128, (i & 7) * 16, i >> 3);
#pragma unroll
                for (int i = 0; i < 16; ++i) {
                    if (i + 3 < 16) vf[(i + 3) & 3] = ldfrag2(Vs, fbv, 128, ((i + 3) & 7) * 16, (i + 3) >> 3);
                    __builtin_amdgcn_sched_barrier(0);
                    acco[0][i & 7] = mfma16(vf[i & 3], pf[i >> 3][0], acco[0][i & 7]); acco[1][i & 7] = mfma16(vf[i & 3], pf[i >> 3][1], acco[1][i & 7]);
                }
            }
        };
        __syncthreads();
        dma(0, 0); dma(1, 1);
        asm volatile("s_waitcnt vmcnt(0)" ::: "memory");
        __syncthreads();
        const int nkt = SB / 64;
        const bool grpA = w < 4;
        int st = 0, stp = 2;
        for (int kt = 0; kt < nkt; ++kt) {
            const bool more2 = (kt + 2) < nkt;
            if (grpA) do_S(st); else if (kt > 0) do_SM_PV(stp);
            asm volatile("s_waitcnt lgkmcnt(0)" ::: "memory");
            __builtin_amdgcn_s_barrier();
            asm volatile("" ::: "memory");
            if (more2) dma(kt + 2, stp);
            if (grpA) do_SM_PV(st); else do_S(st);
            if (more2) asm volatile("s_waitcnt vmcnt(5)" ::: "memory"); else asm volatile("s_waitcnt vmcnt(0)" ::: "memory");
            asm volatile("s_waitcnt lgkmcnt(0)" ::: "memory");
            __builtin_amdgcn_s_barrier();
            asm volatile("" ::: "memory");
            stp = st; st = (st == 2) ? 0 : st + 1;
        }
        if (!grpA) do_SM_PV(stp);
#pragma unroll
        for (int m = 0; m < 2; ++m) {
            const float il = 1.0f / lacc[m][0];
            bf16_t* op = OB + (size_t)(qrow0 + m * 16 + (lane & 15)) * D + h * 128 + 4 * (lane >> 4);
#pragma unroll
            for (int n = 0; n < 8; ++n) *(uint2*)(op + n * 16) = make_uint2(pack2(acco[m][n][0] * il, acco[m][n][1] * il), pack2(acco[m][n][2] * il, acco[m][n][3] * il));
        }
    }
}

__device__ __forceinline__ void phase_attention8(const Params& p, char* lds) {
    const int tid = threadIdx.x, lane = tid & 63, w = tid >> 6;
    const bf16_t* QF = (const bf16_t*)(p.ws + OFF_QF); const bf16_t* KN = (const bf16_t*)(p.ws + OFF_KN);
    const bf16_t* KR = (const bf16_t*)(p.ws + OFF_KR); const bf16_t* VTg = (const bf16_t*)(p.ws + OFF_VT);
    bf16_t* OB = (bf16_t*)(p.ws + OFF_OB);
    char* Ps = lds + 98304 + w * 4096;
    const FragBase fbv = fragbase(lane, 128);
    const int fr = lane & 15, fq = lane >> 4;
    for (int it = blockIdx.x; it < NB * 8 * 16; it += vG()) {
        const int b = it >> 7, h = (it >> 4) & 7, qt = it & 15;
        const int qrow0 = b * SB + CTXL + qt * 256 + w * 32;
        g8::i32x8 q8[2][2];
#pragma unroll
        for (int m = 0; m < 2; ++m) {
            const char* qp = p.ws + OFF_QF + (size_t)(qrow0 + m * 16 + fr) * 1536 + h * 192 + 32 * fq;
            q8[m][0] = __builtin_shufflevector(*(const g8::i32x4_t*)qp, *(const g8::i32x4_t*)(qp + 16), 0, 1, 2, 3, 4, 5, 6, 7);
            q8[m][1] = (g8::i32x8){0, 0, 0, 0, 0, 0, 0, 0};
            if (fq < 2) q8[m][1] = __builtin_shufflevector(*(const g8::i32x4_t*)(qp + 128), *(const g8::i32x4_t*)(qp + 144), 0, 1, 2, 3, 4, 5, 6, 7);
        }
        f32x4 acco[2][8];
#pragma unroll
        for (int m = 0; m < 2; ++m)
#pragma unroll
            for (int n = 0; n < 8; ++n) acco[m][n] = (f32x4){0.f, 0.f, 0.f, 0.f};
        float mrun[2] = {0.f, 0.f}; bool first = true;
        f32x4 lacc[2] = {(f32x4){0.f, 0.f, 0.f, 0.f}, (f32x4){0.f, 0.f, 0.f, 0.f}};
        unsigned koff[2], kstep[2], voff[2];
#pragma unroll
        for (int i = 0; i < 2; ++i) {
            const int L = (w + 8 * i) * 64 + lane, r = L >> 4, q = L & 15, c = q ^ (r & 15);
            if (c < 8) { koff[i] = (unsigned)(OFF_KN + (size_t)(b * SB + r) * D + h * 128 + c * 16); kstep[i] = 64u * D; }
            else if (c < 12) { koff[i] = (unsigned)(OFF_KR + (size_t)(b * SB + r) * 64 + (c - 8) * 16); kstep[i] = 64u * 64u; }
            else { koff[i] = (unsigned)(OFF_ZERO64 + (c - 12) * 16); kstep[i] = 0u; }
        }
#pragma unroll
        for (int i = 0; i < 2; ++i) {
            const int L = (w + 8 * i) * 64 + lane, r = L >> 3, q = L & 7, c = q ^ ((r >> 1) & 7);
            voff[i] = (unsigned)(OFF_VT + ((size_t)((b * 8 + h) * 128 + r) * SB + c * 8) * 2);
        }
        auto dma = [&](int kt, int st) {
            char* Ks = lds + st * 16384; char* Vs = lds + 49152 + st * 16384;
#pragma unroll
            for (int i = 0; i < 2; ++i)
                __builtin_amdgcn_global_load_lds((const unsigned*)(p.ws + (size_t)(koff[i] + (unsigned)kt * kstep[i])), (LAS unsigned*)(Ks + (w + 8 * i) * 1024 + lane * 16), 16, 0, 0);
#pragma unroll
            for (int i = 0; i < 2; ++i)
                __builtin_amdgcn_global_load_lds((const unsigned*)(p.ws + (size_t)(voff[i] + (unsigned)kt * 128u)), (LAS unsigned*)(Vs + (w + 8 * i) * 1024 + lane * 16), 16, 0, 0);
        };
        f32x4 s[2][4];
        auto do_S = [&](int st) {
            const char* Ks = lds + st * 16384;
#pragma unroll
            for (int m = 0; m < 2; ++m)
#pragma unroll
                for (int n = 0; n < 4; ++n) s[m][n] = (f32x4){-mrun[m], -mrun[m], -mrun[m], -mrun[m]};
            const int ksc = 0x7F7F7F7F, qsc = 0x7B7B7B7B;
            auto ldk = [&](int i) {
                const int c0 = 8 * (i >> 2) + 2 * fq;
                const char* rp = Ks + ((i & 3) * 16 + fr) * 256;
                return __builtin_shufflevector(*(const g8::i32x4_t*)(rp + ((c0 ^ fr) << 4)), *(const g8::i32x4_t*)(rp + (((c0 + 1) ^ fr) << 4)), 0, 1, 2, 3, 4, 5, 6, 7);
            };
            g8::i32x8 kf[3];
            kf[0] = ldk(0); kf[1] = ldk(1);
#pragma unroll
            for (int i = 0; i < 8; ++i) {
                if (i + 2 < 8) kf[(i + 2) % 3] = ldk(i + 2);
                __builtin_amdgcn_sched_barrier(0);
                asm volatile("s_nop 1\n\tv_mfma_scale_f32_16x16x128_f8f6f4 %0, %1, %2, %0, %3, %4 op_sel_hi:[0,0,0]" : "+v"(s[0][i & 3]) : "v"(kf[i % 3]), "v"(q8[0][i >> 2]), "v"(ksc), "v"(qsc));
                asm volatile("s_nop 1\n\tv_mfma_scale_f32_16x16x128_f8f6f4 %0, %1, %2, %0, %3, %4 op_sel_hi:[0,0,0]" : "+v"(s[1][i & 3]) : "v"(kf[i % 3]), "v"(q8[1][i >> 2]), "v"(ksc), "v"(qsc));
            }
            __builtin_amdgcn_sched_barrier(0); asm volatile("s_nop 15\n\ts_nop 15" ::: "memory"); __builtin_amdgcn_sched_barrier(0);
        };
        auto do_SM_PV = [&](int st) {
            const char* Vs = lds + 49152 + st * 16384;
#pragma unroll
            for (int m = 0; m < 2; ++m) {
                float mx = s[m][0][0];
#pragma unroll
                for (int n = 0; n < 4; ++n)
#pragma unroll
                    for (int q = 0; q < 4; ++q) mx = fmaxf(mx, s[m][n][q]);
                if (__any(first || mx > 64.0f)) {
                    mx = fmaxf(mx, __shfl_xor(mx, 16)); mx = fmaxf(mx, __shfl_xor(mx, 32));
                    const float delta = first ? mx : fmaxf(mx, 0.f), alpha = first ? 1.0f : __builtin_amdgcn_exp2f(-delta);
                    lacc[m] *= alpha;
#pragma unroll
                    for (int n = 0; n < 8; ++n) acco[m][n] *= alpha;
#pragma unroll
                    for (int n = 0; n < 4; ++n) s[m][n] -= delta;
                    mrun[m] += delta;
                }
#pragma unroll
                for (int n = 0; n < 4; ++n) {
                    float pv[4];
#pragma unroll
                    for (int q = 0; q < 4; ++q) pv[q] = __builtin_amdgcn_exp2f(s[m][n][q]);
                    *(uint2*)(Ps + m * 2048 + (lane & 15) * 128 + ((((n * 2) | (lane >> 5)) ^ (((lane & 15) >> 1) & 7)) << 4) + ((lane >> 4) & 1) * 8) = make_uint2(pack2(pv[0], pv[1]), pack2(pv[2], pv[3]));
                }
            }
            first = false;
            __builtin_amdgcn_wave_barrier();
            {
                bf16x8 pf[2][2], vf[4];
#pragma unroll
                for (int ks = 0; ks < 2; ++ks) { pf[ks][0] = ldfrag2(Ps, fbv, 128, 0, ks); pf[ks][1] = ldfrag2(Ps, fbv, 128, 16, ks); }
                {
                    const bf16x8 ones = (bf16x8){16256, 16256, 16256, 16256, 16256, 16256, 16256, 16256};
#pragma unroll
                    for (int ks = 0; ks < 2; ++ks) { lacc[0] = mfma16(ones, pf[ks][0], lacc[0]); lacc[1] = mfma16(ones, pf[ks][1], lacc[1]); }
                }
#pragma unroll
                for (int i = 0; i < 3; ++i) vf[i] = ldfrag2(Vs, fbv, 128, (i & 7) * 16, i >> 3);
#pragma unroll
                for (int i = 0; i < 16; ++i) {
                    if (i + 3 < 16) vf[(i + 3) & 3] = ldfrag2(Vs, fbv, 128, ((i + 3) & 7) * 16, (i + 3) >> 3);
                    __builtin_amdgcn_sched_barrier(0);
                    acco[0][i & 7] = mfma16(vf[i & 3], pf[i >> 3][0], acco[0][i & 7]); acco[1][i & 7] = mfma16(vf[i & 3], pf[i >> 3][1], acco[1][i & 7]);
                }
            }
        };
        __syncthreads();
        dma(0, 0); dma(1, 1);
        asm volatile("s_waitcnt vmcnt(0)" ::: "memory");
        __syncthreads();
        const int nkt = SB / 64;
        const bool grpA = w < 4;
        int st = 0, stp = 2;
        for (int kt = 0; kt < nkt; ++kt) {
            const bool more2 = (kt + 2) < nkt;
            if (grpA) do_S(st); else if (kt > 0) do_SM_PV(stp);
            asm volatile("s_waitcnt lgkmcnt(0)" ::: "memory");
            __builtin_amdgcn_s_barrier();
            asm volatile("" ::: "memory");
            if (more2) dma(kt + 2, stp);
            if (grpA) do_SM_PV(st); else do_S(st);
            if (more2) asm volatile("s_waitcnt vmcnt(5)" ::: "memory"); else asm volatile("s_waitcnt vmcnt(0)" ::: "memory");
            asm volatile("s_waitcnt lgkmcnt(0)" ::: "memory");
            __builtin_amdgcn_s_barrier();
            asm volatile("" ::: "memory");
            stp = st; st = (st == 2) ? 0 : st + 1;
        }
        if (!grpA) do_SM_PV(stp);
#pragma unroll
        for (int m = 0; m < 2; ++m) {
            const float il = 1.0f / lacc[m][0];
            bf16_t* op = OB + (size_t)(qrow0 + m * 16 + (lane & 15)) * D + h * 128 + 4 * (lane >> 4);
#pragma unroll
            for (int n = 0; n < 8; ++n) *(uint2*)(op + n * 16) = make_uint2(pack2(acco[m][n][0] * il, acco[m][n][1] * il), pack2(acco[m][n][2] * il, acco[m][n][3] * il));
        }
    }
}

constexpr int LDS_BYTES = 16 + 155648 + 512;
#ifndef ONLY_PHASE
#define ONLY_PHASE -1
#endif
#define RUN_PHASE(i, call) do { if ((ONLY_PHASE < 0 || ONLY_PHASE == (i)) && p.phase_lo <= (i) && (i) < p.phase_hi) { call; } if (p.phase_lo <= (i) && (i) + 1 < p.phase_hi) xcd_barrier(bar); } while (0)

__global__ void __launch_bounds__(512, 2) hybrid_forward(Params p) {
    extern __shared__ __attribute__((aligned(16))) char smem[];
    if (threadIdx.x == 0) *(uint4*)smem = make_uint4(0u, 0u, gridDim.x, 0u);
    __syncthreads();
    char* lds = smem + 16;
    XcdBarrier bar; bar.bar = (unsigned*)(p.ws + OFF_BAR); bar.x = 0; bar.st = (volatile LAS unsigned*)smem;
    if (p.phase_hi - p.phase_lo > 1) bar = xcd_barrier_post((unsigned*)(p.ws + OFF_BAR), (volatile LAS unsigned*)smem);
    RUN_PHASE(0, { phase_prologue0(p, lds); phase_prologue1(p, lds); });
    RUN_PHASE(1, phase_prenorm(p, 0));
    const bool split = (gridDim.x == 256);
#define RUN_SPLIT(i, nc, q, base, hi, call) do { if (split && p.phase_lo <= (i) && (i) < p.phase_hi) set_vG(nc); \
        RUN_PHASE(i, { if (!split || (int)blockIdx.x < (nc)) { call; } else convert_static(p, base, (int)blockIdx.x - (nc), 256 - (nc), q, hi, lds); }); \
        if (split && p.phase_lo <= (i) && (i) < p.phase_hi) set_vG((int)gridDim.x); } while (0)
    RUN_SPLIT(3, CV3_NC, CV3_Q, CV_B3, CV_TILES_SET, phase_gemm_recin8(p, lds));
    RUN_PHASE(4, phase_rec_local(p, lds));
    RUN_PHASE(5, phase_gla_scan(p));
    RUN_PHASE(6, phase_rec_out(p, lds));
    RUN_SPLIT(7, CV7_NC, CV7_Q, CV_B7, CV_TILES_SET, phase_gemm_glu8(p, lds));
    RUN_SPLIT(8, CV8_NC, CV8_Q, CV_B8, CV_TILES_SET, phase_gemm_recout8(p, lds));
    RUN_PHASE(9, { phase_postmix(p, 0, false, lds); convert_static(p, split ? CV_B9 : 0, (int)blockIdx.x, (int)gridDim.x, 1 << 20, CV_TILES_SET, lds); });
    RUN_PHASE(10, phase_moe1_8(p, 0, lds));
    RUN_PHASE(11, phase_moe2_8(p, 0, lds));
    RUN_PHASE(12, phase_combine(p, 0, false, lds));
    RUN_SPLIT(13, CV13_NC, CV13_Q, CV_B13, 2 * CV_TILES_SET, phase_gemm_down8(p, lds));
    RUN_PHASE(14, phase_mla_norm(p));
    RUN_SPLIT(15, CV15_NC, CV15_Q, CV_B15, 2 * CV_TILES_SET, { phase_gemm_kv8(p, lds); __syncthreads(); phase_gemm_q8(p, lds); });
    RUN_PHASE(16, { if (FP8_QK) phase_attention8(p, lds); else phase_attention(p, lds); });
    RUN_PHASE(17, { phase_gemm_wo8(p, lds); convert_static(p, split ? CV_B17 : CV_TILES_SET, (int)blockIdx.x, (int)gridDim.x, 1 << 20, 2 * CV_TILES_SET, lds); });
    RUN_PHASE(18, phase_postmix(p, 1, true, lds));
    RUN_PHASE(19, phase_moe1_8(p, 1, lds));
    RUN_PHASE(20, phase_moe2_8(p, 1, lds));
    RUN_PHASE(21, phase_combine(p, 1, true, lds));
#if DBG_STOP >= 0
    if (p.phase_lo == 22) {
        float* o = p.out;
        for (size_t e = (size_t)blockIdx.x * 512 + threadIdx.x; e < (size_t)NB * SEQ * 1024; e += (size_t)gridDim.x * 512) {
            const int ri = (int)(e >> 10), c = (int)(e & 1023), r = (ri >> 12) * SB + CTXL + (ri & 4095);
            float v;
            if (DBG_SRC == 0) v = ((const float*)(p.ws + OFF_XS))[(size_t)r * 1024 + c];
            else if (DBG_SRC == 1) v = bf2f(((const bf16_t*)(p.ws + OFF_PB))[(size_t)r * PW + DBG_COL + c]);
            else if (DBG_SRC == 2) v = bf2f(((const bf16_t*)(p.ws + OFF_MIX))[(size_t)r * 1024 + (DBG_COL + c) % 1024]);
            else if (DBG_SRC == 3) v = bf2f(((const bf16_t*)(p.ws + OFF_YX))[(size_t)r * 1024 + c]);
            else if (DBG_SRC == 4) v = bf2f(((const bf16_t*)(p.ws + OFF_Y))[(size_t)r * 512 + (c & 511)]);
            else if (DBG_SRC == 5) v = bf2f(((const bf16_t*)(p.ws + OFF_HB))[(size_t)r * 1024 + c]);
            else if (DBG_SRC == 6) v = bf2f(((const bf16_t*)(p.ws + OFF_WRI))[(size_t)(ri % 2304) * 1024 + c]);
            else v = ((const float*)(p.ws + OFF_MF))[(size_t)(e % 61440)];
            if (!(fabsf(v) < 1.0e30f)) v = 1.0e4f;
            o[e] = v;
        }
    }
#endif
}

extern "C" void kernel_launch(void* const* d_in, const int* in_sizes, int n_in, void* d_out, int out_size, void* d_ws, size_t ws_size, hipStream_t stream) {
    static int grid = 0;
    if (!grid) {
        int dev = 0, cus = 0, per_cu = 0;
        hipGetDevice(&dev);
        hipDeviceGetAttribute(&cus, hipDeviceAttributeMultiprocessorCount, dev);
        hipFuncSetAttribute((const void*)hybrid_forward, hipFuncAttributeMaxDynamicSharedMemorySize, LDS_BYTES);
        hipOccupancyMaxActiveBlocksPerMultiprocessor(&per_cu, hybrid_forward, 512, LDS_BYTES);
        if (per_cu < 1) { fprintf(stderr, "occupancy query returned %d\n", per_cu); per_cu = 1; }
        grid = cus * 1;
    }
    if (ws_size < WS_TOTAL) { fprintf(stderr, "workspace too small: %zu < %zu\n", ws_size, (size_t)WS_TOTAL); return; }
    hipMemsetAsync(d_ws, 0, ZERO_BYTES, stream);
    Params p{};
    const float** f = (const float**)&p;
    for (int i = 0; i < 37; ++i) f[i] = (const float*)d_in[i];
    p.out = (float*)d_out; p.ws = (char*)d_ws;
#if DBG_STOP >= 0
    for (int i = 0; i <= DBG_STOP; ++i) { p.phase_lo = i; p.phase_hi = i + 1; hipLaunchKernelGGL(hybrid_forward, dim3(grid), dim3(512), LDS_BYTES, stream, p); }
    p.phase_lo = 22; p.phase_hi = 23; hipLaunchKernelGGL(hybrid_forward, dim3(grid), dim3(512), LDS_BYTES, stream, p);
#elif MK_MULTI
    for (int i = 0; i < NPHASE; ++i) { p.phase_lo = i; p.phase_hi = i + 1; hipLaunchKernelGGL(hybrid_forward, dim3(grid), dim3(512), LDS_BYTES, stream, p); }
#else
    p.phase_lo = 0; p.phase_hi = NPHASE;
    hipLaunchKernelGGL(hybrid_forward, dim3(grid), dim3(512), LDS_BYTES, stream, p);
#endif
}
```
